# Optimizing an MI355X kernel written in HIP

```python
import jax, jax.numpy as jnp
from jax import lax
import numpy as np

D_MODEL = 1024
BATCH = 8
SEQ = 4096
DEPTH = 4

GRID_W = 64
CTX_LEN = 256
NORM_EPS = 1e-6
N_MOD = 6
D_RNN = 1024
LRU_HEADS = 16
LRU_BW = D_RNN // LRU_HEADS
LRU_C = 8.0
CONV_W = 4
CONV_LEFT = 2
RET_HEADS = 8
RET_DK = 64
RET_DV = 128
RET_CHUNK = 128
ATT_HEADS = 16
ATT_KV_HEADS = 4
ATT_HD = 64
ATT_WIN = 128
ATT_BLOCK = 128
ROPE_BASE = 10000.0
N_GROUPS = 4
EXPERTS_PER_GROUP = 8
N_EXPERTS = N_GROUPS * EXPERTS_PER_GROUP
TOP_K = 2
D_EXPERT = 512
MOE_BLOCK = 128
N_BRANCHES = 3
IN_SPLITS = (D_RNN, D_RNN, RET_HEADS * RET_DK, RET_HEADS * RET_DK, RET_HEADS * RET_DV,
             RET_HEADS * RET_DV, ATT_HEADS * ATT_HD, ATT_KV_HEADS * ATT_HD, ATT_KV_HEADS * ATT_HD,
             N_BRANCHES * D_MODEL)
D_IN = sum(IN_SPLITS)
CTX_STATE_PARTS = (0, 3, 4, 7, 8)

kernel_name = 'hybrid_lru_retention_swa_hmoe_dit'


def split_cols(p):
    idx = [int(v) for v in np.cumsum(IN_SPLITS)[:-1]]
    return jnp.split(p, idx, axis=-1)


def rmsnorm(x, g):
    xf = x.astype(jnp.float32)
    y = xf * lax.rsqrt(jnp.mean(xf * xf, axis=-1, keepdims=True) + NORM_EPS)
    return (y * g.astype(jnp.float32)).astype(x.dtype)


def modulate(h, shift, scale):
    return h * (1 + scale) + shift


def rope_angles(pos, dim):
    inv = ROPE_BASE ** (-(jnp.arange(0, dim, 2, dtype=jnp.float32) / dim))
    return pos[:, None] * inv[None, :]


def apply_rope(x, ang):
    half = x.shape[-1] // 2
    shape = (1, ang.shape[0]) + (1,) * (x.ndim - 3) + (half,)
    cos = jnp.cos(ang).reshape(shape)
    sin = jnp.sin(ang).reshape(shape)
    xf = x.astype(jnp.float32)
    x1, x2 = xf[..., :half], xf[..., half:]
    return jnp.concatenate([x1 * cos - x2 * sin, x2 * cos + x1 * sin], axis=-1).astype(x.dtype)


def axial_rope(x, ang_row, ang_col):
    h = ATT_HD // 2
    return jnp.concatenate([apply_rope(x[..., :h], ang_row), apply_rope(x[..., h:], ang_col)], axis=-1)


def dwconv(u, w, b):
    y = lax.conv_general_dilated(u, w[:, None, :].astype(u.dtype), window_strides=(1,),
                                 padding=[(CONV_LEFT, CONV_W - 1 - CONV_LEFT)],
                                 dimension_numbers=('NWC', 'WIO', 'NWC'),
                                 feature_group_count=u.shape[-1])
    return y + b.astype(u.dtype)


def _linear_combine(e1, e2):
    a1, b1 = e1
    a2, b2 = e2
    return a1 * a2, a2 * b1 + b2


def lru_scan(u, wa, ba, wx, bx, lam, h0, reverse):
    B, L, _ = u.shape
    ub = u.reshape(B, L, LRU_HEADS, LRU_BW)
    r = jax.nn.sigmoid(jnp.einsum('blhi,hij->blhj', ub, wa).reshape(B, L, D_RNN) + ba)
    i = jax.nn.sigmoid(jnp.einsum('blhi,hij->blhj', ub, wx).reshape(B, L, D_RNN) + bx)
    log_a = -LRU_C * r * jax.nn.softplus(-lam)
    a = jnp.exp(log_a)
    b = jnp.sqrt(-jnp.expm1(2.0 * log_a)) * (i * u)
    a_cum, b_cum = lax.associative_scan(_linear_combine, (a, b), reverse=reverse, axis=1)
    return a_cum * h0[:, None, :] + b_cum


def lru_mixer(ax, ay, ax_c, ay_c, conv_w, conv_b, wa, ba, wx, bx, lam):
    f32 = jnp.float32
    wa, ba, wx, bx, lam = (t.astype(f32) for t in (wa, ba, wx, bx, lam))
    u = dwconv(ax, conv_w, conv_b).astype(f32)
    u_c = dwconv(ax_c, conv_w, conv_b).astype(f32)
    zero = jnp.zeros((ax.shape[0], D_RNN), f32)
    hc_f = lru_scan(u_c, wa[0], ba[0], wx[0], bx[0], lam[0], zero, False)
    hc_b = lru_scan(u_c, wa[1], ba[1], wx[1], bx[1], lam[1], zero, True)
    h_f = lru_scan(u, wa[0], ba[0], wx[0], bx[0], lam[0], hc_f[:, -1], False)
    h_b = lru_scan(u, wa[1], ba[1], wx[1], bx[1], lam[1], hc_b[:, 0], True)
    y = ((h_f + h_b) * jax.nn.gelu(ay.astype(f32))).astype(ax.dtype)
    if ay_c is None:
        return y, None
    y_c = ((hc_f + hc_b) * jax.nn.gelu(ay_c.astype(f32))).astype(ax.dtype)
    return y, y_c


def retention_chunked(q, k, v, log_g, s0):
    B, H, L, DK = k.shape
    DV = v.shape[-1]
    C = RET_CHUNK
    N = L // C
    pos = jnp.arange(C, dtype=jnp.float32)
    kc = k.reshape(B, H, N, C, DK)
    vc = v.reshape(B, H, N, C, DV)
    k_dec = jnp.exp(log_g[:, None] * (C - 1 - pos))
    chunk_kv = jnp.einsum('bhncd,bhnce->nbhde', kc * k_dec[None, :, None, :, None], vc)
    chunk_decay = jnp.exp(log_g * C)[None, :, None, None]

    def step(s, kv):
        return chunk_decay * s + kv, s

    s_final, s_before = lax.scan(step, s0, chunk_kv)
    if q is None:
        return None, s_final
    qc = q.reshape(B, H, N, C, DK)
    rel = pos[:, None] - pos[None, :]
    dmask = jnp.where(rel >= 0, jnp.exp(log_g[:, None, None] * jnp.maximum(rel, 0.0)), 0.0)
    att = jnp.einsum('bhnid,bhnjd->bhnij', qc, kc) * dmask[None, :, None]
    y = jnp.einsum('bhnij,bhnje->bhnie', att, vc)
    q_dec = jnp.exp(log_g[:, None] * (pos + 1.0))
    y = y + jnp.einsum('bhnid,nbhde->bhnie', qc * q_dec[None, :, None, :, None], s_before)
    return y.reshape(B, H, L, DV), s_final


def retention_out(y, g):
    mu = jnp.mean(y, axis=-1, keepdims=True)
    var = jnp.mean(jnp.square(y - mu), axis=-1, keepdims=True)
    yn = (y - mu) * lax.rsqrt(var + NORM_EPS)
    B, H, L, DV = y.shape
    yn = yn.transpose(0, 2, 1, 3).reshape(B, L, H * DV)
    return (jax.nn.silu(g.astype(jnp.float32)) * yn).astype(g.dtype)


def retention_mixer(bq, bk, bv, bg, bq_c, bk_c, bv_c, bg_c, ret_lam, ang_ret):
    f32 = jnp.float32
    B, L, _ = bk.shape
    LC = bk_c.shape[1]
    log_g = -jax.nn.softplus(-ret_lam.astype(f32))
    k_scale = RET_DK ** -0.5

    def to_heads(t, n, d):
        return t.astype(f32).reshape(B, n, RET_HEADS, d).transpose(0, 2, 1, 3)

    def rev(t):
        return None if t is None else jnp.flip(t, axis=2)

    q = to_heads(apply_rope(bq.reshape(B, L, RET_HEADS, RET_DK), ang_ret), L, RET_DK)
    k = to_heads(apply_rope(bk.reshape(B, L, RET_HEADS, RET_DK), ang_ret), L, RET_DK) * k_scale
    v = to_heads(bv, L, RET_DV)
    q_c = None if bq_c is None else to_heads(bq_c, LC, RET_DK)
    k_c = to_heads(bk_c, LC, RET_DK) * k_scale
    v_c = to_heads(bv_c, LC, RET_DV)
    zero = jnp.zeros((B, RET_HEADS, RET_DK, RET_DV), f32)
    yc_f, s_f = retention_chunked(q_c, k_c, v_c, log_g[0], zero)
    yc_b, s_b = retention_chunked(rev(q_c), rev(k_c), rev(v_c), log_g[1], zero)
    y_f, _ = retention_chunked(q, k, v, log_g[0], s_f)
    y_b, _ = retention_chunked(rev(q), rev(k), rev(v), log_g[1], s_b)
    y = retention_out(y_f + rev(y_b), bg)
    if q_c is None:
        return y, None
    return y, retention_out(yc_f + rev(yc_b), bg_c)


def attend_with_sink(q, ks, vs, masks, sink):
    scale = ATT_HD ** -0.5
    scores = []
    for k, m in zip(ks, masks):
        s = jnp.einsum('bqgrd,bkgd->bgrqk', q, k).astype(jnp.float32) * scale
        scores.append(s if m is None else jnp.where(m, s, -jnp.inf))
    sink_col = jnp.broadcast_to(sink[None, :, :, None, None], scores[0].shape[:-1] + (1,))
    p = jax.nn.softmax(jnp.concatenate(scores + [sink_col], axis=-1), axis=-1)
    out = jnp.zeros(q.shape, jnp.float32)
    off = 0
    for k, v in zip(ks, vs):
        n = k.shape[1]
        out = out + jnp.einsum('bgrqk,bkgd->bqgrd', p[..., off:off + n].astype(v.dtype), v).astype(jnp.float32)
        off += n
    return out.astype(q.dtype)


def window_attention(q, k, v, k_c, v_c, sink):
    B, S = q.shape[:2]
    n_blocks = S // ATT_BLOCK
    span = ATT_BLOCK + 2 * ATT_WIN
    pad = ((0, 0), (ATT_WIN, ATT_WIN), (0, 0), (0, 0))
    k_p = jnp.pad(k, pad)
    v_p = jnp.pad(v, pad)
    offs_q = jnp.arange(ATT_BLOCK)
    offs_k = jnp.arange(span) - ATT_WIN

    def block(bi):
        start = bi * ATT_BLOCK
        q_b = lax.dynamic_slice_in_dim(q, start, ATT_BLOCK, axis=1)
        k_b = lax.dynamic_slice_in_dim(k_p, start, span, axis=1)
        v_b = lax.dynamic_slice_in_dim(v_p, start, span, axis=1)
        q_pos = start + offs_q
        k_pos = start + offs_k
        mask = ((jnp.abs(q_pos[:, None] - k_pos[None, :]) <= ATT_WIN)
                & (k_pos >= 0)[None, :] & (k_pos < S)[None, :])
        return attend_with_sink(q_b, (k_b, k_c), (v_b, v_c), (mask, None), sink)

    out = lax.map(block, jnp.arange(n_blocks))
    return out.transpose(1, 0, 2, 3, 4, 5).reshape(B, S, ATT_HEADS * ATT_HD)


def attention_mixer(cq, ck, cv, cq_c, ck_c, cv_c, sink, ang_row, ang_col):
    B, L, _ = cq.shape
    LC = ck_c.shape[1]
    G, R, HD = ATT_KV_HEADS, ATT_HEADS // ATT_KV_HEADS, ATT_HD
    sink = sink.astype(jnp.float32).reshape(G, R)
    q = axial_rope(cq.reshape(B, L, G, R, HD), ang_row, ang_col)
    k = axial_rope(ck.reshape(B, L, G, HD), ang_row, ang_col)
    v = cv.reshape(B, L, G, HD)
    k_c = ck_c.reshape(B, LC, G, HD)
    v_c = cv_c.reshape(B, LC, G, HD)
    y = window_attention(q, k, v, k_c, v_c, sink)
    if cq_c is None:
        return y, None
    y_c = attend_with_sink(cq_c.reshape(B, LC, G, R, HD), (k_c,), (v_c,), (None,), sink)
    return y, y_c.reshape(B, LC, ATT_HEADS * HD)


def merge(ya, yb, yc, gates, w_ba, w_bb, w_bc, w_o):
    g_a, g_b, g_c = jnp.split(jax.nn.sigmoid(gates), N_BRANCHES, axis=-1)
    return (g_a * (ya @ w_ba) + g_b * (yb @ w_bb) + g_c * (yc @ w_bc)) @ w_o


def mixer_sublayer(u, u_c, w_in, conv_w, conv_b, wa, ba, wx, bx, lam, ret_lam, sink,
                   w_ba, w_bb, w_bc, w_o, ang_ret, ang_row, ang_col, with_ctx_out):
    lat = split_cols(u @ w_in)
    if with_ctx_out:
        ctxp = split_cols(u_c @ w_in)
    else:
        w_parts = split_cols(w_in)
        ctxp = [u_c @ w_parts[i] if i in CTX_STATE_PARTS else None for i in range(len(IN_SPLITS))]
    ax, ay, bq, bk, bv, bg, cq, ck, cv, gates = lat
    ax_c, ay_c, bq_c, bk_c, bv_c, bg_c, cq_c, ck_c, cv_c, gates_c = ctxp
    ya, ya_c = lru_mixer(ax, ay, ax_c, ay_c, conv_w, conv_b, wa, ba, wx, bx, lam)
    yb, yb_c = retention_mixer(bq, bk, bv, bg, bq_c, bk_c, bv_c, bg_c, ret_lam, ang_ret)
    yc, yc_c = attention_mixer(cq, ck, cv, cq_c, ck_c, cv_c, sink, ang_row, ang_col)
    out = merge(ya, yb, yc, gates, w_ba, w_bb, w_bc, w_o)
    if not with_ctx_out:
        return out, None
    return out, merge(ya_c, yb_c, yc_c, gates_c, w_ba, w_bb, w_bc, w_o)


def hier_moe(t, w_gr, b_gr, w_er, b_er, w_gate, w_up, w_down):
    N, D = t.shape
    f32 = jnp.float32
    tf = t.astype(f32)
    g_logit = tf @ w_gr.astype(f32) + b_gr.astype(f32)
    g_idx = jnp.argmax(g_logit, axis=-1)
    g_w = jnp.take_along_axis(jax.nn.softmax(g_logit, axis=-1), g_idx[:, None], axis=-1)
    e_logit = (tf @ w_er.astype(f32) + b_er.astype(f32)).reshape(N, N_GROUPS, EXPERTS_PER_GROUP)
    e_logit = jnp.take_along_axis(e_logit, g_idx[:, None, None], axis=1)[:, 0]
    top_p, top_i = lax.top_k(jax.nn.softmax(e_logit, axis=-1), TOP_K)
    top_w = top_p / jnp.sum(top_p, axis=-1, keepdims=True) * g_w
    A = N * TOP_K
    eid = (g_idx[:, None] * EXPERTS_PER_GROUP + top_i).reshape(-1).astype(jnp.int32)
    tok = jnp.repeat(jnp.arange(N, dtype=jnp.int32), TOP_K)
    order = jnp.argsort(eid)
    s_e, s_t, s_w = eid[order], tok[order], top_w.reshape(-1)[order]
    counts = jax.ops.segment_sum(jnp.ones_like(eid), eid, num_segments=N_EXPERTS)
    padded = (counts + MOE_BLOCK - 1) // MOE_BLOCK * MOE_BLOCK
    p_end = jnp.cumsum(padded)
    p_start = p_end - padded
    u_start = jnp.cumsum(counts) - counts
    dest = p_start[s_e] + jnp.arange(A, dtype=jnp.int32) - u_start[s_e]
    P = (A + N_EXPERTS * (MOE_BLOCK - 1) + MOE_BLOCK - 1) // MOE_BLOCK * MOE_BLOCK
    n_blk = P // MOE_BLOCK
    row_tok = jnp.full((P,), N, jnp.int32).at[dest].set(s_t)
    row_w = jnp.zeros((P,), f32).at[dest].set(s_w)
    block_e = jnp.minimum(jnp.searchsorted(p_end, jnp.arange(n_blk, dtype=jnp.int32) * MOE_BLOCK,
                                           side='right'), N_EXPERTS - 1)
    t_pad = jnp.concatenate([t, jnp.zeros((1, D), t.dtype)], axis=0)

    def run(bi):
        rows = lax.dynamic_slice_in_dim(row_tok, bi * MOE_BLOCK, MOE_BLOCK)
        xb = t_pad[rows]
        e = block_e[bi]
        return (jax.nn.silu(xb @ w_gate[e]) * (xb @ w_up[e])) @ w_down[e]

    y_rows = lax.map(run, jnp.arange(n_blk)).reshape(P, D)
    y = jax.ops.segment_sum(y_rows * row_w[:, None].astype(y_rows.dtype), row_tok, num_segments=N + 1)
    return y[:N]


def setup_inputs(seed: int = 0) -> dict:
    key = jax.random.key(seed)
    ks = jax.random.split(key, 30)
    f32 = jnp.float32

    def nrm(i, shape, scale):
        return jax.random.normal(ks[i], shape, f32) * scale

    D = D_MODEL
    a0 = jax.random.uniform(ks[15], (DEPTH, 2, D_RNN), f32, 0.9, 0.999)
    a_base = a0 ** (1.0 / LRU_C)
    gamma = 1.0 - 2.0 ** (-5.0 - jnp.arange(RET_HEADS, dtype=f32))
    return {
        'x': nrm(0, (BATCH, SEQ, D), 1.0),
        'c': nrm(1, (BATCH, D), 1.0),
        'ctx': nrm(2, (BATCH, CTX_LEN, D), 1.0),
        'c_ctx': nrm(3, (D,), 1.0),
        'w_mod': nrm(4, (DEPTH, D, N_MOD * D), 0.5 * D ** -0.5),
        'b_mod': nrm(5, (DEPTH, N_MOD * D), 0.02),
        'norm1_g': 1.0 + nrm(6, (DEPTH, D), 0.02),
        'norm2_g': 1.0 + nrm(7, (DEPTH, D), 0.02),
        'w_in': nrm(8, (DEPTH, D, D_IN), D ** -0.5),
        'lru_conv_w': nrm(9, (DEPTH, CONV_W, D_RNN), CONV_W ** -0.5),
        'lru_conv_b': nrm(10, (DEPTH, D_RNN), 0.02),
        'lru_wa': nrm(11, (DEPTH, 2, LRU_HEADS, LRU_BW, LRU_BW), LRU_BW ** -0.5),
        'lru_ba': nrm(12, (DEPTH, 2, D_RNN), 0.02),
        'lru_wx': nrm(13, (DEPTH, 2, LRU_HEADS, LRU_BW, LRU_BW), LRU_BW ** -0.5),
        'lru_bx': nrm(14, (DEPTH, 2, D_RNN), 0.02),
        'lru_lambda': jnp.log(a_base) - jnp.log1p(-a_base),
        'ret_lambda': jnp.log(gamma) - jnp.log1p(-gamma) + nrm(16, (DEPTH, 2, RET_HEADS), 0.05),
        'attn_sink': nrm(17, (DEPTH, ATT_HEADS), 0.5),
        'w_branch_a': nrm(18, (DEPTH, D_RNN, D), D_RNN ** -0.5),
        'w_branch_b': nrm(19, (DEPTH, RET_HEADS * RET_DV, D), (RET_HEADS * RET_DV) ** -0.5),
        'w_branch_c': nrm(20, (DEPTH, ATT_HEADS * ATT_HD, D), (ATT_HEADS * ATT_HD) ** -0.5),
        'w_out': nrm(21, (DEPTH, D, D), D ** -0.5),
        'router_group_w': nrm(22, (DEPTH, D, N_GROUPS), D ** -0.5),
        'router_group_b': nrm(23, (DEPTH, N_GROUPS), 0.01),
        'router_expert_w': nrm(24, (DEPTH, D, N_EXPERTS), D ** -0.5),
        'router_expert_b': nrm(25, (DEPTH, N_EXPERTS), 0.01),
        'expert_w_gate': nrm(26, (DEPTH, N_EXPERTS, D, D_EXPERT), D ** -0.5),
        'expert_w_up': nrm(27, (DEPTH, N_EXPERTS, D, D_EXPERT), D ** -0.5),
        'expert_w_down': nrm(28, (DEPTH, N_EXPERTS, D_EXPERT, D), D_EXPERT ** -0.5),
        'final_norm_g': 1.0 + nrm(29, (D,), 0.02),
    }


def reference(x, c, ctx, c_ctx, w_mod, b_mod, norm1_g, norm2_g, w_in, lru_conv_w, lru_conv_b,
              lru_wa, lru_ba, lru_wx, lru_bx, lru_lambda, ret_lambda, attn_sink, w_branch_a,
              w_branch_b, w_branch_c, w_out, router_group_w, router_group_b, router_expert_w,
              router_expert_b, expert_w_gate, expert_w_up, expert_w_down, final_norm_g):
    B, S, D = x.shape
    LC = ctx.shape[1]
    rows = S // GRID_W
    row = jnp.broadcast_to(jnp.arange(rows)[:, None], (rows, GRID_W)).reshape(-1).astype(jnp.float32)
    col = jnp.broadcast_to(jnp.arange(GRID_W)[None, :], (rows, GRID_W)).reshape(-1).astype(jnp.float32)
    ang_row = rope_angles(row, ATT_HD // 2)
    ang_col = rope_angles(col, ATT_HD // 2)
    ang_ret = rope_angles(jnp.arange(S, dtype=jnp.float32), RET_DK)
    s_c = jax.nn.silu(c)
    s_cc = jax.nn.silu(c_ctx)
    h, hc = x, ctx
    for l in range(DEPTH):
        last = l == DEPTH - 1
        mod = jnp.split((s_c @ w_mod[l] + b_mod[l])[:, None, :], N_MOD, axis=-1)
        mod_c = jnp.split(s_cc @ w_mod[l] + b_mod[l], N_MOD, axis=-1)
        u = modulate(rmsnorm(h, norm1_g[l]), mod[0], mod[1])
        u_c = modulate(rmsnorm(hc, norm1_g[l]), mod_c[0], mod_c[1])
        out, out_c = mixer_sublayer(u, u_c, w_in[l], lru_conv_w[l], lru_conv_b[l], lru_wa[l], lru_ba[l],
                                    lru_wx[l], lru_bx[l], lru_lambda[l], ret_lambda[l], attn_sink[l],
                                    w_branch_a[l], w_branch_b[l], w_branch_c[l], w_out[l],
                                    ang_ret, ang_row, ang_col, not last)
        h = h + mod[2] * out
        v = modulate(rmsnorm(h, norm2_g[l]), mod[3], mod[4]).reshape(B * S, D)
        moe_w = (router_group_w[l], router_group_b[l], router_expert_w[l], router_expert_b[l],
                 expert_w_gate[l], expert_w_up[l], expert_w_down[l])
        if last:
            h = h + mod[5] * hier_moe(v, *moe_w).reshape(B, S, D)
        else:
            hc = hc + mod_c[2] * out_c
            v_c = modulate(rmsnorm(hc, norm2_g[l]), mod_c[3], mod_c[4]).reshape(B * LC, D)
            y = hier_moe(jnp.concatenate([v, v_c], axis=0), *moe_w)
            h = h + mod[5] * y[:B * S].reshape(B, S, D)
            hc = hc + mod_c[5] * y[B * S:].reshape(B, LC, D)
    return rmsnorm(h, final_norm_g)
```

```cpp
#include <hip/hip_runtime.h>
#include <cstdio>
#include <cstdint>

#define LAS __attribute__((address_space(3)))
#define GAS __attribute__((address_space(1)))
typedef unsigned short bf16;
typedef short bf16x8 __attribute__((ext_vector_type(8)));
typedef float f32x4 __attribute__((ext_vector_type(4)));
typedef float f32x2 __attribute__((ext_vector_type(2)));
typedef unsigned u32x4 __attribute__((ext_vector_type(4)));
typedef unsigned u32x2 __attribute__((ext_vector_type(2)));

#ifndef MK_N_LAUNCHES
#define MK_N_LAUNCHES 1
#endif

constexpr int D = 1024, NB = 8, SEQ = 4096, LCX = 256, DEPTH = 4;
constexpr int NLAT = NB * SEQ, NCTX = NB * LCX, NTOK = NLAT + NCTX;
constexpr int DIN = 9728;
constexpr int LDP = 6720;
constexpr int C_AX = 0, C_AY = 1024, C_BQ = 2048, C_BK = 2560, C_BV = 3072, C_BG = 4096, C_CQ = 5120, C_CK = 6144, C_CV = 6400, C_GA = 6656;
constexpr int NMOD = 6, NMB = 9;
constexpr int NEXP = 32, DEXP = 512, RCOLS = 36;
constexpr int PMAX = 77824;
constexpr float EPS = 1e-6f;

constexpr size_t MiB = 1u << 20;
constexpr size_t WS_CTL = 0, CTL_BYTES = 1 * MiB;
constexpr size_t WS_MOD = 1 * MiB;
constexpr size_t WS_ROPE = 2 * MiB;
constexpr size_t WS_RW = 4 * MiB;
constexpr size_t WS_HC = 12 * MiB;
constexpr size_t WS_TOKINFO = 20 * MiB;
constexpr size_t WS_ROWTOK = 22 * MiB;
constexpr size_t WS_WT = 28 * MiB;
constexpr size_t WT_IN = 0, WT_BR = 19 * MiB, WT_WO = 25 * MiB, WT_GU = 27 * MiB, WT_DN = 91 * MiB, WT_BYTES = 123 * MiB;
constexpr size_t WS_X = 152 * MiB;
constexpr size_t WS_KV = 220 * MiB;
constexpr size_t WS_PROJ = 288 * MiB;
constexpr size_t WS_HROWS = WS_PROJ;
constexpr size_t WS_YROWS = WS_PROJ + 80 * MiB;
constexpr size_t WS_GT = 736 * MiB;
constexpr size_t WS_YB = 940 * MiB;
constexpr size_t WS_END = 1144 * MiB;
static_assert(WS_PROJ + (size_t)NTOK * LDP * 2 <= WS_GT && WS_GT + (size_t)3 * NTOK * 1024 * 2 <= WS_YB, "ws map");
constexpr int CW_BAR = 1024;
constexpr int CW_BAR_L = 20480, CW_BAR_C = 24576;
constexpr int CW_CNT = 8192;
constexpr size_t CTL_ZROW = 64 * 1024;

constexpr int LDS_BYTES = 163840;
constexpr int LDS_CTL = 155648;
constexpr int MISC_OFF = LDS_CTL + 320;

__device__ __forceinline__ unsigned f2bf(float f) { unsigned u = __builtin_bit_cast(unsigned, f); return (u + 0x7fffu + ((u >> 16) & 1u)) >> 16; }
typedef __bf16 bf16x2_t __attribute__((ext_vector_type(2)));
__device__ __forceinline__ unsigned pk2(float lo, float hi) { const f32x2 v = {lo, hi}; return __builtin_bit_cast(unsigned, __builtin_convertvector(v, bf16x2_t)); }
__device__ __forceinline__ float bf2f(unsigned b) { return __builtin_bit_cast(float, b << 16); }
__device__ __forceinline__ float bflo(unsigned w) { return __builtin_bit_cast(float, w << 16); }
__device__ __forceinline__ float bfhi(unsigned w) { return __builtin_bit_cast(float, w & 0xffff0000u); }
__device__ __forceinline__ float wave_sum(float v) {
#pragma unroll
    for (int o = 1; o < 64; o <<= 1) v += __shfl_xor(v, o);
    return v;
}
__device__ __forceinline__ float sigmoidf_(float x) { return 1.0f / (1.0f + __expf(-x)); }
__device__ __forceinline__ float siluf_(float x) { return x / (1.0f + __expf(-x)); }
__device__ __forceinline__ float gelu_tanh(float x) {
    const float u = 0.7978845608028654f * (x + 0.044715f * x * x * x);
    return x / (1.0f + __expf(-2.0f * u));
}
__device__ __forceinline__ float log1p_fast(float x) { const float u = 1.0f + x; const float d = u - 1.0f; return d == 0.f ? x : __logf(u) * (x / d); }
__device__ __forceinline__ float expm1_fast(float x) { const float u = __expf(x); const float um1 = u - 1.0f; if (um1 == 0.f) return x; const float lu = __logf(u); return um1 == -1.0f ? -1.0f : um1 * (x / lu); }
#define LDS_BARRIER() do { asm volatile("s_waitcnt lgkmcnt(0)" ::: "memory"); __builtin_amdgcn_s_barrier(); asm volatile("" ::: "memory"); } while (0)
#define LDS_WAIT() asm volatile("s_waitcnt lgkmcnt(0)" ::: "memory")
#define VM_WAIT() asm volatile("s_waitcnt vmcnt(0)" ::: "memory")

#define XB_TMO      128
#define XB_XCNT(j)  (256  + 64 * (j))
#define XB_XSUB(j)  (1280 + 64 * (j))
#define XB_XGEN(j)  (2304 + 64 * (j))
#define XB_TOP      3328
#define XB_TOPGEN   3392
#define XCD_BAR_WORDS 3456
#define XB_SPIN_CAP (1u << 22)
__device__ __forceinline__ unsigned xb_ld(unsigned* p)              { return __hip_atomic_load(p, __ATOMIC_RELAXED, __HIP_MEMORY_SCOPE_AGENT); }
__device__ __forceinline__ unsigned xb_add(unsigned* p, unsigned v) { return __hip_atomic_fetch_add(p, v, __ATOMIC_RELAXED, __HIP_MEMORY_SCOPE_AGENT); }
__device__ __forceinline__ unsigned xb_xcc_id() { return (unsigned)__builtin_amdgcn_s_getreg((3 << 11) | 20) & 0xFu; }
#define XB_SPIN(cond, bar) do { unsigned _sp = 0; while (cond) { __builtin_amdgcn_s_sleep(1); \
    if ((++_sp & 255u) == 0u) { if (xb_ld(&(bar)[XB_TMO])) break; if (_sp > XB_SPIN_CAP) { atomicAdd(&(bar)[XB_TMO], 1u); break; } } } } while (0)
struct XcdBarrier { unsigned* bar; unsigned x; volatile LAS unsigned* st; unsigned G; };
__device__ __forceinline__ XcdBarrier xcd_barrier_post(unsigned* bar, volatile LAS unsigned* st, unsigned G) {
    XcdBarrier b; b.bar = bar; b.x = xb_xcc_id(); b.st = st; b.G = G;
    if (threadIdx.x == 0) (void)xb_add(&bar[XB_XCNT(b.x)], 1u);
    return b;
}
__device__ __forceinline__ void xcd_barrier_complete(unsigned* bar, unsigned x, unsigned G, unsigned& nloc, unsigned& nx) {
    unsigned sum, cnt, mine, sp = 0u;
    for (;;) {
        sum = 0u; cnt = 0u; mine = 0u;
#pragma unroll
        for (unsigned j = 0; j < 16; ++j) { const unsigned c = xb_ld(&bar[XB_XCNT(j)]); sum += c; cnt += (c > 0u) ? 1u : 0u; mine = (j == x) ? c : mine; }
        if (sum == G) break;
        __builtin_amdgcn_s_sleep(1);
        if ((++sp & 255u) == 0u) { if (xb_ld(&bar[XB_TMO])) break; if (sp > XB_SPIN_CAP) { atomicAdd(&bar[XB_TMO], 1u); break; } }
    }
    nloc = mine > 0u ? mine : 1u; nx = cnt > 0u ? cnt : 1u;
}
__device__ __forceinline__ void xcd_barrier(const XcdBarrier& b) {
    asm volatile("s_waitcnt vmcnt(0)" ::: "memory");
    __syncthreads();
    if (threadIdx.x == 0) {
        unsigned* bar = b.bar;
        __builtin_amdgcn_s_waitcnt(0);
        unsigned nloc = b.st[0], nx = b.st[1];
        if (nloc == 0u) { xcd_barrier_complete(bar, b.x, b.G, nloc, nx); b.st[0] = nloc; b.st[1] = nx; }
        const unsigned old = xb_add(&bar[XB_XSUB(b.x)], 1u);
        const unsigned gen = old / nloc;
        if (old + 1u == (gen + 1u) * nloc) {
            __builtin_amdgcn_fence(__ATOMIC_RELEASE, "agent");
            asm volatile("s_waitcnt vmcnt(0)" ::: "memory");
            const unsigned og = xb_add(&bar[XB_TOP], 1u);
            const unsigned tg = og / nx;
            if (og + 1u == (tg + 1u) * nx) xb_add(&bar[XB_TOPGEN], 1u);
            else XB_SPIN(xb_ld(&bar[XB_TOPGEN]) == tg, bar);
            __builtin_amdgcn_fence(__ATOMIC_ACQUIRE, "agent");
            xb_add(&bar[XB_XGEN(b.x)], 1u);
            asm volatile("s_waitcnt vmcnt(0)" ::: "memory");
        } else {
            XB_SPIN(xb_ld(&bar[XB_XGEN(b.x)]) == gen, bar);
            __builtin_amdgcn_fence(__ATOMIC_ACQUIRE, "agent");
            asm volatile("s_waitcnt vmcnt(0)" ::: "memory");
        }
    }
    __syncthreads();
}

namespace pg8 {
constexpr int BM = 256, BK = 64, HALF = 128, HTB = HALF * BK * 2, STAGE_BYTES = 8 * HTB;
__device__ __forceinline__ int lds_byte(int r, int c) { const int st = (r >> 4) * 2 + (c >> 5), rr = r & 15, cc = c & 31, ob = rr * 64 + cc * 2; return st * 1024 + (ob ^ (((ob >> 9) & 1) << 5)); }
__device__ __forceinline__ void stage_rc(int b, int& R, int& C) { const int st = b / 1024, sb = b % 1024, swz = sb ^ (((sb >> 9) & 1) << 5); R = (st >> 1) * 16 + swz / 64; C = (st & 1) * 32 + (swz % 64) / 2; }
__device__ __forceinline__ int perm32(int rho) { const int n = rho >> 4, i = rho & 15; return 8 * (i >> 2) + 4 * n + (i & 3); }
__device__ __forceinline__ unsigned cvt_pk_bf16(float lo, float hi) { return pk2(lo, hi); }

template <class Epi, class Sched>
__device__ __forceinline__ void gemm_phase(LAS unsigned char* lds, const Sched& S, const Epi& E, const int tid) {
    typedef typename Sched::Unit Unit;
    const int wid = __builtin_amdgcn_readfirstlane(tid >> 6), lane = tid & 63, wr = wid >> 2, wc = wid & 3, fr = lane & 15, fq = lane >> 4;
    constexpr int nt = Sched::KT; constexpr int K = nt * BK;
    int R[2], C[2]; unsigned voffB[2];
#pragma unroll
    for (int i = 0; i < 2; ++i) { stage_rc(tid * 16 + i * 8192, R[i], C[i]); const int Rb = Epi::PERM ? ((R[i] & ~31) + perm32(R[i] & 31)) : R[i]; voffB[i] = (unsigned)(Rb * K + C[i]) * 2u; }
    constexpr size_t kstep = (size_t)(BK * 2);
    constexpr size_t hstepB = (size_t)HALF * K * 2;
    const unsigned ldsw = (unsigned)wid * 1024u;
    const int aoff = lds_byte(wr * 64 + fr, fq * 8), boff = lds_byte(wc * 32 + fr, fq * 8);
#define PG8_SA(b, h) (((b) * 2 + (h)) * HTB)
#define PG8_SB(b, h) ((4 + (b) * 2 + (h)) * HTB)
#define PG8_STAGEA(bufoff, gbase, vv, h) do { _Pragma("unroll") for (int _i = 0; _i < 2; ++_i) \
        __builtin_amdgcn_global_load_lds((const unsigned*)((const char*)(gbase) + (vv)[h][_i]), (LAS unsigned*)(lds + (bufoff) + ldsw + _i * 8192), 16, 0, 0); } while (0)
#define PG8_STAGEB(bufoff, gbase) do { _Pragma("unroll") for (int _i = 0; _i < 2; ++_i) \
        __builtin_amdgcn_global_load_lds((const unsigned*)((const char*)(gbase) + voffB[_i]), (LAS unsigned*)(lds + (bufoff) + ldsw + _i * 8192), 16, 0, 0); } while (0)
#define PG8_LDA(dst, b, h) do { _Pragma("unroll") for (int m = 0; m < 4; ++m) _Pragma("unroll") for (int k = 0; k < 2; ++k) dst[m][k] = *(const LAS bf16x8*)(lds + PG8_SA(b, h) + aoff + m * 2048 + k * 1024); } while (0)
#define PG8_LDB(dst, b, h) do { _Pragma("unroll") for (int n = 0; n < 2; ++n) _Pragma("unroll") for (int k = 0; k < 2; ++k) dst[n][k] = *(const LAS bf16x8*)(lds + PG8_SB(b, h) + boff + n * 2048 + k * 1024); } while (0)
#define PG8_MMA(ai, bj, At, Bt) do { __builtin_amdgcn_s_setprio(1); _Pragma("unroll") for (int m = 0; m < 4; ++m) _Pragma("unroll") for (int n = 0; n < 2; ++n) _Pragma("unroll") for (int k = 0; k < 2; ++k) \
        acc[ai][bj][m][n] = __builtin_amdgcn_mfma_f32_16x16x32_bf16(Bt[n][k], At[m][k], acc[ai][bj][m][n], 0, 0, 0); __builtin_amdgcn_s_setprio(0); } while (0)
#define PG8_WAIT_V(n) asm volatile("s_waitcnt vmcnt(" #n ")" ::: "memory")
#define PG8_WAIT_L(n) asm volatile("s_waitcnt lgkmcnt(" #n ")" ::: "memory")
#define PG8_BAR __builtin_amdgcn_s_barrier()
#define PG8_SCHED __builtin_amdgcn_sched_barrier(0)
    Unit cur, nxt; int ui = 0;
    if (!S.next(0, cur)) return;
    f32x4 acc[2][2][4][2];
#pragma unroll
    for (int a = 0; a < 2; ++a)
#pragma unroll
        for (int b = 0; b < 2; ++b)
#pragma unroll
            for (int m = 0; m < 4; ++m)
#pragma unroll
                for (int n = 0; n < 2; ++n) acc[a][b][m][n] = (f32x4){0.f, 0.f, 0.f, 0.f};
    bf16x8 At[4][2], B0[2][2], B1[2][2];
    unsigned vA[2][2], vAn[2][2];
    S.a_voff(cur, tid, vA);
#pragma unroll
    for (int h = 0; h < 2; ++h)
#pragma unroll
        for (int i = 0; i < 2; ++i) vAn[h][i] = vA[h][i];
    const char* cA = S.a_base(cur); const char* cB = S.b_base(cur);
    { const char* a0 = cA + S.a_koff(0); const char* a1p = cA + S.a_koff(1);
      PG8_STAGEB(PG8_SB(0, 0), cB); PG8_STAGEB(PG8_SB(0, 1), cB + hstepB); PG8_STAGEA(PG8_SA(0, 0), a0, vA, 0); PG8_STAGEA(PG8_SA(0, 1), a0, vA, 1);
      if (wr == 1) PG8_BAR;
      PG8_WAIT_V(2); PG8_BAR;
      PG8_STAGEB(PG8_SB(1, 0), cB + kstep); PG8_STAGEA(PG8_SA(1, 0), a1p, vA, 0); PG8_STAGEB(PG8_SB(1, 1), cB + hstepB + kstep);
      PG8_WAIT_V(6); PG8_BAR; }
    for (;;) {
        const bool has_next = S.next(ui + 1, nxt);
        const char* nA = cA; const char* nB = cB;
        if (has_next) { nA = S.a_base(nxt); nB = S.b_base(nxt); }
#pragma unroll 1
        for (int t = 0; t < nt; t += 2) {
            const bool last = (t == nt - 2);
            if constexpr (Epi::MIDK) { if (t == 16 || t == 32) E.mid(acc, cur, t, wr, wc, fr, fq); }
            if constexpr (Sched::GATHER) { if (t == nt - 4 && has_next) S.a_voff(nxt, tid, vAn); }
            const char* a1 = cA + S.a_koff(t + 1);
            const char* a2 = last ? nA + S.a_koff(0) : cA + S.a_koff(t + 2);
            const char* a3 = last ? nA + S.a_koff(1) : cA + S.a_koff(t + 3);
            const char* b2 = last ? nB : cB + (size_t)(t + 2) * kstep; const char* b3 = b2 + kstep;
            PG8_LDB(B0, 0, 0); PG8_LDB(B1, 0, 1); PG8_SCHED; PG8_LDA(At, 0, 0); PG8_STAGEA(PG8_SA(1, 1), a1, vA, 1);
            PG8_WAIT_V(8); PG8_WAIT_L(0); PG8_BAR; PG8_MMA(0, 0, At, B0); PG8_MMA(0, 1, At, B1); PG8_BAR; PG8_SCHED;
            PG8_LDA(At, 0, 1); PG8_STAGEB(PG8_SB(0, 0), b2); PG8_STAGEB(PG8_SB(0, 1), b2 + hstepB);
            if (last) { PG8_STAGEA(PG8_SA(0, 0), a2, vAn, 0); } else { PG8_STAGEA(PG8_SA(0, 0), a2, vA, 0); }
            PG8_WAIT_V(8); PG8_WAIT_L(0); PG8_BAR; PG8_MMA(1, 0, At, B0); PG8_MMA(1, 1, At, B1); PG8_BAR; PG8_SCHED;
            PG8_LDB(B0, 1, 0); PG8_LDB(B1, 1, 1); PG8_SCHED; PG8_LDA(At, 1, 0);
            if (last) { PG8_STAGEA(PG8_SA(0, 1), a2, vAn, 1); } else { PG8_STAGEA(PG8_SA(0, 1), a2, vA, 1); }
            PG8_WAIT_V(8); PG8_WAIT_L(0); PG8_BAR; PG8_MMA(0, 0, At, B0); PG8_MMA(0, 1, At, B1); PG8_BAR; PG8_SCHED;
            PG8_LDA(At, 1, 1); PG8_STAGEB(PG8_SB(1, 0), b3); PG8_STAGEB(PG8_SB(1, 1), b3 + hstepB);
            if (last) { PG8_STAGEA(PG8_SA(1, 0), a3, vAn, 0); } else { PG8_STAGEA(PG8_SA(1, 0), a3, vA, 0); }
            PG8_WAIT_V(8); PG8_WAIT_L(0); PG8_BAR; PG8_MMA(1, 0, At, B0); PG8_MMA(1, 1, At, B1); PG8_BAR; PG8_SCHED;
        }
        if (wr == 0) PG8_BAR;
        E(acc, cur, wr, wc, fr, fq);
        if (!has_next) break;
#pragma unroll
        for (int a = 0; a < 2; ++a)
#pragma unroll
            for (int b = 0; b < 2; ++b)
#pragma unroll
                for (int m = 0; m < 4; ++m)
#pragma unroll
                    for (int n = 0; n < 2; ++n) acc[a][b][m][n] = (f32x4){0.f, 0.f, 0.f, 0.f};
        cur = nxt; cA = nA; cB = nB; ++ui;
        if constexpr (Sched::GATHER) {
#pragma unroll
            for (int h = 0; h < 2; ++h)
#pragma unroll
                for (int i = 0; i < 2; ++i) vA[h][i] = vAn[h][i];
        }
        if (wr == 1) PG8_BAR;
    }
    PG8_WAIT_V(0);
    PG8_BAR;
#undef PG8_SA
#undef PG8_SB
#undef PG8_STAGEA
#undef PG8_STAGEB
#undef PG8_LDA
#undef PG8_LDB
#undef PG8_MMA
#undef PG8_WAIT_V
#undef PG8_WAIT_L
#undef PG8_BAR
#undef PG8_SCHED
}
}
namespace gm {
using pg8::cvt_pk_bf16;
__device__ __forceinline__ float fexp_(float x) { return __builtin_amdgcn_exp2f(1.4426950408889634f * x); }
__device__ __forceinline__ float fsig_(float x) { return __builtin_amdgcn_rcpf(1.0f + fexp_(-x)); }
__device__ __forceinline__ float fsilu_(float x) { return x * fsig_(x); }
struct Unit { int pm, pn; };
struct OrderBase {
    int nM, nN, nwg, G, c;
    __device__ __forceinline__ void init(int nM_, int nN_, int G_, int c_) { nM = nM_; nN = nN_; nwg = nM * nN; G = G_; c = c_; }
    __device__ __forceinline__ bool next(int i, Unit& u) const {
        const int L = i * G + c; if (L >= nwg) return false;
        int wgid = L; { const int q = nwg / 8, r = nwg % 8, xcd = wgid % 8, off = wgid / 8; wgid = (xcd < r ? xcd * (q + 1) : r * (q + 1) + (xcd - r) * q) + off; }
        const int nig = 8 * nN, gid = wgid / nig, fm = gid * 8, gsz = (nM - fm) < 8 ? (nM - fm) : 8;
        u.pm = fm + ((wgid % nig) % gsz); u.pn = (wgid % nig) / gsz; return true;
    }
};
struct OrderColAffine {
    int nM, nN, nwg, G, c;
    __device__ __forceinline__ void init(int nM_, int nN_, int G_, int c_) { nM = nM_; nN = nN_; nwg = nM * nN; G = G_; c = c_; }
    __device__ __forceinline__ bool next(int i, Unit& u) const {
        if (G != 256 || nN != 4) { const int L = i * G + c; if (L >= nwg) return false; u.pm = L / nN; u.pn = L % nN; return true; }
        const int x = c & 7, k = c >> 3, j = i * 32 + k; if (2 * j + (x >> 2) >= nM) return false;
        u.pm = 2 * j + (x >> 2); u.pn = x & 3; return true;
    }
};
struct OrderSub : OrderBase {
    int pm0; bool on;
    __device__ __forceinline__ void init(int nM_, int nN_, int Gs, int cs, int pm0_, bool on_) { OrderBase::init(nM_, nN_, Gs, cs); pm0 = pm0_; on = on_; }
    __device__ __forceinline__ bool next(int i, Unit& u) const { if (!on || !OrderBase::next(i, u)) return false; u.pm += pm0; return true; }
};
template <int KT_, int LDA, class Order = OrderBase> struct SchedPlain : Order {
    typedef gm::Unit Unit; static constexpr int KT = KT_; static constexpr bool GATHER = false;
    const char* A; const char* Bt;
    __device__ __forceinline__ const char* a_base(const Unit& u) const { return A + (size_t)u.pm * 256 * LDA * 2; }
    __device__ __forceinline__ void a_voff(const Unit&, int tid, unsigned (&v)[2][2]) const {
#pragma unroll
        for (int i = 0; i < 2; ++i) { int R, C; pg8::stage_rc(tid * 16 + i * 8192, R, C);
#pragma unroll
            for (int h = 0; h < 2; ++h) v[h][i] = (unsigned)((h * 128 + R) * LDA + C) * 2u; }
    }
    __device__ __forceinline__ size_t a_koff(int kt) const { return (size_t)kt * 128; }
    __device__ __forceinline__ const char* b_base(const Unit& u) const { return Bt + (size_t)u.pn * 256 * (KT * 64) * 2; }
};
struct SchedMerge : OrderBase {
    typedef gm::Unit Unit; static constexpr int KT = 48; static constexpr bool GATHER = false;
    const char* A; const char* Bt;
    __device__ __forceinline__ const char* a_base(const Unit& u) const { return A + (size_t)u.pm * 256 * LDP * 2; }
    __device__ __forceinline__ void a_voff(const Unit&, int tid, unsigned (&v)[2][2]) const {
#pragma unroll
        for (int i = 0; i < 2; ++i) { int R, C; pg8::stage_rc(tid * 16 + i * 8192, R, C);
#pragma unroll
            for (int h = 0; h < 2; ++h) v[h][i] = (unsigned)((h * 128 + R) * LDP + C) * 2u; }
    }
    __device__ __forceinline__ size_t a_koff(int kt) const { return (size_t)(kt < 16 ? (C_AY + 64 * kt) : (C_BG - 1024 + 64 * kt)) * 2; }
    __device__ __forceinline__ const char* b_base(const Unit& u) const { return Bt + (size_t)u.pn * 256 * 3072 * 2; }
};
struct MUnit { int e, tile, pn, slot0; };
template <int KT_, bool GATHER_> struct SchedMoe {
    typedef gm::MUnit Unit; static constexpr int KT = KT_; static constexpr bool GATHER = GATHER_;
    const volatile LAS int* tileoff; const volatile LAS int* cnt;
    int G, c, nunits;
    const char* wsbase; const int* rowtok; const char* A; const char* Bt;
    __device__ __forceinline__ bool next(int i, Unit& u) const {
        const int L = i * G + c; if (L >= nunits) return false;
        const int rt = L >> 2; u.pn = L & 3;
        int e = 0;
#pragma unroll 1
        for (int k = 1; k < 32; ++k) e = (rt >= tileoff[k]) ? k : e;
        u.e = e; u.tile = rt - tileoff[e]; u.slot0 = rt * 256; return true;
    }
    __device__ __forceinline__ const char* a_base(const Unit& u) const { if constexpr (GATHER) return wsbase; else return A + (size_t)u.slot0 * DEXP * 2; }
    __device__ __forceinline__ void a_voff(const Unit& u, int tid, unsigned (&v)[2][2]) const {
        if constexpr (GATHER) {
            asm volatile("" : "+v"(tid));
            const int n = cnt[u.e]; const int* rt = rowtok + (size_t)u.e * NTOK + u.tile * 256;
#pragma unroll
            for (int i = 0; i < 2; ++i) { int R, C; pg8::stage_rc(tid * 16 + i * 8192, R, C);
#pragma unroll
                for (int h = 0; h < 2; ++h) { const int r = h * 128 + R; const bool ok = (u.tile * 256 + r) < n; const int tok = ok ? rt[r] : 0;
                    v[h][i] = ok ? (unsigned)(WS_X + (size_t)tok * 2048 + C * 2) : (unsigned)(CTL_ZROW + C * 2); } }
        } else {
#pragma unroll
            for (int i = 0; i < 2; ++i) { int R, C; pg8::stage_rc(tid * 16 + i * 8192, R, C);
#pragma unroll
                for (int h = 0; h < 2; ++h) v[h][i] = (unsigned)((h * 128 + R) * DEXP + C) * 2u; }
        }
    }
    __device__ __forceinline__ size_t a_koff(int kt) const { return (size_t)kt * 128; }
    __device__ __forceinline__ const char* b_base(const Unit& u) const { return Bt + ((size_t)u.e * 1024 + u.pn * 256) * (KT * 64) * 2; }
};

struct EpiProj {
    static constexpr bool PERM = true, MIDK = false; bf16* O; unsigned char* GT;
    static __device__ __forceinline__ unsigned gq8_(float z) { return (unsigned)fmaxf(fsig_(z) * 255.0f + 0.5f, 1.0f); }
    __device__ __forceinline__ void operator()(const f32x4 (&acc)[2][2][4][2], const Unit& u, int wr, int wc, int fr, int fq) const {
        if (u.pn >= 26) {
            const int br = (u.pn - 26) >> 2, pq = (u.pn - 26) & 3; const int wave = wr * 4 + wc, lane = fq * 16 + fr;
            unsigned char* t = GT + (((size_t)(br * 136 + u.pm) * 4 + pq) << 16) + (size_t)(wave * 64 + lane) * 16;
#pragma unroll
            for (int ai = 0; ai < 2; ++ai)
#pragma unroll
                for (int m = 0; m < 4; ++m) { u32x4 w;
#pragma unroll
                    for (int bj = 0; bj < 2; ++bj) { const f32x4 v0 = acc[ai][bj][m][0], v1 = acc[ai][bj][m][1];
                        w[2 * bj] = gq8_(v0[0]) | (gq8_(v0[1]) << 8) | (gq8_(v0[2]) << 16) | (gq8_(v0[3]) << 24);
                        w[2 * bj + 1] = gq8_(v1[0]) | (gq8_(v1[1]) << 8) | (gq8_(v1[2]) << 16) | (gq8_(v1[3]) << 24); }
                    *(u32x4*)(t + (ai * 4 + m) * 8192) = w; }
            return;
        }
        bf16* base = O + (size_t)(u.pm * 256 + wr * 64 + fr) * LDP + u.pn * 256 + wc * 32 + 8 * fq;
#pragma unroll
        for (int ai = 0; ai < 2; ++ai)
#pragma unroll
            for (int m = 0; m < 4; ++m) { bf16* rowp = base + (size_t)(ai * 128 + m * 16) * LDP;
#pragma unroll
                for (int bj = 0; bj < 2; ++bj) { const f32x4 v0 = acc[ai][bj][m][0], v1 = acc[ai][bj][m][1];
                    u32x4 w; w.x = cvt_pk_bf16(v0[0], v0[1]); w.y = cvt_pk_bf16(v0[2], v0[3]); w.z = cvt_pk_bf16(v1[0], v1[1]); w.w = cvt_pk_bf16(v1[2], v1[3]);
                    *(u32x4*)(rowp + bj * 128) = w; } }
    }
};
struct EpiPlain {
    static constexpr bool PERM = true, MIDK = false; bf16* O;
    __device__ __forceinline__ void operator()(const f32x4 (&acc)[2][2][4][2], const Unit& u, int wr, int wc, int fr, int fq) const {
        bf16* base = O + (size_t)(u.pm * 256 + wr * 64 + fr) * 1024 + u.pn * 256 + wc * 32 + 8 * fq;
#pragma unroll
        for (int ai = 0; ai < 2; ++ai)
#pragma unroll
            for (int m = 0; m < 4; ++m) { bf16* rowp = base + (size_t)(ai * 128 + m * 16) * 1024;
#pragma unroll
                for (int bj = 0; bj < 2; ++bj) { const f32x4 v0 = acc[ai][bj][m][0], v1 = acc[ai][bj][m][1];
                    u32x4 w; w.x = cvt_pk_bf16(v0[0], v0[1]); w.y = cvt_pk_bf16(v0[2], v0[3]); w.z = cvt_pk_bf16(v1[0], v1[1]); w.w = cvt_pk_bf16(v1[2], v1[3]);
                    *(u32x4*)(rowp + bj * 128) = w; } }
    }
};
struct EpiMerge {
    static constexpr bool PERM = true, MIDK = true; const unsigned char* GT; bf16* O;
    __device__ __forceinline__ const unsigned char* tile(const Unit& u, int br, int wr, int wc, int fr, int fq) const {
        return GT + (((size_t)(br * 136 + u.pm) * 4 + u.pn) << 16) + (size_t)((wr * 4 + wc) * 64 + fq * 16 + fr) * 16; }
    static __device__ __forceinline__ float b8_(unsigned w, int k) { return (float)((w >> (8 * k)) & 0xffu); }
    __device__ __forceinline__ void mid(f32x4 (&acc)[2][2][4][2], const Unit& u, int t, int wr, int wc, int fr, int fq) const {
        const int br = (t == 16) ? 0 : 1; const unsigned char* ta = tile(u, br, wr, wc, fr, fq); const unsigned char* tb = tile(u, br + 1, wr, wc, fr, fq);
        u32x4 ga[8], gb[8];
#pragma unroll
        for (int j = 0; j < 8; ++j) { ga[j] = *(const u32x4*)(ta + 8192 * j); gb[j] = *(const u32x4*)(tb + 8192 * j); }
#pragma unroll
        for (int ai = 0; ai < 2; ++ai)
#pragma unroll
            for (int m = 0; m < 4; ++m)
#pragma unroll
                for (int bj = 0; bj < 2; ++bj)
#pragma unroll
                    for (int hw = 0; hw < 2; ++hw) { const unsigned wa = ga[ai * 4 + m][2 * bj + hw], wb = gb[ai * 4 + m][2 * bj + hw];
#pragma unroll
                        for (int k = 0; k < 4; ++k) acc[ai][bj][m][hw][k] *= b8_(wa, k) * __builtin_amdgcn_rcpf(b8_(wb, k)); }
    }
    __device__ __forceinline__ void operator()(const f32x4 (&acc)[2][2][4][2], const Unit& u, int wr, int wc, int fr, int fq) const {
        const unsigned char* tc = tile(u, 2, wr, wc, fr, fq);
        u32x4 gc[8];
#pragma unroll
        for (int j = 0; j < 8; ++j) gc[j] = *(const u32x4*)(tc + 8192 * j);
        const size_t row0 = (size_t)(u.pm * 256 + wr * 64 + fr); const int col0 = u.pn * 256 + wc * 32 + 8 * fq;
        constexpr float S = 1.0f / 255.0f;
#pragma unroll
        for (int ai = 0; ai < 2; ++ai)
#pragma unroll
            for (int m = 0; m < 4; ++m) { const size_t row = row0 + ai * 128 + m * 16;
#pragma unroll
                for (int bj = 0; bj < 2; ++bj) { const unsigned g0 = gc[ai * 4 + m][2 * bj], g1 = gc[ai * 4 + m][2 * bj + 1];
                    const f32x4 v0 = acc[ai][bj][m][0] * S, v1 = acc[ai][bj][m][1] * S; u32x4 w;
                    w.x = cvt_pk_bf16(v0[0] * b8_(g0, 0), v0[1] * b8_(g0, 1)); w.y = cvt_pk_bf16(v0[2] * b8_(g0, 2), v0[3] * b8_(g0, 3));
                    w.z = cvt_pk_bf16(v1[0] * b8_(g1, 0), v1[1] * b8_(g1, 1)); w.w = cvt_pk_bf16(v1[2] * b8_(g1, 2), v1[3] * b8_(g1, 3));
                    *(u32x4*)(O + row * 1024 + col0 + bj * 128) = w; } }
    }
};
struct EpiWo {
    static constexpr bool PERM = false, MIDK = false; float* h; float* hc; const float* mod; bool wen; const float* hsrc; const float* hcsrc;
    __device__ __forceinline__ void operator()(const f32x4 (&acc)[2][2][4][2], const Unit& u, int wr, int wc, int fr, int fq) const {
        const bool lat = u.pm < 128; const int mb = lat ? (u.pm >> 4) : 8;
        float* hb = lat ? h + (size_t)u.pm * 256 * 1024 : hc + (size_t)(u.pm - 128) * 256 * 1024;
        const float* sb = lat ? hsrc + (size_t)u.pm * 256 * 1024 : hcsrc + (size_t)(u.pm - 128) * 256 * 1024;
        const int col0 = u.pn * 256 + wc * 32 + 4 * fq; const float* mp = mod + (size_t)mb * 6144 + 2 * 1024 + col0;
        f32x4 mv[2][2];
#pragma unroll
        for (int bj = 0; bj < 2; ++bj)
#pragma unroll
            for (int n = 0; n < 2; ++n) mv[bj][n] = *(const f32x4*)(mp + bj * 128 + n * 16);
#pragma unroll
        for (int ai = 0; ai < 2; ++ai)
#pragma unroll
            for (int m = 0; m < 4; ++m) { const size_t ro = (size_t)(ai * 128 + wr * 64 + m * 16 + fr) * 1024 + col0; float* rowp = hb + ro; const float* srcp = sb + ro;
#pragma unroll
                for (int bj = 0; bj < 2; ++bj)
#pragma unroll
                    for (int n = 0; n < 2; ++n) { f32x4 hv = *(const f32x4*)(srcp + bj * 128 + n * 16); hv = hv + mv[bj][n] * acc[ai][bj][m][n]; if (wen) *(f32x4*)(rowp + bj * 128 + n * 16) = hv; } }
    }
};
struct EpiGU {
    static constexpr bool PERM = true, MIDK = false; bf16* H;
    __device__ __forceinline__ void operator()(const f32x4 (&acc)[2][2][4][2], const MUnit& u, int wr, int wc, int fr, int fq) const {
        bf16* base = H + (size_t)(u.slot0 + wr * 64 + fr) * DEXP + u.pn * 128 + wc * 32 + 8 * fq;
#pragma unroll
        for (int ai = 0; ai < 2; ++ai)
#pragma unroll
            for (int m = 0; m < 4; ++m) { const f32x4 g0 = acc[ai][0][m][0], g1 = acc[ai][0][m][1], u0 = acc[ai][1][m][0], u1 = acc[ai][1][m][1]; u32x4 w;
                w.x = cvt_pk_bf16(fsilu_(g0[0]) * u0[0], fsilu_(g0[1]) * u0[1]); w.y = cvt_pk_bf16(fsilu_(g0[2]) * u0[2], fsilu_(g0[3]) * u0[3]);
                w.z = cvt_pk_bf16(fsilu_(g1[0]) * u1[0], fsilu_(g1[1]) * u1[1]); w.w = cvt_pk_bf16(fsilu_(g1[2]) * u1[2], fsilu_(g1[3]) * u1[3]);
                *(u32x4*)(base + (size_t)(ai * 128 + m * 16) * DEXP) = w; }
    }
};
struct EpiDN {
    static constexpr bool PERM = true, MIDK = false; bf16* Y;
    __device__ __forceinline__ void operator()(const f32x4 (&acc)[2][2][4][2], const MUnit& u, int wr, int wc, int fr, int fq) const {
        bf16* base = Y + (size_t)(u.slot0 + wr * 64 + fr) * 1024 + u.pn * 256 + wc * 32 + 8 * fq;
#pragma unroll
        for (int ai = 0; ai < 2; ++ai)
#pragma unroll
            for (int m = 0; m < 4; ++m) { bf16* rowp = base + (size_t)(ai * 128 + m * 16) * 1024;
#pragma unroll
                for (int bj = 0; bj < 2; ++bj) { const f32x4 v0 = acc[ai][bj][m][0], v1 = acc[ai][bj][m][1];
                    u32x4 w; w.x = cvt_pk_bf16(v0[0], v0[1]); w.y = cvt_pk_bf16(v0[2], v0[3]); w.z = cvt_pk_bf16(v1[0], v1[1]); w.w = cvt_pk_bf16(v1[2], v1[3]);
                    *(u32x4*)(rowp + bj * 128) = w; } }
    }
};
}
struct Args { const float* in[30]; float* out; unsigned char* ws; int ph_lo, ph_hi; };
enum { I_X = 0, I_C, I_CTX, I_CCTX, I_WMOD, I_BMOD, I_N1G, I_N2G, I_WIN, I_CONVW, I_CONVB, I_WA, I_BA, I_WX, I_BX, I_LAM, I_RLAM, I_SINK,
       I_WBA, I_WBB, I_WBC, I_WOUT, I_RGW, I_RGB, I_REW, I_REB, I_EWG, I_EWU, I_EWD, I_FNG };
typedef const GAS float* cfp_t;
struct Frame {
    LAS unsigned char* lds; int tid, lane, wave, G, bid, gw, NGW; bool wr;
    const __attribute__((address_space(4))) cfp_t* in; float* out; unsigned char* ws;
};
#define FIN(i)     ((const float*)F.in[i])
#define F_MOD(F)   ((float*)((F).ws + WS_MOD))
#define F_HC(F)    ((float*)((F).ws + WS_HC))
#define F_X(F)     ((bf16*)((F).ws + WS_X))
#define F_PROJ(F)  ((bf16*)((F).ws + WS_PROJ))
#define F_YB(F)    ((bf16*)((F).ws + WS_YB))
#define F_CNT(F)   ((int*)((F).ws + WS_CTL) + CW_CNT)

__device__ __forceinline__ void ph_prologue(Frame& F) {
    LAS float* sc = (LAS float*)F.lds;
    LAS float* part = (LAS float*)(F.lds + 40960);
    for (int i = F.tid; i < 9 * 1024; i += 512) { const int mb = i >> 10, k = i & 1023; const float cv = mb < 8 ? FIN(I_C)[mb * 1024 + k] : FIN(I_CCTX)[k]; sc[i] = siluf_(cv); }
    __syncthreads();
    for (int item = F.bid; item < 4 * 96; item += F.G) {
        const int l = item / 96, n0 = (item % 96) * 64;
        const float* wp = FIN(I_WMOD) + ((size_t)l * 1024 + F.wave * 128) * 6144 + n0 + F.lane;
        float acc[9];
#pragma unroll
        for (int mb = 0; mb < 9; ++mb) acc[mb] = 0.f;
#pragma unroll 32
        for (int k = 0; k < 128; ++k) { const float wv = wp[(size_t)k * 6144];
#pragma unroll
            for (int mb = 0; mb < 9; ++mb) acc[mb] += sc[mb * 1024 + F.wave * 128 + k] * wv; }
#pragma unroll
        for (int mb = 0; mb < 9; ++mb) part[(F.wave * 9 + mb) * 64 + F.lane] = acc[mb];
        __syncthreads();
        for (int t = F.tid; t < 576; t += 512) { const int mb = t >> 6, ln = t & 63; float s = FIN(I_BMOD)[l * 6144 + n0 + ln];
#pragma unroll
            for (int w = 0; w < 8; ++w) s += part[(w * 9 + mb) * 64 + ln];
            F_MOD(F)[((size_t)l * 9 + mb) * 6144 + n0 + ln] = s; }
        __syncthreads();
    }
    f32x2* rt = (f32x2*)(F.ws + WS_ROPE);
    for (int i = F.bid * 512 + F.tid; i < 4096 * 32; i += F.G * 512) { const int pos = i >> 5, f = i & 31;
        const float inv = (float)pow(10000.0, -(double)(2 * f) / 64.0); const float ang = (float)pos * inv;
        rt[i] = (f32x2){(float)cos((double)ang), (float)sin((double)ang)}; }
    f32x2* at = (f32x2*)(F.ws + WS_ROPE + 1 * MiB);
    for (int i = F.bid * 512 + F.tid; i < 64 * 16; i += F.G * 512) { const int pos = i >> 4, f = i & 15;
        const float inv = (float)pow(10000.0, -(double)(2 * f) / 32.0); const float ang = (float)pos * inv;
        at[i] = (f32x2){(float)cos((double)ang), (float)sin((double)ang)}; }
}

__device__ __forceinline__ void tr_item(const float* W, int ldw, int k0, int n0, bf16* dst  , int ldk, LAS float* scr, int lane) {
    float wv[32];
#pragma unroll
    for (int i = 0; i < 32; ++i) { const int kk = 2 * i + (lane >> 5); wv[i] = W[(size_t)(k0 + kk) * ldw + n0 + (lane & 31)]; }
#pragma unroll
    for (int i = 0; i < 32; ++i) { const int kk = 2 * i + (lane >> 5); scr[kk * 33 + (lane & 31)] = wv[i]; }
    LDS_WAIT(); asm volatile("" ::: "memory");
    const int c = lane & 7;
#pragma unroll
    for (int j = 0; j < 4; ++j) { const int n = (lane >> 3) + 8 * j; const LAS float* s = scr + (8 * c) * 33 + n;
        u32x4 o; o.x = pk2(s[0 * 33], s[1 * 33]); o.y = pk2(s[2 * 33], s[3 * 33]); o.z = pk2(s[4 * 33], s[5 * 33]); o.w = pk2(s[6 * 33], s[7 * 33]);
        *(u32x4*)(dst + (size_t)n * ldk + 8 * c) = o; }
    LDS_WAIT(); asm volatile("" ::: "memory");
}
__device__ __forceinline__ void ph_convert(Frame& F, int l) {
    LAS float* scr = (LAS float*)(F.lds + F.wave * 16384);
    bf16* wt = (bf16*)(F.ws + WS_WT);
    constexpr int I_IN = 16 * 304, I_BRN = 16 * 32, I_GU1 = 16 * 16, I_DN1 = 8 * 32;
    constexpr int NITEMS = I_IN + 4 * I_BRN + 32 * 2 * I_GU1 + 32 * I_DN1;
    for (int it = F.gw; it < NITEMS; it += F.NGW) {
        int r = it;
        if (r < I_IN) { const int kb = r / 304, nb = r % 304; tr_item(FIN(I_WIN) + (size_t)l * 1024 * DIN, DIN, 64 * kb, 32 * nb, wt + WT_IN / 2 + (size_t)(32 * nb) * 1024 + 64 * kb, 1024, scr, F.lane); continue; }
        r -= I_IN;
        if (r < 3 * I_BRN) { const int br = r / I_BRN, q = r % I_BRN, kb = q / 32, nb = q % 32; const float* W = FIN(I_WBA + br) + (size_t)l * 1024 * 1024;
            tr_item(W, 1024, 64 * kb, 32 * nb, wt + WT_BR / 2 + (size_t)(32 * nb) * 3072 + br * 1024 + 64 * kb, 3072, scr, F.lane); continue; }
        r -= 3 * I_BRN;
        if (r < I_BRN) { const int kb = r / 32, nb = r % 32; tr_item(FIN(I_WOUT) + (size_t)l * 1024 * 1024, 1024, 64 * kb, 32 * nb, wt + WT_WO / 2 + (size_t)(32 * nb) * 1024 + 64 * kb, 1024, scr, F.lane); continue; }
        r -= I_BRN;
        if (r < 32 * 2 * I_GU1) { const int e = r / (2 * I_GU1), q = r % (2 * I_GU1), up = q / I_GU1, q2 = q % I_GU1, kb = q2 / 16, nb = q2 % 16;
            const float* W = FIN(up ? I_EWU : I_EWG) + ((size_t)l * 32 + e) * 1024 * 512; const int n0 = 32 * nb;
            const int drow = e * 1024 + (n0 >> 7) * 256 + up * 128 + (n0 & 127);
            tr_item(W, 512, 64 * kb, n0, wt + WT_GU / 2 + (size_t)drow * 1024 + 64 * kb, 1024, scr, F.lane); continue; }
        r -= 32 * 2 * I_GU1;
        { const int e = r / I_DN1, q = r % I_DN1, kb = q / 32, nb = q % 32; const float* W = FIN(I_EWD) + ((size_t)l * 32 + e) * 512 * 1024;
            tr_item(W, 1024, 64 * kb, 32 * nb, wt + WT_DN / 2 + (size_t)(e * 1024 + 32 * nb) * 512 + 64 * kb, 512, scr, F.lane); }
    }
}
constexpr size_t RW_ELEMS = (size_t)4 * 9 * 48 * 1024;
__device__ __forceinline__ void ph_router_fold(Frame& F) {
    float* Wp = (float*)(F.ws + WS_RW); float* rc = Wp + RW_ELEMS;
    for (int i = F.bid * 512 + F.tid; i < (int)RW_ELEMS; i += F.G * 512) {
        const int k = i & 1023, j = (i >> 10) % 48, mb = (i / (48 * 1024)) % 9, l = i / (48 * 1024 * 9);
        float v = 0.f;
        if (j < RCOLS) { const float w = j < 4 ? FIN(I_RGW)[((size_t)l * 1024 + k) * 4 + j] : FIN(I_REW)[((size_t)l * 1024 + k) * 32 + (j - 4)];
            v = FIN(I_N2G)[l * 1024 + k] * (1.0f + F_MOD(F)[((size_t)l * 9 + mb) * 6144 + 4 * 1024 + k]) * w; }
        Wp[i] = v;
    }
    for (int it = F.gw; it < 4 * 9 * RCOLS; it += F.NGW) { const int j = it % RCOLS, mb = (it / RCOLS) % 9, l = it / (RCOLS * 9);
        float s = 0.f;
        for (int k = F.lane; k < 1024; k += 64) { const float w = j < 4 ? FIN(I_RGW)[((size_t)l * 1024 + k) * 4 + j] : FIN(I_REW)[((size_t)l * 1024 + k) * 32 + (j - 4)];
            s += F_MOD(F)[((size_t)l * 9 + mb) * 6144 + 3 * 1024 + k] * w; }
        s = wave_sum(s);
        if (F.lane == 0) rc[(l * 9 + mb) * 64 + j] = s + (j < 4 ? FIN(I_RGB)[l * 4 + j] : FIN(I_REB)[l * 32 + (j - 4)]);
    }
}

struct RowJob { const float* src; float* copy_to; int mb; };
template <class RowFn> __device__ __forceinline__ void rows_norm_loop(Frame& F, int row0, int nrows, int w, int NW, const float* gain, const float* mod, int shift_i, int scale_i, bf16* dst, RowFn rowfn) {
    const int lane = F.lane;
    f32x4 nv[4]; RowJob nj = {nullptr, nullptr, 0};
    int r = row0 + w;
    if (r < nrows) { nj = rowfn(r);
#pragma unroll
        for (int j = 0; j < 4; ++j) nv[j] = *(const f32x4*)(nj.src + 4 * lane + 256 * j); }
    for (; r < nrows; r += NW) {
        f32x4 v[4]; const RowJob cj = nj;
#pragma unroll
        for (int j = 0; j < 4; ++j) v[j] = nv[j];
        const int rn = r + NW;
        if (rn < nrows) { nj = rowfn(rn);
#pragma unroll
            for (int j = 0; j < 4; ++j) nv[j] = *(const f32x4*)(nj.src + 4 * lane + 256 * j); }
        f32x4 g[4], sh[4], sc[4];
#pragma unroll
        for (int j = 0; j < 4; ++j) { g[j] = *(const f32x4*)(gain + 4 * lane + 256 * j); sh[j] = *(const f32x4*)(mod + cj.mb * 6144 + shift_i * 1024 + 4 * lane + 256 * j); sc[j] = *(const f32x4*)(mod + cj.mb * 6144 + scale_i * 1024 + 4 * lane + 256 * j); }
        float ss = 0.f;
#pragma unroll
        for (int j = 0; j < 4; ++j) ss += (v[j].x * v[j].x + v[j].y * v[j].y) + (v[j].z * v[j].z + v[j].w * v[j].w);
        if (cj.copy_to) {
#pragma unroll
            for (int j = 0; j < 4; ++j) *(f32x4*)(cj.copy_to + 4 * lane + 256 * j) = v[j]; }
        const float rstd = 1.0f / sqrtf(wave_sum(ss) * (1.0f / 1024.0f) + EPS);
#pragma unroll
        for (int j = 0; j < 4; ++j) { const f32x4 y = (v[j] * rstd) * g[j] * (sc[j] + 1.0f) + sh[j];
            u32x2 w; w.x = pk2(y.x, y.y); w.y = pk2(y.z, y.w); *(u32x2*)(dst + (size_t)r * 1024 + 4 * lane + 256 * j) = w; }
    }
}
__device__ __forceinline__ void ph_rows_u(Frame& F, int l, bool first) {
    const float* mod = F_MOD(F) + (size_t)l * 9 * 6144; const float* g = FIN(I_N1G) + l * 1024;
    float* out = F.out; float* hc = F_HC(F); const float* xin = FIN(I_X); const float* cin = FIN(I_CTX);
    rows_norm_loop(F, 0, NTOK, F.gw, F.NGW, g, mod, 0, 1, F_X(F), [=](int r) { const bool lat = r < NLAT; RowJob j; j.mb = lat ? (r >> 12) : 8;
        float* hrow = lat ? out + (size_t)r * 1024 : hc + (size_t)(r - NLAT) * 1024;
        j.src = first ? (lat ? xin + (size_t)r * 1024 : cin + (size_t)(r - NLAT) * 1024) : hrow; j.copy_to = nullptr; return j; });
}
__device__ __forceinline__ void ph_rows_v(Frame& F, int l, int row0, int ntok, int w, int NW) {
    const float* mod = F_MOD(F) + (size_t)l * 9 * 6144; const float* g = FIN(I_N2G) + l * 1024;
    float* out = F.out; float* hc = F_HC(F);
    rows_norm_loop(F, row0, ntok, w, NW, g, mod, 3, 4, F_X(F), [=](int r) { const bool lat = r < NLAT; RowJob j; j.mb = lat ? (r >> 12) : 8;
        j.src = lat ? out + (size_t)r * 1024 : hc + (size_t)(r - NLAT) * 1024; j.copy_to = nullptr; return j; });
}

__device__ __forceinline__ void ph_router(Frame& F, int l, int bt0, int bt1, int c, int G) {
    LAS float* Bs = (LAS float*)F.lds;
    LAS float* lgs = (LAS float*)(F.lds + 53248 + F.wave * 4096);
    const float* WpL = (const float*)(F.ws + WS_RW) + (size_t)l * 9 * 48 * 1024; const float* rcL = (const float*)(F.ws + WS_RW) + RW_ELEMS + l * 9 * 64;
    int* cnt = F_CNT(F) + l * 32; int* rowtok = (int*)(F.ws + WS_ROWTOK); unsigned* tinfo = (unsigned*)(F.ws + WS_TOKINFO);
    const int lane = F.lane, i16 = lane & 15, kq = lane >> 4, tid = F.tid;
    for (int bt = bt0 + c; bt < bt1; bt += G) {
        const int tok0 = bt * 128 + F.wave * 16; const bool lat = tok0 < NLAT; const int mb = lat ? (tok0 >> 12) : 8;
        const float* hrow = (lat ? F.out + (size_t)(tok0 + i16) * 1024 : F_HC(F) + (size_t)(tok0 + i16 - NLAT) * 1024) + 4 * kq;
        const float* wsrc = WpL + (size_t)mb * 48 * 1024;
        f32x4 acc[3]; float ss = 0.f;
#pragma unroll
        for (int c = 0; c < 3; ++c) acc[c] = (f32x4){0.f, 0.f, 0.f, 0.f};
        f32x4 bnext[6];
#pragma unroll
        for (int j = 0; j < 6; ++j) { const int i = tid + 512 * j; bnext[j] = *(const f32x4*)(wsrc + (size_t)(i >> 6) * 1024 + 4 * (i & 63)); }
#pragma unroll 1
        for (int kc = 0; kc < 4; ++kc) {
            LDS_BARRIER();
#pragma unroll
            for (int j = 0; j < 6; ++j) { const int i = tid + 512 * j; *(LAS f32x4*)(Bs + (i >> 6) * 260 + 4 * (i & 63)) = bnext[j]; }
            LDS_BARRIER();
            if (kc < 3) {
#pragma unroll
                for (int j = 0; j < 6; ++j) { const int i = tid + 512 * j; bnext[j] = *(const f32x4*)(wsrc + (size_t)(i >> 6) * 1024 + (kc + 1) * 256 + 4 * (i & 63)); } }
            const LAS float* bp = Bs + i16 * 260 + 4 * kq;
#pragma unroll 4
            for (int S = 0; S < 16; ++S) {
                const f32x4 a = *(const f32x4*)(hrow + kc * 256 + 16 * S);
                const f32x4 b0 = *(const LAS f32x4*)(bp + 16 * S), b1 = *(const LAS f32x4*)(bp + 16 * 260 + 16 * S), b2 = *(const LAS f32x4*)(bp + 32 * 260 + 16 * S);
                ss += (a.x * a.x + a.y * a.y) + (a.z * a.z + a.w * a.w);
#pragma unroll
                for (int s = 0; s < 4; ++s) { acc[0] = __builtin_amdgcn_mfma_f32_16x16x4f32(a[s], b0[s], acc[0], 0, 0, 0); acc[1] = __builtin_amdgcn_mfma_f32_16x16x4f32(a[s], b1[s], acc[1], 0, 0, 0);
                    acc[2] = __builtin_amdgcn_mfma_f32_16x16x4f32(a[s], b2[s], acc[2], 0, 0, 0); }
            }
        }
        ss += __shfl_xor(ss, 16); ss += __shfl_xor(ss, 32);
#pragma unroll
        for (int c = 0; c < 3; ++c)
#pragma unroll
            for (int r = 0; r < 4; ++r) lgs[(4 * kq + r) * 52 + 16 * c + i16] = acc[c][r];
        LDS_WAIT(); asm volatile("" ::: "memory");
        const float rstd = 1.0f / sqrtf(ss * (1.0f / 1024.0f) + EPS);
        float lg[RCOLS];
#pragma unroll
        for (int j4 = 0; j4 < RCOLS / 4; ++j4) { const f32x4 v = *(const LAS f32x4*)(lgs + i16 * 52 + 4 * j4); const f32x4 rcv = *(const f32x4*)(rcL + mb * 64 + 4 * j4);
            lg[4 * j4] = v.x * rstd + rcv.x; lg[4 * j4 + 1] = v.y * rstd + rcv.y; lg[4 * j4 + 2] = v.z * rstd + rcv.z; lg[4 * j4 + 3] = v.w * rstd + rcv.w; }
        LDS_WAIT(); asm volatile("" ::: "memory");
        const int tok = tok0 + i16;
        int g = 0; float gm = lg[0];
#pragma unroll
        for (int j = 1; j < 4; ++j) if (lg[j] > gm) { gm = lg[j]; g = j; }
        float gs = 0.f;
#pragma unroll
        for (int j = 0; j < 4; ++j) gs += __expf(lg[j] - gm);
        const float g_w = 1.0f / gs;
        float el[8];
#pragma unroll
        for (int i = 0; i < 8; ++i) { el[i] = lg[4 + i];
#pragma unroll
            for (int gg = 1; gg < 4; ++gg) el[i] = (g == gg) ? lg[4 + gg * 8 + i] : el[i]; }
        int i1 = 0; float m1 = el[0];
#pragma unroll
        for (int i = 1; i < 8; ++i) if (el[i] > m1) { m1 = el[i]; i1 = i; }
        int i2 = -1; float m2 = -3.0e38f;
#pragma unroll
        for (int i = 0; i < 8; ++i) if (i != i1 && el[i] > m2) { m2 = el[i]; i2 = i; }
        const float p2 = __expf(m2 - m1); const float w1 = g_w / (1.0f + p2), w2 = g_w * p2 / (1.0f + p2);
        const int e1 = g * 8 + i1, e2 = g * 8 + i2;
        int r1 = 0, r2 = 0;
        { unsigned long long todo = 0xFFFFull;
          while (todo) { const int ld = __builtin_ctzll(todo); const int x = __shfl(e1, ld); const unsigned long long m = __ballot(e1 == x) & todo;
              int base = 0; if (lane == ld && F.wr) base = atomicAdd(&cnt[x], (int)__builtin_popcountll(m)); base = __shfl(base, ld);
              if (e1 == x) r1 = base + (int)__builtin_popcountll(m & ((1ull << lane) - 1ull)); todo &= ~m; } }
        { unsigned long long todo = 0xFFFFull;
          while (todo) { const int ld = __builtin_ctzll(todo); const int x = __shfl(e2, ld); const unsigned long long m = __ballot(e2 == x) & todo;
              int base = 0; if (lane == ld && F.wr) base = atomicAdd(&cnt[x], (int)__builtin_popcountll(m)); base = __shfl(base, ld);
              if (e2 == x) r2 = base + (int)__builtin_popcountll(m & ((1ull << lane) - 1ull)); todo &= ~m; } }
        if (lane < 16 && F.wr) { rowtok[(size_t)e1 * NTOK + r1] = tok; rowtok[(size_t)e2 * NTOK + r2] = tok;
            u32x4 a; a.x = (unsigned)e1; a.y = (unsigned)r1; a.z = (unsigned)e2; a.w = (unsigned)r2;
            *(u32x4*)(tinfo + (size_t)tok * 8) = a; *(f32x2*)(tinfo + (size_t)tok * 8 + 4) = (f32x2){w1, w2}; }
    }
}
__device__ __forceinline__ void moe_tables(Frame& F, int l, volatile LAS int*& tileoff, volatile LAS int*& cntl) {
    volatile LAS int* t = (volatile LAS int*)(F.lds + LDS_CTL + 512); cntl = t; tileoff = t + 32;
    if (F.tid < 32) t[F.tid] = __hip_atomic_load(F_CNT(F) + l * 32 + F.tid, __ATOMIC_RELAXED, __HIP_MEMORY_SCOPE_AGENT);
    __syncthreads();
    if (F.tid == 0) { int s = 0;
#pragma unroll 1
        for (int e = 0; e < 32; ++e) { t[32 + e] = s; s += (t[e] + 255) >> 8; } t[64] = s; }
    __syncthreads();
}
__device__ __forceinline__ void ph_combine(Frame& F, int l, int ntok) {
    volatile LAS int* tileoff; volatile LAS int* cntl; moe_tables(F, l, tileoff, cntl);
    const float* mod = F_MOD(F) + (size_t)l * 9 * 6144; const bool lastl = (l == DEPTH - 1);
    const float* modn = F_MOD(F) + (size_t)(lastl ? l : l + 1) * 9 * 6144; const float* gn = lastl ? FIN(I_FNG) : FIN(I_N1G) + (l + 1) * 1024;
    const bf16* Y = (const bf16*)(F.ws + WS_YROWS); const unsigned* tinfo = (const unsigned*)(F.ws + WS_TOKINFO);
    const int lane = F.lane;
    u32x4 ninf = (u32x4){0u, 0u, 0u, 0u}; f32x2 nwv = (f32x2){0.f, 0.f}; f32x4 nh[4];
    int r = F.gw;
#define CMB_HROW(rr) ((rr) < NLAT ? F.out + (size_t)(rr) * 1024 : F_HC(F) + (size_t)((rr) - NLAT) * 1024)
    if (r < ntok) { ninf = *(const u32x4*)(tinfo + (size_t)r * 8); nwv = *(const f32x2*)(tinfo + (size_t)r * 8 + 4); const float* hp = CMB_HROW(r);
#pragma unroll
        for (int j = 0; j < 4; ++j) nh[j] = *(const f32x4*)(hp + 4 * lane + 256 * j); }
    for (; r < ntok; r += F.NGW) {
        const u32x4 inf = ninf; const f32x2 wv = nwv; f32x4 hv[4];
#pragma unroll
        for (int j = 0; j < 4; ++j) hv[j] = nh[j];
        const bool lat = r < NLAT; const int mb = lat ? (r >> 12) : 8; float* hrow = CMB_HROW(r);
        const bf16* y1 = Y + ((size_t)tileoff[inf.x] * 256 + inf.y) * 1024; const bf16* y2 = Y + ((size_t)tileoff[inf.z] * 256 + inf.w) * 1024;
        u32x2 ya[4], yb[4];
#pragma unroll
        for (int j = 0; j < 4; ++j) { ya[j] = *(const u32x2*)(y1 + 4 * lane + 256 * j); yb[j] = *(const u32x2*)(y2 + 4 * lane + 256 * j); }
        const int rn = r + F.NGW;
        if (rn < ntok) { ninf = *(const u32x4*)(tinfo + (size_t)rn * 8); nwv = *(const f32x2*)(tinfo + (size_t)rn * 8 + 4); const float* hp = CMB_HROW(rn);
#pragma unroll
            for (int j = 0; j < 4; ++j) nh[j] = *(const f32x4*)(hp + 4 * lane + 256 * j); }
        f32x4 v[4]; float ss = 0.f;
#pragma unroll
        for (int j = 0; j < 4; ++j) { const int c = 4 * lane + 256 * j; const f32x4 m5 = *(const f32x4*)(mod + mb * 6144 + 5 * 1024 + c);
            const u32x2 a = ya[j], b = yb[j];
            f32x4 y; y.x = wv.x * bflo(a.x) + wv.y * bflo(b.x); y.y = wv.x * bfhi(a.x) + wv.y * bfhi(b.x); y.z = wv.x * bflo(a.y) + wv.y * bflo(b.y); y.w = wv.x * bfhi(a.y) + wv.y * bfhi(b.y);
            v[j] = hv[j] + m5 * y; ss += (v[j].x * v[j].x + v[j].y * v[j].y) + (v[j].z * v[j].z + v[j].w * v[j].w); }
        const float rstd = 1.0f / sqrtf(wave_sum(ss) * (1.0f / 1024.0f) + EPS);
        if (lastl) {
#pragma unroll
            for (int j = 0; j < 4; ++j) { const int c = 4 * lane + 256 * j; const f32x4 g = *(const f32x4*)(gn + c); if (F.wr) *(f32x4*)(hrow + c) = (v[j] * rstd) * g; }
        } else {
#pragma unroll
            for (int j = 0; j < 4; ++j) { const int c = 4 * lane + 256 * j; if (F.wr) *(f32x4*)(hrow + c) = v[j];
                const f32x4 g = *(const f32x4*)(gn + c), sh = *(const f32x4*)(modn + mb * 6144 + c), sc = *(const f32x4*)(modn + mb * 6144 + 1024 + c);
                const f32x4 y = (v[j] * rstd) * g * (sc + 1.0f) + sh; u32x2 w; w.x = pk2(y.x, y.y); w.y = pk2(y.z, y.w); if (F.wr) *(u32x2*)(F_X(F) + (size_t)r * 1024 + c) = w; }
        }
    }
#undef CMB_HROW
}
#define MFMA16(a, b, c) __builtin_amdgcn_mfma_f32_16x16x32_bf16((a), (b), (c), 0, 0, 0)
__device__ __forceinline__ bf16x8 ldfrag(const LAS bf16* base, int row0, int k0, int ld, int lane) {
    return *(const LAS bf16x8*)(base + (row0 + (lane & 15)) * ld + k0 + 8 * (lane >> 4));
}
__device__ __forceinline__ float fast_sigmoid(float x) { return __builtin_amdgcn_rcpf(1.0f + __builtin_amdgcn_exp2f(-1.4426950408889634f * x)); }
__device__ __forceinline__ float fast_gelu_tanh(float x) {
    const float u2 = 1.5957691216057308f * (x + 0.044715f * x * x * x);
    return x * __builtin_amdgcn_rcpf(1.0f + __builtin_amdgcn_exp2f(-1.4426950408889634f * u2));
}

__device__ __forceinline__ void att_rope8(const f32x2* tab, const float (&x1)[8], const float (&x2)[8], float (&o1)[8], float (&o2)[8]) {
#pragma unroll
    for (int e = 0; e < 8; ++e) { const f32x2 cs = tab[e]; o1[e] = x1[e] * cs.x - x2[e] * cs.y; o2[e] = x2[e] * cs.x + x1[e] * cs.y; }
}
__device__ __forceinline__ void unpack8(const u32x4 a, float (&x)[8]) { x[0] = bflo(a.x); x[1] = bfhi(a.x); x[2] = bflo(a.y); x[3] = bfhi(a.y); x[4] = bflo(a.z); x[5] = bfhi(a.z); x[6] = bflo(a.w); x[7] = bfhi(a.w); }
__device__ __forceinline__ u32x4 pack8(const float (&x)[8], float s) { u32x4 r; r.x = pk2(x[0] * s, x[1] * s); r.y = pk2(x[2] * s, x[3] * s); r.z = pk2(x[4] * s, x[5] * s); r.w = pk2(x[6] * s, x[7] * s); return r; }

template <int RS> __device__ __forceinline__ void tr_frags4(unsigned addr, bf16x8 (&f)[4]) {
    u32x2 a0, a1, b0, b1, c0, c1, d0, d1;
    asm volatile("ds_read_b64_tr_b16 %0, %8\n\tds_read_b64_tr_b16 %1, %8 offset:%9\n\tds_read_b64_tr_b16 %2, %8 offset:32\n\tds_read_b64_tr_b16 %3, %8 offset:%10\n\t"
                 "ds_read_b64_tr_b16 %4, %8 offset:64\n\tds_read_b64_tr_b16 %5, %8 offset:%11\n\tds_read_b64_tr_b16 %6, %8 offset:96\n\tds_read_b64_tr_b16 %7, %8 offset:%12\n\ts_waitcnt lgkmcnt(0)"
                 : "=&v"(a0), "=&v"(a1), "=&v"(b0), "=&v"(b1), "=&v"(c0), "=&v"(c1), "=&v"(d0), "=&v"(d1)
                 : "v"(addr), "i"(4 * RS), "i"(32 + 4 * RS), "i"(64 + 4 * RS), "i"(96 + 4 * RS) : "memory");
    u32x4 t; t.x = a0.x; t.y = a0.y; t.z = a1.x; t.w = a1.y; f[0] = __builtin_bit_cast(bf16x8, t);
    t.x = b0.x; t.y = b0.y; t.z = b1.x; t.w = b1.y; f[1] = __builtin_bit_cast(bf16x8, t);
    t.x = c0.x; t.y = c0.y; t.z = c1.x; t.w = c1.y; f[2] = __builtin_bit_cast(bf16x8, t);
    t.x = d0.x; t.y = d0.y; t.z = d1.x; t.w = d1.y; f[3] = __builtin_bit_cast(bf16x8, t);
}


__device__ __forceinline__ float xor16_max(float x) { const unsigned xi = __builtin_bit_cast(unsigned, x); const auto r = __builtin_amdgcn_permlane16_swap(xi, xi, false, false); return fmaxf(__builtin_bit_cast(float, (unsigned)r[0]), __builtin_bit_cast(float, (unsigned)r[1])); }
__device__ __forceinline__ float xor32_max(float x) { const unsigned xi = __builtin_bit_cast(unsigned, x); const auto r = __builtin_amdgcn_permlane32_swap(xi, xi, false, false); return fmaxf(__builtin_bit_cast(float, (unsigned)r[0]), __builtin_bit_cast(float, (unsigned)r[1])); }
__device__ __forceinline__ float xor16_sum(float x) { const unsigned xi = __builtin_bit_cast(unsigned, x); const auto r = __builtin_amdgcn_permlane16_swap(xi, xi, false, false); return __builtin_bit_cast(float, (unsigned)r[0]) + __builtin_bit_cast(float, (unsigned)r[1]); }
__device__ __forceinline__ float xor32_sum(float x) { const unsigned xi = __builtin_bit_cast(unsigned, x); const auto r = __builtin_amdgcn_permlane32_swap(xi, xi, false, false); return __builtin_bit_cast(float, (unsigned)r[0]) + __builtin_bit_cast(float, (unsigned)r[1]); }

#ifndef LRU_ABL
#define LRU_ABL 0
#endif
__device__ __forceinline__ void lru_unit(Frame& F, int l, int b, int hd, int half) {
    LAS bf16* ub = (LAS bf16*)F.lds;
    LAS bf16* waT = (LAS bf16*)(F.lds + 36864);
    LAS bf16* wxT = (LAS bf16*)(F.lds + 36864 + 4608);
    LAS f32x2* wcomp = (LAS f32x2*)(F.lds + 92800);
    LAS bf16* ho = (LAS bf16*)(F.lds + 46080 + 3 * 8192 + 256);
    const int tid = F.tid, lane = F.lane, w = F.wave, q = lane >> 4, fr = lane & 15;
    bf16* proj = F_PROJ(F); bf16* X = F_X(F);
    const int chh = hd * 64;
    const int c8 = tid & 7, rg = tid >> 3;
    LAS float* cwl = (LAS float*)(F.lds + 91392 + 128);
    __syncthreads();
    if (tid < 320) { const int j = tid >> 6, c = tid & 63; cwl[tid] = j < 4 ? FIN(I_CONVW)[((size_t)l * 4 + j) * 1024 + chh + c] : FIN(I_CONVB)[l * 1024 + chh + c]; }
    const int orow = tid >> 1, ohh = tid & 1;
#pragma unroll 1
    for (int dir = 0; dir < 2; ++dir) {
        __syncthreads();
        for (int i = tid; i < 2048; i += 512) { const int k = i >> 5, c = i & 31; const size_t gi = ((((size_t)l * 2 + dir) * 16 + hd) * 64 + k) * 64 + half * 32 + c;
            waT[c * 72 + k] = (bf16)f2bf(FIN(I_WA)[gi]); wxT[c * 72 + k] = (bf16)f2bf(FIN(I_WX)[gi]); }
        float ba_[2], bx_[2], sp8_[2], carry[2] = {0.f, 0.f};
#pragma unroll
        for (int cb = 0; cb < 2; ++cb) { const int ch = chh + half * 32 + cb * 16 + fr; const size_t gi = ((size_t)l * 2 + dir) * 1024 + ch;
            ba_[cb] = FIN(I_BA)[gi]; bx_[cb] = FIN(I_BX)[gi]; const float lam = FIN(I_LAM)[gi]; sp8_[cb] = -8.0f * 1.4426950408889634f * log1p_fast(__expf(-lam)); }
        __syncthreads();
        const int rgd = dir ? 63 - rg : rg;
        u32x4 axr[7]; u32x4 pf[4];
#define LRU_CHUNK(ci, isctx_, T0_, rowbase_) const bool isctx_ = (ci) == 0; const int T0_ = isctx_ ? 0 : 256 * (dir ? (16 - (ci)) : ((ci) - 1)); const size_t rowbase_ = isctx_ ? (size_t)NLAT + b * LCX : (size_t)b * SEQ
#define LRU_PREFETCH(ci) do { LRU_CHUNK(ci, ic_, t0_, rb_); const int Ls_ = ic_ ? LCX : SEQ; \
            _Pragma("unroll") for (int j = 0; j < 7; ++j) { const int tt = t0_ + 4 * rgd - 2 + j; const int tc_ = (tt >= 0 && tt < Ls_) ? tt : 0; \
                const GAS bf16* p_ = (const GAS bf16*)(proj + (rb_ + tc_) * LDP + C_AX + chh + 8 * c8); \
                asm volatile("global_load_dwordx4 %0, %1, off" : "=v"(axr[j]) : "v"(p_) : "memory"); } } while (0)
#define LRU_AX_WAIT(ci) do { if (dir == 0) asm volatile("s_waitcnt vmcnt(2)" : "+v"(axr[0]), "+v"(axr[1]), "+v"(axr[2]), "+v"(axr[3]), "+v"(axr[4]), "+v"(axr[5]), "+v"(axr[6]) :: "memory"); \
            else asm volatile("s_waitcnt vmcnt(6)" : "+v"(axr[0]), "+v"(axr[1]), "+v"(axr[2]), "+v"(axr[3]), "+v"(axr[4]), "+v"(axr[5]), "+v"(axr[6]) :: "memory"); \
            LRU_CHUNK(ci, ic_, t0_, rb_); (void)rb_; const int Ls_ = ic_ ? LCX : SEQ; \
            _Pragma("unroll") for (int j = 0; j < 7; ++j) { const int tt = t0_ + 4 * rgd - 2 + j; if (!(tt >= 0 && tt < Ls_)) axr[j] = (u32x4){0u, 0u, 0u, 0u}; } } while (0)
#define LRU_PREFETCH_OUT(ci) do { if (dir == 1) { LRU_CHUNK(ci, ic_, t0_, rb_); const size_t orow_g = rb_ + t0_ + (255 - orow); \
                pf[0] = *(const u32x4*)(X + orow_g * 1024 + chh + half * 32 + ohh * 16); pf[1] = *(const u32x4*)(X + orow_g * 1024 + chh + half * 32 + ohh * 16 + 8); \
                pf[2] = *(const u32x4*)(proj + orow_g * LDP + C_AY + chh + half * 32 + ohh * 16); pf[3] = *(const u32x4*)(proj + orow_g * LDP + C_AY + chh + half * 32 + ohh * 16 + 8); } } while (0)
        LRU_PREFETCH(0); LRU_PREFETCH_OUT(0);
        asm volatile("s_waitcnt vmcnt(0)" : "+v"(axr[0]), "+v"(axr[1]), "+v"(axr[2]), "+v"(axr[3]), "+v"(axr[4]), "+v"(axr[5]), "+v"(axr[6]) :: "memory");
#pragma unroll 1
        for (int ci = 0; ci < 17; ++ci) {
            LRU_CHUNK(ci, isctx, T0, rowbase);
            if (ci > 0) { LRU_AX_WAIT(ci); } else {
#pragma unroll
                for (int j = 0; j < 7; ++j) { const int tt = 4 * rgd - 2 + j; if (!(tt >= 0 && tt < LCX)) axr[j] = (u32x4){0u, 0u, 0u, 0u}; } }
            { float u[4][8];
#pragma unroll
              for (int r = 0; r < 4; ++r) { const f32x4 b0 = *(const LAS f32x4*)(cwl + 256 + 8 * c8), b1 = *(const LAS f32x4*)(cwl + 256 + 8 * c8 + 4);
                  u[r][0] = b0.x; u[r][1] = b0.y; u[r][2] = b0.z; u[r][3] = b0.w; u[r][4] = b1.x; u[r][5] = b1.y; u[r][6] = b1.z; u[r][7] = b1.w; }
#pragma unroll
              for (int j = 0; j < 7; ++j) { float x[8]; x[0] = bflo(axr[j].x); x[1] = bfhi(axr[j].x); x[2] = bflo(axr[j].y); x[3] = bfhi(axr[j].y); x[4] = bflo(axr[j].z); x[5] = bfhi(axr[j].z); x[6] = bflo(axr[j].w); x[7] = bfhi(axr[j].w);
#pragma unroll
                  for (int t = 0; t < 4; ++t) { const int r = j - t; if (r >= 0 && r < 4) {
                      const f32x4 w0 = *(const LAS f32x4*)(cwl + 64 * t + 8 * c8), w1 = *(const LAS f32x4*)(cwl + 64 * t + 8 * c8 + 4);
                      u[r][0] += w0.x * x[0]; u[r][1] += w0.y * x[1]; u[r][2] += w0.z * x[2]; u[r][3] += w0.w * x[3]; u[r][4] += w1.x * x[4]; u[r][5] += w1.y * x[5]; u[r][6] += w1.z * x[6]; u[r][7] += w1.w * x[7]; } } }
#pragma unroll
              for (int r = 0; r < 4; ++r) { const int tl = 4 * rgd + r, p = dir ? (255 - tl) : tl;
                  u32x4 o; o.x = pk2(u[r][0], u[r][1]); o.y = pk2(u[r][2], u[r][3]); o.z = pk2(u[r][4], u[r][5]); o.w = pk2(u[r][6], u[r][7]); *(LAS u32x4*)(ub + p * 72 + 8 * c8) = o; } }
            if (ci + 1 < 17) LRU_PREFETCH(ci + 1);
            LDS_WAIT(); asm volatile("" ::: "memory");
            float hl[2][2][4], Ac[2][2][4], sa[2][2], sb[2][2];
            bf16x8 Ba[2][2], Bx[2][2];
#pragma unroll
            for (int cb = 0; cb < 2; ++cb)
#pragma unroll
                for (int ks = 0; ks < 2; ++ks) { Ba[cb][ks] = ldfrag(waT, cb * 16, ks * 32, 72, lane); Bx[cb][ks] = ldfrag(wxT, cb * 16, ks * 32, 72, lane); }
#pragma unroll
            for (int rb = 0; rb < 2; ++rb) { const bf16x8 A0 = ldfrag(ub, 32 * w + 16 * rb, 0, 72, lane), A1 = ldfrag(ub, 32 * w + 16 * rb, 32, 72, lane);
#pragma unroll
                for (int cb = 0; cb < 2; ++cb) {
                    f32x4 ra = (f32x4){0.f, 0.f, 0.f, 0.f}, rx = ra;
                    ra = MFMA16(A0, Ba[cb][0], ra); ra = MFMA16(A1, Ba[cb][1], ra); rx = MFMA16(A0, Bx[cb][0], rx); rx = MFMA16(A1, Bx[cb][1], rx);
                    float hprev = 0.f, aprev = 1.f;
#pragma unroll
                    for (int r = 0; r < 4; ++r) { const int p = 32 * w + 16 * rb + 4 * q + r; const float u = bf2f(ub[p * 72 + half * 32 + cb * 16 + fr]);
                        const float rgt = fast_sigmoid(ra[r] + ba_[cb]), igt = fast_sigmoid(rx[r] + bx_[cb]);
                        const float a = __builtin_amdgcn_exp2f(sp8_[cb] * rgt), bb = __builtin_amdgcn_sqrtf(fmaxf((1.0f - a) * (1.0f + a), 0.f)) * (igt * u);
                        hprev = a * hprev + bb; aprev = a * aprev; hl[rb][cb][r] = hprev; Ac[rb][cb][r] = aprev; }
                    sa[rb][cb] = aprev; sb[rb][cb] = hprev; } }
            float ea[2][2], eb[2][2];
            const int par = ci & 1;
#pragma unroll
            for (int cb = 0; cb < 2; ++cb) { float ia[2], ib[2];
#pragma unroll
                for (int rb = 0; rb < 2; ++rb) { float a = sa[rb][cb], bq = sb[rb][cb];
                    float a1 = __shfl_up(a, 16), b1 = __shfl_up(bq, 16); if (q >= 1) { bq = a * b1 + bq; a = a * a1; }
                    a1 = __shfl_up(a, 32); b1 = __shfl_up(bq, 32); if (q >= 2) { bq = a * b1 + bq; a = a * a1; }
                    ia[rb] = a; ib[rb] = bq;
                    a1 = __shfl_up(a, 16); b1 = __shfl_up(bq, 16); ea[rb][cb] = q ? a1 : 1.0f; eb[rb][cb] = q ? b1 : 0.0f; }
                const float t0a = __shfl(ia[0], 48 + fr), t0b = __shfl(ib[0], 48 + fr);
                eb[1][cb] = ea[1][cb] * t0b + eb[1][cb]; ea[1][cb] = ea[1][cb] * t0a;
                if (q == 3) wcomp[(par * 8 + w) * 32 + cb * 16 + fr] = (f32x2){ia[1] * t0a, ia[1] * t0b + ib[1]}; }
            LDS_BARRIER();
#pragma unroll
            for (int cb = 0; cb < 2; ++cb) { float h = carry[cb], hin = h;
#pragma unroll
                for (int k = 0; k < 8; ++k) { const f32x2 c = wcomp[(par * 8 + k) * 32 + cb * 16 + fr]; h = c.x * h + c.y; hin = (k + 1 == w) ? h : hin; }
                carry[cb] = h;
#pragma unroll
                for (int rb = 0; rb < 2; ++rb) { const float hs = ea[rb][cb] * hin + eb[rb][cb];
#pragma unroll
                    for (int r = 0; r < 4; ++r) { const int p = 32 * w + 16 * rb + 4 * q + r; ho[p * 40 + cb * 16 + fr] = (bf16)f2bf(Ac[rb][cb][r] * hs + hl[rb][cb][r]); } } }
            LDS_WAIT(); asm volatile("" ::: "memory");
            { const int tl = dir ? (255 - orow) : orow; const size_t row = rowbase + T0 + tl;
              const u32x4 h0 = *(const LAS u32x4*)(ho + orow * 40 + ohh * 16), h1 = *(const LAS u32x4*)(ho + orow * 40 + ohh * 16 + 8);
              if (dir == 0) { *(u32x4*)(X + row * 1024 + chh + half * 32 + ohh * 16) = h0; *(u32x4*)(X + row * 1024 + chh + half * 32 + ohh * 16 + 8) = h1; }
              else { u32x4 o0, o1;
#define LRU_Y(hb, hf, ay) pk2((bflo(hf) + bflo(hb)) * fast_gelu_tanh(bflo(ay)), (bfhi(hf) + bfhi(hb)) * fast_gelu_tanh(bfhi(ay)))
                  o0.x = LRU_Y(h0.x, pf[0].x, pf[2].x); o0.y = LRU_Y(h0.y, pf[0].y, pf[2].y); o0.z = LRU_Y(h0.z, pf[0].z, pf[2].z); o0.w = LRU_Y(h0.w, pf[0].w, pf[2].w);
                  o1.x = LRU_Y(h1.x, pf[1].x, pf[3].x); o1.y = LRU_Y(h1.y, pf[1].y, pf[3].y); o1.z = LRU_Y(h1.z, pf[1].z, pf[3].z); o1.w = LRU_Y(h1.w, pf[1].w, pf[3].w);
#undef LRU_Y
                  { bf16* yb_ = F_YB(F) + row * 3072 + chh + half * 32 + ohh * 16; *(u32x4*)yb_ = o0; *(u32x4*)(yb_ + 8) = o1; } } }
            if (ci + 1 < 17) LRU_PREFETCH_OUT(ci + 1);
        }
#undef LRU_AX_WAIT
#undef LRU_PREFETCH_OUT
#undef LRU_PREFETCH
#undef LRU_CHUNK
    }
}
__device__ __forceinline__ size_t ret_rowbase(int b, int cidx) { return cidx < 2 ? (size_t)NLAT + b * LCX + cidx * 128 : (size_t)b * SEQ + (cidx - 2) * 128; }
__device__ __forceinline__ float ret_logg(Frame& F, int l, int dir, int h) { const float lam = FIN(I_RLAM)[(l * 2 + dir) * 8 + h]; return -log1p_fast(__expf(-lam)); }

__device__ __forceinline__ void ret_load_qk(Frame& F, const bf16* src  , bool rope, int pos0, float scale, float (&o1)[8], float (&o2)[8]) {
    const int row = F.tid >> 2, cp = F.tid & 3;
    const u32x4 a = *(const u32x4*)(src + (size_t)row * LDP + 8 * cp), b = *(const u32x4*)(src + (size_t)row * LDP + 32 + 8 * cp);
    float x1[8] = {bflo(a.x), bfhi(a.x), bflo(a.y), bfhi(a.y), bflo(a.z), bfhi(a.z), bflo(a.w), bfhi(a.w)};
    float x2[8] = {bflo(b.x), bfhi(b.x), bflo(b.y), bfhi(b.y), bflo(b.z), bfhi(b.z), bflo(b.w), bfhi(b.w)};
    if (rope) { const f32x2* rt = (const f32x2*)(F.ws + WS_ROPE) + (size_t)(pos0 + row) * 32 + 8 * cp;
#pragma unroll
        for (int e = 0; e < 8; ++e) { const f32x2 cs = rt[e]; o1[e] = (x1[e] * cs.x - x2[e] * cs.y) * scale; o2[e] = (x2[e] * cs.x + x1[e] * cs.y) * scale; }
    } else {
#pragma unroll
        for (int e = 0; e < 8; ++e) { o1[e] = x1[e] * scale; o2[e] = x2[e] * scale; }
    }
}
__device__ __forceinline__ void ph_ret_r1(Frame& F, int l) {
    LAS bf16* Kf = (LAS bf16*)F.lds;
    LAS bf16* Kb = Kf + 128 * 72;
    LAS bf16* Vs = Kb + 128 * 72;
    const int tid = F.tid, lane = F.lane, w = F.wave, q = lane >> 4, fr = lane & 15;
    const bf16* proj = F_PROJ(F);
    const int row = tid >> 2, cp = tid & 3;
    u32x4 ka, kb, vv[4];
#define R1_LOAD(u) do { const int bh__ = (u) / 34, ci__ = (u) % 34; const size_t rb__ = ret_rowbase(bh__ >> 3, ci__); const int h__ = bh__ & 7; \
        const bf16* ks_ = proj + (rb__ + row) * LDP + C_BK + h__ * 64 + 8 * cp; ka = *(const u32x4*)ks_; kb = *(const u32x4*)(ks_ + 32); \
        _Pragma("unroll") for (int i = 0; i < 4; ++i) { const int t_ = tid + 512 * i; vv[i] = *(const u32x4*)(proj + (rb__ + (t_ >> 4)) * LDP + C_BV + h__ * 128 + 8 * (t_ & 15)); } } while (0)
    int u = F.bid;
    if (u < 64 * 34) R1_LOAD(u);
    const int dir = w >> 2, e0 = 32 * (w & 3);
    const unsigned vlane = (unsigned)(size_t)Vs + (unsigned)((8 * q + (fr >> 2)) * 272 + (fr & 3) * 8 + e0 * 2);
    const unsigned klane = (unsigned)(size_t)(dir ? Kb : Kf) + (unsigned)((8 * q + (fr >> 2)) * 144 + (fr & 3) * 8);
#pragma unroll 1
    for (; u < 64 * 34; u += F.G) {
        const int bh = u / 34, cidx = u % 34, b = bh >> 3, h = bh & 7; const bool lat = cidx >= 2;
        const float lg0 = ret_logg(F, l, 0, h), lg1 = ret_logg(F, l, 1, h);
        LDS_BARRIER();
        { float x1[8], x2[8], o1[8], o2[8]; unpack8(ka, x1); unpack8(kb, x2);
          if (lat) { const f32x2* rt = (const f32x2*)(F.ws + WS_ROPE) + (size_t)((cidx - 2) * 128 + row) * 32 + 8 * cp;
#pragma unroll
              for (int e = 0; e < 8; ++e) { const f32x2 cs = rt[e]; o1[e] = (x1[e] * cs.x - x2[e] * cs.y) * 0.125f; o2[e] = (x2[e] * cs.x + x1[e] * cs.y) * 0.125f; } }
          else {
#pragma unroll
              for (int e = 0; e < 8; ++e) { o1[e] = x1[e] * 0.125f; o2[e] = x2[e] * 0.125f; } }
          const float df = __expf(lg0 * (float)(127 - row)), db = __expf(lg1 * (float)row);
          *(LAS u32x4*)(Kf + row * 72 + 8 * cp) = pack8(o1, df); *(LAS u32x4*)(Kf + row * 72 + 32 + 8 * cp) = pack8(o2, df);
          *(LAS u32x4*)(Kb + row * 72 + 8 * cp) = pack8(o1, db); *(LAS u32x4*)(Kb + row * 72 + 32 + 8 * cp) = pack8(o2, db); }
#pragma unroll
        for (int i = 0; i < 4; ++i) { const int t = tid + 512 * i; *(LAS u32x4*)(Vs + (t >> 4) * 136 + 8 * (t & 15)) = vv[i]; }
        LDS_BARRIER();
        if (u + F.G < 64 * 34) R1_LOAD(u + F.G);
        f32x4 acc[2][4];
#pragma unroll
        for (int eb = 0; eb < 2; ++eb)
#pragma unroll
            for (int db = 0; db < 4; ++db) acc[eb][db] = (f32x4){0.f, 0.f, 0.f, 0.f};
#pragma unroll
        for (int ks = 0; ks < 4; ++ks) { bf16x8 av[4], bk[4];
            tr_frags4<272>(vlane + ks * 32 * 272, av);
            tr_frags4<144>(klane + ks * 32 * 144, bk);
#pragma unroll
            for (int eb = 0; eb < 2; ++eb)
#pragma unroll
                for (int db = 0; db < 4; ++db) acc[eb][db] = MFMA16(bk[db], av[eb], acc[eb][db]); }
        bf16* kv = (bf16*)(F.ws + WS_KV) + ((((size_t)(b * 8 + h) * 34 + cidx) * 2) + dir) * 8192;
#pragma unroll
        for (int eb = 0; eb < 2; ++eb)
#pragma unroll
            for (int db = 0; db < 4; ++db) { u32x2 o; o.x = pk2(acc[eb][db][0], acc[eb][db][1]); o.y = pk2(acc[eb][db][2], acc[eb][db][3]);
                *(u32x2*)(kv + (e0 + 16 * eb + fr) * 64 + 16 * db + 4 * q) = o; }
    }
#undef R1_LOAD
}
__device__ __forceinline__ void ret_scan(Frame& F, int l) {
    unsigned* kvw = (unsigned*)(F.ws + WS_KV);
    for (int i = F.bid * 512 + F.tid; i < 64 * 2 * 4096; i += F.G * 512) { const int pr = i & 4095, dir = (i >> 12) & 1, bh = i >> 13, h = bh & 7;
        const float gC = __expf(ret_logg(F, l, dir, h) * 128.0f);
        unsigned* base = kvw + ((size_t)bh * 34 * 2 + dir) * 4096 + pr;
        unsigned v[34];
#pragma unroll
        for (int k = 0; k < 34; ++k) v[k] = base[(size_t)k * 8192];
        float s0 = 0.f, s1 = 0.f;
        if (dir == 0) {
#pragma unroll
            for (int k = 0; k < 34; ++k) { const unsigned x = v[k]; v[k] = pk2(s0, s1); s0 = gC * s0 + bflo(x); s1 = gC * s1 + bfhi(x); }
        } else {
#pragma unroll
            for (int k = 0; k < 34; ++k) { const int c = k < 2 ? 1 - k : 35 - k; const unsigned x = v[c]; v[c] = pk2(s0, s1); s0 = gC * s0 + bflo(x); s1 = gC * s1 + bfhi(x); }
        }
        if (F.wr) {
#pragma unroll
            for (int k = 0; k < 34; ++k) base[(size_t)k * 8192] = v[k]; }
    }
}
__device__ __forceinline__ void ph_ret_r2(Frame& F, int l, bool lastl) {
    LAS bf16* Qs = (LAS bf16*)F.lds;
    LAS bf16* Ks = Qs + 128 * 72;
    LAS bf16* Vs = Ks + 128 * 72;
    LAS bf16* Ps = Vs + 128 * 136 + F.wave * (16 * 136);
    LAS bf16* Ss = Vs + 128 * 136 + 8 * (16 * 136);
    const int tid = F.tid, lane = F.lane, w = F.wave, q = lane >> 4, fr = lane & 15;
    const bf16* proj = F_PROJ(F);
    const int nch = lastl ? 32 : 34, nunits = 64 * nch;
    const int row = tid >> 2, cp = tid & 3;
    u32x4 qa, qb_, ka, kb, vv[4], sv[4];
#define R2_DECODE(u, bh_, cidx_) const int bh_ = (u) / nch, cidx_ = (u) % nch + (lastl ? 2 : 0)
#define R2_LOAD(u) do { R2_DECODE(u, bh__, ci__); const size_t rb__ = ret_rowbase(bh__ >> 3, ci__); const int h__ = bh__ & 7; \
        const bf16* qs_ = proj + (rb__ + row) * LDP + C_BQ + h__ * 64 + 8 * cp; qa = *(const u32x4*)qs_; qb_ = *(const u32x4*)(qs_ + 32); \
        const bf16* ks_ = proj + (rb__ + row) * LDP + C_BK + h__ * 64 + 8 * cp; ka = *(const u32x4*)ks_; kb = *(const u32x4*)(ks_ + 32); \
        _Pragma("unroll") for (int i = 0; i < 4; ++i) { const int t_ = tid + 512 * i; vv[i] = *(const u32x4*)(proj + (rb__ + (t_ >> 4)) * LDP + C_BV + h__ * 128 + 8 * (t_ & 15)); \
            sv[i] = *(const u32x4*)((const bf16*)(F.ws + WS_KV) + (((size_t)bh__ * 34 + ci__) * 2) * 8192 + (size_t)t_ * 8); } } while (0)
    int u = F.bid;
    if (u < nunits) R2_LOAD(u);
    const unsigned vlane = (unsigned)(size_t)Vs + (unsigned)((8 * q + (fr >> 2)) * 272 + (fr & 3) * 8);
#pragma unroll 1
    for (; u < nunits; u += F.G) {
        R2_DECODE(u, bh, cidx); const int b = bh >> 3, h = bh & 7; const size_t rb = ret_rowbase(b, cidx); const bool lat = cidx >= 2;
        const float lg0 = ret_logg(F, l, 0, h), lg1 = ret_logg(F, l, 1, h);
        LDS_BARRIER();
        { float x1[8], x2[8], o1[8], o2[8];
          unpack8(qa, x1); unpack8(qb_, x2);
          if (lat) { const f32x2* rt = (const f32x2*)(F.ws + WS_ROPE) + (size_t)((cidx - 2) * 128 + row) * 32 + 8 * cp;
#pragma unroll
              for (int e = 0; e < 8; ++e) { const f32x2 cs = rt[e]; o1[e] = x1[e] * cs.x - x2[e] * cs.y; o2[e] = x2[e] * cs.x + x1[e] * cs.y; } }
          else {
#pragma unroll
              for (int e = 0; e < 8; ++e) { o1[e] = x1[e]; o2[e] = x2[e]; } }
          *(LAS u32x4*)(Qs + row * 72 + 8 * cp) = pack8(o1, 1.0f); *(LAS u32x4*)(Qs + row * 72 + 32 + 8 * cp) = pack8(o2, 1.0f);
          unpack8(ka, x1); unpack8(kb, x2);
          if (lat) { const f32x2* rt = (const f32x2*)(F.ws + WS_ROPE) + (size_t)((cidx - 2) * 128 + row) * 32 + 8 * cp;
#pragma unroll
              for (int e = 0; e < 8; ++e) { const f32x2 cs = rt[e]; o1[e] = x1[e] * cs.x - x2[e] * cs.y; o2[e] = x2[e] * cs.x + x1[e] * cs.y; } }
          else {
#pragma unroll
              for (int e = 0; e < 8; ++e) { o1[e] = x1[e]; o2[e] = x2[e]; } }
          *(LAS u32x4*)(Ks + row * 72 + 8 * cp) = pack8(o1, 0.125f); *(LAS u32x4*)(Ks + row * 72 + 32 + 8 * cp) = pack8(o2, 0.125f); }
#pragma unroll
        for (int i = 0; i < 4; ++i) { const int t = tid + 512 * i; *(LAS u32x4*)(Vs + (t >> 4) * 136 + 8 * (t & 15)) = vv[i]; *(LAS u32x4*)(Ss + (t >> 3) * 72 + 8 * (t & 7)) = sv[i]; }
        LDS_BARRIER();
        if (u + F.G < nunits) R2_LOAD(u + F.G);
        const int il = 16 * w + fr;
        const bf16x8 Bq0 = ldfrag(Qs, 16 * w, 0, 72, lane), Bq1 = ldfrag(Qs, 16 * w, 32, 72, lane);
        const float l2g0 = lg0 * 1.4426950408889634f, l2g1 = lg1 * 1.4426950408889634f;
#pragma unroll
        for (int jb = 0; jb < 8; ++jb) { f32x4 acc = (f32x4){0.f, 0.f, 0.f, 0.f};
            acc = MFMA16(ldfrag(Ks, 16 * jb, 0, 72, lane), Bq0, acc); acc = MFMA16(ldfrag(Ks, 16 * jb, 32, 72, lane), Bq1, acc);
            float pv[4];
#pragma unroll
            for (int r = 0; r < 4; ++r) { const int j = 16 * jb + 4 * q + r; const int dd = il - j;
                const float df = dd >= 0 ? __builtin_amdgcn_exp2f(l2g0 * (float)dd) : 0.f, dbk = dd <= 0 ? __builtin_amdgcn_exp2f(l2g1 * (float)(-dd)) : 0.f;
                pv[r] = acc[r] * (df + dbk); }
            u32x2 pw; pw.x = pg8::cvt_pk_bf16(pv[0], pv[1]); pw.y = pg8::cvt_pk_bf16(pv[2], pv[3]); *(LAS u32x2*)(Ps + fr * 136 + 16 * jb + 4 * q) = pw; }
        LDS_WAIT(); asm volatile("" ::: "memory");
        const bf16* gp = proj + (rb + il) * LDP + C_BG + h * 128 + 4 * q;
        u32x2 gwv[4];
#pragma unroll
        for (int eb = 0; eb < 4; ++eb) gwv[eb] = *(const u32x2*)(gp + 16 * eb);
        f32x4 Y[8];
#pragma unroll
        for (int eb = 0; eb < 8; ++eb) Y[eb] = (f32x4){0.f, 0.f, 0.f, 0.f};
#pragma unroll
        for (int ks = 0; ks < 4; ++ks) { const bf16x8 bp = ldfrag(Ps, 0, 32 * ks, 136, lane); bf16x8 av[4];
            tr_frags4<272>(vlane + ks * 32 * 272, av);
#pragma unroll
            for (int eb = 0; eb < 4; ++eb) Y[eb] = MFMA16(av[eb], bp, Y[eb]);
            tr_frags4<272>(vlane + ks * 32 * 272 + 128, av);
#pragma unroll
            for (int eb = 0; eb < 4; ++eb) Y[4 + eb] = MFMA16(av[eb], bp, Y[4 + eb]); }
        const float qf = __builtin_amdgcn_exp2f(l2g0 * (float)(il + 1)), qbw = __builtin_amdgcn_exp2f(l2g1 * (float)(128 - il));
#pragma unroll
        for (int eb = 0; eb < 8; ++eb) { f32x4 zf = (f32x4){0.f, 0.f, 0.f, 0.f}, zb = zf;
            zf = MFMA16(ldfrag(Ss, 16 * eb, 0, 72, lane), Bq0, zf); zf = MFMA16(ldfrag(Ss, 16 * eb, 32, 72, lane), Bq1, zf);
            zb = MFMA16(ldfrag(Ss, 128 + 16 * eb, 0, 72, lane), Bq0, zb); zb = MFMA16(ldfrag(Ss, 128 + 16 * eb, 32, 72, lane), Bq1, zb);
            Y[eb] = Y[eb] + zf * qf + zb * qbw; }
        float s = 0.f;
#pragma unroll
        for (int eb = 0; eb < 8; ++eb) s += (Y[eb][0] + Y[eb][1]) + (Y[eb][2] + Y[eb][3]);
        s += __shfl_xor(s, 16); s += __shfl_xor(s, 32);
        const float mu = s * (1.0f / 128.0f); float vq = 0.f;
#pragma unroll
        for (int eb = 0; eb < 8; ++eb) { const f32x4 d = Y[eb] - mu; vq += (d[0] * d[0] + d[1] * d[1]) + (d[2] * d[2] + d[3] * d[3]); }
        vq += __shfl_xor(vq, 16); vq += __shfl_xor(vq, 32);
        const float rstd = __builtin_amdgcn_rsqf(vq * (1.0f / 128.0f) + EPS);
        bf16* yo = F_YB(F) + (rb + il) * 3072 + 1024 + h * 128 + 4 * q;
        u32x2 gw2[4];
#pragma unroll
        for (int eb = 0; eb < 4; ++eb) gw2[eb] = *(const u32x2*)(gp + 16 * (4 + eb));
#pragma unroll
        for (int eb = 0; eb < 8; ++eb) { const u32x2 gw = eb < 4 ? gwv[eb & 3] : gw2[eb & 3]; const f32x4 yn = (Y[eb] - mu) * rstd;
            u32x2 o; o.x = pg8::cvt_pk_bf16(gm::fsilu_(bflo(gw.x)) * yn[0], gm::fsilu_(bfhi(gw.x)) * yn[1]); o.y = pg8::cvt_pk_bf16(gm::fsilu_(bflo(gw.y)) * yn[2], gm::fsilu_(bfhi(gw.y)) * yn[3]);
            if (F.wr) *(u32x2*)(yo + 16 * eb) = o; }
    }
#undef R2_LOAD
#undef R2_DECODE
}
__device__ __forceinline__ void att_rope_keys(Frame& F) {
    bf16* proj = F_PROJ(F); const f32x2* atab = (const f32x2*)(F.ws + WS_ROPE + 1 * MiB);
    for (int i = F.bid * 512 + F.tid; i < NLAT * 16; i += F.G * 512) { const int pr = i & 3, g = (i >> 2) & 3, row = i >> 4; const int c = (pr & 1) + 4 * (pr >> 1);
        bf16* src = proj + (size_t)row * LDP + C_CK + g * 64 + 8 * c;
        float x1[8], x2[8], o1[8], o2[8]; unpack8(*(const u32x4*)src, x1); unpack8(*(const u32x4*)(src + 16), x2);
        const int pos = row & (SEQ - 1); const int ap = (pr >> 1) ? (pos & 63) : (pos >> 6); att_rope8(atab + ap * 16 + 8 * (pr & 1), x1, x2, o1, o2);
        if (F.wr) { *(u32x4*)src = pack8(o1, 1.0f); *(u32x4*)(src + 16) = pack8(o2, 1.0f); } }
}
__device__ __forceinline__ void att_unit(Frame& F, int l, int b, int g, int qb, bool isctxq) {
    LAS bf16* Kt = (LAS bf16*)F.lds;
    LAS bf16* Vt = Kt + 64 * 72;
    LAS bf16* Pw = Vt + 64 * 72 + F.wave * (64 * 72);
    const int tid = F.tid, lane = F.lane, w = F.wave, q = lane >> 4, fr = lane & 15;
    const bf16* proj = F_PROJ(F); const f32x2* atab = (const f32x2*)(F.ws + WS_ROPE + 1 * MiB);
    const int hq = 4 * g + (w >> 1);
    const size_t qrow0 = (isctxq ? (size_t)NLAT + b * LCX : (size_t)b * SEQ) + qb * 128 + (w & 1) * 64;
    const int qpos0 = qb * 128 + (w & 1) * 64;
    constexpr float QS = 0.125f * 1.4426950408889634f;
    unsigned vmask = 0xFu;
    if (!isctxq) {
#pragma unroll
        for (int t = 4; t < 10; ++t) { const int kp = qb * 128 - 128 + 64 * (t - 4); if (kp >= 0 && kp < SEQ) vmask |= 1u << t; } }
    const int vrow = tid >> 3, vc8 = tid & 7;
    u32x4 kx = (u32x4){0u, 0u, 0u, 0u}, vx = kx;
#define ATT_KROW0(t) ((t) >= 4 ? (size_t)b * SEQ + (qb * 128 - 128 + 64 * ((t) - 4)) : (size_t)NLAT + b * LCX + 64 * (t))
#define ATT_LOAD(t) do { const size_t kr0_ = ATT_KROW0(t); kx = *(const u32x4*)(proj + (kr0_ + vrow) * LDP + C_CK + g * 64 + 8 * vc8); \
        vx = *(const u32x4*)(proj + (kr0_ + vrow) * LDP + C_CV + g * 64 + 8 * vc8); } while (0)
    int t = __builtin_ctz(vmask); vmask &= vmask - 1;
    ATT_LOAD(t);
    LDS_BARRIER();
#pragma unroll
    for (int i = 0; i < 4; ++i) { const int tt = lane + 64 * i, row = tt >> 2, pr = tt & 3;
        const int c = (pr & 1) + 4 * (pr >> 1); const bf16* src = proj + (qrow0 + row) * LDP + C_CQ + hq * 64;
        float x1[8], x2[8], o1[8], o2[8]; unpack8(*(const u32x4*)(src + 8 * c), x1); unpack8(*(const u32x4*)(src + 8 * c + 16), x2);
        if (!isctxq) { const int pos = qpos0 + row; const int ap = (pr >> 1) ? (pos & 63) : (pos >> 6); att_rope8(atab + ap * 16 + 8 * (pr & 1), x1, x2, o1, o2); }
        else {
#pragma unroll
            for (int e = 0; e < 8; ++e) { o1[e] = x1[e]; o2[e] = x2[e]; } }
        *(LAS u32x4*)(Pw + row * 72 + 8 * c) = pack8(o1, QS); *(LAS u32x4*)(Pw + row * 72 + 8 * c + 16) = pack8(o2, QS); }
    LDS_WAIT(); asm volatile("" ::: "memory");
    bf16x8 Bq[4][2];
#pragma unroll
    for (int ib = 0; ib < 4; ++ib)
#pragma unroll
        for (int ks = 0; ks < 2; ++ks) Bq[ib][ks] = ldfrag(Pw, 16 * ib, 32 * ks, 72, lane);
    LDS_WAIT(); asm volatile("" ::: "memory");
    const float sink = FIN(I_SINK)[l * 16 + hq] * 1.4426950408889634f;
    float mrow[4], lrow[4]; f32x4 O[4][4];
#pragma unroll
    for (int ib = 0; ib < 4; ++ib) { mrow[ib] = sink; lrow[ib] = (q == 0) ? 1.0f : 0.0f;
#pragma unroll
        for (int db = 0; db < 4; ++db) O[db][ib] = (f32x4){0.f, 0.f, 0.f, 0.f}; }
    const unsigned vt_lane = (unsigned)(size_t)Vt + (unsigned)((8 * q + (fr >> 2)) * 144 + (fr & 3) * 8);
#pragma unroll 1
    for (;;) {
        const int kpos0 = t >= 4 ? (qb * 128 - 128 + 64 * (t - 4)) : 0;
        LDS_BARRIER();
        *(LAS u32x4*)(Kt + vrow * 72 + 8 * vc8) = kx;
        *(LAS u32x4*)(Vt + vrow * 72 + 8 * vc8) = vx;
        LDS_BARRIER();
        const int tcur = t; const bool more = vmask != 0u;
        if (more) { t = __builtin_ctz(vmask); vmask &= vmask - 1; ATT_LOAD(t); }
        const bool skipt = !isctxq && tcur == ((w & 1) ? 4 : 9);
        const bool maskt = !isctxq && (tcur == ((w & 1) ? 5 : 4) || tcur == ((w & 1) ? 9 : 8));
        if (!skipt) {
#pragma unroll
        for (int hf = 0; hf < 2; ++hf) {
            f32x4 S[4][2];
#pragma unroll
            for (int jb = 0; jb < 4; ++jb) { const bf16x8 a0 = ldfrag(Kt, 16 * jb, 0, 72, lane), a1 = ldfrag(Kt, 16 * jb, 32, 72, lane);
#pragma unroll
                for (int i2 = 0; i2 < 2; ++i2) { f32x4 acc = (f32x4){0.f, 0.f, 0.f, 0.f}; acc = MFMA16(a0, Bq[2 * hf + i2][0], acc); acc = MFMA16(a1, Bq[2 * hf + i2][1], acc); S[jb][i2] = acc; } }
            if (maskt) {
#pragma unroll
                for (int jb = 0; jb < 4; ++jb)
#pragma unroll
                    for (int i2 = 0; i2 < 2; ++i2)
#pragma unroll
                        for (int r = 0; r < 4; ++r) { const int dd = (qpos0 + 16 * (2 * hf + i2) + fr) - (kpos0 + 16 * jb + 4 * q + r); if (dd > 128 || dd < -128) S[jb][i2][r] = -1.0e30f; }
            }
#pragma unroll
            for (int i2 = 0; i2 < 2; ++i2) { const int ib = 2 * hf + i2;
                float mx = -1.0e30f;
#pragma unroll
                for (int jb = 0; jb < 4; ++jb) mx = fmaxf(mx, fmaxf(fmaxf(S[jb][i2][0], S[jb][i2][1]), fmaxf(S[jb][i2][2], S[jb][i2][3])));
                mx = fmaxf(mx, __shfl_xor(mx, 16)); mx = fmaxf(mx, __shfl_xor(mx, 32));
                const float mn = fmaxf(mrow[ib], mx); const float alpha = __builtin_amdgcn_exp2f(mrow[ib] - mn); mrow[ib] = mn;
                float ps = 0.f;
#pragma unroll
                for (int jb = 0; jb < 4; ++jb) { float p[4];
#pragma unroll
                    for (int r = 0; r < 4; ++r) { p[r] = __builtin_amdgcn_exp2f(S[jb][i2][r] - mn); ps += p[r]; }
                    u32x2 pw; pw.x = pk2(p[0], p[1]); pw.y = pk2(p[2], p[3]); *(LAS u32x2*)(Pw + (16 * ib + fr) * 72 + 16 * jb + 4 * q) = pw; }
                lrow[ib] = lrow[ib] * alpha + ps;
#pragma unroll
                for (int db = 0; db < 4; ++db) O[db][ib] = O[db][ib] * alpha;
            }
        }
        LDS_WAIT(); asm volatile("" ::: "memory");
#pragma unroll
        for (int ks = 0; ks < 2; ++ks) { bf16x8 av[4], bp[4];
            tr_frags4<144>(vt_lane + ks * 32 * 144, av); __builtin_amdgcn_sched_barrier(0);
#pragma unroll
            for (int ib = 0; ib < 4; ++ib) bp[ib] = ldfrag(Pw, 16 * ib, 32 * ks, 72, lane);
#pragma unroll
            for (int db = 0; db < 4; ++db)
#pragma unroll
                for (int ib = 0; ib < 4; ++ib) O[db][ib] = MFMA16(av[db], bp[ib], O[db][ib]); }
        LDS_WAIT(); asm volatile("" ::: "memory");
        }
        if (!more) break;
    }
#undef ATT_LOAD
#undef ATT_KROW0
#pragma unroll
    for (int ib = 0; ib < 4; ++ib) { float lt = lrow[ib]; lt += __shfl_xor(lt, 16); lt += __shfl_xor(lt, 32); const float inv = __builtin_amdgcn_rcpf(lt);
        bf16* dst = F_YB(F) + (qrow0 + 16 * ib + fr) * 3072 + 2048 + hq * 64 + 4 * q;
#pragma unroll
        for (int db = 0; db < 4; ++db) { const f32x4 o = O[db][ib] * inv; u32x2 ow; ow.x = pg8::cvt_pk_bf16(o[0], o[1]); ow.y = pg8::cvt_pk_bf16(o[2], o[3]); if (F.wr) *(u32x2*)(dst + 16 * db) = ow; } }
}
#ifndef PROBE_MASK
#define PROBE_MASK 0
#endif
#ifndef PROBE_SUB
#define PROBE_SUB 0
#endif
#ifdef PROBE_REAL
#define WR_DRY wr_true
#else
#define WR_DRY wr_false
#endif
#define NREP(n) (((PROBE_MASK >> (n)) & 1) ? 2 : 1)
#ifndef DIAG_PH
#define PHON(n) true
#else
#define PHON(n) ((n) == DIAG_PH)
#endif
constexpr int N_PHASES = 2 + 10 * DEPTH;
__global__ void __launch_bounds__(512, 2) fwd_kernel(Args args) {
    extern __shared__ __attribute__((aligned(16))) unsigned char lds_raw[];
    Frame F; F.lds = (LAS unsigned char*)lds_raw; F.tid = threadIdx.x; F.lane = F.tid & 63; F.wave = __builtin_amdgcn_readfirstlane(F.tid >> 6);
    F.G = gridDim.x; F.bid = blockIdx.x; F.gw = F.bid * 8 + F.wave; F.NGW = F.G * 8; F.in = (const __attribute__((address_space(4))) cfp_t*)__builtin_amdgcn_kernarg_segment_ptr(); F.out = args.out; F.ws = args.ws;
    volatile LAS unsigned* MISC = (volatile LAS unsigned*)(F.lds + MISC_OFF);
    for (int u = F.tid; u < (LDS_BYTES - LDS_CTL) / 4; u += 512) ((LAS unsigned*)(F.lds + LDS_CTL))[u] = 0u;
    __syncthreads();
    unsigned* ctl = (unsigned*)(F.ws + WS_CTL);
#if MK_N_LAUNCHES == 1
    XcdBarrier bar = xcd_barrier_post(ctl + CW_BAR, MISC + 8, gridDim.x);
    XcdBarrier sbar = xcd_barrier_post(ctl + (blockIdx.x < 32 ? CW_BAR_C : CW_BAR_L), MISC + 12, blockIdx.x < 32 ? 32u : gridDim.x - 32u);
#define SUB_BAR() do { GAS unsigned* _bp = (GAS unsigned*)sbar.bar; asm volatile("" : "+s"(_bp)); XcdBarrier _b2 = sbar; _b2.bar = (unsigned*)_bp; xcd_barrier(_b2); } while (0)
#define GRID_BAR() do { GAS unsigned* _bp = (GAS unsigned*)bar.bar; asm volatile("" : "+s"(_bp)); XcdBarrier _b2 = bar; _b2.bar = (unsigned*)_bp; xcd_barrier(_b2); } while (0)
#else
#define GRID_BAR() do {} while (0)
#define SUB_BAR() do {} while (0)
#endif
    const int wave0 = F.wave; const bool wr_true = args.ph_hi > 0, wr_false = args.ph_hi < 0; F.wr = wr_true;
    const int lo = args.ph_lo, hi = args.ph_hi;
#define FRESH() do { LAS unsigned char* _l = (LAS unsigned char*)lds_raw; asm volatile("" : "+s"(_l)); F.lds = _l; int _ln; asm volatile("v_mbcnt_lo_u32_b32 %0, -1, 0\n\tv_mbcnt_hi_u32_b32 %0, -1, %0" : "=v"(_ln)); F.tid = wave0 * 64 + _ln; F.lane = _ln; F.wave = wave0; F.gw = F.bid * 8 + F.wave; \
        GAS unsigned char* _ws = (GAS unsigned char*)args.ws; asm volatile("" : "+s"(_ws)); F.ws = (unsigned char*)_ws; GAS float* _out = (GAS float*)args.out; asm volatile("" : "+s"(_out)); F.out = (float*)_out; \
        const __attribute__((address_space(4))) cfp_t* _in = (const __attribute__((address_space(4))) cfp_t*)__builtin_amdgcn_kernarg_segment_ptr(); asm volatile("" : "+s"(_in)); F.in = _in; } while (0)
#define IN(k) (lo <= (k) && (k) < hi)
#define SEAM(k) do { if (IN(k) && IN((k) + 1)) GRID_BAR(); } while (0)
    if (PHON(0) && IN(0)) for (int rep_ = NREP(0); rep_ > 0; --rep_) { FRESH(); F.wr = (rep_ == 1) ? wr_true : WR_DRY; if (NREP(0) > 1) GRID_BAR(); ph_prologue(F); } SEAM(0);
    if (PHON(1) && IN(1)) for (int rep_ = NREP(1); rep_ > 0; --rep_) { FRESH(); F.wr = (rep_ == 1) ? wr_true : WR_DRY; if (NREP(1) > 1) GRID_BAR(); ph_convert(F, 0); ph_rows_u(F, 0, true); ph_router_fold(F); } SEAM(1);
#pragma unroll 1
    for (int l = 0; l < DEPTH; ++l) {
        const int pb = 2 + 10 * l; const bool lastl = (l == DEPTH - 1); const int nM2 = lastl ? 128 : 136; const int ntok = lastl ? NLAT : NTOK;
        unsigned char* wt = F.ws + WS_WT;
        if (PHON(2) && IN(pb + 0)) for (int rep_ = NREP(2); rep_ > 0; --rep_) { FRESH(); F.wr = (rep_ == 1) ? wr_true : WR_DRY; if (NREP(2) > 1) GRID_BAR();
            gm::SchedPlain<16, 1024> S; S.init(136, 38, F.G, F.bid); S.A = (const char*)(F.ws + WS_X); S.Bt = (const char*)(wt + WT_IN);
            gm::EpiProj E{F_PROJ(F), F.ws + WS_GT}; pg8::gemm_phase(F.lds, S, E, F.tid);
        } SEAM(pb + 0);
        if (PHON(3) && IN(pb + 1)) for (int rep_ = NREP(3); rep_ > 0; --rep_) { FRESH(); F.wr = (rep_ == 1) ? wr_true : WR_DRY; if (NREP(3) > 1) GRID_BAR();
            if (!(rep_ > 1 && PROBE_SUB == 2)) for (int u = F.bid; u < 256; u += F.G) { const int hu = ((u >> 4) << 3) + (u & 7); lru_unit(F, l, hu >> 4, hu & 15, (u >> 3) & 1); }
            if (!(rep_ > 1 && PROBE_SUB == 1)) { __syncthreads(); ph_ret_r1(F, l); __syncthreads(); }
            att_rope_keys(F);
        } SEAM(pb + 1);
        if (PHON(4) && IN(pb + 2)) for (int rep_ = NREP(4); rep_ > 0; --rep_) { FRESH(); F.wr = (rep_ == 1) ? wr_true : WR_DRY; if (NREP(4) > 1) GRID_BAR();
            if (!(rep_ > 1 && PROBE_SUB == 2)) ret_scan(F, l);
            if (!(rep_ > 1 && PROBE_SUB == 1))
            for (int u = F.bid; u < (lastl ? 1024 : 1088); u += F.G) { const bool cq = u >= 1024; const int v = u - 1024;
                int ab = cq ? (v >> 3) : (u >> 7), ag = cq ? ((v >> 1) & 3) : ((u >> 5) & 3), aq = cq ? (v & 1) : (u & 31);
                if (F.G == 256) { const int x = F.bid & 7, y = F.bid >> 3;
                    ab = x; ag = cq ? (y >> 1) : (u >> 8); aq = cq ? (y & 1) : y; }
                att_unit(F, l, ab, ag, aq, cq); }
        } SEAM(pb + 2);
        if (PHON(5) && IN(pb + 3)) for (int rep_ = NREP(5); rep_ > 0; --rep_) { FRESH(); F.wr = (rep_ == 1) ? wr_true : WR_DRY; if (NREP(5) > 1) GRID_BAR();
            ph_ret_r2(F, l, lastl);
        } SEAM(pb + 3);
#ifdef PROBE_MERGE_K
        if (IN(pb + 4)) { FRESH(); GRID_BAR();
            gm::SchedPlain<PROBE_MERGE_K, 3072> S; S.init(nM2, 4, F.G, F.bid); S.A = (const char*)(F.ws + WS_YB); S.Bt = (const char*)(wt + WT_BR);
            gm::EpiPlain E{(bf16*)(F.ws + WS_KV)}; pg8::gemm_phase(F.lds, S, E, F.tid); GRID_BAR(); }
#endif
        const bool split = !lastl && gridDim.x == 256 && MK_N_LAUNCHES == 1;
        if (PHON(6) && IN(pb + 4)) for (int rep_ = NREP(6); rep_ > 0; --rep_) { FRESH(); F.wr = (rep_ == 1) ? wr_true : WR_DRY; if (NREP(6) > 1) GRID_BAR();
            gm::SchedPlain<48, 3072> S; S.init(split ? 128 : nM2, 4, F.G, F.bid); S.A = (const char*)(F.ws + WS_YB); S.Bt = (const char*)(wt + WT_BR);
            gm::EpiMerge E{F.ws + WS_GT, F_X(F)}; pg8::gemm_phase(F.lds, S, E, F.tid);
        } SEAM(pb + 4);
        if (IN(pb + 5)) { FRESH(); F.wr = wr_true;
            const bool cgrp = split && F.bid < 32;
            if (cgrp) {
                gm::SchedPlain<48, 3072, gm::OrderSub> S; S.init(8, 4, 32, F.bid, 128, true); S.A = (const char*)(F.ws + WS_YB); S.Bt = (const char*)(wt + WT_BR);
                gm::EpiMerge E{F.ws + WS_GT, F_X(F)}; pg8::gemm_phase(F.lds, S, E, F.tid);
                SUB_BAR(); FRESH();
            }
            {
                gm::SchedPlain<16, 1024, gm::OrderSub> S; S.init(split ? (cgrp ? 8 : 128) : nM2, 4, split ? (cgrp ? 32 : 224) : F.G, split && !cgrp ? F.bid - 32 : F.bid, cgrp ? 128 : 0, true);
                S.A = (const char*)(F.ws + WS_X); S.Bt = (const char*)(wt + WT_WO);
                gm::EpiWo E{F.out, F_HC(F), F_MOD(F) + (size_t)l * 9 * 6144, F.wr, l == 0 ? (const float*)FIN(I_X) : (const float*)F.out, l == 0 ? (const float*)FIN(I_CTX) : (const float*)F_HC(F)}; pg8::gemm_phase(F.lds, S, E, F.tid);
            }
        }
        if (split) { if (IN(pb + 5) && IN(pb + 6)) SUB_BAR(); } else SEAM(pb + 5);
        if (PHON(8) && IN(pb + 6)) for (int rep_ = NREP(8); rep_ > 0; --rep_) { FRESH(); F.wr = (rep_ == 1) ? wr_true : WR_DRY; if (NREP(8) > 1) GRID_BAR();
            const bool cgrp = split && F.bid < 32;
            const int row0 = cgrp ? NLAT : 0, row1 = split && !cgrp ? NLAT : ntok, gc = split && !cgrp ? F.bid - 32 : F.bid, gn = split ? (cgrp ? 32 : 224) : F.G;
            if (!(rep_ > 1 && PROBE_SUB == 2)) ph_rows_v(F, l, row0, row1, gc * 8 + F.wave, gn * 8);
            if (!(rep_ > 1 && PROBE_SUB == 1)) ph_router(F, l, row0 / 128, row1 / 128, gc, gn);
        } SEAM(pb + 6);
        if (PHON(9) && IN(pb + 7)) for (int rep_ = NREP(9); rep_ > 0; --rep_) { FRESH(); F.wr = (rep_ == 1) ? wr_true : WR_DRY; if (NREP(9) > 1) GRID_BAR();
            volatile LAS int* tileoff; volatile LAS int* cntl; moe_tables(F, l, tileoff, cntl);
            gm::SchedMoe<16, true> S; S.tileoff = tileoff; S.cnt = cntl; S.G = F.G; S.c = F.bid; S.nunits = tileoff[32] * 4; S.wsbase = (const char*)F.ws; S.rowtok = (const int*)(F.ws + WS_ROWTOK);
            S.A = nullptr; S.Bt = (const char*)(wt + WT_GU);
            gm::EpiGU E{(bf16*)(F.ws + WS_HROWS)}; pg8::gemm_phase(F.lds, S, E, F.tid);
        } SEAM(pb + 7);
        if (PHON(10) && IN(pb + 8)) for (int rep_ = NREP(10); rep_ > 0; --rep_) { FRESH(); F.wr = (rep_ == 1) ? wr_true : WR_DRY; if (NREP(10) > 1) GRID_BAR();
            volatile LAS int* tileoff; volatile LAS int* cntl; moe_tables(F, l, tileoff, cntl);
            gm::SchedMoe<8, false> S; S.tileoff = tileoff; S.cnt = cntl; S.G = F.G; S.c = F.bid; S.nunits = tileoff[32] * 4; S.wsbase = (const char*)F.ws; S.rowtok = nullptr;
            S.A = (const char*)(F.ws + WS_HROWS); S.Bt = (const char*)(wt + WT_DN);
            gm::EpiDN E{(bf16*)(F.ws + WS_YROWS)}; pg8::gemm_phase(F.lds, S, E, F.tid);
        } SEAM(pb + 8);
        if (PHON(11) && IN(pb + 9)) for (int rep_ = NREP(11); rep_ > 0; --rep_) { FRESH(); F.wr = (rep_ == 1) ? wr_true : WR_DRY; if (NREP(11) > 1) GRID_BAR();
            if (!(rep_ > 1 && PROBE_SUB == 2)) ph_combine(F, l, ntok);
            if (!lastl && !(rep_ > 1 && PROBE_SUB == 1)) ph_convert(F, l + 1);
        } if (!lastl) SEAM(pb + 9);
    }
#undef IN
#undef SEAM
}

extern "C" void kernel_launch(void* const* d_in, const int* in_sizes, int n_in, void* d_out, int out_size, void* d_ws, size_t ws_size, hipStream_t stream) {
    static int grid = 0;
    if (grid == 0) {
        if (n_in != 30 || out_size != NLAT * D || ws_size < WS_END) { fprintf(stderr, "kernel_launch: unexpected shapes (n_in %d out %d ws %zu, need %zu)\n", n_in, out_size, ws_size, (size_t)WS_END); grid = -1; return; }
        int dev = 0, cus = 0;
        if (hipGetDevice(&dev) != hipSuccess || hipDeviceGetAttribute(&cus, hipDeviceAttributeMultiprocessorCount, dev) != hipSuccess) { grid = -1; return; }
        if (hipFuncSetAttribute((const void*)fwd_kernel, hipFuncAttributeMaxDynamicSharedMemorySize, LDS_BYTES) != hipSuccess) { fprintf(stderr, "kernel_launch: hipFuncSetAttribute failed\n"); grid = -1; return; }
        int per_cu = 0;
        if (hipOccupancyMaxActiveBlocksPerMultiprocessor(&per_cu, (const void*)fwd_kernel, 512, LDS_BYTES) != hipSuccess || per_cu < 1) { fprintf(stderr, "kernel_launch: occupancy query says %d\n", per_cu); }
        (void)hipGetLastError();
        grid = cus;
    }
    if (grid < 0) return;
    (void)hipMemsetAsync((char*)d_ws + WS_CTL, 0, CTL_BYTES, stream);
#ifdef DIAG_ZERO_GT
    (void)hipMemsetAsync((char*)d_ws + WS_GT, 0x3f, (size_t)204 * MiB, stream);
#endif
    Args a{};
    for (int i = 0; i < 30; ++i) a.in[i] = (const float*)d_in[i];
    a.out = (float*)d_out; a.ws = (unsigned char*)d_ws;
#if MK_N_LAUNCHES == 1
    a.ph_lo = 0; a.ph_hi = N_PHASES;
    hipLaunchKernelGGL(fwd_kernel, dim3(grid), dim3(512), LDS_BYTES, stream, a);
#else
    for (int p = 0; p < N_PHASES; ++p) { a.ph_lo = p; a.ph_hi = p + 1; hipLaunchKernelGGL(fwd_kernel, dim3(grid), dim3(512), LDS_BYTES, stream, a); }
#endif
}
```

```cpp
#include <hip/hip_runtime.h>
#include <cstdio>
#include <cstdint>

#define LAS __attribute__((address_space(3)))
#define GAS __attribute__((address_space(1)))
typedef unsigned short bf16;
typedef short bf16x8 __attribute__((ext_vector_type(8)));
typedef float f32x4 __attribute__((ext_vector_type(4)));
typedef float f32x2 __attribute__((ext_vector_type(2)));
typedef unsigned u32x4 __attribute__((ext_vector_type(4)));
typedef unsigned u32x2 __attribute__((ext_vector_type(2)));

#ifndef MK_N_LAUNCHES
#define MK_N_LAUNCHES 1
#endif

constexpr int D = 1024, NB = 8, SEQ = 4096, LCX = 256, DEPTH = 4;
constexpr int NLAT = NB * SEQ, NCTX = NB * LCX, NTOK = NLAT + NCTX;
constexpr int DIN = 9728;
constexpr int LDP = 6720;
constexpr int C_AX = 0, C_AY = 1024, C_BQ = 2048, C_BK = 2560, C_BV = 3072, C_BG = 4096, C_CQ = 5120, C_CK = 6144, C_CV = 6400, C_GA = 6656;
constexpr int NMOD = 6, NMB = 9;
constexpr int NEXP = 32, DEXP = 512, RCOLS = 36;
constexpr int PMAX = 77824;
constexpr float EPS = 1e-6f;

constexpr size_t MiB = 1u << 20;
constexpr size_t WS_CTL = 0, CTL_BYTES = 1 * MiB;
constexpr size_t WS_MOD = 1 * MiB;
constexpr size_t WS_ROPE = 2 * MiB;
constexpr size_t WS_RW = 4 * MiB;
constexpr size_t WS_HC = 12 * MiB;
constexpr size_t WS_TOKINFO = 20 * MiB;
constexpr size_t WS_ROWTOK = 22 * MiB;
constexpr size_t WS_WT = 28 * MiB;
constexpr size_t WT_IN = 0, WT_BR = 19 * MiB, WT_WO = 25 * MiB, WT_GU = 27 * MiB, WT_DN = 91 * MiB, WT_BYTES = 123 * MiB;
constexpr size_t WS_X = 152 * MiB;
constexpr size_t WS_KV = 220 * MiB;
constexpr size_t WS_PROJ = 288 * MiB;
constexpr size_t WS_HROWS = WS_PROJ;
constexpr size_t WS_YROWS = WS_PROJ + 80 * MiB;
constexpr size_t WS_GT = 736 * MiB;
constexpr size_t WS_YB = 940 * MiB;
constexpr size_t WS_END = 1144 * MiB;
static_assert(WS_PROJ + (size_t)NTOK * LDP * 2 <= WS_GT && WS_GT + (size_t)3 * NTOK * 1024 * 2 <= WS_YB, "ws map");
constexpr int CW_BAR = 1024;
constexpr int CW_BAR_L = 20480, CW_BAR_C = 24576;
constexpr int CW_CNT = 8192;
constexpr size_t CTL_ZROW = 64 * 1024;

constexpr int LDS_BYTES = 163840;
constexpr int LDS_CTL = 155648;
constexpr int MISC_OFF = LDS_CTL + 320;

__device__ __forceinline__ unsigned f2bf(float f) { unsigned u = __builtin_bit_cast(unsigned, f); return (u + 0x7fffu + ((u >> 16) & 1u)) >> 16; }
typedef __bf16 bf16x2_t __attribute__((ext_vector_type(2)));
__device__ __forceinline__ unsigned pk2(float lo, float hi) { const f32x2 v = {lo, hi}; return __builtin_bit_cast(unsigned, __builtin_convertvector(v, bf16x2_t)); }
__device__ __forceinline__ float bf2f(unsigned b) { return __builtin_bit_cast(float, b << 16); }
__device__ __forceinline__ float bflo(unsigned w) { return __builtin_bit_cast(float, w << 16); }
__device__ __forceinline__ float bfhi(unsigned w) { return __builtin_bit_cast(float, w & 0xffff0000u); }
__device__ __forceinline__ float wave_sum(float v) {
#pragma unroll
    for (int o = 1; o < 64; o <<= 1) v += __shfl_xor(v, o);
    return v;
}
__device__ __forceinline__ float sigmoidf_(float x) { return 1.0f / (1.0f + __expf(-x)); }
__device__ __forceinline__ float siluf_(float x) { return x / (1.0f + __expf(-x)); }
__device__ __forceinline__ float gelu_tanh(float x) {
    const float u = 0.7978845608028654f * (x + 0.044715f * x * x * x);
    return x / (1.0f + __expf(-2.0f * u));
}
__device__ __forceinline__ float log1p_fast(float x) { const float u = 1.0f + x; const float d = u - 1.0f; return d == 0.f ? x : __logf(u) * (x / d); }
__device__ __forceinline__ float expm1_fast(float x) { const float u = __expf(x); const float um1 = u - 1.0f; if (um1 == 0.f) return x; const float lu = __logf(u); return um1 == -1.0f ? -1.0f : um1 * (x / lu); }
#define LDS_BARRIER() do { asm volatile("s_waitcnt lgkmcnt(0)" ::: "memory"); __builtin_amdgcn_s_barrier(); asm volatile("" ::: "memory"); } while (0)
#define LDS_WAIT() asm volatile("s_waitcnt lgkmcnt(0)" ::: "memory")
#define VM_WAIT() asm volatile("s_waitcnt vmcnt(0)" ::: "memory")

#define XB_TMO      128
#define XB_XCNT(j)  (256  + 64 * (j))
#define XB_XSUB(j)  (1280 + 64 * (j))
#define XB_XGEN(j)  (2304 + 64 * (j))
#define XB_TOP      3328
#define XB_TOPGEN   3392
#define XCD_BAR_WORDS 3456
#define XB_SPIN_CAP (1u << 22)
__device__ __forceinline__ unsigned xb_ld(unsigned* p)              { return __hip_atomic_load(p, __ATOMIC_RELAXED, __HIP_MEMORY_SCOPE_AGENT); }
__device__ __forceinline__ unsigned xb_add(unsigned* p, unsigned v) { return __hip_atomic_fetch_add(p, v, __ATOMIC_RELAXED, __HIP_MEMORY_SCOPE_AGENT); }
__device__ __forceinline__ unsigned xb_xcc_id() { return (unsigned)__builtin_amdgcn_s_getreg((3 << 11) | 20) & 0xFu; }
#define XB_SPIN(cond, bar) do { unsigned _sp = 0; while (cond) { __builtin_amdgcn_s_sleep(1); \
    if ((++_sp & 255u) == 0u) { if (xb_ld(&(bar)[XB_TMO])) break; if (_sp > XB_SPIN_CAP) { atomicAdd(&(bar)[XB_TMO], 1u); break; } } } } while (0)
struct XcdBarrier { unsigned* bar; unsigned x; volatile LAS unsigned* st; unsigned G; };
__device__ __forceinline__ XcdBarrier xcd_barrier_post(unsigned* bar, volatile LAS unsigned* st, unsigned G) {
    XcdBarrier b; b.bar = bar; b.x = xb_xcc_id(); b.st = st; b.G = G;
    if (threadIdx.x == 0) (void)xb_add(&bar[XB_XCNT(b.x)], 1u);
    return b;
}
__device__ __forceinline__ void xcd_barrier_complete(unsigned* bar, unsigned x, unsigned G, unsigned& nloc, unsigned& nx) {
    unsigned sum, cnt, mine, sp = 0u;
    for (;;) {
        sum = 0u; cnt = 0u; mine = 0u;
#pragma unroll
        for (unsigned j = 0; j < 16; ++j) { const unsigned c = xb_ld(&bar[XB_XCNT(j)]); sum += c; cnt += (c > 0u) ? 1u : 0u; mine = (j == x) ? c : mine; }
        if (sum == G) break;
        __builtin_amdgcn_s_sleep(1);
        if ((++sp & 255u) == 0u) { if (xb_ld(&bar[XB_TMO])) break; if (sp > XB_SPIN_CAP) { atomicAdd(&bar[XB_TMO], 1u); break; } }
    }
    nloc = mine > 0u ? mine : 1u; nx = cnt > 0u ? cnt : 1u;
}
__device__ __forceinline__ void xcd_barrier(const XcdBarrier& b) {
    asm volatile("s_waitcnt vmcnt(0)" ::: "memory");
    __syncthreads();
    if (threadIdx.x == 0) {
        unsigned* bar = b.bar;
        __builtin_amdgcn_s_waitcnt(0);
        unsigned nloc = b.st[0], nx = b.st[1];
        if (nloc == 0u) { xcd_barrier_complete(bar, b.x, b.G, nloc, nx); b.st[0] = nloc; b.st[1] = nx; }
        const unsigned old = xb_add(&bar[XB_XSUB(b.x)], 1u);
        const unsigned gen = old / nloc;
        if (old + 1u == (gen + 1u) * nloc) {
            __builtin_amdgcn_fence(__ATOMIC_RELEASE, "agent");
            asm volatile("s_waitcnt vmcnt(0)" ::: "memory");
            const unsigned og = xb_add(&bar[XB_TOP], 1u);
            const unsigned tg = og / nx;
            if (og + 1u == (tg + 1u) * nx) xb_add(&bar[XB_TOPGEN], 1u);
            else XB_SPIN(xb_ld(&bar[XB_TOPGEN]) == tg, bar);
            __builtin_amdgcn_fence(__ATOMIC_ACQUIRE, "agent");
            xb_add(&bar[XB_XGEN(b.x)], 1u);
            asm volatile("s_waitcnt vmcnt(0)" ::: "memory");
        } else {
            XB_SPIN(xb_ld(&bar[XB_XGEN(b.x)]) == gen, bar);
            __builtin_amdgcn_fence(__ATOMIC_ACQUIRE, "agent");
            asm volatile("s_waitcnt vmcnt(0)" ::: "memory");
        }
    }
    __syncthreads();
}

namespace pg8 {
constexpr int BM = 256, BK = 64, HALF = 128, HTB = HALF * BK * 2, STAGE_BYTES = 8 * HTB;
__device__ __forceinline__ int lds_byte(int r, int c) { const int st = (r >> 4) * 2 + (c >> 5), rr = r & 15, cc = c & 31, ob = rr * 64 + cc * 2; return st * 1024 + (ob ^ (((ob >> 9) & 1) << 5)); }
__device__ __forceinline__ void stage_rc(int b, int& R, int& C) { const int st = b / 1024, sb = b % 1024, swz = sb ^ (((sb >> 9) & 1) << 5); R = (st >> 1) * 16 + swz / 64; C = (st & 1) * 32 + (swz % 64) / 2; }
__device__ __forceinline__ int perm32(int rho) { const int n = rho >> 4, i = rho & 15; return 8 * (i >> 2) + 4 * n + (i & 3); }
__device__ __forceinline__ unsigned cvt_pk_bf16(float lo, float hi) { return pk2(lo, hi); }

template <class Epi, class Sched>
__device__ __forceinline__ void gemm_phase(LAS unsigned char* lds, const Sched& S, const Epi& E, const int tid) {
    typedef typename Sched::Unit Unit;
    const int wid = __builtin_amdgcn_readfirstlane(tid >> 6), lane = tid & 63, wr = wid >> 2, wc = wid & 3, fr = lane & 15, fq = lane >> 4;
    constexpr int nt = Sched::KT; constexpr int K = nt * BK;
    int R[2], C[2]; unsigned voffB[2];
#pragma unroll
    for (int i = 0; i < 2; ++i) { stage_rc(tid * 16 + i * 8192, R[i], C[i]); const int Rb = Epi::PERM ? ((R[i] & ~31) + perm32(R[i] & 31)) : R[i]; voffB[i] = (unsigned)(Rb * K + C[i]) * 2u; }
    constexpr size_t kstep = (size_t)(BK * 2);
    constexpr size_t hstepB = (size_t)HALF * K * 2;
    const unsigned ldsw = (unsigned)wid * 1024u;
    const int aoff = lds_byte(wr * 64 + fr, fq * 8), boff = lds_byte(wc * 32 + fr, fq * 8);
#define PG8_SA(b, h) (((b) * 2 + (h)) * HTB)
#define PG8_SB(b, h) ((4 + (b) * 2 + (h)) * HTB)
#define PG8_STAGEA(bufoff, gbase, vv, h) do { _Pragma("unroll") for (int _i = 0; _i < 2; ++_i) \
        __builtin_amdgcn_global_load_lds((const unsigned*)((const char*)(gbase) + (vv)[h][_i]), (LAS unsigned*)(lds + (bufoff) + ldsw + _i * 8192), 16, 0, 0); } while (0)
#define PG8_STAGEB(bufoff, gbase) do { _Pragma("unroll") for (int _i = 0; _i < 2; ++_i) \
        __builtin_amdgcn_global_load_lds((const unsigned*)((const char*)(gbase) + voffB[_i]), (LAS unsigned*)(lds + (bufoff) + ldsw + _i * 8192), 16, 0, 0); } while (0)
#define PG8_LDA(dst, b, h) do { _Pragma("unroll") for (int m = 0; m < 4; ++m) _Pragma("unroll") for (int k = 0; k < 2; ++k) dst[m][k] = *(const LAS bf16x8*)(lds + PG8_SA(b, h) + aoff + m * 2048 + k * 1024); } while (0)
#define PG8_LDB(dst, b, h) do { _Pragma("unroll") for (int n = 0; n < 2; ++n) _Pragma("unroll") for (int k = 0; k < 2; ++k) dst[n][k] = *(const LAS bf16x8*)(lds + PG8_SB(b, h) + boff + n * 2048 + k * 1024); } while (0)
#define PG8_MMA(ai, bj, At, Bt) do { __builtin_amdgcn_s_setprio(1); _Pragma("unroll") for (int m = 0; m < 4; ++m) _Pragma("unroll") for (int n = 0; n < 2; ++n) _Pragma("unroll") for (int k = 0; k < 2; ++k) \
        acc[ai][bj][m][n] = __builtin_amdgcn_mfma_f32_16x16x32_bf16(Bt[n][k], At[m][k], acc[ai][bj][m][n], 0, 0, 0); __builtin_amdgcn_s_setprio(0); } while (0)
#define PG8_WAIT_V(n) asm volatile("s_waitcnt vmcnt(" #n ")" ::: "memory")
#define PG8_WAIT_L(n) asm volatile("s_waitcnt lgkmcnt(" #n ")" ::: "memory")
#define PG8_BAR __builtin_amdgcn_s_barrier()
#define PG8_SCHED __builtin_amdgcn_sched_barrier(0)
    Unit cur, nxt; int ui = 0;
    if (!S.next(0, cur)) return;
    f32x4 acc[2][2][4][2];
#pragma unroll
    for (int a = 0; a < 2; ++a)
#pragma unroll
        for (int b = 0; b < 2; ++b)
#pragma unroll
            for (int m = 0; m < 4; ++m)
#pragma unroll
                for (int n = 0; n < 2; ++n) acc[a][b][m][n] = (f32x4){0.f, 0.f, 0.f, 0.f};
    bf16x8 At[4][2], B0[2][2], B1[2][2];
    unsigned vA[2][2], vAn[2][2];
    S.a_voff(cur, tid, vA);
#pragma unroll
    for (int h = 0; h < 2; ++h)
#pragma unroll
        for (int i = 0; i < 2; ++i) vAn[h][i] = vA[h][i];
    const char* cA = S.a_base(cur); const char* cB = S.b_base(cur);
    { const char* a0 = cA + S.a_koff(0); const char* a1p = cA + S.a_koff(1);
      PG8_STAGEB(PG8_SB(0, 0), cB); PG8_STAGEB(PG8_SB(0, 1), cB + hstepB); PG8_STAGEA(PG8_SA(0, 0), a0, vA, 0); PG8_STAGEA(PG8_SA(0, 1), a0, vA, 1);
      if (wr == 1) PG8_BAR;
      PG8_WAIT_V(2); PG8_BAR;
      PG8_STAGEB(PG8_SB(1, 0), cB + kstep); PG8_STAGEA(PG8_SA(1, 0), a1p, vA, 0); PG8_STAGEB(PG8_SB(1, 1), cB + hstepB + kstep);
      PG8_WAIT_V(6); PG8_BAR; }
    for (;;) {
        const bool has_next = S.next(ui + 1, nxt);
        const char* nA = cA; const char* nB = cB;
        if (has_next) { nA = S.a_base(nxt); nB = S.b_base(nxt); }
#pragma unroll 1
        for (int t = 0; t < nt; t += 2) {
            const bool last = (t == nt - 2);
            if constexpr (Epi::MIDK) { if (t == 16 || t == 32) E.mid(acc, cur, t, wr, wc, fr, fq); }
            if constexpr (Sched::GATHER) { if (t == nt - 4 && has_next) S.a_voff(nxt, tid, vAn); }
            const char* a1 = cA + S.a_koff(t + 1);
            const char* a2 = last ? nA + S.a_koff(0) : cA + S.a_koff(t + 2);
            const char* a3 = last ? nA + S.a_koff(1) : cA + S.a_koff(t + 3);
            const char* b2 = last ? nB : cB + (size_t)(t + 2) * kstep; const char* b3 = b2 + kstep;
            PG8_LDB(B0, 0, 0); PG8_LDB(B1, 0, 1); PG8_SCHED; PG8_LDA(At, 0, 0); PG8_STAGEA(PG8_SA(1, 1), a1, vA, 1);
            PG8_WAIT_V(8); PG8_WAIT_L(0); PG8_BAR; PG8_MMA(0, 0, At, B0); PG8_MMA(0, 1, At, B1); PG8_BAR; PG8_SCHED;
            PG8_LDA(At, 0, 1); PG8_STAGEB(PG8_SB(0, 0), b2); PG8_STAGEB(PG8_SB(0, 1), b2 + hstepB);
            if (last) { PG8_STAGEA(PG8_SA(0, 0), a2, vAn, 0); } else { PG8_STAGEA(PG8_SA(0, 0), a2, vA, 0); }
            PG8_WAIT_V(8); PG8_WAIT_L(0); PG8_BAR; PG8_MMA(1, 0, At, B0); PG8_MMA(1, 1, At, B1); PG8_BAR; PG8_SCHED;
            PG8_LDB(B0, 1, 0); PG8_LDB(B1, 1, 1); PG8_SCHED; PG8_LDA(At, 1, 0);
            if (last) { PG8_STAGEA(PG8_SA(0, 1), a2, vAn, 1); } else { PG8_STAGEA(PG8_SA(0, 1), a2, vA, 1); }
            PG8_WAIT_V(8); PG8_WAIT_L(0); PG8_BAR; PG8_MMA(0, 0, At, B0); PG8_MMA(0, 1, At, B1); PG8_BAR; PG8_SCHED;
            PG8_LDA(At, 1, 1); PG8_STAGEB(PG8_SB(1, 0), b3); PG8_STAGEB(PG8_SB(1, 1), b3 + hstepB);
            if (last) { PG8_STAGEA(PG8_SA(1, 0), a3, vAn, 0); } else { PG8_STAGEA(PG8_SA(1, 0), a3, vA, 0); }
            PG8_WAIT_V(8); PG8_WAIT_L(0); PG8_BAR; PG8_MMA(1, 0, At, B0); PG8_MMA(1, 1, At, B1); PG8_BAR; PG8_SCHED;
        }
        if (wr == 0) PG8_BAR;
        E(acc, cur, wr, wc, fr, fq);
        if (!has_next) break;
#pragma unroll
        for (int a = 0; a < 2; ++a)
#pragma unroll
            for (int b = 0; b < 2; ++b)
#pragma unroll
                for (int m = 0; m < 4; ++m)
#pragma unroll
                    for (int n = 0; n < 2; ++n) acc[a][b][m][n] = (f32x4){0.f, 0.f, 0.f, 0.f};
        cur = nxt; cA = nA; cB = nB; ++ui;
        if constexpr (Sched::GATHER) {
#pragma unroll
            for (int h = 0; h < 2; ++h)
#pragma unroll
                for (int i = 0; i < 2; ++i) vA[h][i] = vAn[h][i];
        }
        if (wr == 1) PG8_BAR;
    }
    PG8_WAIT_V(0);
    PG8_BAR;
#undef PG8_SA
#undef PG8_SB
#undef PG8_STAGEA
#undef PG8_STAGEB
#undef PG8_LDA
#undef PG8_LDB
#undef PG8_MMA
#undef PG8_WAIT_V
#undef PG8_WAIT_L
#undef PG8_BAR
#undef PG8_SCHED
}
}
namespace gm {
using pg8::cvt_pk_bf16;
__device__ __forceinline__ float fexp_(float x) { return __builtin_amdgcn_exp2f(1.4426950408889634f * x); }
__device__ __forceinline__ float fsig_(float x) { return __builtin_amdgcn_rcpf(1.0f + fexp_(-x)); }
__device__ __forceinline__ float fsilu_(float x) { return x * fsig_(x); }
struct Unit { int pm, pn; };
struct OrderBase {
    int nM, nN, nwg, G, c;
    __device__ __forceinline__ void init(int nM_, int nN_, int G_, int c_) { nM = nM_; nN = nN_; nwg = nM * nN; G = G_; c = c_; }
    __device__ __forceinline__ bool next(int i, Unit& u) const {
        const int L = i * G + c; if (L >= nwg) return false;
        int wgid = L; { const int q = nwg / 8, r = nwg % 8, xcd = wgid % 8, off = wgid / 8; wgid = (xcd < r ? xcd * (q + 1) : r * (q + 1) + (xcd - r) * q) + off; }
        const int nig = 8 * nN, gid = wgid / nig, fm = gid * 8, gsz = (nM - fm) < 8 ? (nM - fm) : 8;
        u.pm = fm + ((wgid % nig) % gsz); u.pn = (wgid % nig) / gsz; return true;
    }
};
struct OrderColAffine {
    int nM, nN, nwg, G, c;
    __device__ __forceinline__ void init(int nM_, int nN_, int G_, int c_) { nM = nM_; nN = nN_; nwg = nM * nN; G = G_; c = c_; }
    __device__ __forceinline__ bool next(int i, Unit& u) const {
        if (G != 256 || nN != 4) { const int L = i * G + c; if (L >= nwg) return false; u.pm = L / nN; u.pn = L % nN; return true; }
        const int x = c & 7, k = c >> 3, j = i * 32 + k; if (2 * j + (x >> 2) >= nM) return false;
        u.pm = 2 * j + (x >> 2); u.pn = x & 3; return true;
    }
};
struct OrderSub : OrderBase {
    int pm0; bool on;
    __device__ __forceinline__ void init(int nM_, int nN_, int Gs, int cs, int pm0_, bool on_) { OrderBase::init(nM_, nN_, Gs, cs); pm0 = pm0_; on = on_; }
    __device__ __forceinline__ bool next(int i, Unit& u) const { if (!on || !OrderBase::next(i, u)) return false; u.pm += pm0; return true; }
};
template <int KT_, int LDA, class Order = OrderBase> struct SchedPlain : Order {
    typedef gm::Unit Unit; static constexpr int KT = KT_; static constexpr bool GATHER = false;
    const char* A; const char* Bt;
    __device__ __forceinline__ const char* a_base(const Unit& u) const { return A + (size_t)u.pm * 256 * LDA * 2; }
    __device__ __forceinline__ void a_voff(const Unit&, int tid, unsigned (&v)[2][2]) const {
#pragma unroll
        for (int i = 0; i < 2; ++i) { int R, C; pg8::stage_rc(tid * 16 + i * 8192, R, C);
#pragma unroll
            for (int h = 0; h < 2; ++h) v[h][i] = (unsigned)((h * 128 + R) * LDA + C) * 2u; }
    }
    __device__ __forceinline__ size_t a_koff(int kt) const { return (size_t)kt * 128; }
    __device__ __forceinline__ const char* b_base(const Unit& u) const { return Bt + (size_t)u.pn * 256 * (KT * 64) * 2; }
};
struct SchedMerge : OrderBase {
    typedef gm::Unit Unit; static constexpr int KT = 48; static constexpr bool GATHER = false;
    const char* A; const char* Bt;
    __device__ __forceinline__ const char* a_base(const Unit& u) const { return A + (size_t)u.pm * 256 * LDP * 2; }
    __device__ __forceinline__ void a_voff(const Unit&, int tid, unsigned (&v)[2][2]) const {
#pragma unroll
        for (int i = 0; i < 2; ++i) { int R, C; pg8::stage_rc(tid * 16 + i * 8192, R, C);
#pragma unroll
            for (int h = 0; h < 2; ++h) v[h][i] = (unsigned)((h * 128 + R) * LDP + C) * 2u; }
    }
    __device__ __forceinline__ size_t a_koff(int kt) const { return (size_t)(kt < 16 ? (C_AY + 64 * kt) : (C_BG - 1024 + 64 * kt)) * 2; }
    __device__ __forceinline__ const char* b_base(const Unit& u) const { return Bt + (size_t)u.pn * 256 * 3072 * 2; }
};
struct MUnit { int e, tile, pn, slot0; };
template <int KT_, bool GATHER_> struct SchedMoe {
    typedef gm::MUnit Unit; static constexpr int KT = KT_; static constexpr bool GATHER = GATHER_;
    const volatile LAS int* tileoff; const volatile LAS int* cnt;
    int G, c, nunits;
    const char* wsbase; const int* rowtok; const char* A; const char* Bt;
    __device__ __forceinline__ bool next(int i, Unit& u) const {
        const int L = i * G + c; if (L >= nunits) return false;
        const int rt = L >> 2; u.pn = L & 3;
        int e = 0;
#pragma unroll 1
        for (int k = 1; k < 32; ++k) e = (rt >= tileoff[k]) ? k : e;
        u.e = e; u.tile = rt - tileoff[e]; u.slot0 = rt * 256; return true;
    }
    __device__ __forceinline__ const char* a_base(const Unit& u) const { if constexpr (GATHER) return wsbase; else return A + (size_t)u.slot0 * DEXP * 2; }
    __device__ __forceinline__ void a_voff(const Unit& u, int tid, unsigned (&v)[2][2]) const {
        if constexpr (GATHER) {
            asm volatile("" : "+v"(tid));
            const int n = cnt[u.e]; const int* rt = rowtok + (size_t)u.e * NTOK + u.tile * 256;
#pragma unroll
            for (int i = 0; i < 2; ++i) { int R, C; pg8::stage_rc(tid * 16 + i * 8192, R, C);
#pragma unroll
                for (int h = 0; h < 2; ++h) { const int r = h * 128 + R; const bool ok = (u.tile * 256 + r) < n; const int tok = ok ? rt[r] : 0;
                    v[h][i] = ok ? (unsigned)(WS_X + (size_t)tok * 2048 + C * 2) : (unsigned)(CTL_ZROW + C * 2); } }
        } else {
#pragma unroll
            for (int i = 0; i < 2; ++i) { int R, C; pg8::stage_rc(tid * 16 + i * 8192, R, C);
#pragma unroll
                for (int h = 0; h < 2; ++h) v[h][i] = (unsigned)((h * 128 + R) * DEXP + C) * 2u; }
        }
    }
    __device__ __forceinline__ size_t a_koff(int kt) const { return (size_t)kt * 128; }
    __device__ __forceinline__ const char* b_base(const Unit& u) const { return Bt + ((size_t)u.e * 1024 + u.pn * 256) * (KT * 64) * 2; }
};

struct EpiProj {
    static constexpr bool PERM = true, MIDK = false; bf16* O; unsigned char* GT;
    static __device__ __forceinline__ unsigned gq8_(float z) { return (unsigned)fmaxf(fsig_(z) * 255.0f + 0.5f, 1.0f); }
    __device__ __forceinline__ void operator()(const f32x4 (&acc)[2][2][4][2], const Unit& u, int wr, int wc, int fr, int fq) const {
        if (u.pn >= 26) {
            const int br = (u.pn - 26) >> 2, pq = (u.pn - 26) & 3; const int wave = wr * 4 + wc, lane = fq * 16 + fr;
            unsigned char* t = GT + (((size_t)(br * 136 + u.pm) * 4 + pq) << 16) + (size_t)(wave * 64 + lane) * 16;
#pragma unroll
            for (int ai = 0; ai < 2; ++ai)
#pragma unroll
                for (int m = 0; m < 4; ++m) { u32x4 w;
#pragma unroll
                    for (int bj = 0; bj < 2; ++bj) { const f32x4 v0 = acc[ai][bj][m][0], v1 = acc[ai][bj][m][1];
                        w[2 * bj] = gq8_(v0[0]) | (gq8_(v0[1]) << 8) | (gq8_(v0[2]) << 16) | (gq8_(v0[3]) << 24);
                        w[2 * bj + 1] = gq8_(v1[0]) | (gq8_(v1[1]) << 8) | (gq8_(v1[2]) << 16) | (gq8_(v1[3]) << 24); }
                    *(u32x4*)(t + (ai * 4 + m) * 8192) = w; }
            return;
        }
        bf16* base = O + (size_t)(u.pm * 256 + wr * 64 + fr) * LDP + u.pn * 256 + wc * 32 + 8 * fq;
#pragma unroll
        for (int ai = 0; ai < 2; ++ai)
#pragma unroll
            for (int m = 0; m < 4; ++m) { bf16* rowp = base + (size_t)(ai * 128 + m * 16) * LDP;
#pragma unroll
                for (int bj = 0; bj < 2; ++bj) { const f32x4 v0 = acc[ai][bj][m][0], v1 = acc[ai][bj][m][1];
                    u32x4 w; w.x = cvt_pk_bf16(v0[0], v0[1]); w.y = cvt_pk_bf16(v0[2], v0[3]); w.z = cvt_pk_bf16(v1[0], v1[1]); w.w = cvt_pk_bf16(v1[2], v1[3]);
                    *(u32x4*)(rowp + bj * 128) = w; } }
    }
};
struct EpiPlain {
    static constexpr bool PERM = true, MIDK = false; bf16* O;
    __device__ __forceinline__ void operator()(const f32x4 (&acc)[2][2][4][2], const Unit& u, int wr, int wc, int fr, int fq) const {
        bf16* base = O + (size_t)(u.pm * 256 + wr * 64 + fr) * 1024 + u.pn * 256 + wc * 32 + 8 * fq;
#pragma unroll
        for (int ai = 0; ai < 2; ++ai)
#pragma unroll
            for (int m = 0; m < 4; ++m) { bf16* rowp = base + (size_t)(ai * 128 + m * 16) * 1024;
#pragma unroll
                for (int bj = 0; bj < 2; ++bj) { const f32x4 v0 = acc[ai][bj][m][0], v1 = acc[ai][bj][m][1];
                    u32x4 w; w.x = cvt_pk_bf16(v0[0], v0[1]); w.y = cvt_pk_bf16(v0[2], v0[3]); w.z = cvt_pk_bf16(v1[0], v1[1]); w.w = cvt_pk_bf16(v1[2], v1[3]);
                    *(u32x4*)(rowp + bj * 128) = w; } }
    }
};
struct EpiMerge {
    static constexpr bool PERM = true, MIDK = true; const unsigned char* GT; bf16* O;
    __device__ __forceinline__ const unsigned char* tile(const Unit& u, int br, int wr, int wc, int fr, int fq) const {
        return GT + (((size_t)(br * 136 + u.pm) * 4 + u.pn) << 16) + (size_t)((wr * 4 + wc) * 64 + fq * 16 + fr) * 16; }
    static __device__ __forceinline__ float b8_(unsigned w, int k) { return (float)((w >> (8 * k)) & 0xffu); }
    __device__ __forceinline__ void mid(f32x4 (&acc)[2][2][4][2], const Unit& u, int t, int wr, int wc, int fr, int fq) const {
        const int br = (t == 16) ? 0 : 1; const unsigned char* ta = tile(u, br, wr, wc, fr, fq); const unsigned char* tb = tile(u, br + 1, wr, wc, fr, fq);
        u32x4 ga[8], gb[8];
#pragma unroll
        for (int j = 0; j < 8; ++j) { ga[j] = *(const u32x4*)(ta + 8192 * j); gb[j] = *(const u32x4*)(tb + 8192 * j); }
#pragma unroll
        for (int ai = 0; ai < 2; ++ai)
#pragma unroll
            for (int m = 0; m < 4; ++m)
#pragma unroll
                for (int bj = 0; bj < 2; ++bj)
#pragma unroll
                    for (int hw = 0; hw < 2; ++hw) { const unsigned wa = ga[ai * 4 + m][2 * bj + hw], wb = gb[ai * 4 + m][2 * bj + hw];
#pragma unroll
                        for (int k = 0; k < 4; ++k) acc[ai][bj][m][hw][k] *= b8_(wa, k) * __builtin_amdgcn_rcpf(b8_(wb, k)); }
    }
    __device__ __forceinline__ void operator()(const f32x4 (&acc)[2][2][4][2], const Unit& u, int wr, int wc, int fr, int fq) const {
        const unsigned char* tc = tile(u, 2, wr, wc, fr, fq);
        u32x4 gc[8];
#pragma unroll
        for (int j = 0; j < 8; ++j) gc[j] = *(const u32x4*)(tc + 8192 * j);
        const size_t row0 = (size_t)(u.pm * 256 + wr * 64 + fr); const int col0 = u.pn * 256 + wc * 32 + 8 * fq;
        constexpr float S = 1.0f / 255.0f;
#pragma unroll
        for (int ai = 0; ai < 2; ++ai)
#pragma unroll
            for (int m = 0; m < 4; ++m) { const size_t row = row0 + ai * 128 + m * 16;
#pragma unroll
                for (int bj = 0; bj < 2; ++bj) { const unsigned g0 = gc[ai * 4 + m][2 * bj], g1 = gc[ai * 4 + m][2 * bj + 1];
                    const f32x4 v0 = acc[ai][bj][m][0] * S, v1 = acc[ai][bj][m][1] * S; u32x4 w;
                    w.x = cvt_pk_bf16(v0[0] * b8_(g0, 0), v0[1] * b8_(g0, 1)); w.y = cvt_pk_bf16(v0[2] * b8_(g0, 2), v0[3] * b8_(g0, 3));
                    w.z = cvt_pk_bf16(v1[0] * b8_(g1, 0), v1[1] * b8_(g1, 1)); w.w = cvt_pk_bf16(v1[2] * b8_(g1, 2), v1[3] * b8_(g1, 3));
                    *(u32x4*)(O + row * 1024 + col0 + bj * 128) = w; } }
    }
};
struct EpiWo {
    static constexpr bool PERM = false, MIDK = false; float* h; float* hc; const float* mod; bool wen; const float* hsrc; const float* hcsrc;
    __device__ __forceinline__ void operator()(const f32x4 (&acc)[2][2][4][2], const Unit& u, int wr, int wc, int fr, int fq) const {
        const bool lat = u.pm < 128; const int mb = lat ? (u.pm >> 4) : 8;
        float* hb = lat ? h + (size_t)u.pm * 256 * 1024 : hc + (size_t)(u.pm - 128) * 256 * 1024;
        const float* sb = lat ? hsrc + (size_t)u.pm * 256 * 1024 : hcsrc + (size_t)(u.pm - 128) * 256 * 1024;
        const int col0 = u.pn * 256 + wc * 32 + 4 * fq; const float* mp = mod + (size_t)mb * 6144 + 2 * 1024 + col0;
        f32x4 mv[2][2];
#pragma unroll
        for (int bj = 0; bj < 2; ++bj)
#pragma unroll
            for (int n = 0; n < 2; ++n) mv[bj][n] = *(const f32x4*)(mp + bj * 128 + n * 16);
#pragma unroll
        for (int ai = 0; ai < 2; ++ai)
#pragma unroll
            for (int m = 0; m < 4; ++m) { const size_t ro = (size_t)(ai * 128 + wr * 64 + m * 16 + fr) * 1024 + col0; float* rowp = hb + ro; const float* srcp = sb + ro;
#pragma unroll
                for (int bj = 0; bj < 2; ++bj)
#pragma unroll
                    for (int n = 0; n < 2; ++n) { f32x4 hv = *(const f32x4*)(srcp + bj * 128 + n * 16); hv = hv + mv[bj][n] * acc[ai][bj][m][n]; if (wen) *(f32x4*)(rowp + bj * 128 + n * 16) = hv; } }
    }
};
struct EpiGU {
    static constexpr bool PERM = true, MIDK = false; bf16* H;
    __device__ __forceinline__ void operator()(const f32x4 (&acc)[2][2][4][2], const MUnit& u, int wr, int wc, int fr, int fq) const {
        bf16* base = H + (size_t)(u.slot0 + wr * 64 + fr) * DEXP + u.pn * 128 + wc * 32 + 8 * fq;
#pragma unroll
        for (int ai = 0; ai < 2; ++ai)
#pragma unroll
            for (int m = 0; m < 4; ++m) { const f32x4 g0 = acc[ai][0][m][0], g1 = acc[ai][0][m][1], u0 = acc[ai][1][m][0], u1 = acc[ai][1][m][1]; u32x4 w;
                w.x = cvt_pk_bf16(fsilu_(g0[0]) * u0[0], fsilu_(g0[1]) * u0[1]); w.y = cvt_pk_bf16(fsilu_(g0[2]) * u0[2], fsilu_(g0[3]) * u0[3]);
                w.z = cvt_pk_bf16(fsilu_(g1[0]) * u1[0], fsilu_(g1[1]) * u1[1]); w.w = cvt_pk_bf16(fsilu_(g1[2]) * u1[2], fsilu_(g1[3]) * u1[3]);
                *(u32x4*)(base + (size_t)(ai * 128 + m * 16) * DEXP) = w; }
    }
};
struct EpiDN {
    static constexpr bool PERM = true, MIDK = false; bf16* Y;
    __device__ __forceinline__ void operator()(const f32x4 (&acc)[2][2][4][2], const MUnit& u, int wr, int wc, int fr, int fq) const {
        bf16* base = Y + (size_t)(u.slot0 + wr * 64 + fr) * 1024 + u.pn * 256 + wc * 32 + 8 * fq;
#pragma unroll
        for (int ai = 0; ai < 2; ++ai)
#pragma unroll
            for (int m = 0; m < 4; ++m) { bf16* rowp = base + (size_t)(ai * 128 + m * 16) * 1024;
#pragma unroll
                for (int bj = 0; bj < 2; ++bj) { const f32x4 v0 = acc[ai][bj][m][0], v1 = acc[ai][bj][m][1];
                    u32x4 w; w.x = cvt_pk_bf16(v0[0], v0[1]); w.y = cvt_pk_bf16(v0[2], v0[3]); w.z = cvt_pk_bf16(v1[0], v1[1]); w.w = cvt_pk_bf16(v1[2], v1[3]);
                    *(u32x4*)(rowp + bj * 128) = w; } }
    }
};
}
struct Args { const float* in[30]; float* out; unsigned char* ws; int ph_lo, ph_hi; };
enum { I_X = 0, I_C, I_CTX, I_CCTX, I_WMOD, I_BMOD, I_N1G, I_N2G, I_WIN, I_CONVW, I_CONVB, I_WA, I_BA, I_WX, I_BX, I_LAM, I_RLAM, I_SINK,
       I_WBA, I_WBB, I_WBC, I_WOUT, I_RGW, I_RGB, I_REW, I_REB, I_EWG, I_EWU, I_EWD, I_FNG };
typedef const GAS float* cfp_t;
struct Frame {
    LAS unsigned char* lds; int tid, lane, wave, G, bid, gw, NGW; bool wr;
    const __attribute__((address_space(4))) cfp_t* in; float* out; unsigned char* ws;
};
#define FIN(i)     ((const float*)F.in[i])
#define F_MOD(F)   ((float*)((F).ws + WS_MOD))
#define F_HC(F)    ((float*)((F).ws + WS_HC))
#define F_X(F)     ((bf16*)((F).ws + WS_X))
#define F_PROJ(F)  ((bf16*)((F).ws + WS_PROJ))
#define F_YB(F)    ((bf16*)((F).ws + WS_YB))
#define F_CNT(F)   ((int*)((F).ws + WS_CTL) + CW_CNT)

__device__ __forceinline__ void ph_prologue(Frame& F) {
    LAS float* sc = (LAS float*)F.lds;
    LAS float* part = (LAS float*)(F.lds + 40960);
    for (int i = F.tid; i < 9 * 1024; i += 512) { const int mb = i >> 10, k = i & 1023; const float cv = mb < 8 ? FIN(I_C)[mb * 1024 + k] : FIN(I_CCTX)[k]; sc[i] = siluf_(cv); }
    __syncthreads();
    for (int item = F.bid; item < 4 * 96; item += F.G) {
        const int l = item / 96, n0 = (item % 96) * 64;
        const float* wp = FIN(I_WMOD) + ((size_t)l * 1024 + F.wave * 128) * 6144 + n0 + F.lane;
        float acc[9];
#pragma unroll
        for (int mb = 0; mb < 9; ++mb) acc[mb] = 0.f;
#pragma unroll 32
        for (int k = 0; k < 128; ++k) { const float wv = wp[(size_t)k * 6144];
#pragma unroll
            for (int mb = 0; mb < 9; ++mb) acc[mb] += sc[mb * 1024 + F.wave * 128 + k] * wv; }
#pragma unroll
        for (int mb = 0; mb < 9; ++mb) part[(F.wave * 9 + mb) * 64 + F.lane] = acc[mb];
        __syncthreads();
        for (int t = F.tid; t < 576; t += 512) { const int mb = t >> 6, ln = t & 63; float s = FIN(I_BMOD)[l * 6144 + n0 + ln];
#pragma unroll
            for (int w = 0; w < 8; ++w) s += part[(w * 9 + mb) * 64 + ln];
            F_MOD(F)[((size_t)l * 9 + mb) * 6144 + n0 + ln] = s; }
        __syncthreads();
    }
    f32x2* rt = (f32x2*)(F.ws + WS_ROPE);
    for (int i = F.bid * 512 + F.tid; i < 4096 * 32; i += F.G * 512) { const int pos = i >> 5, f = i & 31;
        const float inv = (float)pow(10000.0, -(double)(2 * f) / 64.0); const float ang = (float)pos * inv;
        rt[i] = (f32x2){(float)cos((double)ang), (float)sin((double)ang)}; }
    f32x2* at = (f32x2*)(F.ws + WS_ROPE + 1 * MiB);
    for (int i = F.bid * 512 + F.tid; i < 64 * 16; i += F.G * 512) { const int pos = i >> 4, f = i & 15;
        const float inv = (float)pow(10000.0, -(double)(2 * f) / 32.0); const float ang = (float)pos * inv;
        at[i] = (f32x2){(float)cos((double)ang), (float)sin((double)ang)}; }
}

__device__ __forceinline__ void tr_item(const float* W, int ldw, int k0, int n0, bf16* dst  , int ldk, LAS float* scr, int lane) {
    float wv[32];
#pragma unroll
    for (int i = 0; i < 32; ++i) { const int kk = 2 * i + (lane >> 5); wv[i] = W[(size_t)(k0 + kk) * ldw + n0 + (lane & 31)]; }
#pragma unroll
    for (int i = 0; i < 32; ++i) { const int kk = 2 * i + (lane >> 5); scr[kk * 33 + (lane & 31)] = wv[i]; }
    LDS_WAIT(); asm volatile("" ::: "memory");
    const int c = lane & 7;
#pragma unroll
    for (int j = 0; j < 4; ++j) { const int n = (lane >> 3) + 8 * j; const LAS float* s = scr + (8 * c) * 33 + n;
        u32x4 o; o.x = pk2(s[0 * 33], s[1 * 33]); o.y = pk2(s[2 * 33], s[3 * 33]); o.z = pk2(s[4 * 33], s[5 * 33]); o.w = pk2(s[6 * 33], s[7 * 33]);
        *(u32x4*)(dst + (size_t)n * ldk + 8 * c) = o; }
    LDS_WAIT(); asm volatile("" ::: "memory");
}
__device__ __forceinline__ void ph_convert(Frame& F, int l) {
    LAS float* scr = (LAS float*)(F.lds + F.wave * 16384);
    bf16* wt = (bf16*)(F.ws + WS_WT);
    constexpr int I_IN = 16 * 304, I_BRN = 16 * 32, I_GU1 = 16 * 16, I_DN1 = 8 * 32;
    constexpr int NITEMS = I_IN + 4 * I_BRN + 32 * 2 * I_GU1 + 32 * I_DN1;
    for (int it = F.gw; it < NITEMS; it += F.NGW) {
        int r = it;
        if (r < I_IN) { const int kb = r / 304, nb = r % 304; tr_item(FIN(I_WIN) + (size_t)l * 1024 * DIN, DIN, 64 * kb, 32 * nb, wt + WT_IN / 2 + (size_t)(32 * nb) * 1024 + 64 * kb, 1024, scr, F.lane); continue; }
        r -= I_IN;
        if (r < 3 * I_BRN) { const int br = r / I_BRN, q = r % I_BRN, kb = q / 32, nb = q % 32; const float* W = FIN(I_WBA + br) + (size_t)l * 1024 * 1024;
            tr_item(W, 1024, 64 * kb, 32 * nb, wt + WT_BR / 2 + (size_t)(32 * nb) * 3072 + br * 1024 + 64 * kb, 3072, scr, F.lane); continue; }
        r -= 3 * I_BRN;
        if (r < I_BRN) { const int kb = r / 32, nb = r % 32; tr_item(FIN(I_WOUT) + (size_t)l * 1024 * 1024, 1024, 64 * kb, 32 * nb, wt + WT_WO / 2 + (size_t)(32 * nb) * 1024 + 64 * kb, 1024, scr, F.lane); continue; }
        r -= I_BRN;
        if (r < 32 * 2 * I_GU1) { const int e = r / (2 * I_GU1), q = r % (2 * I_GU1), up = q / I_GU1, q2 = q % I_GU1, kb = q2 / 16, nb = q2 % 16;
            const float* W = FIN(up ? I_EWU : I_EWG) + ((size_t)l * 32 + e) * 1024 * 512; const int n0 = 32 * nb;
            const int drow = e * 1024 + (n0 >> 7) * 256 + up * 128 + (n0 & 127);
            tr_item(W, 512, 64 * kb, n0, wt + WT_GU / 2 + (size_t)drow * 1024 + 64 * kb, 1024, scr, F.lane); continue; }
        r -= 32 * 2 * I_GU1;
        { const int e = r / I_DN1, q = r % I_DN1, kb = q / 32, nb = q % 32; const float* W = FIN(I_EWD) + ((size_t)l * 32 + e) * 512 * 1024;
            tr_item(W, 1024, 64 * kb, 32 * nb, wt + WT_DN / 2 + (size_t)(e * 1024 + 32 * nb) * 512 + 64 * kb, 512, scr, F.lane); }
    }
}
constexpr size_t RW_ELEMS = (size_t)4 * 9 * 48 * 1024;
__device__ __forceinline__ void ph_router_fold(Frame& F) {
    float* Wp = (float*)(F.ws + WS_RW); float* rc = Wp + RW_ELEMS;
    for (int i = F.bid * 512 + F.tid; i < (int)RW_ELEMS; i += F.G * 512) {
        const int k = i & 1023, j = (i >> 10) % 48, mb = (i / (48 * 1024)) % 9, l = i / (48 * 1024 * 9);
        float v = 0.f;
        if (j < RCOLS) { const float w = j < 4 ? FIN(I_RGW)[((size_t)l * 1024 + k) * 4 + j] : FIN(I_REW)[((size_t)l * 1024 + k) * 32 + (j - 4)];
            v = FIN(I_N2G)[l * 1024 + k] * (1.0f + F_MOD(F)[((size_t)l * 9 + mb) * 6144 + 4 * 1024 + k]) * w; }
        Wp[i] = v;
    }
    for (int it = F.gw; it < 4 * 9 * RCOLS; it += F.NGW) { const int j = it % RCOLS, mb = (it / RCOLS) % 9, l = it / (RCOLS * 9);
        float s = 0.f;
        for (int k = F.lane; k < 1024; k += 64) { const float w = j < 4 ? FIN(I_RGW)[((size_t)l * 1024 + k) * 4 + j] : FIN(I_REW)[((size_t)l * 1024 + k) * 32 + (j - 4)];
            s += F_MOD(F)[((size_t)l * 9 + mb) * 6144 + 3 * 1024 + k] * w; }
        s = wave_sum(s);
        if (F.lane == 0) rc[(l * 9 + mb) * 64 + j] = s + (j < 4 ? FIN(I_RGB)[l * 4 + j] : FIN(I_REB)[l * 32 + (j - 4)]);
    }
}

struct RowJob { const float* src; float* copy_to; int mb; };
template <class RowFn> __device__ __forceinline__ void rows_norm_loop(Frame& F, int row0, int nrows, int w, int NW, const float* gain, const float* mod, int shift_i, int scale_i, bf16* dst, RowFn rowfn) {
    const int lane = F.lane;
    f32x4 nv[4]; RowJob nj = {nullptr, nullptr, 0};
    int r = row0 + w;
    if (r < nrows) { nj = rowfn(r);
#pragma unroll
        for (int j = 0; j < 4; ++j) nv[j] = *(const f32x4*)(nj.src + 4 * lane + 256 * j); }
    for (; r < nrows; r += NW) {
        f32x4 v[4]; const RowJob cj = nj;
#pragma unroll
        for (int j = 0; j < 4; ++j) v[j] = nv[j];
        const int rn = r + NW;
        if (rn < nrows) { nj = rowfn(rn);
#pragma unroll
            for (int j = 0; j < 4; ++j) nv[j] = *(const f32x4*)(nj.src + 4 * lane + 256 * j); }
        f32x4 g[4], sh[4], sc[4];
#pragma unroll
        for (int j = 0; j < 4; ++j) { g[j] = *(const f32x4*)(gain + 4 * lane + 256 * j); sh[j] = *(const f32x4*)(mod + cj.mb * 6144 + shift_i * 1024 + 4 * lane + 256 * j); sc[j] = *(const f32x4*)(mod + cj.mb * 6144 + scale_i * 1024 + 4 * lane + 256 * j); }
        float ss = 0.f;
#pragma unroll
        for (int j = 0; j < 4; ++j) ss += (v[j].x * v[j].x + v[j].y * v[j].y) + (v[j].z * v[j].z + v[j].w * v[j].w);
        if (cj.copy_to) {
#pragma unroll
            for (int j = 0; j < 4; ++j) *(f32x4*)(cj.copy_to + 4 * lane + 256 * j) = v[j]; }
        const float rstd = 1.0f / sqrtf(wave_sum(ss) * (1.0f / 1024.0f) + EPS);
#pragma unroll
        for (int j = 0; j < 4; ++j) { const f32x4 y = (v[j] * rstd) * g[j] * (sc[j] + 1.0f) + sh[j];
            u32x2 w; w.x = pk2(y.x, y.y); w.y = pk2(y.z, y.w); *(u32x2*)(dst + (size_t)r * 1024 + 4 * lane + 256 * j) = w; }
    }
}
__device__ __forceinline__ void ph_rows_u(Frame& F, int l, bool first) {
    const float* mod = F_MOD(F) + (size_t)l * 9 * 6144; const float* g = FIN(I_N1G) + l * 1024;
    float* out = F.out; float* hc = F_HC(F); const float* xin = FIN(I_X); const float* cin = FIN(I_CTX);
    rows_norm_loop(F, 0, NTOK, F.gw, F.NGW, g, mod, 0, 1, F_X(F), [=](int r) { const bool lat = r < NLAT; RowJob j; j.mb = lat ? (r >> 12) : 8;
        float* hrow = lat ? out + (size_t)r * 1024 : hc + (size_t)(r - NLAT) * 1024;
        j.src = first ? (lat ? xin + (size_t)r * 1024 : cin + (size_t)(r - NLAT) * 1024) : hrow; j.copy_to = nullptr; return j; });
}
__device__ __forceinline__ void ph_rows_v(Frame& F, int l, int row0, int ntok, int w, int NW) {
    const float* mod = F_MOD(F) + (size_t)l * 9 * 6144; const float* g = FIN(I_N2G) + l * 1024;
    float* out = F.out; float* hc = F_HC(F);
    rows_norm_loop(F, row0, ntok, w, NW, g, mod, 3, 4, F_X(F), [=](int r) { const bool lat = r < NLAT; RowJob j; j.mb = lat ? (r >> 12) : 8;
        j.src = lat ? out + (size_t)r * 1024 : hc + (size_t)(r - NLAT) * 1024; j.copy_to = nullptr; return j; });
}

__device__ __forceinline__ void ph_router(Frame& F, int l, int bt0, int bt1, int c, int G) {
    LAS float* Bs = (LAS float*)F.lds;
    LAS float* lgs = (LAS float*)(F.lds + 53248 + F.wave * 4096);
    const float* WpL = (const float*)(F.ws + WS_RW) + (size_t)l * 9 * 48 * 1024; const float* rcL = (const float*)(F.ws + WS_RW) + RW_ELEMS + l * 9 * 64;
    int* cnt = F_CNT(F) + l * 32; int* rowtok = (int*)(F.ws + WS_ROWTOK); unsigned* tinfo = (unsigned*)(F.ws + WS_TOKINFO);
    const int lane = F.lane, i16 = lane & 15, kq = lane >> 4, tid = F.tid;
    for (int bt = bt0 + c; bt < bt1; bt += G) {
        const int tok0 = bt * 128 + F.wave * 16; const bool lat = tok0 < NLAT; const int mb = lat ? (tok0 >> 12) : 8;
        const float* hrow = (lat ? F.out + (size_t)(tok0 + i16) * 1024 : F_HC(F) + (size_t)(tok0 + i16 - NLAT) * 1024) + 4 * kq;
        const float* wsrc = WpL + (size_t)mb * 48 * 1024;
        f32x4 acc[3]; float ss = 0.f;
#pragma unroll
        for (int c = 0; c < 3; ++c) acc[c] = (f32x4){0.f, 0.f, 0.f, 0.f};
        f32x4 bnext[6];
#pragma unroll
        for (int j = 0; j < 6; ++j) { const int i = tid + 512 * j; bnext[j] = *(const f32x4*)(wsrc + (size_t)(i >> 6) * 1024 + 4 * (i & 63)); }
#pragma unroll 1
        for (int kc = 0; kc < 4; ++kc) {
            LDS_BARRIER();
#pragma unroll
            for (int j = 0; j < 6; ++j) { const int i = tid + 512 * j; *(LAS f32x4*)(Bs + (i >> 6) * 260 + 4 * (i & 63)) = bnext[j]; }
            LDS_BARRIER();
            if (kc < 3) {
#pragma unroll
                for (int j = 0; j < 6; ++j) { const int i = tid + 512 * j; bnext[j] = *(const f32x4*)(wsrc + (size_t)(i >> 6) * 1024 + (kc + 1) * 256 + 4 * (i & 63)); } }
            const LAS float* bp = Bs + i16 * 260 + 4 * kq;
#pragma unroll 4
            for (int S = 0; S < 16; ++S) {
                const f32x4 a = *(const f32x4*)(hrow + kc * 256 + 16 * S);
                const f32x4 b0 = *(const LAS f32x4*)(bp + 16 * S), b1 = *(const LAS f32x4*)(bp + 16 * 260 + 16 * S), b2 = *(const LAS f32x4*)(bp + 32 * 260 + 16 * S);
                ss += (a.x * a.x + a.y * a.y) + (a.z * a.z + a.w * a.w);
#pragma unroll
                for (int s = 0; s < 4; ++s) { acc[0] = __builtin_amdgcn_mfma_f32_16x16x4f32(a[s], b0[s], acc[0], 0, 0, 0); acc[1] = __builtin_amdgcn_mfma_f32_16x16x4f32(a[s], b1[s], acc[1], 0, 0, 0);
                    acc[2] = __builtin_amdgcn_mfma_f32_16x16x4f32(a[s], b2[s], acc[2], 0, 0, 0); }
            }
        }
        ss += __shfl_xor(ss, 16); ss += __shfl_xor(ss, 32);
#pragma unroll
        for (int c = 0; c < 3; ++c)
#pragma unroll
            for (int r = 0; r < 4; ++r) lgs[(4 * kq + r) * 52 + 16 * c + i16] = acc[c][r];
        LDS_WAIT(); asm volatile("" ::: "memory");
        const float rstd = 1.0f / sqrtf(ss * (1.0f / 1024.0f) + EPS);
        float lg[RCOLS];
#pragma unroll
        for (int j4 = 0; j4 < RCOLS / 4; ++j4) { const f32x4 v = *(const LAS f32x4*)(lgs + i16 * 52 + 4 * j4); const f32x4 rcv = *(const f32x4*)(rcL + mb * 64 + 4 * j4);
            lg[4 * j4] = v.x * rstd + rcv.x; lg[4 * j4 + 1] = v.y * rstd + rcv.y; lg[4 * j4 + 2] = v.z * rstd + rcv.z; lg[4 * j4 + 3] = v.w * rstd + rcv.w; }
        LDS_WAIT(); asm volatile("" ::: "memory");
        const int tok = tok0 + i16;
        int g = 0; float gm = lg[0];
#pragma unroll
        for (int j = 1; j < 4; ++j) if (lg[j] > gm) { gm = lg[j]; g = j; }
        float gs = 0.f;
#pragma unroll
        for (int j = 0; j < 4; ++j) gs += __expf(lg[j] - gm);
        const float g_w = 1.0f / gs;
        float el[8];
#pragma unroll
        for (int i = 0; i < 8; ++i) { el[i] = lg[4 + i];
#pragma unroll
            for (int gg = 1; gg < 4; ++gg) el[i] = (g == gg) ? lg[4 + gg * 8 + i] : el[i]; }
        int i1 = 0; float m1 = el[0];
#pragma unroll
        for (int i = 1; i < 8; ++i) if (el[i] > m1) { m1 = el[i]; i1 = i; }
        int i2 = -1; float m2 = -3.0e38f;
#pragma unroll
        for (int i = 0; i < 8; ++i) if (i != i1 && el[i] > m2) { m2 = el[i]; i2 = i; }
        const float p2 = __expf(m2 - m1); const float w1 = g_w / (1.0f + p2), w2 = g_w * p2 / (1.0f + p2);
        const int e1 = g * 8 + i1, e2 = g * 8 + i2;
        int r1 = 0, r2 = 0;
        { unsigned long long todo = 0xFFFFull;
          while (todo) { const int ld = __builtin_ctzll(todo); const int x = __shfl(e1, ld); const unsigned long long m = __ballot(e1 == x) & todo;
              int base = 0; if (lane == ld && F.wr) base = atomicAdd(&cnt[x], (int)__builtin_popcountll(m)); base = __shfl(base, ld);
              if (e1 == x) r1 = base + (int)__builtin_popcountll(m & ((1ull << lane) - 1ull)); todo &= ~m; } }
        { unsigned long long todo = 0xFFFFull;
          while (todo) { const int ld = __builtin_ctzll(todo); const int x = __shfl(e2, ld); const unsigned long long m = __ballot(e2 == x) & todo;
              int base = 0; if (lane == ld && F.wr) base = atomicAdd(&cnt[x], (int)__builtin_popcountll(m)); base = __shfl(base, ld);
              if (e2 == x) r2 = base + (int)__builtin_popcountll(m & ((1ull << lane) - 1ull)); todo &= ~m; } }
        if (lane < 16 && F.wr) { rowtok[(size_t)e1 * NTOK + r1] = tok; rowtok[(size_t)e2 * NTOK + r2] = tok;
            u32x4 a; a.x = (unsigned)e1; a.y = (unsigned)r1; a.z = (unsigned)e2; a.w = (unsigned)r2;
            *(u32x4*)(tinfo + (size_t)tok * 8) = a; *(f32x2*)(tinfo + (size_t)tok * 8 + 4) = (f32x2){w1, w2}; }
    }
}
__device__ __forceinline__ void moe_tables(Frame& F, int l, volatile LAS int*& tileoff, volatile LAS int*& cntl) {
    volatile LAS int* t = (volatile LAS int*)(F.lds + LDS_CTL + 512); cntl = t; tileoff = t + 32;
    if (F.tid < 32) t[F.tid] = __hip_atomic_load(F_CNT(F) + l * 32 + F.tid, __ATOMIC_RELAXED, __HIP_MEMORY_SCOPE_AGENT);
    __syncthreads();
    if (F.tid == 0) { int s = 0;
#pragma unroll 1
        for (int e = 0; e < 32; ++e) { t[32 + e] = s; s += (t[e] + 255) >> 8; } t[64] = s; }
    __syncthreads();
}
__device__ __forceinline__ void ph_combine(Frame& F, int l, int ntok) {
    volatile LAS int* tileoff; volatile LAS int* cntl; moe_tables(F, l, tileoff, cntl);
    const float* mod = F_MOD(F) + (size_t)l * 9 * 6144; const bool lastl = (l == DEPTH - 1);
    const float* modn = F_MOD(F) + (size_t)(lastl ? l : l + 1) * 9 * 6144; const float* gn = lastl ? FIN(I_FNG) : FIN(I_N1G) + (l + 1) * 1024;
    const bf16* Y = (const bf16*)(F.ws + WS_YROWS); const unsigned* tinfo = (const unsigned*)(F.ws + WS_TOKINFO);
    const int lane = F.lane;
    u32x4 ninf = (u32x4){0u, 0u, 0u, 0u}; f32x2 nwv = (f32x2){0.f, 0.f}; f32x4 nh[4];
    int r = F.gw;
#define CMB_HROW(rr) ((rr) < NLAT ? F.out + (size_t)(rr) * 1024 : F_HC(F) + (size_t)((rr) - NLAT) * 1024)
    if (r < ntok) { ninf = *(const u32x4*)(tinfo + (size_t)r * 8); nwv = *(const f32x2*)(tinfo + (size_t)r * 8 + 4); const float* hp = CMB_HROW(r);
#pragma unroll
        for (int j = 0; j < 4; ++j) nh[j] = *(const f32x4*)(hp + 4 * lane + 256 * j); }
    for (; r < ntok; r += F.NGW) {
        const u32x4 inf = ninf; const f32x2 wv = nwv; f32x4 hv[4];
#pragma unroll
        for (int j = 0; j < 4; ++j) hv[j] = nh[j];
        const bool lat = r < NLAT; const int mb = lat ? (r >> 12) : 8; float* hrow = CMB_HROW(r);
        const bf16* y1 = Y + ((size_t)tileoff[inf.x] * 256 + inf.y) * 1024; const bf16* y2 = Y + ((size_t)tileoff[inf.z] * 256 + inf.w) * 1024;
        u32x2 ya[4], yb[4];
#pragma unroll
        for (int j = 0; j < 4; ++j) { ya[j] = *(const u32x2*)(y1 + 4 * lane + 256 * j); yb[j] = *(const u32x2*)(y2 + 4 * lane + 256 * j); }
        const int rn = r + F.NGW;
        if (rn < ntok) { ninf = *(const u32x4*)(tinfo + (size_t)rn * 8); nwv = *(const f32x2*)(tinfo + (size_t)rn * 8 + 4); const float* hp = CMB_HROW(rn);
#pragma unroll
            for (int j = 0; j < 4; ++j) nh[j] = *(const f32x4*)(hp + 4 * lane + 256 * j); }
        f32x4 v[4]; float ss = 0.f;
#pragma unroll
        for (int j = 0; j < 4; ++j) { const int c = 4 * lane + 256 * j; const f32x4 m5 = *(const f32x4*)(mod + mb * 6144 + 5 * 1024 + c);
            const u32x2 a = ya[j], b = yb[j];
            f32x4 y; y.x = wv.x * bflo(a.x) + wv.y * bflo(b.x); y.y = wv.x * bfhi(a.x) + wv.y * bfhi(b.x); y.z = wv.x * bflo(a.y) + wv.y * bflo(b.y); y.w = wv.x * bfhi(a.y) + wv.y * bfhi(b.y);
            v[j] = hv[j] + m5 * y; ss += (v[j].x * v[j].x + v[j].y * v[j].y) + (v[j].z * v[j].z + v[j].w * v[j].w); }
        const float rstd = 1.0f / sqrtf(wave_sum(ss) * (1.0f / 1024.0f) + EPS);
        if (lastl) {
#pragma unroll
            for (int j = 0; j < 4; ++j) { const int c = 4 * lane + 256 * j; const f32x4 g = *(const f32x4*)(gn + c); if (F.wr) *(f32x4*)(hrow + c) = (v[j] * rstd) * g; }
        } else {
#pragma unroll
            for (int j = 0; j < 4; ++j) { const int c = 4 * lane + 256 * j; if (F.wr) *(f32x4*)(hrow + c) = v[j];
                const f32x4 g = *(const f32x4*)(gn + c), sh = *(const f32x4*)(modn + mb * 6144 + c), sc = *(const f32x4*)(modn + mb * 6144 + 1024 + c);
                const f32x4 y = (v[j] * rstd) * g * (sc + 1.0f) + sh; u32x2 w; w.x = pk2(y.x, y.y); w.y = pk2(y.z, y.w); if (F.wr) *(u32x2*)(F_X(F) + (size_t)r * 1024 + c) = w; }
        }
    }
#undef CMB_HROW
}
#define MFMA16(a, b, c) __builtin_amdgcn_mfma_f32_16x16x32_bf16((a), (b), (c), 0, 0, 0)
__device__ __forceinline__ bf16x8 ldfrag(const LAS bf16* base, int row0, int k0, int ld, int lane) {
    return *(const LAS bf16x8*)(base + (row0 + (lane & 15)) * ld + k0 + 8 * (lane >> 4));
}
__device__ __forceinline__ float fast_sigmoid(float x) { return __builtin_amdgcn_rcpf(1.0f + __builtin_amdgcn_exp2f(-1.4426950408889634f * x)); }
__device__ __forceinline__ float fast_gelu_tanh(float x) {
    const float u2 = 1.5957691216057308f * (x + 0.044715f * x * x * x);
    return x * __builtin_amdgcn_rcpf(1.0f + __builtin_amdgcn_exp2f(-1.4426950408889634f * u2));
}

__device__ __forceinline__ void att_rope8(const f32x2* tab, const float (&x1)[8], const float (&x2)[8], float (&o1)[8], float (&o2)[8]) {
#pragma unroll
    for (int e = 0; e < 8; ++e) { const f32x2 cs = tab[e]; o1[e] = x1[e] * cs.x - x2[e] * cs.y; o2[e] = x2[e] * cs.x + x1[e] * cs.y; }
}
__device__ __forceinline__ void unpack8(const u32x4 a, float (&x)[8]) { x[0] = bflo(a.x); x[1] = bfhi(a.x); x[2] = bflo(a.y); x[3] = bfhi(a.y); x[4] = bflo(a.z); x[5] = bfhi(a.z); x[6] = bflo(a.w); x[7] = bfhi(a.w); }
__device__ __forceinline__ u32x4 pack8(const float (&x)[8], float s) { u32x4 r; r.x = pk2(x[0] * s, x[1] * s); r.y = pk2(x[2] * s, x[3] * s); r.z = pk2(x[4] * s, x[5] * s); r.w = pk2(x[6] * s, x[7] * s); return r; }

template <int RS> __device__ __forceinline__ void tr_frags4(unsigned addr, bf16x8 (&f)[4]) {
    u32x2 a0, a1, b0, b1, c0, c1, d0, d1;
    asm volatile("ds_read_b64_tr_b16 %0, %8\n\tds_read_b64_tr_b16 %1, %8 offset:%9\n\tds_read_b64_tr_b16 %2, %8 offset:32\n\tds_read_b64_tr_b16 %3, %8 offset:%10\n\t"
                 "ds_read_b64_tr_b16 %4, %8 offset:64\n\tds_read_b64_tr_b16 %5, %8 offset:%11\n\tds_read_b64_tr_b16 %6, %8 offset:96\n\tds_read_b64_tr_b16 %7, %8 offset:%12\n\ts_waitcnt lgkmcnt(0)"
                 : "=&v"(a0), "=&v"(a1), "=&v"(b0), "=&v"(b1), "=&v"(c0), "=&v"(c1), "=&v"(d0), "=&v"(d1)
                 : "v"(addr), "i"(4 * RS), "i"(32 + 4 * RS), "i"(64 + 4 * RS), "i"(96 + 4 * RS) : "memory");
    u32x4 t; t.x = a0.x; t.y = a0.y; t.z = a1.x; t.w = a1.y; f[0] = __builtin_bit_cast(bf16x8, t);
    t.x = b0.x; t.y = b0.y; t.z = b1.x; t.w = b1.y; f[1] = __builtin_bit_cast(bf16x8, t);
    t.x = c0.x; t.y = c0.y; t.z = c1.x; t.w = c1.y; f[2] = __builtin_bit_cast(bf16x8, t);
    t.x = d0.x; t.y = d0.y; t.z = d1.x; t.w = d1.y; f[3] = __builtin_bit_cast(bf16x8, t);
}


__device__ __forceinline__ float xor16_max(float x) { const unsigned xi = __builtin_bit_cast(unsigned, x); const auto r = __builtin_amdgcn_permlane16_swap(xi, xi, false, false); return fmaxf(__builtin_bit_cast(float, (unsigned)r[0]), __builtin_bit_cast(float, (unsigned)r[1])); }
__device__ __forceinline__ float xor32_max(float x) { const unsigned xi = __builtin_bit_cast(unsigned, x); const auto r = __builtin_amdgcn_permlane32_swap(xi, xi, false, false); return fmaxf(__builtin_bit_cast(float, (unsigned)r[0]), __builtin_bit_cast(float, (unsigned)r[1])); }
__device__ __forceinline__ float xor16_sum(float x) { const unsigned xi = __builtin_bit_cast(unsigned, x); const auto r = __builtin_amdgcn_permlane16_swap(xi, xi, false, false); return __builtin_bit_cast(float, (unsigned)r[0]) + __builtin_bit_cast(float, (unsigned)r[1]); }
__device__ __forceinline__ float xor32_sum(float x) { const unsigned xi = __builtin_bit_cast(unsigned, x); const auto r = __builtin_amdgcn_permlane32_swap(xi, xi, false, false); return __builtin_bit_cast(float, (unsigned)r[0]) + __builtin_bit_cast(float, (unsigned)r[1]); }

#ifndef LRU_ABL
#define LRU_ABL 0
#endif
__device__ __forceinline__ void lru_unit(Frame& F, int l, int b, int hd, int half) {
    LAS bf16* ub = (LAS bf16*)F.lds;
    LAS bf16* waT = (LAS bf16*)(F.lds + 36864);
    LAS bf16* wxT = (LAS bf16*)(F.lds + 36864 + 4608);
    LAS f32x2* wcomp = (LAS f32x2*)(F.lds + 92800);
    LAS bf16* ho = (LAS bf16*)(F.lds + 46080 + 3 * 8192 + 256);
    const int tid = F.tid, lane = F.lane, w = F.wave, q = lane >> 4, fr = lane & 15;
    bf16* proj = F_PROJ(F); bf16* X = F_X(F);
    const int chh = hd * 64;
    const int c8 = tid & 7, rg = tid >> 3;
    LAS float* cwl = (LAS float*)(F.lds + 91392 + 128);
    __syncthreads();
    if (tid < 320) { const int j = tid >> 6, c = tid & 63; cwl[tid] = j < 4 ? FIN(I_CONVW)[((size_t)l * 4 + j) * 1024 + chh + c] : FIN(I_CONVB)[l * 1024 + chh + c]; }
    const int orow = tid >> 1, ohh = tid & 1;
#pragma unroll 1
    for (int dir = 0; dir < 2; ++dir) {
        __syncthreads();
        for (int i = tid; i < 2048; i += 512) { const int k = i >> 5, c = i & 31; const size_t gi = ((((size_t)l * 2 + dir) * 16 + hd) * 64 + k) * 64 + half * 32 + c;
            waT[c * 72 + k] = (bf16)f2bf(FIN(I_WA)[gi]); wxT[c * 72 + k] = (bf16)f2bf(FIN(I_WX)[gi]); }
        float ba_[2], bx_[2], sp8_[2], carry[2] = {0.f, 0.f};
#pragma unroll
        for (int cb = 0; cb < 2; ++cb) { const int ch = chh + half * 32 + cb * 16 + fr; const size_t gi = ((size_t)l * 2 + dir) * 1024 + ch;
            ba_[cb] = FIN(I_BA)[gi]; bx_[cb] = FIN(I_BX)[gi]; const float lam = FIN(I_LAM)[gi]; sp8_[cb] = -8.0f * 1.4426950408889634f * log1p_fast(__expf(-lam)); }
        __syncthreads();
        const int rgd = dir ? 63 - rg : rg;
        u32x4 axr[7]; u32x4 pf[4];
#define LRU_CHUNK(ci, isctx_, T0_, rowbase_) const bool isctx_ = (ci) == 0; const int T0_ = isctx_ ? 0 : 256 * (dir ? (16 - (ci)) : ((ci) - 1)); const size_t rowbase_ = isctx_ ? (size_t)NLAT + b * LCX : (size_t)b * SEQ
#define LRU_PREFETCH(ci) do { LRU_CHUNK(ci, ic_, t0_, rb_); const int Ls_ = ic_ ? LCX : SEQ; \
            _Pragma("unroll") for (int j = 0; j < 7; ++j) { const int tt = t0_ + 4 * rgd - 2 + j; const int tc_ = (tt >= 0 && tt < Ls_) ? tt : 0; \
                const GAS bf16* p_ = (const GAS bf16*)(proj + (rb_ + tc_) * LDP + C_AX + chh + 8 * c8); \
                asm volatile("global_load_dwordx4 %0, %1, off" : "=v"(axr[j]) : "v"(p_) : "memory"); } } while (0)
#define LRU_AX_WAIT(ci) do { if (dir == 0) asm volatile("s_waitcnt vmcnt(2)" : "+v"(axr[0]), "+v"(axr[1]), "+v"(axr[2]), "+v"(axr[3]), "+v"(axr[4]), "+v"(axr[5]), "+v"(axr[6]) :: "memory"); \
            else asm volatile("s_waitcnt vmcnt(6)" : "+v"(axr[0]), "+v"(axr[1]), "+v"(axr[2]), "+v"(axr[3]), "+v"(axr[4]), "+v"(axr[5]), "+v"(axr[6]) :: "memory"); \
            LRU_CHUNK(ci, ic_, t0_, rb_); (void)rb_; const int Ls_ = ic_ ? LCX : SEQ; \
            _Pragma("unroll") for (int j = 0; j < 7; ++j) { const int tt = t0_ + 4 * rgd - 2 + j; if (!(tt >= 0 && tt < Ls_)) axr[j] = (u32x4){0u, 0u, 0u, 0u}; } } while (0)
#define LRU_PREFETCH_OUT(ci) do { if (dir == 1) { LRU_CHUNK(ci, ic_, t0_, rb_); const size_t orow_g = rb_ + t0_ + (255 - orow); \
                pf[0] = *(const u32x4*)(X + orow_g * 1024 + chh + half * 32 + ohh * 16); pf[1] = *(const u32x4*)(X + orow_g * 1024 + chh + half * 32 + ohh * 16 + 8); \
                pf[2] = *(const u32x4*)(proj + orow_g * LDP + C_AY + chh + half * 32 + ohh * 16); pf[3] = *(const u32x4*)(proj + orow_g * LDP + C_AY + chh + half * 32 + ohh * 16 + 8); } } while (0)
        LRU_PREFETCH(0); LRU_PREFETCH_OUT(0);
        asm volatile("s_waitcnt vmcnt(0)" : "+v"(axr[0]), "+v"(axr[1]), "+v"(axr[2]), "+v"(axr[3]), "+v"(axr[4]), "+v"(axr[5]), "+v"(axr[6]) :: "memory");
#pragma unroll 1
        for (int ci = 0; ci < 17; ++ci) {
            LRU_CHUNK(ci, isctx, T0, rowbase);
            if (ci > 0) { LRU_AX_WAIT(ci); } else {
#pragma unroll
                for (int j = 0; j < 7; ++j) { const int tt = 4 * rgd - 2 + j; if (!(tt >= 0 && tt < LCX)) axr[j] = (u32x4){0u, 0u, 0u, 0u}; } }
            { float u[4][8];
#pragma unroll
              for (int r = 0; r < 4; ++r) { const f32x4 b0 = *(const LAS f32x4*)(cwl + 256 + 8 * c8), b1 = *(const LAS f32x4*)(cwl + 256 + 8 * c8 + 4);
                  u[r][0] = b0.x; u[r][1] = b0.y; u[r][2] = b0.z; u[r][3] = b0.w; u[r][4] = b1.x; u[r][5] = b1.y; u[r][6] = b1.z; u[r][7] = b1.w; }
#pragma unroll
              for (int j = 0; j < 7; ++j) { float x[8]; x[0] = bflo(axr[j].x); x[1] = bfhi(axr[j].x); x[2] = bflo(axr[j].y); x[3] = bfhi(axr[j].y); x[4] = bflo(axr[j].z); x[5] = bfhi(axr[j].z); x[6] = bflo(axr[j].w); x[7] = bfhi(axr[j].w);
#pragma unroll
                  for (int t = 0; t < 4; ++t) { const int r = j - t; if (r >= 0 && r < 4) {
                      const f32x4 w0 = *(const LAS f32x4*)(cwl + 64 * t + 8 * c8), w1 = *(const LAS f32x4*)(cwl + 64 * t + 8 * c8 + 4);
                      u[r][0] += w0.x * x[0]; u[r][1] += w0.y * x[1]; u[r][2] += w0.z * x[2]; u[r][3] += w0.w * x[3]; u[r][4] += w1.x * x[4]; u[r][5] += w1.y * x[5]; u[r][6] += w1.z * x[6]; u[r][7] += w1.w * x[7]; } } }
#pragma unroll
              for (int r = 0; r < 4; ++r) { const int tl = 4 * rgd + r, p = dir ? (255 - tl) : tl;
                  u32x4 o; o.x = pk2(u[r][0], u[r][1]); o.y = pk2(u[r][2], u[r][3]); o.z = pk2(u[r][4], u[r][5]); o.w = pk2(u[r][6], u[r][7]); *(LAS u32x4*)(ub + p * 72 + 8 * c8) = o; } }
            if (ci + 1 < 17) LRU_PREFETCH(ci + 1);
            LDS_WAIT(); asm volatile("" ::: "memory");
            float hl[2][2][4], Ac[2][2][4], sa[2][2], sb[2][2];
            bf16x8 Ba[2][2], Bx[2][2];
#pragma unroll
            for (int cb = 0; cb < 2; ++cb)
#pragma unroll
                for (int ks = 0; ks < 2; ++ks) { Ba[cb][ks] = ldfrag(waT, cb * 16, ks * 32, 72, lane); Bx[cb][ks] = ldfrag(wxT, cb * 16, ks * 32, 72, lane); }
#pragma unroll
            for (int rb = 0; rb < 2; ++rb) { const bf16x8 A0 = ldfrag(ub, 32 * w + 16 * rb, 0, 72, lane), A1 = ldfrag(ub, 32 * w + 16 * rb, 32, 72, lane);
#pragma unroll
                for (int cb = 0; cb < 2; ++cb) {
                    f32x4 ra = (f32x4){0.f, 0.f, 0.f, 0.f}, rx = ra;
                    ra = MFMA16(A0, Ba[cb][0], ra); ra = MFMA16(A1, Ba[cb][1], ra); rx = MFMA16(A0, Bx[cb][0], rx); rx = MFMA16(A1, Bx[cb][1], rx);
                    float hprev = 0.f, aprev = 1.f;
#pragma unroll
                    for (int r = 0; r < 4; ++r) { const int p = 32 * w + 16 * rb + 4 * q + r; const float u = bf2f(ub[p * 72 + half * 32 + cb * 16 + fr]);
                        const float rgt = fast_sigmoid(ra[r] + ba_[cb]), igt = fast_sigmoid(rx[r] + bx_[cb]);
                        const float a = __builtin_amdgcn_exp2f(sp8_[cb] * rgt), bb = __builtin_amdgcn_sqrtf(fmaxf((1.0f - a) * (1.0f + a), 0.f)) * (igt * u);
                        hprev = a * hprev + bb; aprev = a * aprev; hl[rb][cb][r] = hprev; Ac[rb][cb][r] = aprev; }
                    sa[rb][cb] = aprev; sb[rb][cb] = hprev; } }
            float ea[2][2], eb[2][2];
            const int par = ci & 1;
#pragma unroll
            for (int cb = 0; cb < 2; ++cb) { float ia[2], ib[2];
#pragma unroll
                for (int rb = 0; rb < 2; ++rb) { float a = sa[rb][cb], bq = sb[rb][cb];
                    float a1 = __shfl_up(a, 16), b1 = __shfl_up(bq, 16); if (q >= 1) { bq = a * b1 + bq; a = a * a1; }
                    a1 = __shfl_up(a, 32); b1 = __shfl_up(bq, 32); if (q >= 2) { bq = a * b1 + bq; a = a * a1; }
                    ia[rb] = a; ib[rb] = bq;
                    a1 = __shfl_up(a, 16); b1 = __shfl_up(bq, 16); ea[rb][cb] = q ? a1 : 1.0f; eb[rb][cb] = q ? b1 : 0.0f; }
                const float t0a = __shfl(ia[0], 48 + fr), t0b = __shfl(ib[0], 48 + fr);
                eb[1][cb] = ea[1][cb] * t0b + eb[1][cb]; ea[1][cb] = ea[1][cb] * t0a;
                if (q == 3) wcomp[(par * 8 + w) * 32 + cb * 16 + fr] = (f32x2){ia[1] * t0a, ia[1] * t0b + ib[1]}; }
            LDS_BARRIER();
#pragma unroll
            for (int cb = 0; cb < 2; ++cb) { float h = carry[cb], hin = h;
#pragma unroll
                for (int k = 0; k < 8; ++k) { const f32x2 c = wcomp[(par * 8 + k) * 32 + cb * 16 + fr]; h = c.x * h + c.y; hin = (k + 1 == w) ? h : hin; }
                carry[cb] = h;
#pragma unroll
                for (int rb = 0; rb < 2; ++rb) { const float hs = ea[rb][cb] * hin + eb[rb][cb];
#pragma unroll
                    for (int r = 0; r < 4; ++r) { const int p = 32 * w + 16 * rb + 4 * q + r; ho[p * 40 + cb * 16 + fr] = (bf16)f2bf(Ac[rb][cb][r] * hs + hl[rb][cb][r]); } } }
            LDS_WAIT(); asm volatile("" ::: "memory");
            { const int tl = dir ? (255 - orow) : orow; const size_t row = rowbase + T0 + tl;
              const u32x4 h0 = *(const LAS u32x4*)(ho + orow * 40 + ohh * 16), h1 = *(const LAS u32x4*)(ho + orow * 40 + ohh * 16 + 8);
              if (dir == 0) { *(u32x4*)(X + row * 1024 + chh + half * 32 + ohh * 16) = h0; *(u32x4*)(X + row * 1024 + chh + half * 32 + ohh * 16 + 8) = h1; }
              else { u32x4 o0, o1;
#define LRU_Y(hb, hf, ay) pk2((bflo(hf) + bflo(hb)) * fast_gelu_tanh(bflo(ay)), (bfhi(hf) + bfhi(hb)) * fast_gelu_tanh(bfhi(ay)))
                  o0.x = LRU_Y(h0.x, pf[0].x, pf[2].x); o0.y = LRU_Y(h0.y, pf[0].y, pf[2].y); o0.z = LRU_Y(h0.z, pf[0].z, pf[2].z); o0.w = LRU_Y(h0.w, pf[0].w, pf[2].w);
                  o1.x = LRU_Y(h1.x, pf[1].x, pf[3].x); o1.y = LRU_Y(h1.y, pf[1].y, pf[3].y); o1.z = LRU_Y(h1.z, pf[1].z, pf[3].z); o1.w = LRU_Y(h1.w, pf[1].w, pf[3].w);
#undef LRU_Y
                  { bf16* yb_ = F_YB(F) + row * 3072 + chh + half * 32 + ohh * 16; *(u32x4*)yb_ = o0; *(u32x4*)(yb_ + 8) = o1; } } }
            if (ci + 1 < 17) LRU_PREFETCH_OUT(ci + 1);
        }
#undef LRU_AX_WAIT
#undef LRU_PREFETCH_OUT
#undef LRU_PREFETCH
#undef LRU_CHUNK
    }
}
__device__ __forceinline__ size_t ret_rowbase(int b, int cidx) { return cidx < 2 ? (size_t)NLAT + b * LCX + cidx * 128 : (size_t)b * SEQ + (cidx - 2) * 128; }
__device__ __forceinline__ float ret_logg(Frame& F, int l, int dir, int h) { const float lam = FIN(I_RLAM)[(l * 2 + dir) * 8 + h]; return -log1p_fast(__expf(-lam)); }

__device__ __forceinline__ void ret_load_qk(Frame& F, const bf16* src  , bool rope, int pos0, float scale, float (&o1)[8], float (&o2)[8]) {
    const int row = F.tid >> 2, cp = F.tid & 3;
    const u32x4 a = *(const u32x4*)(src + (size_t)row * LDP + 8 * cp), b = *(const u32x4*)(src + (size_t)row * LDP + 32 + 8 * cp);
    float x1[8] = {bflo(a.x), bfhi(a.x), bflo(a.y), bfhi(a.y), bflo(a.z), bfhi(a.z), bflo(a.w), bfhi(a.w)};
    float x2[8] = {bflo(b.x), bfhi(b.x), bflo(b.y), bfhi(b.y), bflo(b.z), bfhi(b.z), bflo(b.w), bfhi(b.w)};
    if (rope) { const f32x2* rt = (const f32x2*)(F.ws + WS_ROPE) + (size_t)(pos0 + row) * 32 + 8 * cp;
#pragma unroll
        for (int e = 0; e < 8; ++e) { const f32x2 cs = rt[e]; o1[e] = (x1[e] * cs.x - x2[e] * cs.y) * scale; o2[e] = (x2[e] * cs.x + x1[e] * cs.y) * scale; }
    } else {
#pragma unroll
        for (int e = 0; e < 8; ++e) { o1[e] = x1[e] * scale; o2[e] = x2[e] * scale; }
    }
}
__device__ __forceinline__ void ph_ret_r1(Frame& F, int l) {
    LAS bf16* Kf = (LAS bf16*)F.lds;
    LAS bf16* Kb = Kf + 128 * 72;
    LAS bf16* Vs = Kb + 128 * 72;
    const int tid = F.tid, lane = F.lane, w = F.wave, q = lane >> 4, fr = lane & 15;
    const bf16* proj = F_PROJ(F);
    const int row = tid >> 2, cp = tid & 3;
    u32x4 ka, kb, vv[4];
#define R1_LOAD(u) do { const int bh__ = (u) / 34, ci__ = (u) % 34; const size_t rb__ = ret_rowbase(bh__ >> 3, ci__); const int h__ = bh__ & 7; \
        const bf16* ks_ = proj + (rb__ + row) * LDP + C_BK + h__ * 64 + 8 * cp; ka = *(const u32x4*)ks_; kb = *(const u32x4*)(ks_ + 32); \
        _Pragma("unroll") for (int i = 0; i < 4; ++i) { const int t_ = tid + 512 * i; vv[i] = *(const u32x4*)(proj + (rb__ + (t_ >> 4)) * LDP + C_BV + h__ * 128 + 8 * (t_ & 15)); } } while (0)
    int u = F.bid;
    if (u < 64 * 34) R1_LOAD(u);
    const int dir = w >> 2, e0 = 32 * (w & 3);
    const unsigned vlane = (unsigned)(size_t)Vs + (unsigned)((8 * q + (fr >> 2)) * 272 + (fr & 3) * 8 + e0 * 2);
    const unsigned klane = (unsigned)(size_t)(dir ? Kb : Kf) + (unsigned)((8 * q + (fr >> 2)) * 144 + (fr & 3) * 8);
#pragma unroll 1
    for (; u < 64 * 34; u += F.G) {
        const int bh = u / 34, cidx = u % 34, b = bh >> 3, h = bh & 7; const bool lat = cidx >= 2;
        const float lg0 = ret_logg(F, l, 0, h), lg1 = ret_logg(F, l, 1, h);
        LDS_BARRIER();
        { float x1[8], x2[8], o1[8], o2[8]; unpack8(ka, x1); unpack8(kb, x2);
          if (lat) { const f32x2* rt = (const f32x2*)(F.ws + WS_ROPE) + (size_t)((cidx - 2) * 128 + row) * 32 + 8 * cp;
#pragma unroll
              for (int e = 0; e < 8; ++e) { const f32x2 cs = rt[e]; o1[e] = (x1[e] * cs.x - x2[e] * cs.y) * 0.125f; o2[e] = (x2[e] * cs.x + x1[e] * cs.y) * 0.125f; } }
          else {
#pragma unroll
              for (int e = 0; e < 8; ++e) { o1[e] = x1[e] * 0.125f; o2[e] = x2[e] * 0.125f; } }
          const float df = __expf(lg0 * (float)(127 - row)), db = __expf(lg1 * (float)row);
          *(LAS u32x4*)(Kf + row * 72 + 8 * cp) = pack8(o1, df); *(LAS u32x4*)(Kf + row * 72 + 32 + 8 * cp) = pack8(o2, df);
          *(LAS u32x4*)(Kb + row * 72 + 8 * cp) = pack8(o1, db); *(LAS u32x4*)(Kb + row * 72 + 32 + 8 * cp) = pack8(o2, db); }
#pragma unroll
        for (int i = 0; i < 4; ++i) { const int t = tid + 512 * i; *(LAS u32x4*)(Vs + (t >> 4) * 136 + 8 * (t & 15)) = vv[i]; }
        LDS_BARRIER();
        if (u + F.G < 64 * 34) R1_LOAD(u + F.G);
        f32x4 acc[2][4];
#pragma unroll
        for (int eb = 0; eb < 2; ++eb)
#pragma unroll
            for (int db = 0; db < 4; ++db) acc[eb][db] = (f32x4){0.f, 0.f, 0.f, 0.f};
#pragma unroll
        for (int ks = 0; ks < 4; ++ks) { bf16x8 av[4], bk[4];
            tr_frags4<272>(vlane + ks * 32 * 272, av);
            tr_frags4<144>(klane + ks * 32 * 144, bk);
#pragma unroll
            for (int eb = 0; eb < 2; ++eb)
#pragma unroll
                for (int db = 0; db < 4; ++db) acc[eb][db] = MFMA16(bk[db], av[eb], acc[eb][db]); }
        bf16* kv = (bf16*)(F.ws + WS_KV) + ((((size_t)(b * 8 + h) * 34 + cidx) * 2) + dir) * 8192;
#pragma unroll
        for (int eb = 0; eb < 2; ++eb)
#pragma unroll
            for (int db = 0; db < 4; ++db) { u32x2 o; o.x = pk2(acc[eb][db][0], acc[eb][db][1]); o.y = pk2(acc[eb][db][2], acc[eb][db][3]);
                *(u32x2*)(kv + (e0 + 16 * eb + fr) * 64 + 16 * db + 4 * q) = o; }
    }
#undef R1_LOAD
}
__device__ __forceinline__ void ret_scan(Frame& F, int l) {
    unsigned* kvw = (unsigned*)(F.ws + WS_KV);
    for (int i = F.bid * 512 + F.tid; i < 64 * 2 * 4096; i += F.G * 512) { const int pr = i & 4095, dir = (i >> 12) & 1, bh = i >> 13, h = bh & 7;
        const float gC = __expf(ret_logg(F, l, dir, h) * 128.0f);
        unsigned* base = kvw + ((size_t)bh * 34 * 2 + dir) * 4096 + pr;
        unsigned v[34];
#pragma unroll
        for (int k = 0; k < 34; ++k) v[k] = base[(size_t)k * 8192];
        float s0 = 0.f, s1 = 0.f;
        if (dir == 0) {
#pragma unroll
            for (int k = 0; k < 34; ++k) { const unsigned x = v[k]; v[k] = pk2(s0, s1); s0 = gC * s0 + bflo(x); s1 = gC * s1 + bfhi(x); }
        } else {
#pragma unroll
            for (int k = 0; k < 34; ++k) { const int c = k < 2 ? 1 - k : 35 - k; const unsigned x = v[c]; v[c] = pk2(s0, s1); s0 = gC * s0 + bflo(x); s1 = gC * s1 + bfhi(x); }
        }
        if (F.wr) {
#pragma unroll
            for (int k = 0; k < 34; ++k) base[(size_t)k * 8192] = v[k]; }
    }
}
__device__ __forceinline__ void ph_ret_r2(Frame& F, int l, bool lastl) {
    LAS bf16* Qs = (LAS bf16*)F.lds;
    LAS bf16* Ks = Qs + 128 * 72;
    LAS bf16* Vs = Ks + 128 * 72;
    LAS bf16* Ps = Vs + 128 * 136 + F.wave * (16 * 136);
    LAS bf16* Ss = Vs + 128 * 136 + 8 * (16 * 136);
    const int tid = F.tid, lane = F.lane, w = F.wave, q = lane >> 4, fr = lane & 15;
    const bf16* proj = F_PROJ(F);
    const int nch = lastl ? 32 : 34, nunits = 64 * nch;
    const int row = tid >> 2, cp = tid & 3;
    u32x4 qa, qb_, ka, kb, vv[4], sv[4];
#define R2_DECODE(u, bh_, cidx_) const int bh_ = (u) / nch, cidx_ = (u) % nch + (lastl ? 2 : 0)
#define R2_LOAD(u) do { R2_DECODE(u, bh__, ci__); const size_t rb__ = ret_rowbase(bh__ >> 3, ci__); const int h__ = bh__ & 7; \
        const bf16* qs_ = proj + (rb__ + row) * LDP + C_BQ + h__ * 64 + 8 * cp; qa = *(const u32x4*)qs_; qb_ = *(const u32x4*)(qs_ + 32); \
        const bf16* ks_ = proj + (rb__ + row) * LDP + C_BK + h__ * 64 + 8 * cp; ka = *(const u32x4*)ks_; kb = *(const u32x4*)(ks_ + 32); \
        _Pragma("unroll") for (int i = 0; i < 4; ++i) { const int t_ = tid + 512 * i; vv[i] = *(const u32x4*)(proj + (rb__ + (t_ >> 4)) * LDP + C_BV + h__ * 128 + 8 * (t_ & 15)); \
            sv[i] = *(const u32x4*)((const bf16*)(F.ws + WS_KV) + (((size_t)bh__ * 34 + ci__) * 2) * 8192 + (size_t)t_ * 8); } } while (0)
    int u = F.bid;
    if (u < nunits) R2_LOAD(u);
    const unsigned vlane = (unsigned)(size_t)Vs + (unsigned)((8 * q + (fr >> 2)) * 272 + (fr & 3) * 8);
#pragma unroll 1
    for (; u < nunits; u += F.G) {
        R2_DECODE(u, bh, cidx); const int b = bh >> 3, h = bh & 7; const size_t rb = ret_rowbase(b, cidx); const bool lat = cidx >= 2;
        const float lg0 = ret_logg(F, l, 0, h), lg1 = ret_logg(F, l, 1, h);
        LDS_BARRIER();
        { float x1[8], x2[8], o1[8], o2[8];
          unpack8(qa, x1); unpack8(qb_, x2);
          if (lat) { const f32x2* rt = (const f32x2*)(F.ws + WS_ROPE) + (size_t)((cidx - 2) * 128 + row) * 32 + 8 * cp;
#pragma unroll
              for (int e = 0; e < 8; ++e) { const f32x2 cs = rt[e]; o1[e] = x1[e] * cs.x - x2[e] * cs.y; o2[e] = x2[e] * cs.x + x1[e] * cs.y; } }
          else {
#pragma unroll
              for (int e = 0; e < 8; ++e) { o1[e] = x1[e]; o2[e] = x2[e]; } }
          *(LAS u32x4*)(Qs + row * 72 + 8 * cp) = pack8(o1, 1.0f); *(LAS u32x4*)(Qs + row * 72 + 32 + 8 * cp) = pack8(o2, 1.0f);
          unpack8(ka, x1); unpack8(kb, x2);
          if (lat) { const f32x2* rt = (const f32x2*)(F.ws + WS_ROPE) + (size_t)((cidx - 2) * 128 + row) * 32 + 8 * cp;
#pragma unroll
              for (int e = 0; e < 8; ++e) { const f32x2 cs = rt[e]; o1[e] = x1[e] * cs.x - x2[e] * cs.y; o2[e] = x2[e] * cs.x + x1[e] * cs.y; } }
          else {
#pragma unroll
              for (int e = 0; e < 8; ++e) { o1[e] = x1[e]; o2[e] = x2[e]; } }
          *(LAS u32x4*)(Ks + row * 72 + 8 * cp) = pack8(o1, 0.125f); *(LAS u32x4*)(Ks + row * 72 + 32 + 8 * cp) = pack8(o2, 0.125f); }
#pragma unroll
        for (int i = 0; i < 4; ++i) { const int t = tid + 512 * i; *(LAS u32x4*)(Vs + (t >> 4) * 136 + 8 * (t & 15)) = vv[i]; *(LAS u32x4*)(Ss + (t >> 3) * 72 + 8 * (t & 7)) = sv[i]; }
        LDS_BARRIER();
        if (u + F.G < nunits) R2_LOAD(u + F.G);
        const int il = 16 * w + fr;
        const bf16x8 Bq0 = ldfrag(Qs, 16 * w, 0, 72, lane), Bq1 = ldfrag(Qs, 16 * w, 32, 72, lane);
        const float l2g0 = lg0 * 1.4426950408889634f, l2g1 = lg1 * 1.4426950408889634f;
#pragma unroll
        for (int jb = 0; jb < 8; ++jb) { f32x4 acc = (f32x4){0.f, 0.f, 0.f, 0.f};
            acc = MFMA16(ldfrag(Ks, 16 * jb, 0, 72, lane), Bq0, acc); acc = MFMA16(ldfrag(Ks, 16 * jb, 32, 72, lane), Bq1, acc);
            float pv[4];
#pragma unroll
            for (int r = 0; r < 4; ++r) { const int j = 16 * jb + 4 * q + r; const int dd = il - j;
                const float df = dd >= 0 ? __builtin_amdgcn_exp2f(l2g0 * (float)dd) : 0.f, dbk = dd <= 0 ? __builtin_amdgcn_exp2f(l2g1 * (float)(-dd)) : 0.f;
                pv[r] = acc[r] * (df + dbk); }
            u32x2 pw; pw.x = pg8::cvt_pk_bf16(pv[0], pv[1]); pw.y = pg8::cvt_pk_bf16(pv[2], pv[3]); *(LAS u32x2*)(Ps + fr * 136 + 16 * jb + 4 * q) = pw; }
        LDS_WAIT(); asm volatile("" ::: "memory");
        const bf16* gp = proj + (rb + il) * LDP + C_BG + h * 128 + 4 * q;
        u32x2 gwv[4];
#pragma unroll
        for (int eb = 0; eb < 4; ++eb) gwv[eb] = *(const u32x2*)(gp + 16 * eb);
        f32x4 Y[8];
#pragma unroll
        for (int eb = 0; eb < 8; ++eb) Y[eb] = (f32x4){0.f, 0.f, 0.f, 0.f};
#pragma unroll
        for (int ks = 0; ks < 4; ++ks) { const bf16x8 bp = ldfrag(Ps, 0, 32 * ks, 136, lane); bf16x8 av[4];
            tr_frags4<272>(vlane + ks * 32 * 272, av);
#pragma unroll
            for (int eb = 0; eb < 4; ++eb) Y[eb] = MFMA16(av[eb], bp, Y[eb]);
            tr_frags4<272>(vlane + ks * 32 * 272 + 128, av);
#pragma unroll
            for (int eb = 0; eb < 4; ++eb) Y[4 + eb] = MFMA16(av[eb], bp, Y[4 + eb]); }
        const float qf = __builtin_amdgcn_exp2f(l2g0 * (float)(il + 1)), qbw = __builtin_amdgcn_exp2f(l2g1 * (float)(128 - il));
#pragma unroll
        for (int eb = 0; eb < 8; ++eb) { f32x4 zf = (f32x4){0.f, 0.f, 0.f, 0.f}, zb = zf;
            zf = MFMA16(ldfrag(Ss, 16 * eb, 0, 72, lane), Bq0, zf); zf = MFMA16(ldfrag(Ss, 16 * eb, 32, 72, lane), Bq1, zf);
            zb = MFMA16(ldfrag(Ss, 128 + 16 * eb, 0, 72, lane), Bq0, zb); zb = MFMA16(ldfrag(Ss, 128 + 16 * eb, 32, 72, lane), Bq1, zb);
            Y[eb] = Y[eb] + zf * qf + zb * qbw; }
        float s = 0.f;
#pragma unroll
        for (int eb = 0; eb < 8; ++eb) s += (Y[eb][0] + Y[eb][1]) + (Y[eb][2] + Y[eb][3]);
        s += __shfl_xor(s, 16); s += __shfl_xor(s, 32);
        const float mu = s * (1.0f / 128.0f); float vq = 0.f;
#pragma unroll
        for (int eb = 0; eb < 8; ++eb) { const f32x4 d = Y[eb] - mu; vq += (d[0] * d[0] + d[1] * d[1]) + (d[2] * d[2] + d[3] * d[3]); }
        vq += __shfl_xor(vq, 16); vq += __shfl_xor(vq, 32);
        const float rstd = __builtin_amdgcn_rsqf(vq * (1.0f / 128.0f) + EPS);
        bf16* yo = F_YB(F) + (rb + il) * 3072 + 1024 + h * 128 + 4 * q;
        u32x2 gw2[4];
#pragma unroll
        for (int eb = 0; eb < 4; ++eb) gw2[eb] = *(const u32x2*)(gp + 16 * (4 + eb));
#pragma unroll
        for (int eb = 0; eb < 8; ++eb) { const u32x2 gw = eb < 4 ? gwv[eb & 3] : gw2[eb & 3]; const f32x4 yn = (Y[eb] - mu) * rstd;
            u32x2 o; o.x = pg8::cvt_pk_bf16(gm::fsilu_(bflo(gw.x)) * yn[0], gm::fsilu_(bfhi(gw.x)) * yn[1]); o.y = pg8::cvt_pk_bf16(gm::fsilu_(bflo(gw.y)) * yn[2], gm::fsilu_(bfhi(gw.y)) * yn[3]);
            if (F.wr) *(u32x2*)(yo + 16 * eb) = o; }
    }
#undef R2_LOAD
#undef R2_DECODE
}
__device__ __forceinline__ void att_rope_keys(Frame& F) {
    bf16* proj = F_PROJ(F); const f32x2* atab = (const f32x2*)(F.ws + WS_ROPE + 1 * MiB);
    for (int i = F.bid * 512 + F.tid; i < NLAT * 16; i += F.G * 512) { const int pr = i & 3, g = (i >> 2) & 3, row = i >> 4; const int c = (pr & 1) + 4 * (pr >> 1);
        bf16* src = proj + (size_t)row * LDP + C_CK + g * 64 + 8 * c;
        float x1[8], x2[8], o1[8], o2[8]; unpack8(*(const u32x4*)src, x1); unpack8(*(const u32x4*)(src + 16), x2);
        const int pos = row & (SEQ - 1); const int ap = (pr >> 1) ? (pos & 63) : (pos >> 6); att_rope8(atab + ap * 16 + 8 * (pr & 1), x1, x2, o1, o2);
        if (F.wr) { *(u32x4*)src = pack8(o1, 1.0f); *(u32x4*)(src + 16) = pack8(o2, 1.0f); } }
}
__device__ __forceinline__ void att_unit(Frame& F, int l, int b, int g, int qb, bool isctxq) {
    LAS bf16* Kt = (LAS bf16*)F.lds;
    LAS bf16* Vt = Kt + 64 * 72;
    LAS bf16* Pw = Vt + 64 * 72 + F.wave * (64 * 72);
    const int tid = F.tid, lane = F.lane, w = F.wave, q = lane >> 4, fr = lane & 15;
    const bf16* proj = F_PROJ(F); const f32x2* atab = (const f32x2*)(F.ws + WS_ROPE + 1 * MiB);
    const int hq = 4 * g + (w >> 1);
    const size_t qrow0 = (isctxq ? (size_t)NLAT + b * LCX : (size_t)b * SEQ) + qb * 128 + (w & 1) * 64;
    const int qpos0 = qb * 128 + (w & 1) * 64;
    constexpr float QS = 0.125f * 1.4426950408889634f;
    unsigned vmask = 0xFu;
    if (!isctxq) {
#pragma unroll
        for (int t = 4; t < 10; ++t) { const int kp = qb * 128 - 128 + 64 * (t - 4); if (kp >= 0 && kp < SEQ) vmask |= 1u << t; } }
    const int vrow = tid >> 3, vc8 = tid & 7;
    u32x4 kx = (u32x4){0u, 0u, 0u, 0u}, vx = kx;
#define ATT_KROW0(t) ((t) >= 4 ? (size_t)b * SEQ + (qb * 128 - 128 + 64 * ((t) - 4)) : (size_t)NLAT + b * LCX + 64 * (t))
#define ATT_LOAD(t) do { const size_t kr0_ = ATT_KROW0(t); kx = *(const u32x4*)(proj + (kr0_ + vrow) * LDP + C_CK + g * 64 + 8 * vc8); \
        vx = *(const u32x4*)(proj + (kr0_ + vrow) * LDP + C_CV + g * 64 + 8 * vc8); } while (0)
    int t = __builtin_ctz(vmask); vmask &= vmask - 1;
    ATT_LOAD(t);
    LDS_BARRIER();
#pragma unroll
    for (int i = 0; i < 4; ++i) { const int tt = lane + 64 * i, row = tt >> 2, pr = tt & 3;
        const int c = (pr & 1) + 4 * (pr >> 1); const bf16* src = proj + (qrow0 + row) * LDP + C_CQ + hq * 64;
        float x1[8], x2[8], o1[8], o2[8]; unpack8(*(const u32x4*)(src + 8 * c), x1); unpack8(*(const u32x4*)(src + 8 * c + 16), x2);
        if (!isctxq) { const int pos = qpos0 + row; const int ap = (pr >> 1) ? (pos & 63) : (pos >> 6); att_rope8(atab + ap * 16 + 8 * (pr & 1), x1, x2, o1, o2); }
        else {
#pragma unroll
            for (int e = 0; e < 8; ++e) { o1[e] = x1[e]; o2[e] = x2[e]; } }
        *(LAS u32x4*)(Pw + row * 72 + 8 * c) = pack8(o1, QS); *(LAS u32x4*)(Pw + row * 72 + 8 * c + 16) = pack8(o2, QS); }
    LDS_WAIT(); asm volatile("" ::: "memory");
    bf16x8 Bq[4][2];
#pragma unroll
    for (int ib = 0; ib < 4; ++ib)
#pragma unroll
        for (int ks = 0; ks < 2; ++ks) Bq[ib][ks] = ldfrag(Pw, 16 * ib, 32 * ks, 72, lane);
    LDS_WAIT(); asm volatile("" ::: "memory");
    const float sink = FIN(I_SINK)[l * 16 + hq] * 1.4426950408889634f;
    float mrow[4], lrow[4], aprev[4]; f32x4 O[4][4];
#pragma unroll
    for (int ib = 0; ib < 4; ++ib) { mrow[ib] = sink; aprev[ib] = 1.0f; lrow[ib] = (q == 0) ? 1.0f : 0.0f;
#pragma unroll
        for (int db = 0; db < 4; ++db) O[db][ib] = (f32x4){0.f, 0.f, 0.f, 0.f}; }
    const unsigned vt_lane = (unsigned)(size_t)Vt + (unsigned)((8 * q + (fr >> 2)) * 144 + (fr & 3) * 8);
#pragma unroll 1
    for (;;) {
        const int kpos0 = t >= 4 ? (qb * 128 - 128 + 64 * (t - 4)) : 0;
        LDS_BARRIER();
        *(LAS u32x4*)(Kt + vrow * 72 + 8 * vc8) = kx;
        *(LAS u32x4*)(Vt + vrow * 72 + 8 * vc8) = vx;
        LDS_BARRIER();
        const int tcur = t; const bool more = vmask != 0u;
        if (more) { t = __builtin_ctz(vmask); vmask &= vmask - 1; ATT_LOAD(t); }
        const bool skipt = !isctxq && tcur == ((w & 1) ? 4 : 9);
        const bool maskt = !isctxq && (tcur == ((w & 1) ? 5 : 4) || tcur == ((w & 1) ? 9 : 8));
        if (!skipt) {
#pragma unroll
        for (int hf = 0; hf < 2; ++hf) {
            f32x4 S[4][2];
#pragma unroll
            for (int jb = 0; jb < 4; ++jb) { const bf16x8 a0 = ldfrag(Kt, 16 * jb, 0, 72, lane), a1 = ldfrag(Kt, 16 * jb, 32, 72, lane);
#pragma unroll
                for (int i2 = 0; i2 < 2; ++i2) { const float nm = -mrow[2 * hf + i2]; f32x4 acc = (f32x4){nm, nm, nm, nm};
                    acc = MFMA16(a0, Bq[2 * hf + i2][0], acc); acc = MFMA16(a1, Bq[2 * hf + i2][1], acc); S[jb][i2] = acc; } }
            if (maskt) {
#pragma unroll
                for (int jb = 0; jb < 4; ++jb)
#pragma unroll
                    for (int i2 = 0; i2 < 2; ++i2)
#pragma unroll
                        for (int r = 0; r < 4; ++r) { const int dd = (qpos0 + 16 * (2 * hf + i2) + fr) - (kpos0 + 16 * jb + 4 * q + r); if (dd > 128 || dd < -128) S[jb][i2][r] = -1.0e30f; }
            }
#pragma unroll
            for (int i2 = 0; i2 < 2; ++i2) { const int ib = 2 * hf + i2;
                float mx = -1.0e30f;
#pragma unroll
                for (int jb = 0; jb < 4; ++jb) mx = fmaxf(mx, fmaxf(fmaxf(S[jb][i2][0], S[jb][i2][1]), fmaxf(S[jb][i2][2], S[jb][i2][3])));
                mx = fmaxf(mx, __shfl_xor(mx, 16)); mx = fmaxf(mx, __shfl_xor(mx, 32));
                const float alpha = aprev[ib]; const float dm = fmaxf(mx, 0.f); aprev[ib] = __builtin_amdgcn_exp2f(-dm); mrow[ib] += dm;
                float ps = 0.f;
#pragma unroll
                for (int jb = 0; jb < 4; ++jb) { float p[4];
#pragma unroll
                    for (int r = 0; r < 4; ++r) { p[r] = __builtin_amdgcn_exp2f(S[jb][i2][r]); ps += p[r]; }
                    u32x2 pw; pw.x = pk2(p[0], p[1]); pw.y = pk2(p[2], p[3]); *(LAS u32x2*)(Pw + (16 * ib + fr) * 72 + 16 * jb + 4 * q) = pw; }
                lrow[ib] = lrow[ib] * alpha + ps;
#pragma unroll
                for (int db = 0; db < 4; ++db) O[db][ib] = O[db][ib] * alpha;
            }
        }
        LDS_WAIT(); asm volatile("" ::: "memory");
#pragma unroll
        for (int ks = 0; ks < 2; ++ks) { bf16x8 av[4], bp[4];
            tr_frags4<144>(vt_lane + ks * 32 * 144, av); __builtin_amdgcn_sched_barrier(0);
#pragma unroll
            for (int ib = 0; ib < 4; ++ib) bp[ib] = ldfrag(Pw, 16 * ib, 32 * ks, 72, lane);
#pragma unroll
            for (int db = 0; db < 4; ++db)
#pragma unroll
                for (int ib = 0; ib < 4; ++ib) O[db][ib] = MFMA16(av[db], bp[ib], O[db][ib]); }
        LDS_WAIT(); asm volatile("" ::: "memory");
        }
        if (!more) break;
    }
#undef ATT_LOAD
#undef ATT_KROW0
#pragma unroll
    for (int ib = 0; ib < 4; ++ib) { float lt = lrow[ib]; lt += __shfl_xor(lt, 16); lt += __shfl_xor(lt, 32); const float inv = __builtin_amdgcn_rcpf(lt);
        bf16* dst = F_YB(F) + (qrow0 + 16 * ib + fr) * 3072 + 2048 + hq * 64 + 4 * q;
#pragma unroll
        for (int db = 0; db < 4; ++db) { const f32x4 o = O[db][ib] * inv; u32x2 ow; ow.x = pg8::cvt_pk_bf16(o[0], o[1]); ow.y = pg8::cvt_pk_bf16(o[2], o[3]); if (F.wr) *(u32x2*)(dst + 16 * db) = ow; } }
}
#ifndef PROBE_MASK
#define PROBE_MASK 0
#endif
#ifndef PROBE_SUB
#define PROBE_SUB 0
#endif
#ifdef PROBE_REAL
#define WR_DRY wr_true
#else
#define WR_DRY wr_false
#endif
#define NREP(n) (((PROBE_MASK >> (n)) & 1) ? 2 : 1)
#ifndef DIAG_PH
#define PHON(n) true
#else
#define PHON(n) ((n) == DIAG_PH)
#endif
constexpr int N_PHASES = 2 + 10 * DEPTH;
__global__ void __launch_bounds__(512, 2) fwd_kernel(Args args) {
    extern __shared__ __attribute__((aligned(16))) unsigned char lds_raw[];
    Frame F; F.lds = (LAS unsigned char*)lds_raw; F.tid = threadIdx.x; F.lane = F.tid & 63; F.wave = __builtin_amdgcn_readfirstlane(F.tid >> 6);
    F.G = gridDim.x; F.bid = blockIdx.x; F.gw = F.bid * 8 + F.wave; F.NGW = F.G * 8; F.in = (const __attribute__((address_space(4))) cfp_t*)__builtin_amdgcn_kernarg_segment_ptr(); F.out = args.out; F.ws = args.ws;
    volatile LAS unsigned* MISC = (volatile LAS unsigned*)(F.lds + MISC_OFF);
    for (int u = F.tid; u < (LDS_BYTES - LDS_CTL) / 4; u += 512) ((LAS unsigned*)(F.lds + LDS_CTL))[u] = 0u;
    __syncthreads();
    unsigned* ctl = (unsigned*)(F.ws + WS_CTL);
#if MK_N_LAUNCHES == 1
    XcdBarrier bar = xcd_barrier_post(ctl + CW_BAR, MISC + 8, gridDim.x);
    XcdBarrier sbar = xcd_barrier_post(ctl + (blockIdx.x < 32 ? CW_BAR_C : CW_BAR_L), MISC + 12, blockIdx.x < 32 ? 32u : gridDim.x - 32u);
#define SUB_BAR() do { GAS unsigned* _bp = (GAS unsigned*)sbar.bar; asm volatile("" : "+s"(_bp)); XcdBarrier _b2 = sbar; _b2.bar = (unsigned*)_bp; xcd_barrier(_b2); } while (0)
#define GRID_BAR() do { GAS unsigned* _bp = (GAS unsigned*)bar.bar; asm volatile("" : "+s"(_bp)); XcdBarrier _b2 = bar; _b2.bar = (unsigned*)_bp; xcd_barrier(_b2); } while (0)
#else
#define GRID_BAR() do {} while (0)
#define SUB_BAR() do {} while (0)
#endif
    const int wave0 = F.wave; const bool wr_true = args.ph_hi > 0, wr_false = args.ph_hi < 0; F.wr = wr_true;
    const int lo = args.ph_lo, hi = args.ph_hi;
#define FRESH() do { LAS unsigned char* _l = (LAS unsigned char*)lds_raw; asm volatile("" : "+s"(_l)); F.lds = _l; int _ln; asm volatile("v_mbcnt_lo_u32_b32 %0, -1, 0\n\tv_mbcnt_hi_u32_b32 %0, -1, %0" : "=v"(_ln)); F.tid = wave0 * 64 + _ln; F.lane = _ln; F.wave = wave0; F.gw = F.bid * 8 + F.wave; \
        GAS unsigned char* _ws = (GAS unsigned char*)args.ws; asm volatile("" : "+s"(_ws)); F.ws = (unsigned char*)_ws; GAS float* _out = (GAS float*)args.out; asm volatile("" : "+s"(_out)); F.out = (float*)_out; \
        const __attribute__((address_space(4))) cfp_t* _in = (const __attribute__((address_space(4))) cfp_t*)__builtin_amdgcn_kernarg_segment_ptr(); asm volatile("" : "+s"(_in)); F.in = _in; } while (0)
#define IN(k) (lo <= (k) && (k) < hi)
#define SEAM(k) do { if (IN(k) && IN((k) + 1)) GRID_BAR(); } while (0)
    if (PHON(0) && IN(0)) for (int rep_ = NREP(0); rep_ > 0; --rep_) { FRESH(); F.wr = (rep_ == 1) ? wr_true : WR_DRY; if (NREP(0) > 1) GRID_BAR(); ph_prologue(F); } SEAM(0);
    if (PHON(1) && IN(1)) for (int rep_ = NREP(1); rep_ > 0; --rep_) { FRESH(); F.wr = (rep_ == 1) ? wr_true : WR_DRY; if (NREP(1) > 1) GRID_BAR(); ph_convert(F, 0); ph_rows_u(F, 0, true); ph_router_fold(F); } SEAM(1);
#pragma unroll 1
    for (int l = 0; l < DEPTH; ++l) {
        const int pb = 2 + 10 * l; const bool lastl = (l == DEPTH - 1); const int nM2 = lastl ? 128 : 136; const int ntok = lastl ? NLAT : NTOK;
        unsigned char* wt = F.ws + WS_WT;
        if (PHON(2) && IN(pb + 0)) for (int rep_ = NREP(2); rep_ > 0; --rep_) { FRESH(); F.wr = (rep_ == 1) ? wr_true : WR_DRY; if (NREP(2) > 1) GRID_BAR();
            gm::SchedPlain<16, 1024> S; S.init(136, 38, F.G, F.bid); S.A = (const char*)(F.ws + WS_X); S.Bt = (const char*)(wt + WT_IN);
            gm::EpiProj E{F_PROJ(F), F.ws + WS_GT}; pg8::gemm_phase(F.lds, S, E, F.tid);
        } SEAM(pb + 0);
        if (PHON(3) && IN(pb + 1)) for (int rep_ = NREP(3); rep_ > 0; --rep_) { FRESH(); F.wr = (rep_ == 1) ? wr_true : WR_DRY; if (NREP(3) > 1) GRID_BAR();
            if (!(rep_ > 1 && PROBE_SUB == 2)) for (int u = F.bid; u < 256; u += F.G) { const int hu = ((u >> 4) << 3) + (u & 7); lru_unit(F, l, hu >> 4, hu & 15, (u >> 3) & 1); }
            if (!(rep_ > 1 && PROBE_SUB == 1)) { __syncthreads(); ph_ret_r1(F, l); __syncthreads(); }
            att_rope_keys(F);
        } SEAM(pb + 1);
        if (PHON(4) && IN(pb + 2)) for (int rep_ = NREP(4); rep_ > 0; --rep_) { FRESH(); F.wr = (rep_ == 1) ? wr_true : WR_DRY; if (NREP(4) > 1) GRID_BAR();
            if (!(rep_ > 1 && PROBE_SUB == 2)) ret_scan(F, l);
            if (!(rep_ > 1 && PROBE_SUB == 1))
            for (int u = F.bid; u < (lastl ? 1024 : 1088); u += F.G) { const bool cq = u >= 1024; const int v = u - 1024;
                int ab = cq ? (v >> 3) : (u >> 7), ag = cq ? ((v >> 1) & 3) : ((u >> 5) & 3), aq = cq ? (v & 1) : (u & 31);
                if (F.G == 256) { const int x = F.bid & 7, y = F.bid >> 3;
                    ab = x; ag = cq ? (y >> 1) : (u >> 8); aq = cq ? (y & 1) : y; }
                att_unit(F, l, ab, ag, aq, cq); }
        } SEAM(pb + 2);
        if (PHON(5) && IN(pb + 3)) for (int rep_ = NREP(5); rep_ > 0; --rep_) { FRESH(); F.wr = (rep_ == 1) ? wr_true : WR_DRY; if (NREP(5) > 1) GRID_BAR();
            ph_ret_r2(F, l, lastl);
        } SEAM(pb + 3);
#ifdef PROBE_MERGE_K
        if (IN(pb + 4)) { FRESH(); GRID_BAR();
            gm::SchedPlain<PROBE_MERGE_K, 3072> S; S.init(nM2, 4, F.G, F.bid); S.A = (const char*)(F.ws + WS_YB); S.Bt = (const char*)(wt + WT_BR);
            gm::EpiPlain E{(bf16*)(F.ws + WS_KV)}; pg8::gemm_phase(F.lds, S, E, F.tid); GRID_BAR(); }
#endif
        const bool split = !lastl && gridDim.x == 256 && MK_N_LAUNCHES == 1;
        if (PHON(6) && IN(pb + 4)) for (int rep_ = NREP(6); rep_ > 0; --rep_) { FRESH(); F.wr = (rep_ == 1) ? wr_true : WR_DRY; if (NREP(6) > 1) GRID_BAR();
            gm::SchedPlain<48, 3072> S; S.init(split ? 128 : nM2, 4, F.G, F.bid); S.A = (const char*)(F.ws + WS_YB); S.Bt = (const char*)(wt + WT_BR);
            gm::EpiMerge E{F.ws + WS_GT, F_X(F)}; pg8::gemm_phase(F.lds, S, E, F.tid);
        } SEAM(pb + 4);
        if (IN(pb + 5)) { FRESH(); F.wr = wr_true;
            const bool cgrp = split && F.bid < 32;
            if (cgrp) {
                gm::SchedPlain<48, 3072, gm::OrderSub> S; S.init(8, 4, 32, F.bid, 128, true); S.A = (const char*)(F.ws + WS_YB); S.Bt = (const char*)(wt + WT_BR);
                gm::EpiMerge E{F.ws + WS_GT, F_X(F)}; pg8::gemm_phase(F.lds, S, E, F.tid);
                SUB_BAR(); FRESH();
            }
            {
                gm::SchedPlain<16, 1024, gm::OrderSub> S; S.init(split ? (cgrp ? 8 : 128) : nM2, 4, split ? (cgrp ? 32 : 224) : F.G, split && !cgrp ? F.bid - 32 : F.bid, cgrp ? 128 : 0, true);
                S.A = (const char*)(F.ws + WS_X); S.Bt = (const char*)(wt + WT_WO);
                gm::EpiWo E{F.out, F_HC(F), F_MOD(F) + (size_t)l * 9 * 6144, F.wr, l == 0 ? (const float*)FIN(I_X) : (const float*)F.out, l == 0 ? (const float*)FIN(I_CTX) : (const float*)F_HC(F)}; pg8::gemm_phase(F.lds, S, E, F.tid);
            }
        }
        if (split) { if (IN(pb + 5) && IN(pb + 6)) SUB_BAR(); } else SEAM(pb + 5);
        if (PHON(8) && IN(pb + 6)) for (int rep_ = NREP(8); rep_ > 0; --rep_) { FRESH(); F.wr = (rep_ == 1) ? wr_true : WR_DRY; if (NREP(8) > 1) GRID_BAR();
            const bool cgrp = split && F.bid < 32;
            const int row0 = cgrp ? NLAT : 0, row1 = split && !cgrp ? NLAT : ntok, gc = split && !cgrp ? F.bid - 32 : F.bid, gn = split ? (cgrp ? 32 : 224) : F.G;
            if (!(rep_ > 1 && PROBE_SUB == 2)) ph_rows_v(F, l, row0, row1, gc * 8 + F.wave, gn * 8);
            if (!(rep_ > 1 && PROBE_SUB == 1)) ph_router(F, l, row0 / 128, row1 / 128, gc, gn);
        } SEAM(pb + 6);
        if (PHON(9) && IN(pb + 7)) for (int rep_ = NREP(9); rep_ > 0; --rep_) { FRESH(); F.wr = (rep_ == 1) ? wr_true : WR_DRY; if (NREP(9) > 1) GRID_BAR();
            volatile LAS int* tileoff; volatile LAS int* cntl; moe_tables(F, l, tileoff, cntl);
            gm::SchedMoe<16, true> S; S.tileoff = tileoff; S.cnt = cntl; S.G = F.G; S.c = F.bid; S.nunits = tileoff[32] * 4; S.wsbase = (const char*)F.ws; S.rowtok = (const int*)(F.ws + WS_ROWTOK);
            S.A = nullptr; S.Bt = (const char*)(wt + WT_GU);
            gm::EpiGU E{(bf16*)(F.ws + WS_HROWS)}; pg8::gemm_phase(F.lds, S, E, F.tid);
        } SEAM(pb + 7);
        if (PHON(10) && IN(pb + 8)) for (int rep_ = NREP(10); rep_ > 0; --rep_) { FRESH(); F.wr = (rep_ == 1) ? wr_true : WR_DRY; if (NREP(10) > 1) GRID_BAR();
            volatile LAS int* tileoff; volatile LAS int* cntl; moe_tables(F, l, tileoff, cntl);
            gm::SchedMoe<8, false> S; S.tileoff = tileoff; S.cnt = cntl; S.G = F.G; S.c = F.bid; S.nunits = tileoff[32] * 4; S.wsbase = (const char*)F.ws; S.rowtok = nullptr;
            S.A = (const char*)(F.ws + WS_HROWS); S.Bt = (const char*)(wt + WT_DN);
            gm::EpiDN E{(bf16*)(F.ws + WS_YROWS)}; pg8::gemm_phase(F.lds, S, E, F.tid);
        } SEAM(pb + 8);
        if (PHON(11) && IN(pb + 9)) for (int rep_ = NREP(11); rep_ > 0; --rep_) { FRESH(); F.wr = (rep_ == 1) ? wr_true : WR_DRY; if (NREP(11) > 1) GRID_BAR();
            if (!(rep_ > 1 && PROBE_SUB == 2)) ph_combine(F, l, ntok);
            if (!lastl && !(rep_ > 1 && PROBE_SUB == 1)) ph_convert(F, l + 1);
        } if (!lastl) SEAM(pb + 9);
    }
#undef IN
#undef SEAM
}

extern "C" void kernel_launch(void* const* d_in, const int* in_sizes, int n_in, void* d_out, int out_size, void* d_ws, size_t ws_size, hipStream_t stream) {
    static int grid = 0;
    if (grid == 0) {
        if (n_in != 30 || out_size != NLAT * D || ws_size < WS_END) { fprintf(stderr, "kernel_launch: unexpected shapes (n_in %d out %d ws %zu, need %zu)\n", n_in, out_size, ws_size, (size_t)WS_END); grid = -1; return; }
        int dev = 0, cus = 0;
        if (hipGetDevice(&dev) != hipSuccess || hipDeviceGetAttribute(&cus, hipDeviceAttributeMultiprocessorCount, dev) != hipSuccess) { grid = -1; return; }
        if (hipFuncSetAttribute((const void*)fwd_kernel, hipFuncAttributeMaxDynamicSharedMemorySize, LDS_BYTES) != hipSuccess) { fprintf(stderr, "kernel_launch: hipFuncSetAttribute failed\n"); grid = -1; return; }
        int per_cu = 0;
        if (hipOccupancyMaxActiveBlocksPerMultiprocessor(&per_cu, (const void*)fwd_kernel, 512, LDS_BYTES) != hipSuccess || per_cu < 1) { fprintf(stderr, "kernel_launch: occupancy query says %d\n", per_cu); }
        (void)hipGetLastError();
        grid = cus;
    }
    if (grid < 0) return;
    (void)hipMemsetAsync((char*)d_ws + WS_CTL, 0, CTL_BYTES, stream);
#ifdef DIAG_ZERO_GT
    (void)hipMemsetAsync((char*)d_ws + WS_GT, 0x3f, (size_t)204 * MiB, stream);
#endif
    Args a{};
    for (int i = 0; i < 30; ++i) a.in[i] = (const float*)d_in[i];
    a.out = (float*)d_out; a.ws = (unsigned char*)d_ws;
#if MK_N_LAUNCHES == 1
    a.ph_lo = 0; a.ph_hi = N_PHASES;
    hipLaunchKernelGGL(fwd_kernel, dim3(grid), dim3(512), LDS_BYTES, stream, a);
#else
    for (int p = 0; p < N_PHASES; ++p) { a.ph_lo = p; a.ph_hi = p + 1; hipLaunchKernelGGL(fwd_kernel, dim3(grid), dim3(512), LDS_BYTES, stream, a); }
#endif
}
```

```cpp
#include <hip/hip_runtime.h>
#include <cstdio>
#include <cstdint>

#define LAS __attribute__((address_space(3)))
#define GAS __attribute__((address_space(1)))
typedef unsigned short bf16;
typedef short bf16x8 __attribute__((ext_vector_type(8)));
typedef float f32x4 __attribute__((ext_vector_type(4)));
typedef float f32x2 __attribute__((ext_vector_type(2)));
typedef unsigned u32x4 __attribute__((ext_vector_type(4)));
typedef unsigned u32x2 __attribute__((ext_vector_type(2)));

#ifndef MK_N_LAUNCHES
#define MK_N_LAUNCHES 1
#endif

constexpr int D = 1024, NB = 8, SEQ = 4096, LCX = 256, DEPTH = 4;
constexpr int NLAT = NB * SEQ, NCTX = NB * LCX, NTOK = NLAT + NCTX;
constexpr int DIN = 9728;
constexpr int LDP = 6720;
constexpr int C_AX = 0, C_AY = 1024, C_BQ = 2048, C_BK = 2560, C_BV = 3072, C_BG = 4096, C_CQ = 5120, C_CK = 6144, C_CV = 6400, C_GA = 6656;
constexpr int NMOD = 6, NMB = 9;
constexpr int NEXP = 32, DEXP = 512, RCOLS = 36;
constexpr int PMAX = 77824;
constexpr float EPS = 1e-6f;

constexpr size_t MiB = 1u << 20;
constexpr size_t WS_CTL = 0, CTL_BYTES = 1 * MiB;
constexpr size_t WS_MOD = 1 * MiB;
constexpr size_t WS_ROPE = 2 * MiB;
constexpr size_t WS_RW = 4 * MiB;
constexpr size_t WS_HC = 12 * MiB;
constexpr size_t WS_TOKINFO = 20 * MiB;
constexpr size_t WS_ROWTOK = 22 * MiB;
constexpr size_t WS_WT = 28 * MiB;
constexpr size_t WT_IN = 0, WT_BR = 19 * MiB, WT_WO = 25 * MiB, WT_GU = 27 * MiB, WT_DN = 91 * MiB, WT_BYTES = 123 * MiB;
constexpr size_t WS_X = 152 * MiB;
constexpr size_t WS_KV = 220 * MiB;
constexpr size_t WS_PROJ = 288 * MiB;
constexpr size_t WS_HROWS = WS_PROJ;
constexpr size_t WS_YROWS = WS_PROJ + 80 * MiB;
constexpr size_t WS_GT = 736 * MiB;
constexpr size_t WS_YB = 940 * MiB;
constexpr size_t WS_END = 1144 * MiB;
static_assert(WS_PROJ + (size_t)NTOK * LDP * 2 <= WS_GT && WS_GT + (size_t)3 * NTOK * 1024 * 2 <= WS_YB, "ws map");
constexpr int CW_BAR = 1024;
constexpr int CW_BAR_L = 20480, CW_BAR_C = 24576;
constexpr int CW_CNT = 8192;
constexpr size_t CTL_ZROW = 64 * 1024;

constexpr int LDS_BYTES = 163840;
constexpr int LDS_CTL = 155648;
constexpr int MISC_OFF = LDS_CTL + 320;

__device__ __forceinline__ unsigned f2bf(float f) { unsigned u = __builtin_bit_cast(unsigned, f); return (u + 0x7fffu + ((u >> 16) & 1u)) >> 16; }
typedef __bf16 bf16x2_t __attribute__((ext_vector_type(2)));
__device__ __forceinline__ unsigned pk2(float lo, float hi) { const f32x2 v = {lo, hi}; return __builtin_bit_cast(unsigned, __builtin_convertvector(v, bf16x2_t)); }
__device__ __forceinline__ float bf2f(unsigned b) { return __builtin_bit_cast(float, b << 16); }
__device__ __forceinline__ float bflo(unsigned w) { return __builtin_bit_cast(float, w << 16); }
__device__ __forceinline__ float bfhi(unsigned w) { return __builtin_bit_cast(float, w & 0xffff0000u); }
__device__ __forceinline__ float wave_sum(float v) {
#pragma unroll
    for (int o = 1; o < 64; o <<= 1) v += __shfl_xor(v, o);
    return v;
}
__device__ __forceinline__ float sigmoidf_(float x) { return 1.0f / (1.0f + __expf(-x)); }
__device__ __forceinline__ float siluf_(float x) { return x / (1.0f + __expf(-x)); }
__device__ __forceinline__ float gelu_tanh(float x) {
    const float u = 0.7978845608028654f * (x + 0.044715f * x * x * x);
    return x / (1.0f + __expf(-2.0f * u));
}
__device__ __forceinline__ float log1p_fast(float x) { const float u = 1.0f + x; const float d = u - 1.0f; return d == 0.f ? x : __logf(u) * (x / d); }
__device__ __forceinline__ float expm1_fast(float x) { const float u = __expf(x); const float um1 = u - 1.0f; if (um1 == 0.f) return x; const float lu = __logf(u); return um1 == -1.0f ? -1.0f : um1 * (x / lu); }
#define LDS_BARRIER() do { asm volatile("s_waitcnt lgkmcnt(0)" ::: "memory"); __builtin_amdgcn_s_barrier(); asm volatile("" ::: "memory"); } while (0)
#define LDS_WAIT() asm volatile("s_waitcnt lgkmcnt(0)" ::: "memory")
#define VM_WAIT() asm volatile("s_waitcnt vmcnt(0)" ::: "memory")

#define XB_TMO      128
#define XB_XCNT(j)  (256  + 64 * (j))
#define XB_XSUB(j)  (1280 + 64 * (j))
#define XB_XGEN(j)  (2304 + 64 * (j))
#define XB_TOP      3328
#define XB_TOPGEN   3392
#define XCD_BAR_WORDS 3456
#define XB_SPIN_CAP (1u << 22)
__device__ __forceinline__ unsigned xb_ld(unsigned* p)              { return __hip_atomic_load(p, __ATOMIC_RELAXED, __HIP_MEMORY_SCOPE_AGENT); }
__device__ __forceinline__ unsigned xb_add(unsigned* p, unsigned v) { return __hip_atomic_fetch_add(p, v, __ATOMIC_RELAXED, __HIP_MEMORY_SCOPE_AGENT); }
__device__ __forceinline__ unsigned xb_xcc_id() { return (unsigned)__builtin_amdgcn_s_getreg((3 << 11) | 20) & 0xFu; }
#define XB_SPIN(cond, bar) do { unsigned _sp = 0; while (cond) { __builtin_amdgcn_s_sleep(1); \
    if ((++_sp & 255u) == 0u) { if (xb_ld(&(bar)[XB_TMO])) break; if (_sp > XB_SPIN_CAP) { atomicAdd(&(bar)[XB_TMO], 1u); break; } } } } while (0)
struct XcdBarrier { unsigned* bar; unsigned x; volatile LAS unsigned* st; unsigned G; };
__device__ __forceinline__ XcdBarrier xcd_barrier_post(unsigned* bar, volatile LAS unsigned* st, unsigned G) {
    XcdBarrier b; b.bar = bar; b.x = xb_xcc_id(); b.st = st; b.G = G;
    if (threadIdx.x == 0) (void)xb_add(&bar[XB_XCNT(b.x)], 1u);
    return b;
}
__device__ __forceinline__ void xcd_barrier_complete(unsigned* bar, unsigned x, unsigned G, unsigned& nloc, unsigned& nx) {
    unsigned sum, cnt, mine, sp = 0u;
    for (;;) {
        sum = 0u; cnt = 0u; mine = 0u;
#pragma unroll
        for (unsigned j = 0; j < 16; ++j) { const unsigned c = xb_ld(&bar[XB_XCNT(j)]); sum += c; cnt += (c > 0u) ? 1u : 0u; mine = (j == x) ? c : mine; }
        if (sum == G) break;
        __builtin_amdgcn_s_sleep(1);
        if ((++sp & 255u) == 0u) { if (xb_ld(&bar[XB_TMO])) break; if (sp > XB_SPIN_CAP) { atomicAdd(&bar[XB_TMO], 1u); break; } }
    }
    nloc = mine > 0u ? mine : 1u; nx = cnt > 0u ? cnt : 1u;
}
__device__ __forceinline__ void xcd_barrier(const XcdBarrier& b) {
    asm volatile("s_waitcnt vmcnt(0)" ::: "memory");
    __syncthreads();
    if (threadIdx.x == 0) {
        unsigned* bar = b.bar;
        __builtin_amdgcn_s_waitcnt(0);
        unsigned nloc = b.st[0], nx = b.st[1];
        if (nloc == 0u) { xcd_barrier_complete(bar, b.x, b.G, nloc, nx); b.st[0] = nloc; b.st[1] = nx; }
        const unsigned old = xb_add(&bar[XB_XSUB(b.x)], 1u);
        const unsigned gen = old / nloc;
        if (old + 1u == (gen + 1u) * nloc) {
            __builtin_amdgcn_fence(__ATOMIC_RELEASE, "agent");
            asm volatile("s_waitcnt vmcnt(0)" ::: "memory");
            const unsigned og = xb_add(&bar[XB_TOP], 1u);
            const unsigned tg = og / nx;
            if (og + 1u == (tg + 1u) * nx) xb_add(&bar[XB_TOPGEN], 1u);
            else XB_SPIN(xb_ld(&bar[XB_TOPGEN]) == tg, bar);
            __builtin_amdgcn_fence(__ATOMIC_ACQUIRE, "agent");
            xb_add(&bar[XB_XGEN(b.x)], 1u);
            asm volatile("s_waitcnt vmcnt(0)" ::: "memory");
        } else {
            XB_SPIN(xb_ld(&bar[XB_XGEN(b.x)]) == gen, bar);
            __builtin_amdgcn_fence(__ATOMIC_ACQUIRE, "agent");
            asm volatile("s_waitcnt vmcnt(0)" ::: "memory");
        }
    }
    __syncthreads();
}

namespace pg8 {
constexpr int BM = 256, BK = 64, HALF = 128, HTB = HALF * BK * 2, STAGE_BYTES = 8 * HTB;
__device__ __forceinline__ int lds_byte(int r, int c) { const int st = (r >> 4) * 2 + (c >> 5), rr = r & 15, cc = c & 31, ob = rr * 64 + cc * 2; return st * 1024 + (ob ^ (((ob >> 9) & 1) << 5)); }
__device__ __forceinline__ void stage_rc(int b, int& R, int& C) { const int st = b / 1024, sb = b % 1024, swz = sb ^ (((sb >> 9) & 1) << 5); R = (st >> 1) * 16 + swz / 64; C = (st & 1) * 32 + (swz % 64) / 2; }
__device__ __forceinline__ int perm32(int rho) { const int n = rho >> 4, i = rho & 15; return 8 * (i >> 2) + 4 * n + (i & 3); }
__device__ __forceinline__ unsigned cvt_pk_bf16(float lo, float hi) { return pk2(lo, hi); }

template <class Epi, class Sched>
__device__ __forceinline__ void gemm_phase(LAS unsigned char* lds, const Sched& S, const Epi& E, const int tid) {
    typedef typename Sched::Unit Unit;
    const int wid = __builtin_amdgcn_readfirstlane(tid >> 6), lane = tid & 63, wr = wid >> 2, wc = wid & 3, fr = lane & 15, fq = lane >> 4;
    constexpr int nt = Sched::KT; constexpr int K = nt * BK;
    int R[2], C[2]; unsigned voffB[2];
#pragma unroll
    for (int i = 0; i < 2; ++i) { stage_rc(tid * 16 + i * 8192, R[i], C[i]); const int Rb = Epi::PERM ? ((R[i] & ~31) + perm32(R[i] & 31)) : R[i]; voffB[i] = (unsigned)(Rb * K + C[i]) * 2u; }
    constexpr size_t kstep = (size_t)(BK * 2);
    constexpr size_t hstepB = (size_t)HALF * K * 2;
    const unsigned ldsw = (unsigned)wid * 1024u;
    const int aoff = lds_byte(wr * 64 + fr, fq * 8), boff = lds_byte(wc * 32 + fr, fq * 8);
#define PG8_SA(b, h) (((b) * 2 + (h)) * HTB)
#define PG8_SB(b, h) ((4 + (b) * 2 + (h)) * HTB)
#define PG8_STAGEA(bufoff, gbase, vv, h) do { _Pragma("unroll") for (int _i = 0; _i < 2; ++_i) \
        __builtin_amdgcn_global_load_lds((const unsigned*)((const char*)(gbase) + (vv)[h][_i]), (LAS unsigned*)(lds + (bufoff) + ldsw + _i * 8192), 16, 0, 0); } while (0)
#define PG8_STAGEB(bufoff, gbase) do { _Pragma("unroll") for (int _i = 0; _i < 2; ++_i) \
        __builtin_amdgcn_global_load_lds((const unsigned*)((const char*)(gbase) + voffB[_i]), (LAS unsigned*)(lds + (bufoff) + ldsw + _i * 8192), 16, 0, 0); } while (0)
#define PG8_LDA(dst, b, h) do { _Pragma("unroll") for (int m = 0; m < 4; ++m) _Pragma("unroll") for (int k = 0; k < 2; ++k) dst[m][k] = *(const LAS bf16x8*)(lds + PG8_SA(b, h) + aoff + m * 2048 + k * 1024); } while (0)
#define PG8_LDB(dst, b, h) do { _Pragma("unroll") for (int n = 0; n < 2; ++n) _Pragma("unroll") for (int k = 0; k < 2; ++k) dst[n][k] = *(const LAS bf16x8*)(lds + PG8_SB(b, h) + boff + n * 2048 + k * 1024); } while (0)
#define PG8_MMA(ai, bj, At, Bt) do { __builtin_amdgcn_s_setprio(1); _Pragma("unroll") for (int m = 0; m < 4; ++m) _Pragma("unroll") for (int n = 0; n < 2; ++n) _Pragma("unroll") for (int k = 0; k < 2; ++k) \
        acc[ai][bj][m][n] = __builtin_amdgcn_mfma_f32_16x16x32_bf16(Bt[n][k], At[m][k], acc[ai][bj][m][n], 0, 0, 0); __builtin_amdgcn_s_setprio(0); } while (0)
#define PG8_WAIT_V(n) asm volatile("s_waitcnt vmcnt(" #n ")" ::: "memory")
#define PG8_WAIT_L(n) asm volatile("s_waitcnt lgkmcnt(" #n ")" ::: "memory")
#define PG8_BAR __builtin_amdgcn_s_barrier()
#define PG8_SCHED __builtin_amdgcn_sched_barrier(0)
    Unit cur, nxt; int ui = 0;
    if (!S.next(0, cur)) return;
    f32x4 acc[2][2][4][2];
#pragma unroll
    for (int a = 0; a < 2; ++a)
#pragma unroll
        for (int b = 0; b < 2; ++b)
#pragma unroll
            for (int m = 0; m < 4; ++m)
#pragma unroll
                for (int n = 0; n < 2; ++n) acc[a][b][m][n] = (f32x4){0.f, 0.f, 0.f, 0.f};
    bf16x8 At[4][2], B0[2][2], B1[2][2];
    unsigned vA[2][2], vAn[2][2];
    S.a_voff(cur, tid, vA);
#pragma unroll
    for (int h = 0; h < 2; ++h)
#pragma unroll
        for (int i = 0; i < 2; ++i) vAn[h][i] = vA[h][i];
    const char* cA = S.a_base(cur); const char* cB = S.b_base(cur);
    { const char* a0 = cA + S.a_koff(0); const char* a1p = cA + S.a_koff(1);
      PG8_STAGEB(PG8_SB(0, 0), cB); PG8_STAGEB(PG8_SB(0, 1), cB + hstepB); PG8_STAGEA(PG8_SA(0, 0), a0, vA, 0); PG8_STAGEA(PG8_SA(0, 1), a0, vA, 1);
      if (wr == 1) PG8_BAR;
      PG8_WAIT_V(2); PG8_BAR;
      PG8_STAGEB(PG8_SB(1, 0), cB + kstep); PG8_STAGEA(PG8_SA(1, 0), a1p, vA, 0); PG8_STAGEB(PG8_SB(1, 1), cB + hstepB + kstep);
      PG8_WAIT_V(6); PG8_BAR; }
    for (;;) {
        const bool has_next = S.next(ui + 1, nxt);
        const char* nA = cA; const char* nB = cB;
        if (has_next) { nA = S.a_base(nxt); nB = S.b_base(nxt); }
#pragma unroll 1
        for (int t = 0; t < nt; t += 2) {
            const bool last = (t == nt - 2);
            if constexpr (Epi::MIDK) { if (t == 16 || t == 32) E.mid(acc, cur, t, wr, wc, fr, fq); }
            if constexpr (Sched::GATHER) { if (t == nt - 4 && has_next) S.a_voff(nxt, tid, vAn); }
            const char* a1 = cA + S.a_koff(t + 1);
            const char* a2 = last ? nA + S.a_koff(0) : cA + S.a_koff(t + 2);
            const char* a3 = last ? nA + S.a_koff(1) : cA + S.a_koff(t + 3);
            const char* b2 = last ? nB : cB + (size_t)(t + 2) * kstep; const char* b3 = b2 + kstep;
            PG8_LDB(B0, 0, 0); PG8_LDB(B1, 0, 1); PG8_SCHED; PG8_LDA(At, 0, 0); PG8_STAGEA(PG8_SA(1, 1), a1, vA, 1);
            PG8_WAIT_V(8); PG8_WAIT_L(0); PG8_BAR; PG8_MMA(0, 0, At, B0); PG8_MMA(0, 1, At, B1); PG8_BAR; PG8_SCHED;
            PG8_LDA(At, 0, 1); PG8_STAGEB(PG8_SB(0, 0), b2); PG8_STAGEB(PG8_SB(0, 1), b2 + hstepB);
            if (last) { PG8_STAGEA(PG8_SA(0, 0), a2, vAn, 0); } else { PG8_STAGEA(PG8_SA(0, 0), a2, vA, 0); }
            PG8_WAIT_V(8); PG8_WAIT_L(0); PG8_BAR; PG8_MMA(1, 0, At, B0); PG8_MMA(1, 1, At, B1); PG8_BAR; PG8_SCHED;
            PG8_LDB(B0, 1, 0); PG8_LDB(B1, 1, 1); PG8_SCHED; PG8_LDA(At, 1, 0);
            if (last) { PG8_STAGEA(PG8_SA(0, 1), a2, vAn, 1); } else { PG8_STAGEA(PG8_SA(0, 1), a2, vA, 1); }
            PG8_WAIT_V(8); PG8_WAIT_L(0); PG8_BAR; PG8_MMA(0, 0, At, B0); PG8_MMA(0, 1, At, B1); PG8_BAR; PG8_SCHED;
            PG8_LDA(At, 1, 1); PG8_STAGEB(PG8_SB(1, 0), b3); PG8_STAGEB(PG8_SB(1, 1), b3 + hstepB);
            if (last) { PG8_STAGEA(PG8_SA(1, 0), a3, vAn, 0); } else { PG8_STAGEA(PG8_SA(1, 0), a3, vA, 0); }
            PG8_WAIT_V(8); PG8_WAIT_L(0); PG8_BAR; PG8_MMA(1, 0, At, B0); PG8_MMA(1, 1, At, B1); PG8_BAR; PG8_SCHED;
        }
        if (wr == 0) PG8_BAR;
        E(acc, cur, wr, wc, fr, fq);
        if (!has_next) break;
#pragma unroll
        for (int a = 0; a < 2; ++a)
#pragma unroll
            for (int b = 0; b < 2; ++b)
#pragma unroll
                for (int m = 0; m < 4; ++m)
#pragma unroll
                    for (int n = 0; n < 2; ++n) acc[a][b][m][n] = (f32x4){0.f, 0.f, 0.f, 0.f};
        cur = nxt; cA = nA; cB = nB; ++ui;
        if constexpr (Sched::GATHER) {
#pragma unroll
            for (int h = 0; h < 2; ++h)
#pragma unroll
                for (int i = 0; i < 2; ++i) vA[h][i] = vAn[h][i];
        }
        if (wr == 1) PG8_BAR;
    }
    PG8_WAIT_V(0);
    PG8_BAR;
#undef PG8_SA
#undef PG8_SB
#undef PG8_STAGEA
#undef PG8_STAGEB
#undef PG8_LDA
#undef PG8_LDB
#undef PG8_MMA
#undef PG8_WAIT_V
#undef PG8_WAIT_L
#undef PG8_BAR
#undef PG8_SCHED
}
}
namespace gm {
using pg8::cvt_pk_bf16;
__device__ __forceinline__ float fexp_(float x) { return __builtin_amdgcn_exp2f(1.4426950408889634f * x); }
__device__ __forceinline__ float fsig_(float x) { return __builtin_amdgcn_rcpf(1.0f + fexp_(-x)); }
__device__ __forceinline__ float fsilu_(float x) { return x * fsig_(x); }
struct Unit { int pm, pn; };
struct OrderBase {
    int nM, nN, nwg, G, c;
    __device__ __forceinline__ void init(int nM_, int nN_, int G_, int c_) { nM = nM_; nN = nN_; nwg = nM * nN; G = G_; c = c_; }
    __device__ __forceinline__ bool next(int i, Unit& u) const {
        const int L = i * G + c; if (L >= nwg) return false;
        int wgid = L; { const int q = nwg / 8, r = nwg % 8, xcd = wgid % 8, off = wgid / 8; wgid = (xcd < r ? xcd * (q + 1) : r * (q + 1) + (xcd - r) * q) + off; }
        const int nig = 8 * nN, gid = wgid / nig, fm = gid * 8, gsz = (nM - fm) < 8 ? (nM - fm) : 8;
        u.pm = fm + ((wgid % nig) % gsz); u.pn = (wgid % nig) / gsz; return true;
    }
};
struct OrderColAffine {
    int nM, nN, nwg, G, c;
    __device__ __forceinline__ void init(int nM_, int nN_, int G_, int c_) { nM = nM_; nN = nN_; nwg = nM * nN; G = G_; c = c_; }
    __device__ __forceinline__ bool next(int i, Unit& u) const {
        if (G != 256 || nN != 4) { const int L = i * G + c; if (L >= nwg) return false; u.pm = L / nN; u.pn = L % nN; return true; }
        const int x = c & 7, k = c >> 3, j = i * 32 + k; if (2 * j + (x >> 2) >= nM) return false;
        u.pm = 2 * j + (x >> 2); u.pn = x & 3; return true;
    }
};
struct OrderSub : OrderBase {
    int pm0; bool on;
    __device__ __forceinline__ void init(int nM_, int nN_, int Gs, int cs, int pm0_, bool on_) { OrderBase::init(nM_, nN_, Gs, cs); pm0 = pm0_; on = on_; }
    __device__ __forceinline__ bool next(int i, Unit& u) const { if (!on || !OrderBase::next(i, u)) return false; u.pm += pm0; return true; }
};
template <int KT_, int LDA, class Order = OrderBase> struct SchedPlain : Order {
    typedef gm::Unit Unit; static constexpr int KT = KT_; static constexpr bool GATHER = false;
    const char* A; const char* Bt;
    __device__ __forceinline__ const char* a_base(const Unit& u) const { return A + (size_t)u.pm * 256 * LDA * 2; }
    __device__ __forceinline__ void a_voff(const Unit&, int tid, unsigned (&v)[2][2]) const {
#pragma unroll
        for (int i = 0; i < 2; ++i) { int R, C; pg8::stage_rc(tid * 16 + i * 8192, R, C);
#pragma unroll
            for (int h = 0; h < 2; ++h) v[h][i] = (unsigned)((h * 128 + R) * LDA + C) * 2u; }
    }
    __device__ __forceinline__ size_t a_koff(int kt) const { return (size_t)kt * 128; }
    __device__ __forceinline__ const char* b_base(const Unit& u) const { return Bt + (size_t)u.pn * 256 * (KT * 64) * 2; }
};
struct SchedMerge : OrderBase {
    typedef gm::Unit Unit; static constexpr int KT = 48; static constexpr bool GATHER = false;
    const char* A; const char* Bt;
    __device__ __forceinline__ const char* a_base(const Unit& u) const { return A + (size_t)u.pm * 256 * LDP * 2; }
    __device__ __forceinline__ void a_voff(const Unit&, int tid, unsigned (&v)[2][2]) const {
#pragma unroll
        for (int i = 0; i < 2; ++i) { int R, C; pg8::stage_rc(tid * 16 + i * 8192, R, C);
#pragma unroll
            for (int h = 0; h < 2; ++h) v[h][i] = (unsigned)((h * 128 + R) * LDP + C) * 2u; }
    }
    __device__ __forceinline__ size_t a_koff(int kt) const { return (size_t)(kt < 16 ? (C_AY + 64 * kt) : (C_BG - 1024 + 64 * kt)) * 2; }
    __device__ __forceinline__ const char* b_base(const Unit& u) const { return Bt + (size_t)u.pn * 256 * 3072 * 2; }
};
struct MUnit { int e, tile, pn, slot0; };
template <int KT_, bool GATHER_> struct SchedMoe {
    typedef gm::MUnit Unit; static constexpr int KT = KT_; static constexpr bool GATHER = GATHER_;
    const volatile LAS int* tileoff; const volatile LAS int* cnt;
    int G, c, nunits;
    const char* wsbase; const int* rowtok; const char* A; const char* Bt;
    __device__ __forceinline__ bool next(int i, Unit& u) const {
        const int L = i * G + c; if (L >= nunits) return false;
        const int rt = L >> 2; u.pn = L & 3;
        int e = 0;
#pragma unroll 1
        for (int k = 1; k < 32; ++k) e = (rt >= tileoff[k]) ? k : e;
        u.e = e; u.tile = rt - tileoff[e]; u.slot0 = rt * 256; return true;
    }
    __device__ __forceinline__ const char* a_base(const Unit& u) const { if constexpr (GATHER) return wsbase; else return A + (size_t)u.slot0 * DEXP * 2; }
    __device__ __forceinline__ void a_voff(const Unit& u, int tid, unsigned (&v)[2][2]) const {
        if constexpr (GATHER) {
            asm volatile("" : "+v"(tid));
            const int n = cnt[u.e]; const int* rt = rowtok + (size_t)u.e * NTOK + u.tile * 256;
#pragma unroll
            for (int i = 0; i < 2; ++i) { int R, C; pg8::stage_rc(tid * 16 + i * 8192, R, C);
#pragma unroll
                for (int h = 0; h < 2; ++h) { const int r = h * 128 + R; const bool ok = (u.tile * 256 + r) < n; const int tok = ok ? rt[r] : 0;
                    v[h][i] = ok ? (unsigned)(WS_X + (size_t)tok * 2048 + C * 2) : (unsigned)(CTL_ZROW + C * 2); } }
        } else {
#pragma unroll
            for (int i = 0; i < 2; ++i) { int R, C; pg8::stage_rc(tid * 16 + i * 8192, R, C);
#pragma unroll
                for (int h = 0; h < 2; ++h) v[h][i] = (unsigned)((h * 128 + R) * DEXP + C) * 2u; }
        }
    }
    __device__ __forceinline__ size_t a_koff(int kt) const { return (size_t)kt * 128; }
    __device__ __forceinline__ const char* b_base(const Unit& u) const { return Bt + ((size_t)u.e * 1024 + u.pn * 256) * (KT * 64) * 2; }
};

struct EpiProj {
    static constexpr bool PERM = true, MIDK = false; bf16* O; unsigned char* GT;
    static __device__ __forceinline__ unsigned gq8_(float z) { return (unsigned)fmaxf(fsig_(z) * 255.0f + 0.5f, 1.0f); }
    __device__ __forceinline__ void operator()(const f32x4 (&acc)[2][2][4][2], const Unit& u, int wr, int wc, int fr, int fq) const {
        if (u.pn >= 26) {
            const int br = (u.pn - 26) >> 2, pq = (u.pn - 26) & 3; const int wave = wr * 4 + wc, lane = fq * 16 + fr;
            unsigned char* t = GT + (((size_t)(br * 136 + u.pm) * 4 + pq) << 16) + (size_t)(wave * 64 + lane) * 16;
#pragma unroll
            for (int ai = 0; ai < 2; ++ai)
#pragma unroll
                for (int m = 0; m < 4; ++m) { u32x4 w;
#pragma unroll
                    for (int bj = 0; bj < 2; ++bj) { const f32x4 v0 = acc[ai][bj][m][0], v1 = acc[ai][bj][m][1];
                        w[2 * bj] = gq8_(v0[0]) | (gq8_(v0[1]) << 8) | (gq8_(v0[2]) << 16) | (gq8_(v0[3]) << 24);
                        w[2 * bj + 1] = gq8_(v1[0]) | (gq8_(v1[1]) << 8) | (gq8_(v1[2]) << 16) | (gq8_(v1[3]) << 24); }
                    *(u32x4*)(t + (ai * 4 + m) * 8192) = w; }
            return;
        }
        bf16* base = O + (size_t)(u.pm * 256 + wr * 64 + fr) * LDP + u.pn * 256 + wc * 32 + 8 * fq;
#pragma unroll
        for (int ai = 0; ai < 2; ++ai)
#pragma unroll
            for (int m = 0; m < 4; ++m) { bf16* rowp = base + (size_t)(ai * 128 + m * 16) * LDP;
#pragma unroll
                for (int bj = 0; bj < 2; ++bj) { const f32x4 v0 = acc[ai][bj][m][0], v1 = acc[ai][bj][m][1];
                    u32x4 w; w.x = cvt_pk_bf16(v0[0], v0[1]); w.y = cvt_pk_bf16(v0[2], v0[3]); w.z = cvt_pk_bf16(v1[0], v1[1]); w.w = cvt_pk_bf16(v1[2], v1[3]);
                    *(u32x4*)(rowp + bj * 128) = w; } }
    }
};
struct EpiPlain {
    static constexpr bool PERM = true, MIDK = false; bf16* O;
    __device__ __forceinline__ void operator()(const f32x4 (&acc)[2][2][4][2], const Unit& u, int wr, int wc, int fr, int fq) const {
        bf16* base = O + (size_t)(u.pm * 256 + wr * 64 + fr) * 1024 + u.pn * 256 + wc * 32 + 8 * fq;
#pragma unroll
        for (int ai = 0; ai < 2; ++ai)
#pragma unroll
            for (int m = 0; m < 4; ++m) { bf16* rowp = base + (size_t)(ai * 128 + m * 16) * 1024;
#pragma unroll
                for (int bj = 0; bj < 2; ++bj) { const f32x4 v0 = acc[ai][bj][m][0], v1 = acc[ai][bj][m][1];
                    u32x4 w; w.x = cvt_pk_bf16(v0[0], v0[1]); w.y = cvt_pk_bf16(v0[2], v0[3]); w.z = cvt_pk_bf16(v1[0], v1[1]); w.w = cvt_pk_bf16(v1[2], v1[3]);
                    *(u32x4*)(rowp + bj * 128) = w; } }
    }
};
struct EpiMerge {
    static constexpr bool PERM = true, MIDK = true; const unsigned char* GT; bf16* O;
    __device__ __forceinline__ const unsigned char* tile(const Unit& u, int br, int wr, int wc, int fr, int fq) const {
        return GT + (((size_t)(br * 136 + u.pm) * 4 + u.pn) << 16) + (size_t)((wr * 4 + wc) * 64 + fq * 16 + fr) * 16; }
    static __device__ __forceinline__ float b8_(unsigned w, int k) { return (float)((w >> (8 * k)) & 0xffu); }
    __device__ __forceinline__ void mid(f32x4 (&acc)[2][2][4][2], const Unit& u, int t, int wr, int wc, int fr, int fq) const {
        const int br = (t == 16) ? 0 : 1; const unsigned char* ta = tile(u, br, wr, wc, fr, fq); const unsigned char* tb = tile(u, br + 1, wr, wc, fr, fq);
        u32x4 ga[8], gb[8];
#pragma unroll
        for (int j = 0; j < 8; ++j) { ga[j] = *(const u32x4*)(ta + 8192 * j); gb[j] = *(const u32x4*)(tb + 8192 * j); }
#pragma unroll
        for (int ai = 0; ai < 2; ++ai)
#pragma unroll
            for (int m = 0; m < 4; ++m)
#pragma unroll
                for (int bj = 0; bj < 2; ++bj)
#pragma unroll
                    for (int hw = 0; hw < 2; ++hw) { const unsigned wa = ga[ai * 4 + m][2 * bj + hw], wb = gb[ai * 4 + m][2 * bj + hw];
#pragma unroll
                        for (int k = 0; k < 4; ++k) acc[ai][bj][m][hw][k] *= b8_(wa, k) * __builtin_amdgcn_rcpf(b8_(wb, k)); }
    }
    __device__ __forceinline__ void operator()(const f32x4 (&acc)[2][2][4][2], const Unit& u, int wr, int wc, int fr, int fq) const {
        const unsigned char* tc = tile(u, 2, wr, wc, fr, fq);
        u32x4 gc[8];
#pragma unroll
        for (int j = 0; j < 8; ++j) gc[j] = *(const u32x4*)(tc + 8192 * j);
        const size_t row0 = (size_t)(u.pm * 256 + wr * 64 + fr); const int col0 = u.pn * 256 + wc * 32 + 8 * fq;
        constexpr float S = 1.0f / 255.0f;
#pragma unroll
        for (int ai = 0; ai < 2; ++ai)
#pragma unroll
            for (int m = 0; m < 4; ++m) { const size_t row = row0 + ai * 128 + m * 16;
#pragma unroll
                for (int bj = 0; bj < 2; ++bj) { const unsigned g0 = gc[ai * 4 + m][2 * bj], g1 = gc[ai * 4 + m][2 * bj + 1];
                    const f32x4 v0 = acc[ai][bj][m][0] * S, v1 = acc[ai][bj][m][1] * S; u32x4 w;
                    w.x = cvt_pk_bf16(v0[0] * b8_(g0, 0), v0[1] * b8_(g0, 1)); w.y = cvt_pk_bf16(v0[2] * b8_(g0, 2), v0[3] * b8_(g0, 3));
                    w.z = cvt_pk_bf16(v1[0] * b8_(g1, 0), v1[1] * b8_(g1, 1)); w.w = cvt_pk_bf16(v1[2] * b8_(g1, 2), v1[3] * b8_(g1, 3));
                    *(u32x4*)(O + row * 1024 + col0 + bj * 128) = w; } }
    }
};
struct EpiWo {
    static constexpr bool PERM = false, MIDK = false; float* h; float* hc; const float* mod; bool wen; const float* hsrc; const float* hcsrc;
    __device__ __forceinline__ void operator()(const f32x4 (&acc)[2][2][4][2], const Unit& u, int wr, int wc, int fr, int fq) const {
        const bool lat = u.pm < 128; const int mb = lat ? (u.pm >> 4) : 8;
        float* hb = lat ? h + (size_t)u.pm * 256 * 1024 : hc + (size_t)(u.pm - 128) * 256 * 1024;
        const float* sb = lat ? hsrc + (size_t)u.pm * 256 * 1024 : hcsrc + (size_t)(u.pm - 128) * 256 * 1024;
        const int col0 = u.pn * 256 + wc * 32 + 4 * fq; const float* mp = mod + (size_t)mb * 6144 + 2 * 1024 + col0;
        f32x4 mv[2][2];
#pragma unroll
        for (int bj = 0; bj < 2; ++bj)
#pragma unroll
            for (int n = 0; n < 2; ++n) mv[bj][n] = *(const f32x4*)(mp + bj * 128 + n * 16);
#pragma unroll
        for (int ai = 0; ai < 2; ++ai)
#pragma unroll
            for (int m = 0; m < 4; ++m) { const size_t ro = (size_t)(ai * 128 + wr * 64 + m * 16 + fr) * 1024 + col0; float* rowp = hb + ro; const float* srcp = sb + ro;
#pragma unroll
                for (int bj = 0; bj < 2; ++bj)
#pragma unroll
                    for (int n = 0; n < 2; ++n) { f32x4 hv = *(const f32x4*)(srcp + bj * 128 + n * 16); hv = hv + mv[bj][n] * acc[ai][bj][m][n]; if (wen) *(f32x4*)(rowp + bj * 128 + n * 16) = hv; } }
    }
};
struct EpiGU {
    static constexpr bool PERM = true, MIDK = false; bf16* H;
    __device__ __forceinline__ void operator()(const f32x4 (&acc)[2][2][4][2], const MUnit& u, int wr, int wc, int fr, int fq) const {
        bf16* base = H + (size_t)(u.slot0 + wr * 64 + fr) * DEXP + u.pn * 128 + wc * 32 + 8 * fq;
#pragma unroll
        for (int ai = 0; ai < 2; ++ai)
#pragma unroll
            for (int m = 0; m < 4; ++m) { const f32x4 g0 = acc[ai][0][m][0], g1 = acc[ai][0][m][1], u0 = acc[ai][1][m][0], u1 = acc[ai][1][m][1]; u32x4 w;
                w.x = cvt_pk_bf16(fsilu_(g0[0]) * u0[0], fsilu_(g0[1]) * u0[1]); w.y = cvt_pk_bf16(fsilu_(g0[2]) * u0[2], fsilu_(g0[3]) * u0[3]);
                w.z = cvt_pk_bf16(fsilu_(g1[0]) * u1[0], fsilu_(g1[1]) * u1[1]); w.w = cvt_pk_bf16(fsilu_(g1[2]) * u1[2], fsilu_(g1[3]) * u1[3]);
                *(u32x4*)(base + (size_t)(ai * 128 + m * 16) * DEXP) = w; }
    }
};
struct EpiDN {
    static constexpr bool PERM = true, MIDK = false; bf16* Y;
    __device__ __forceinline__ void operator()(const f32x4 (&acc)[2][2][4][2], const MUnit& u, int wr, int wc, int fr, int fq) const {
        bf16* base = Y + (size_t)(u.slot0 + wr * 64 + fr) * 1024 + u.pn * 256 + wc * 32 + 8 * fq;
#pragma unroll
        for (int ai = 0; ai < 2; ++ai)
#pragma unroll
            for (int m = 0; m < 4; ++m) { bf16* rowp = base + (size_t)(ai * 128 + m * 16) * 1024;
#pragma unroll
                for (int bj = 0; bj < 2; ++bj) { const f32x4 v0 = acc[ai][bj][m][0], v1 = acc[ai][bj][m][1];
                    u32x4 w; w.x = cvt_pk_bf16(v0[0], v0[1]); w.y = cvt_pk_bf16(v0[2], v0[3]); w.z = cvt_pk_bf16(v1[0], v1[1]); w.w = cvt_pk_bf16(v1[2], v1[3]);
                    *(u32x4*)(rowp + bj * 128) = w; } }
    }
};
}
struct Args { const float* in[30]; float* out; unsigned char* ws; int ph_lo, ph_hi; };
enum { I_X = 0, I_C, I_CTX, I_CCTX, I_WMOD, I_BMOD, I_N1G, I_N2G, I_WIN, I_CONVW, I_CONVB, I_WA, I_BA, I_WX, I_BX, I_LAM, I_RLAM, I_SINK,
       I_WBA, I_WBB, I_WBC, I_WOUT, I_RGW, I_RGB, I_REW, I_REB, I_EWG, I_EWU, I_EWD, I_FNG };
typedef const GAS float* cfp_t;
struct Frame {
    LAS unsigned char* lds; int tid, lane, wave, G, bid, gw, NGW; bool wr;
    const __attribute__((address_space(4))) cfp_t* in; float* out; unsigned char* ws;
};
#define FIN(i)     ((const float*)F.in[i])
#define F_MOD(F)   ((float*)((F).ws + WS_MOD))
#define F_HC(F)    ((float*)((F).ws + WS_HC))
#define F_X(F)     ((bf16*)((F).ws + WS_X))
#define F_PROJ(F)  ((bf16*)((F).ws + WS_PROJ))
#define F_YB(F)    ((bf16*)((F).ws + WS_YB))
#define F_CNT(F)   ((int*)((F).ws + WS_CTL) + CW_CNT)

__device__ __forceinline__ void ph_prologue(Frame& F) {
    LAS float* sc = (LAS float*)F.lds;
    LAS float* part = (LAS float*)(F.lds + 40960);
    for (int i = F.tid; i < 9 * 1024; i += 512) { const int mb = i >> 10, k = i & 1023; const float cv = mb < 8 ? FIN(I_C)[mb * 1024 + k] : FIN(I_CCTX)[k]; sc[i] = siluf_(cv); }
    __syncthreads();
    for (int item = F.bid; item < 4 * 96; item += F.G) {
        const int l = item / 96, n0 = (item % 96) * 64;
        const float* wp = FIN(I_WMOD) + ((size_t)l * 1024 + F.wave * 128) * 6144 + n0 + F.lane;
        float acc[9];
#pragma unroll
        for (int mb = 0; mb < 9; ++mb) acc[mb] = 0.f;
#pragma unroll 32
        for (int k = 0; k < 128; ++k) { const float wv = wp[(size_t)k * 6144];
#pragma unroll
            for (int mb = 0; mb < 9; ++mb) acc[mb] += sc[mb * 1024 + F.wave * 128 + k] * wv; }
#pragma unroll
        for (int mb = 0; mb < 9; ++mb) part[(F.wave * 9 + mb) * 64 + F.lane] = acc[mb];
        __syncthreads();
        for (int t = F.tid; t < 576; t += 512) { const int mb = t >> 6, ln = t & 63; float s = FIN(I_BMOD)[l * 6144 + n0 + ln];
#pragma unroll
            for (int w = 0; w < 8; ++w) s += part[(w * 9 + mb) * 64 + ln];
            F_MOD(F)[((size_t)l * 9 + mb) * 6144 + n0 + ln] = s; }
        __syncthreads();
    }
    f32x2* rt = (f32x2*)(F.ws + WS_ROPE);
    for (int i = F.bid * 512 + F.tid; i < 4096 * 32; i += F.G * 512) { const int pos = i >> 5, f = i & 31;
        const float inv = (float)pow(10000.0, -(double)(2 * f) / 64.0); const float ang = (float)pos * inv;
        rt[i] = (f32x2){(float)cos((double)ang), (float)sin((double)ang)}; }
    f32x2* at = (f32x2*)(F.ws + WS_ROPE + 1 * MiB);
    for (int i = F.bid * 512 + F.tid; i < 64 * 16; i += F.G * 512) { const int pos = i >> 4, f = i & 15;
        const float inv = (float)pow(10000.0, -(double)(2 * f) / 32.0); const float ang = (float)pos * inv;
        at[i] = (f32x2){(float)cos((double)ang), (float)sin((double)ang)}; }
}

__device__ __forceinline__ void tr_item(const float* W, int ldw, int k0, int n0, bf16* dst  , int ldk, LAS float* scr, int lane) {
    float wv[32];
#pragma unroll
    for (int i = 0; i < 32; ++i) { const int kk = 2 * i + (lane >> 5); wv[i] = W[(size_t)(k0 + kk) * ldw + n0 + (lane & 31)]; }
#pragma unroll
    for (int i = 0; i < 32; ++i) { const int kk = 2 * i + (lane >> 5); scr[kk * 33 + (lane & 31)] = wv[i]; }
    LDS_WAIT(); asm volatile("" ::: "memory");
    const int c = lane & 7;
#pragma unroll
    for (int j = 0; j < 4; ++j) { const int n = (lane >> 3) + 8 * j; const LAS float* s = scr + (8 * c) * 33 + n;
        u32x4 o; o.x = pk2(s[0 * 33], s[1 * 33]); o.y = pk2(s[2 * 33], s[3 * 33]); o.z = pk2(s[4 * 33], s[5 * 33]); o.w = pk2(s[6 * 33], s[7 * 33]);
        *(u32x4*)(dst + (size_t)n * ldk + 8 * c) = o; }
    LDS_WAIT(); asm volatile("" ::: "memory");
}
__device__ __forceinline__ void ph_convert(Frame& F, int l) {
    LAS float* scr = (LAS float*)(F.lds + F.wave * 16384);
    bf16* wt = (bf16*)(F.ws + WS_WT);
    constexpr int I_IN = 16 * 304, I_BRN = 16 * 32, I_GU1 = 16 * 16, I_DN1 = 8 * 32;
    constexpr int NITEMS = I_IN + 4 * I_BRN + 32 * 2 * I_GU1 + 32 * I_DN1;
    for (int it = F.gw; it < NITEMS; it += F.NGW) {
        int r = it;
        if (r < I_IN) { const int kb = r / 304, nb = r % 304; tr_item(FIN(I_WIN) + (size_t)l * 1024 * DIN, DIN, 64 * kb, 32 * nb, wt + WT_IN / 2 + (size_t)(32 * nb) * 1024 + 64 * kb, 1024, scr, F.lane); continue; }
        r -= I_IN;
        if (r < 3 * I_BRN) { const int br = r / I_BRN, q = r % I_BRN, kb = q / 32, nb = q % 32; const float* W = FIN(I_WBA + br) + (size_t)l * 1024 * 1024;
            tr_item(W, 1024, 64 * kb, 32 * nb, wt + WT_BR / 2 + (size_t)(32 * nb) * 3072 + br * 1024 + 64 * kb, 3072, scr, F.lane); continue; }
        r -= 3 * I_BRN;
        if (r < I_BRN) { const int kb = r / 32, nb = r % 32; tr_item(FIN(I_WOUT) + (size_t)l * 1024 * 1024, 1024, 64 * kb, 32 * nb, wt + WT_WO / 2 + (size_t)(32 * nb) * 1024 + 64 * kb, 1024, scr, F.lane); continue; }
        r -= I_BRN;
        if (r < 32 * 2 * I_GU1) { const int e = r / (2 * I_GU1), q = r % (2 * I_GU1), up = q / I_GU1, q2 = q % I_GU1, kb = q2 / 16, nb = q2 % 16;
            const float* W = FIN(up ? I_EWU : I_EWG) + ((size_t)l * 32 + e) * 1024 * 512; const int n0 = 32 * nb;
            const int drow = e * 1024 + (n0 >> 7) * 256 + up * 128 + (n0 & 127);
            tr_item(W, 512, 64 * kb, n0, wt + WT_GU / 2 + (size_t)drow * 1024 + 64 * kb, 1024, scr, F.lane); continue; }
        r -= 32 * 2 * I_GU1;
        { const int e = r / I_DN1, q = r % I_DN1, kb = q / 32, nb = q % 32; const float* W = FIN(I_EWD) + ((size_t)l * 32 + e) * 512 * 1024;
            tr_item(W, 1024, 64 * kb, 32 * nb, wt + WT_DN / 2 + (size_t)(e * 1024 + 32 * nb) * 512 + 64 * kb, 512, scr, F.lane); }
    }
}
constexpr size_t RW_ELEMS = (size_t)4 * 9 * 48 * 1024;
__device__ __forceinline__ void ph_router_fold(Frame& F) {
    float* Wp = (float*)(F.ws + WS_RW); float* rc = Wp + RW_ELEMS;
    for (int i = F.bid * 512 + F.tid; i < (int)RW_ELEMS; i += F.G * 512) {
        const int k = i & 1023, j = (i >> 10) % 48, mb = (i / (48 * 1024)) % 9, l = i / (48 * 1024 * 9);
        float v = 0.f;
        if (j < RCOLS) { const float w = j < 4 ? FIN(I_RGW)[((size_t)l * 1024 + k) * 4 + j] : FIN(I_REW)[((size_t)l * 1024 + k) * 32 + (j - 4)];
            v = FIN(I_N2G)[l * 1024 + k] * (1.0f + F_MOD(F)[((size_t)l * 9 + mb) * 6144 + 4 * 1024 + k]) * w; }
        Wp[i] = v;
    }
    for (int it = F.gw; it < 4 * 9 * RCOLS; it += F.NGW) { const int j = it % RCOLS, mb = (it / RCOLS) % 9, l = it / (RCOLS * 9);
        float s = 0.f;
        for (int k = F.lane; k < 1024; k += 64) { const float w = j < 4 ? FIN(I_RGW)[((size_t)l * 1024 + k) * 4 + j] : FIN(I_REW)[((size_t)l * 1024 + k) * 32 + (j - 4)];
            s += F_MOD(F)[((size_t)l * 9 + mb) * 6144 + 3 * 1024 + k] * w; }
        s = wave_sum(s);
        if (F.lane == 0) rc[(l * 9 + mb) * 64 + j] = s + (j < 4 ? FIN(I_RGB)[l * 4 + j] : FIN(I_REB)[l * 32 + (j - 4)]);
    }
}

struct RowJob { const float* src; float* copy_to; int mb; };
template <class RowFn> __device__ __forceinline__ void rows_norm_loop(Frame& F, int row0, int nrows, int w, int NW, const float* gain, const float* mod, int shift_i, int scale_i, bf16* dst, RowFn rowfn) {
    const int lane = F.lane;
    f32x4 nv[4]; RowJob nj = {nullptr, nullptr, 0};
    int r = row0 + w;
    if (r < nrows) { nj = rowfn(r);
#pragma unroll
        for (int j = 0; j < 4; ++j) nv[j] = *(const f32x4*)(nj.src + 4 * lane + 256 * j); }
    for (; r < nrows; r += NW) {
        f32x4 v[4]; const RowJob cj = nj;
#pragma unroll
        for (int j = 0; j < 4; ++j) v[j] = nv[j];
        const int rn = r + NW;
        if (rn < nrows) { nj = rowfn(rn);
#pragma unroll
            for (int j = 0; j < 4; ++j) nv[j] = *(const f32x4*)(nj.src + 4 * lane + 256 * j); }
        f32x4 g[4], sh[4], sc[4];
#pragma unroll
        for (int j = 0; j < 4; ++j) { g[j] = *(const f32x4*)(gain + 4 * lane + 256 * j); sh[j] = *(const f32x4*)(mod + cj.mb * 6144 + shift_i * 1024 + 4 * lane + 256 * j); sc[j] = *(const f32x4*)(mod + cj.mb * 6144 + scale_i * 1024 + 4 * lane + 256 * j); }
        float ss = 0.f;
#pragma unroll
        for (int j = 0; j < 4; ++j) ss += (v[j].x * v[j].x + v[j].y * v[j].y) + (v[j].z * v[j].z + v[j].w * v[j].w);
        if (cj.copy_to) {
#pragma unroll
            for (int j = 0; j < 4; ++j) *(f32x4*)(cj.copy_to + 4 * lane + 256 * j) = v[j]; }
        const float rstd = 1.0f / sqrtf(wave_sum(ss) * (1.0f / 1024.0f) + EPS);
#pragma unroll
        for (int j = 0; j < 4; ++j) { const f32x4 y = (v[j] * rstd) * g[j] * (sc[j] + 1.0f) + sh[j];
            u32x2 w; w.x = pk2(y.x, y.y); w.y = pk2(y.z, y.w); *(u32x2*)(dst + (size_t)r * 1024 + 4 * lane + 256 * j) = w; }
    }
}
__device__ __forceinline__ void ph_rows_u(Frame& F, int l, bool first) {
    const float* mod = F_MOD(F) + (size_t)l * 9 * 6144; const float* g = FIN(I_N1G) + l * 1024;
    float* out = F.out; float* hc = F_HC(F); const float* xin = FIN(I_X); const float* cin = FIN(I_CTX);
    rows_norm_loop(F, 0, NTOK, F.gw, F.NGW, g, mod, 0, 1, F_X(F), [=](int r) { const bool lat = r < NLAT; RowJob j; j.mb = lat ? (r >> 12) : 8;
        float* hrow = lat ? out + (size_t)r * 1024 : hc + (size_t)(r - NLAT) * 1024;
        j.src = first ? (lat ? xin + (size_t)r * 1024 : cin + (size_t)(r - NLAT) * 1024) : hrow; j.copy_to = nullptr; return j; });
}
__device__ __forceinline__ void ph_rows_v(Frame& F, int l, int row0, int ntok, int w, int NW) {
    const float* mod = F_MOD(F) + (size_t)l * 9 * 6144; const float* g = FIN(I_N2G) + l * 1024;
    float* out = F.out; float* hc = F_HC(F);
    rows_norm_loop(F, row0, ntok, w, NW, g, mod, 3, 4, F_X(F), [=](int r) { const bool lat = r < NLAT; RowJob j; j.mb = lat ? (r >> 12) : 8;
        j.src = lat ? out + (size_t)r * 1024 : hc + (size_t)(r - NLAT) * 1024; j.copy_to = nullptr; return j; });
}

__device__ __forceinline__ void ph_router(Frame& F, int l, int bt0, int bt1, int c, int G) {
    LAS float* Bs = (LAS float*)F.lds;
    LAS float* lgs = (LAS float*)(F.lds + 53248 + F.wave * 4096);
    const float* WpL = (const float*)(F.ws + WS_RW) + (size_t)l * 9 * 48 * 1024; const float* rcL = (const float*)(F.ws + WS_RW) + RW_ELEMS + l * 9 * 64;
    int* cnt = F_CNT(F) + l * 32; int* rowtok = (int*)(F.ws + WS_ROWTOK); unsigned* tinfo = (unsigned*)(F.ws + WS_TOKINFO);
    const int lane = F.lane, i16 = lane & 15, kq = lane >> 4, tid = F.tid;
    const int ntask = bt1 - bt0, nfull = (ntask / G) * G, rem = ntask - nfull;
    const int rtok0 = (bt0 + nfull) * 128, rtok1 = bt1 * 128 - 1;
    const bool minis = rem > 0 && ((rtok0 < NLAT ? (rtok0 >> 12) : 8) == (rtok1 < NLAT ? (rtok1 >> 12) : 8));
    const int npass = nfull / G + (rem > 0 ? (minis ? 1 : (c < rem ? 1 : 0)) : 0);
    for (int ps_ = 0; ps_ < npass; ++ps_) {
        const bool mini = minis && ps_ == nfull / G;
        const int mt = c + G * F.wave;
        const bool active = !mini || mt < rem * 8;
        const int tok0 = mini ? (active ? rtok0 + mt * 16 : rtok0) : (bt0 + c + ps_ * G) * 128 + F.wave * 16; const bool lat = tok0 < NLAT; const int mb = lat ? (tok0 >> 12) : 8;
        const float* hrow = (lat ? F.out + (size_t)(tok0 + i16) * 1024 : F_HC(F) + (size_t)(tok0 + i16 - NLAT) * 1024) + 4 * kq;
        const float* wsrc = WpL + (size_t)mb * 48 * 1024;
        f32x4 acc[3]; float ss = 0.f;
#pragma unroll
        for (int c = 0; c < 3; ++c) acc[c] = (f32x4){0.f, 0.f, 0.f, 0.f};
        f32x4 bnext[6];
#pragma unroll
        for (int j = 0; j < 6; ++j) { const int i = tid + 512 * j; bnext[j] = *(const f32x4*)(wsrc + (size_t)(i >> 6) * 1024 + 4 * (i & 63)); }
#pragma unroll 1
        for (int kc = 0; kc < 4; ++kc) {
            LDS_BARRIER();
#pragma unroll
            for (int j = 0; j < 6; ++j) { const int i = tid + 512 * j; *(LAS f32x4*)(Bs + (i >> 6) * 260 + 4 * (i & 63)) = bnext[j]; }
            LDS_BARRIER();
            if (kc < 3) {
#pragma unroll
                for (int j = 0; j < 6; ++j) { const int i = tid + 512 * j; bnext[j] = *(const f32x4*)(wsrc + (size_t)(i >> 6) * 1024 + (kc + 1) * 256 + 4 * (i & 63)); } }
            const LAS float* bp = Bs + i16 * 260 + 4 * kq;
            if (active)
#pragma unroll 4
            for (int S = 0; S < 16; ++S) {
                const f32x4 a = *(const f32x4*)(hrow + kc * 256 + 16 * S);
                const f32x4 b0 = *(const LAS f32x4*)(bp + 16 * S), b1 = *(const LAS f32x4*)(bp + 16 * 260 + 16 * S), b2 = *(const LAS f32x4*)(bp + 32 * 260 + 16 * S);
                ss += (a.x * a.x + a.y * a.y) + (a.z * a.z + a.w * a.w);
#pragma unroll
                for (int s = 0; s < 4; ++s) { acc[0] = __builtin_amdgcn_mfma_f32_16x16x4f32(a[s], b0[s], acc[0], 0, 0, 0); acc[1] = __builtin_amdgcn_mfma_f32_16x16x4f32(a[s], b1[s], acc[1], 0, 0, 0);
                    acc[2] = __builtin_amdgcn_mfma_f32_16x16x4f32(a[s], b2[s], acc[2], 0, 0, 0); }
            }
        }
        if (active) {
        ss += __shfl_xor(ss, 16); ss += __shfl_xor(ss, 32);
#pragma unroll
        for (int c = 0; c < 3; ++c)
#pragma unroll
            for (int r = 0; r < 4; ++r) lgs[(4 * kq + r) * 52 + 16 * c + i16] = acc[c][r];
        LDS_WAIT(); asm volatile("" ::: "memory");
        const float rstd = 1.0f / sqrtf(ss * (1.0f / 1024.0f) + EPS);
        float lg[RCOLS];
#pragma unroll
        for (int j4 = 0; j4 < RCOLS / 4; ++j4) { const f32x4 v = *(const LAS f32x4*)(lgs + i16 * 52 + 4 * j4); const f32x4 rcv = *(const f32x4*)(rcL + mb * 64 + 4 * j4);
            lg[4 * j4] = v.x * rstd + rcv.x; lg[4 * j4 + 1] = v.y * rstd + rcv.y; lg[4 * j4 + 2] = v.z * rstd + rcv.z; lg[4 * j4 + 3] = v.w * rstd + rcv.w; }
        LDS_WAIT(); asm volatile("" ::: "memory");
        const int tok = tok0 + i16;
        int g = 0; float gm = lg[0];
#pragma unroll
        for (int j = 1; j < 4; ++j) if (lg[j] > gm) { gm = lg[j]; g = j; }
        float gs = 0.f;
#pragma unroll
        for (int j = 0; j < 4; ++j) gs += __expf(lg[j] - gm);
        const float g_w = 1.0f / gs;
        float el[8];
#pragma unroll
        for (int i = 0; i < 8; ++i) { el[i] = lg[4 + i];
#pragma unroll
            for (int gg = 1; gg < 4; ++gg) el[i] = (g == gg) ? lg[4 + gg * 8 + i] : el[i]; }
        int i1 = 0; float m1 = el[0];
#pragma unroll
        for (int i = 1; i < 8; ++i) if (el[i] > m1) { m1 = el[i]; i1 = i; }
        int i2 = -1; float m2 = -3.0e38f;
#pragma unroll
        for (int i = 0; i < 8; ++i) if (i != i1 && el[i] > m2) { m2 = el[i]; i2 = i; }
        const float p2 = __expf(m2 - m1); const float w1 = g_w / (1.0f + p2), w2 = g_w * p2 / (1.0f + p2);
        const int e1 = g * 8 + i1, e2 = g * 8 + i2;
        int r1 = 0, r2 = 0;
        { unsigned long long todo = 0xFFFFull;
          while (todo) { const int ld = __builtin_ctzll(todo); const int x = __shfl(e1, ld); const unsigned long long m = __ballot(e1 == x) & todo;
              int base = 0; if (lane == ld && F.wr) base = atomicAdd(&cnt[x], (int)__builtin_popcountll(m)); base = __shfl(base, ld);
              if (e1 == x) r1 = base + (int)__builtin_popcountll(m & ((1ull << lane) - 1ull)); todo &= ~m; } }
        { unsigned long long todo = 0xFFFFull;
          while (todo) { const int ld = __builtin_ctzll(todo); const int x = __shfl(e2, ld); const unsigned long long m = __ballot(e2 == x) & todo;
              int base = 0; if (lane == ld && F.wr) base = atomicAdd(&cnt[x], (int)__builtin_popcountll(m)); base = __shfl(base, ld);
              if (e2 == x) r2 = base + (int)__builtin_popcountll(m & ((1ull << lane) - 1ull)); todo &= ~m; } }
        if (lane < 16 && F.wr) { rowtok[(size_t)e1 * NTOK + r1] = tok; rowtok[(size_t)e2 * NTOK + r2] = tok;
            u32x4 a; a.x = (unsigned)e1; a.y = (unsigned)r1; a.z = (unsigned)e2; a.w = (unsigned)r2;
            *(u32x4*)(tinfo + (size_t)tok * 8) = a; *(f32x2*)(tinfo + (size_t)tok * 8 + 4) = (f32x2){w1, w2}; }
        }
    }
}
__device__ __forceinline__ void moe_tables(Frame& F, int l, volatile LAS int*& tileoff, volatile LAS int*& cntl) {
    volatile LAS int* t = (volatile LAS int*)(F.lds + LDS_CTL + 512); cntl = t; tileoff = t + 32;
    if (F.tid < 32) t[F.tid] = __hip_atomic_load(F_CNT(F) + l * 32 + F.tid, __ATOMIC_RELAXED, __HIP_MEMORY_SCOPE_AGENT);
    __syncthreads();
    if (F.tid == 0) { int s = 0;
#pragma unroll 1
        for (int e = 0; e < 32; ++e) { t[32 + e] = s; s += (t[e] + 255) >> 8; } t[64] = s; }
    __syncthreads();
}
__device__ __forceinline__ void ph_combine(Frame& F, int l, int ntok) {
    volatile LAS int* tileoff; volatile LAS int* cntl; moe_tables(F, l, tileoff, cntl);
    const float* mod = F_MOD(F) + (size_t)l * 9 * 6144; const bool lastl = (l == DEPTH - 1);
    const float* modn = F_MOD(F) + (size_t)(lastl ? l : l + 1) * 9 * 6144; const float* gn = lastl ? FIN(I_FNG) : FIN(I_N1G) + (l + 1) * 1024;
    const bf16* Y = (const bf16*)(F.ws + WS_YROWS); const unsigned* tinfo = (const unsigned*)(F.ws + WS_TOKINFO);
    const int lane = F.lane;
    u32x4 ninf = (u32x4){0u, 0u, 0u, 0u}; f32x2 nwv = (f32x2){0.f, 0.f}; f32x4 nh[4];
    int r = F.gw;
#define CMB_HROW(rr) ((rr) < NLAT ? F.out + (size_t)(rr) * 1024 : F_HC(F) + (size_t)((rr) - NLAT) * 1024)
    if (r < ntok) { ninf = *(const u32x4*)(tinfo + (size_t)r * 8); nwv = *(const f32x2*)(tinfo + (size_t)r * 8 + 4); const float* hp = CMB_HROW(r);
#pragma unroll
        for (int j = 0; j < 4; ++j) nh[j] = *(const f32x4*)(hp + 4 * lane + 256 * j); }
    for (; r < ntok; r += F.NGW) {
        const u32x4 inf = ninf; const f32x2 wv = nwv; f32x4 hv[4];
#pragma unroll
        for (int j = 0; j < 4; ++j) hv[j] = nh[j];
        const bool lat = r < NLAT; const int mb = lat ? (r >> 12) : 8; float* hrow = CMB_HROW(r);
        const bf16* y1 = Y + ((size_t)tileoff[inf.x] * 256 + inf.y) * 1024; const bf16* y2 = Y + ((size_t)tileoff[inf.z] * 256 + inf.w) * 1024;
        u32x2 ya[4], yb[4];
#pragma unroll
        for (int j = 0; j < 4; ++j) { ya[j] = *(const u32x2*)(y1 + 4 * lane + 256 * j); yb[j] = *(const u32x2*)(y2 + 4 * lane + 256 * j); }
        const int rn = r + F.NGW;
        if (rn < ntok) { ninf = *(const u32x4*)(tinfo + (size_t)rn * 8); nwv = *(const f32x2*)(tinfo + (size_t)rn * 8 + 4); const float* hp = CMB_HROW(rn);
#pragma unroll
            for (int j = 0; j < 4; ++j) nh[j] = *(const f32x4*)(hp + 4 * lane + 256 * j); }
        f32x4 v[4]; float ss = 0.f;
#pragma unroll
        for (int j = 0; j < 4; ++j) { const int c = 4 * lane + 256 * j; const f32x4 m5 = *(const f32x4*)(mod + mb * 6144 + 5 * 1024 + c);
            const u32x2 a = ya[j], b = yb[j];
            f32x4 y; y.x = wv.x * bflo(a.x) + wv.y * bflo(b.x); y.y = wv.x * bfhi(a.x) + wv.y * bfhi(b.x); y.z = wv.x * bflo(a.y) + wv.y * bflo(b.y); y.w = wv.x * bfhi(a.y) + wv.y * bfhi(b.y);
            v[j] = hv[j] + m5 * y; ss += (v[j].x * v[j].x + v[j].y * v[j].y) + (v[j].z * v[j].z + v[j].w * v[j].w); }
        const float rstd = 1.0f / sqrtf(wave_sum(ss) * (1.0f / 1024.0f) + EPS);
        if (lastl) {
#pragma unroll
            for (int j = 0; j < 4; ++j) { const int c = 4 * lane + 256 * j; const f32x4 g = *(const f32x4*)(gn + c); if (F.wr) *(f32x4*)(hrow + c) = (v[j] * rstd) * g; }
        } else {
#pragma unroll
            for (int j = 0; j < 4; ++j) { const int c = 4 * lane + 256 * j; if (F.wr) *(f32x4*)(hrow + c) = v[j];
                const f32x4 g = *(const f32x4*)(gn + c), sh = *(const f32x4*)(modn + mb * 6144 + c), sc = *(const f32x4*)(modn + mb * 6144 + 1024 + c);
                const f32x4 y = (v[j] * rstd) * g * (sc + 1.0f) + sh; u32x2 w; w.x = pk2(y.x, y.y); w.y = pk2(y.z, y.w); if (F.wr) *(u32x2*)(F_X(F) + (size_t)r * 1024 + c) = w; }
        }
    }
#undef CMB_HROW
}
#define MFMA16(a, b, c) __builtin_amdgcn_mfma_f32_16x16x32_bf16((a), (b), (c), 0, 0, 0)
__device__ __forceinline__ bf16x8 ldfrag(const LAS bf16* base, int row0, int k0, int ld, int lane) {
    return *(const LAS bf16x8*)(base + (row0 + (lane & 15)) * ld + k0 + 8 * (lane >> 4));
}
__device__ __forceinline__ float fast_sigmoid(float x) { return __builtin_amdgcn_rcpf(1.0f + __builtin_amdgcn_exp2f(-1.4426950408889634f * x)); }
__device__ __forceinline__ float fast_gelu_tanh(float x) {
    const float u2 = 1.5957691216057308f * (x + 0.044715f * x * x * x);
    return x * __builtin_amdgcn_rcpf(1.0f + __builtin_amdgcn_exp2f(-1.4426950408889634f * u2));
}

__device__ __forceinline__ void att_rope8(const f32x2* tab, const float (&x1)[8], const float (&x2)[8], float (&o1)[8], float (&o2)[8]) {
#pragma unroll
    for (int e = 0; e < 8; ++e) { const f32x2 cs = tab[e]; o1[e] = x1[e] * cs.x - x2[e] * cs.y; o2[e] = x2[e] * cs.x + x1[e] * cs.y; }
}
__device__ __forceinline__ void unpack8(const u32x4 a, float (&x)[8]) { x[0] = bflo(a.x); x[1] = bfhi(a.x); x[2] = bflo(a.y); x[3] = bfhi(a.y); x[4] = bflo(a.z); x[5] = bfhi(a.z); x[6] = bflo(a.w); x[7] = bfhi(a.w); }
__device__ __forceinline__ u32x4 pack8(const float (&x)[8], float s) { u32x4 r; r.x = pk2(x[0] * s, x[1] * s); r.y = pk2(x[2] * s, x[3] * s); r.z = pk2(x[4] * s, x[5] * s); r.w = pk2(x[6] * s, x[7] * s); return r; }

template <int RS> __device__ __forceinline__ void tr_frags4(unsigned addr, bf16x8 (&f)[4]) {
    u32x2 a0, a1, b0, b1, c0, c1, d0, d1;
    asm volatile("ds_read_b64_tr_b16 %0, %8\n\tds_read_b64_tr_b16 %1, %8 offset:%9\n\tds_read_b64_tr_b16 %2, %8 offset:32\n\tds_read_b64_tr_b16 %3, %8 offset:%10\n\t"
                 "ds_read_b64_tr_b16 %4, %8 offset:64\n\tds_read_b64_tr_b16 %5, %8 offset:%11\n\tds_read_b64_tr_b16 %6, %8 offset:96\n\tds_read_b64_tr_b16 %7, %8 offset:%12\n\ts_waitcnt lgkmcnt(0)"
                 : "=&v"(a0), "=&v"(a1), "=&v"(b0), "=&v"(b1), "=&v"(c0), "=&v"(c1), "=&v"(d0), "=&v"(d1)
                 : "v"(addr), "i"(4 * RS), "i"(32 + 4 * RS), "i"(64 + 4 * RS), "i"(96 + 4 * RS) : "memory");
    u32x4 t; t.x = a0.x; t.y = a0.y; t.z = a1.x; t.w = a1.y; f[0] = __builtin_bit_cast(bf16x8, t);
    t.x = b0.x; t.y = b0.y; t.z = b1.x; t.w = b1.y; f[1] = __builtin_bit_cast(bf16x8, t);
    t.x = c0.x; t.y = c0.y; t.z = c1.x; t.w = c1.y; f[2] = __builtin_bit_cast(bf16x8, t);
    t.x = d0.x; t.y = d0.y; t.z = d1.x; t.w = d1.y; f[3] = __builtin_bit_cast(bf16x8, t);
}


__device__ __forceinline__ float xor16_max(float x) { const unsigned xi = __builtin_bit_cast(unsigned, x); const auto r = __builtin_amdgcn_permlane16_swap(xi, xi, false, false); return fmaxf(__builtin_bit_cast(float, (unsigned)r[0]), __builtin_bit_cast(float, (unsigned)r[1])); }
__device__ __forceinline__ float xor32_max(float x) { const unsigned xi = __builtin_bit_cast(unsigned, x); const auto r = __builtin_amdgcn_permlane32_swap(xi, xi, false, false); return fmaxf(__builtin_bit_cast(float, (unsigned)r[0]), __builtin_bit_cast(float, (unsigned)r[1])); }
__device__ __forceinline__ float xor16_sum(float x) { const unsigned xi = __builtin_bit_cast(unsigned, x); const auto r = __builtin_amdgcn_permlane16_swap(xi, xi, false, false); return __builtin_bit_cast(float, (unsigned)r[0]) + __builtin_bit_cast(float, (unsigned)r[1]); }
__device__ __forceinline__ float xor32_sum(float x) { const unsigned xi = __builtin_bit_cast(unsigned, x); const auto r = __builtin_amdgcn_permlane32_swap(xi, xi, false, false); return __builtin_bit_cast(float, (unsigned)r[0]) + __builtin_bit_cast(float, (unsigned)r[1]); }

#ifndef LRU_ABL
#define LRU_ABL 0
#endif
__device__ __forceinline__ void lru_unit(Frame& F, int l, int b, int hd, int half) {
    LAS bf16* ub = (LAS bf16*)F.lds;
    LAS bf16* waT = (LAS bf16*)(F.lds + 36864);
    LAS bf16* wxT = (LAS bf16*)(F.lds + 36864 + 4608);
    LAS f32x2* wcomp = (LAS f32x2*)(F.lds + 92800);
    LAS bf16* ho = (LAS bf16*)(F.lds + 46080 + 3 * 8192 + 256);
    const int tid = F.tid, lane = F.lane, w = F.wave, q = lane >> 4, fr = lane & 15;
    bf16* proj = F_PROJ(F); bf16* X = F_X(F);
    const int chh = hd * 64;
    const int c8 = tid & 7, rg = tid >> 3;
    LAS float* cwl = (LAS float*)(F.lds + 91392 + 128);
    __syncthreads();
    if (tid < 320) { const int j = tid >> 6, c = tid & 63; cwl[tid] = j < 4 ? FIN(I_CONVW)[((size_t)l * 4 + j) * 1024 + chh + c] : FIN(I_CONVB)[l * 1024 + chh + c]; }
    const int orow = tid >> 1, ohh = tid & 1;
#pragma unroll 1
    for (int dir = 0; dir < 2; ++dir) {
        __syncthreads();
        for (int i = tid; i < 2048; i += 512) { const int k = i >> 5, c = i & 31; const size_t gi = ((((size_t)l * 2 + dir) * 16 + hd) * 64 + k) * 64 + half * 32 + c;
            waT[c * 72 + k] = (bf16)f2bf(FIN(I_WA)[gi]); wxT[c * 72 + k] = (bf16)f2bf(FIN(I_WX)[gi]); }
        float ba_[2], bx_[2], sp8_[2], carry[2] = {0.f, 0.f};
#pragma unroll
        for (int cb = 0; cb < 2; ++cb) { const int ch = chh + half * 32 + cb * 16 + fr; const size_t gi = ((size_t)l * 2 + dir) * 1024 + ch;
            ba_[cb] = FIN(I_BA)[gi]; bx_[cb] = FIN(I_BX)[gi]; const float lam = FIN(I_LAM)[gi]; sp8_[cb] = -8.0f * 1.4426950408889634f * log1p_fast(__expf(-lam)); }
        __syncthreads();
        const int rgd = dir ? 63 - rg : rg;
        u32x4 axr[7]; u32x4 pf[4];
#define LRU_CHUNK(ci, isctx_, T0_, rowbase_) const bool isctx_ = (ci) == 0; const int T0_ = isctx_ ? 0 : 256 * (dir ? (16 - (ci)) : ((ci) - 1)); const size_t rowbase_ = isctx_ ? (size_t)NLAT + b * LCX : (size_t)b * SEQ
#define LRU_PREFETCH(ci) do { LRU_CHUNK(ci, ic_, t0_, rb_); const int Ls_ = ic_ ? LCX : SEQ; \
            _Pragma("unroll") for (int j = 0; j < 7; ++j) { const int tt = t0_ + 4 * rgd - 2 + j; const int tc_ = (tt >= 0 && tt < Ls_) ? tt : 0; \
                const GAS bf16* p_ = (const GAS bf16*)(proj + (rb_ + tc_) * LDP + C_AX + chh + 8 * c8); \
                asm volatile("global_load_dwordx4 %0, %1, off" : "=v"(axr[j]) : "v"(p_) : "memory"); } } while (0)
#define LRU_AX_WAIT(ci) do { if (dir == 0) asm volatile("s_waitcnt vmcnt(2)" : "+v"(axr[0]), "+v"(axr[1]), "+v"(axr[2]), "+v"(axr[3]), "+v"(axr[4]), "+v"(axr[5]), "+v"(axr[6]) :: "memory"); \
            else asm volatile("s_waitcnt vmcnt(6)" : "+v"(axr[0]), "+v"(axr[1]), "+v"(axr[2]), "+v"(axr[3]), "+v"(axr[4]), "+v"(axr[5]), "+v"(axr[6]) :: "memory"); \
            LRU_CHUNK(ci, ic_, t0_, rb_); (void)rb_; const int Ls_ = ic_ ? LCX : SEQ; \
            _Pragma("unroll") for (int j = 0; j < 7; ++j) { const int tt = t0_ + 4 * rgd - 2 + j; if (!(tt >= 0 && tt < Ls_)) axr[j] = (u32x4){0u, 0u, 0u, 0u}; } } while (0)
#define LRU_PREFETCH_OUT(ci) do { if (dir == 1) { LRU_CHUNK(ci, ic_, t0_, rb_); const size_t orow_g = rb_ + t0_ + (255 - orow); \
                pf[0] = *(const u32x4*)(X + orow_g * 1024 + chh + half * 32 + ohh * 16); pf[1] = *(const u32x4*)(X + orow_g * 1024 + chh + half * 32 + ohh * 16 + 8); \
                pf[2] = *(const u32x4*)(proj + orow_g * LDP + C_AY + chh + half * 32 + ohh * 16); pf[3] = *(const u32x4*)(proj + orow_g * LDP + C_AY + chh + half * 32 + ohh * 16 + 8); } } while (0)
        LRU_PREFETCH(0); LRU_PREFETCH_OUT(0);
        asm volatile("s_waitcnt vmcnt(0)" : "+v"(axr[0]), "+v"(axr[1]), "+v"(axr[2]), "+v"(axr[3]), "+v"(axr[4]), "+v"(axr[5]), "+v"(axr[6]) :: "memory");
#pragma unroll 1
        for (int ci = 0; ci < 17; ++ci) {
            LRU_CHUNK(ci, isctx, T0, rowbase);
            if (ci > 0) { LRU_AX_WAIT(ci); } else {
#pragma unroll
                for (int j = 0; j < 7; ++j) { const int tt = 4 * rgd - 2 + j; if (!(tt >= 0 && tt < LCX)) axr[j] = (u32x4){0u, 0u, 0u, 0u}; } }
            { float u[4][8];
#pragma unroll
              for (int r = 0; r < 4; ++r) { const f32x4 b0 = *(const LAS f32x4*)(cwl + 256 + 8 * c8), b1 = *(const LAS f32x4*)(cwl + 256 + 8 * c8 + 4);
                  u[r][0] = b0.x; u[r][1] = b0.y; u[r][2] = b0.z; u[r][3] = b0.w; u[r][4] = b1.x; u[r][5] = b1.y; u[r][6] = b1.z; u[r][7] = b1.w; }
#pragma unroll
              for (int j = 0; j < 7; ++j) { float x[8]; x[0] = bflo(axr[j].x); x[1] = bfhi(axr[j].x); x[2] = bflo(axr[j].y); x[3] = bfhi(axr[j].y); x[4] = bflo(axr[j].z); x[5] = bfhi(axr[j].z); x[6] = bflo(axr[j].w); x[7] = bfhi(axr[j].w);
#pragma unroll
                  for (int t = 0; t < 4; ++t) { const int r = j - t; if (r >= 0 && r < 4) {
                      const f32x4 w0 = *(const LAS f32x4*)(cwl + 64 * t + 8 * c8), w1 = *(const LAS f32x4*)(cwl + 64 * t + 8 * c8 + 4);
                      u[r][0] += w0.x * x[0]; u[r][1] += w0.y * x[1]; u[r][2] += w0.z * x[2]; u[r][3] += w0.w * x[3]; u[r][4] += w1.x * x[4]; u[r][5] += w1.y * x[5]; u[r][6] += w1.z * x[6]; u[r][7] += w1.w * x[7]; } } }
#pragma unroll
              for (int r = 0; r < 4; ++r) { const int tl = 4 * rgd + r, p = dir ? (255 - tl) : tl;
                  u32x4 o; o.x = pk2(u[r][0], u[r][1]); o.y = pk2(u[r][2], u[r][3]); o.z = pk2(u[r][4], u[r][5]); o.w = pk2(u[r][6], u[r][7]); *(LAS u32x4*)(ub + p * 72 + 8 * c8) = o; } }
            if (ci + 1 < 17) LRU_PREFETCH(ci + 1);
            LDS_WAIT(); asm volatile("" ::: "memory");
            float hl[2][2][4], Ac[2][2][4], sa[2][2], sb[2][2];
            bf16x8 Ba[2][2], Bx[2][2];
#pragma unroll
            for (int cb = 0; cb < 2; ++cb)
#pragma unroll
                for (int ks = 0; ks < 2; ++ks) { Ba[cb][ks] = ldfrag(waT, cb * 16, ks * 32, 72, lane); Bx[cb][ks] = ldfrag(wxT, cb * 16, ks * 32, 72, lane); }
#pragma unroll
            for (int rb = 0; rb < 2; ++rb) { const bf16x8 A0 = ldfrag(ub, 32 * w + 16 * rb, 0, 72, lane), A1 = ldfrag(ub, 32 * w + 16 * rb, 32, 72, lane);
#pragma unroll
                for (int cb = 0; cb < 2; ++cb) {
                    f32x4 ra = (f32x4){0.f, 0.f, 0.f, 0.f}, rx = ra;
                    ra = MFMA16(A0, Ba[cb][0], ra); ra = MFMA16(A1, Ba[cb][1], ra); rx = MFMA16(A0, Bx[cb][0], rx); rx = MFMA16(A1, Bx[cb][1], rx);
                    float hprev = 0.f, aprev = 1.f;
#pragma unroll
                    for (int r = 0; r < 4; ++r) { const int p = 32 * w + 16 * rb + 4 * q + r; const float u = bf2f(ub[p * 72 + half * 32 + cb * 16 + fr]);
                        const float rgt = fast_sigmoid(ra[r] + ba_[cb]), igt = fast_sigmoid(rx[r] + bx_[cb]);
                        const float a = __builtin_amdgcn_exp2f(sp8_[cb] * rgt), bb = __builtin_amdgcn_sqrtf(fmaxf((1.0f - a) * (1.0f + a), 0.f)) * (igt * u);
                        hprev = a * hprev + bb; aprev = a * aprev; hl[rb][cb][r] = hprev; Ac[rb][cb][r] = aprev; }
                    sa[rb][cb] = aprev; sb[rb][cb] = hprev; } }
            float ea[2][2], eb[2][2];
            const int par = ci & 1;
#pragma unroll
            for (int cb = 0; cb < 2; ++cb) { float ia[2], ib[2];
#pragma unroll
                for (int rb = 0; rb < 2; ++rb) { float a = sa[rb][cb], bq = sb[rb][cb];
                    float a1 = __shfl_up(a, 16), b1 = __shfl_up(bq, 16); if (q >= 1) { bq = a * b1 + bq; a = a * a1; }
                    a1 = __shfl_up(a, 32); b1 = __shfl_up(bq, 32); if (q >= 2) { bq = a * b1 + bq; a = a * a1; }
                    ia[rb] = a; ib[rb] = bq;
                    a1 = __shfl_up(a, 16); b1 = __shfl_up(bq, 16); ea[rb][cb] = q ? a1 : 1.0f; eb[rb][cb] = q ? b1 : 0.0f; }
                const float t0a = __shfl(ia[0], 48 + fr), t0b = __shfl(ib[0], 48 + fr);
                eb[1][cb] = ea[1][cb] * t0b + eb[1][cb]; ea[1][cb] = ea[1][cb] * t0a;
                if (q == 3) wcomp[(par * 8 + w) * 32 + cb * 16 + fr] = (f32x2){ia[1] * t0a, ia[1] * t0b + ib[1]}; }
            LDS_BARRIER();
#pragma unroll
            for (int cb = 0; cb < 2; ++cb) { float h = carry[cb], hin = h;
#pragma unroll
                for (int k = 0; k < 8; ++k) { const f32x2 c = wcomp[(par * 8 + k) * 32 + cb * 16 + fr]; h = c.x * h + c.y; hin = (k + 1 == w) ? h : hin; }
                carry[cb] = h;
#pragma unroll
                for (int rb = 0; rb < 2; ++rb) { const float hs = ea[rb][cb] * hin + eb[rb][cb];
#pragma unroll
                    for (int r = 0; r < 4; ++r) { const int p = 32 * w + 16 * rb + 4 * q + r; ho[p * 40 + cb * 16 + fr] = (bf16)f2bf(Ac[rb][cb][r] * hs + hl[rb][cb][r]); } } }
            LDS_WAIT(); asm volatile("" ::: "memory");
            { const int tl = dir ? (255 - orow) : orow; const size_t row = rowbase + T0 + tl;
              const u32x4 h0 = *(const LAS u32x4*)(ho + orow * 40 + ohh * 16), h1 = *(const LAS u32x4*)(ho + orow * 40 + ohh * 16 + 8);
              if (dir == 0) { *(u32x4*)(X + row * 1024 + chh + half * 32 + ohh * 16) = h0; *(u32x4*)(X + row * 1024 + chh + half * 32 + ohh * 16 + 8) = h1; }
              else { u32x4 o0, o1;
#define LRU_Y(hb, hf, ay) pk2((bflo(hf) + bflo(hb)) * fast_gelu_tanh(bflo(ay)), (bfhi(hf) + bfhi(hb)) * fast_gelu_tanh(bfhi(ay)))
                  o0.x = LRU_Y(h0.x, pf[0].x, pf[2].x); o0.y = LRU_Y(h0.y, pf[0].y, pf[2].y); o0.z = LRU_Y(h0.z, pf[0].z, pf[2].z); o0.w = LRU_Y(h0.w, pf[0].w, pf[2].w);
                  o1.x = LRU_Y(h1.x, pf[1].x, pf[3].x); o1.y = LRU_Y(h1.y, pf[1].y, pf[3].y); o1.z = LRU_Y(h1.z, pf[1].z, pf[3].z); o1.w = LRU_Y(h1.w, pf[1].w, pf[3].w);
#undef LRU_Y
                  { bf16* yb_ = F_YB(F) + row * 3072 + chh + half * 32 + ohh * 16; *(u32x4*)yb_ = o0; *(u32x4*)(yb_ + 8) = o1; } } }
            if (ci + 1 < 17) LRU_PREFETCH_OUT(ci + 1);
        }
#undef LRU_AX_WAIT
#undef LRU_PREFETCH_OUT
#undef LRU_PREFETCH
#undef LRU_CHUNK
    }
}
__device__ __forceinline__ size_t ret_rowbase(int b, int cidx) { return cidx < 2 ? (size_t)NLAT + b * LCX + cidx * 128 : (size_t)b * SEQ + (cidx - 2) * 128; }
__device__ __forceinline__ float ret_logg(Frame& F, int l, int dir, int h) { const float lam = FIN(I_RLAM)[(l * 2 + dir) * 8 + h]; return -log1p_fast(__expf(-lam)); }

__device__ __forceinline__ void ret_load_qk(Frame& F, const bf16* src  , bool rope, int pos0, float scale, float (&o1)[8], float (&o2)[8]) {
    const int row = F.tid >> 2, cp = F.tid & 3;
    const u32x4 a = *(const u32x4*)(src + (size_t)row * LDP + 8 * cp), b = *(const u32x4*)(src + (size_t)row * LDP + 32 + 8 * cp);
    float x1[8] = {bflo(a.x), bfhi(a.x), bflo(a.y), bfhi(a.y), bflo(a.z), bfhi(a.z), bflo(a.w), bfhi(a.w)};
    float x2[8] = {bflo(b.x), bfhi(b.x), bflo(b.y), bfhi(b.y), bflo(b.z), bfhi(b.z), bflo(b.w), bfhi(b.w)};
    if (rope) { const f32x2* rt = (const f32x2*)(F.ws + WS_ROPE) + (size_t)(pos0 + row) * 32 + 8 * cp;
#pragma unroll
        for (int e = 0; e < 8; ++e) { const f32x2 cs = rt[e]; o1[e] = (x1[e] * cs.x - x2[e] * cs.y) * scale; o2[e] = (x2[e] * cs.x + x1[e] * cs.y) * scale; }
    } else {
#pragma unroll
        for (int e = 0; e < 8; ++e) { o1[e] = x1[e] * scale; o2[e] = x2[e] * scale; }
    }
}
__device__ __forceinline__ void ph_ret_r1(Frame& F, int l) {
    LAS bf16* Kf = (LAS bf16*)F.lds;
    LAS bf16* Kb = Kf + 128 * 72;
    LAS bf16* Vs = Kb + 128 * 72;
    const int tid = F.tid, lane = F.lane, w = F.wave, q = lane >> 4, fr = lane & 15;
    const bf16* proj = F_PROJ(F);
    const int row = tid >> 2, cp = tid & 3;
    u32x4 ka, kb, vv[4];
#define R1_LOAD(u) do { const int bh__ = (u) / 34, ci__ = (u) % 34; const size_t rb__ = ret_rowbase(bh__ >> 3, ci__); const int h__ = bh__ & 7; \
        const bf16* ks_ = proj + (rb__ + row) * LDP + C_BK + h__ * 64 + 8 * cp; ka = *(const u32x4*)ks_; kb = *(const u32x4*)(ks_ + 32); \
        _Pragma("unroll") for (int i = 0; i < 4; ++i) { const int t_ = tid + 512 * i; vv[i] = *(const u32x4*)(proj + (rb__ + (t_ >> 4)) * LDP + C_BV + h__ * 128 + 8 * (t_ & 15)); } } while (0)
    int u = F.bid;
    if (u < 64 * 34) R1_LOAD(u);
    const int dir = w >> 2, e0 = 32 * (w & 3);
    const unsigned vlane = (unsigned)(size_t)Vs + (unsigned)((8 * q + (fr >> 2)) * 272 + (fr & 3) * 8 + e0 * 2);
    const unsigned klane = (unsigned)(size_t)(dir ? Kb : Kf) + (unsigned)((8 * q + (fr >> 2)) * 144 + (fr & 3) * 8);
#pragma unroll 1
    for (; u < 64 * 34; u += F.G) {
        const int bh = u / 34, cidx = u % 34, b = bh >> 3, h = bh & 7; const bool lat = cidx >= 2;
        const float lg0 = ret_logg(F, l, 0, h), lg1 = ret_logg(F, l, 1, h);
        LDS_BARRIER();
        { float x1[8], x2[8], o1[8], o2[8]; unpack8(ka, x1); unpack8(kb, x2);
          if (lat) { const f32x2* rt = (const f32x2*)(F.ws + WS_ROPE) + (size_t)((cidx - 2) * 128 + row) * 32 + 8 * cp;
#pragma unroll
              for (int e = 0; e < 8; ++e) { const f32x2 cs = rt[e]; o1[e] = (x1[e] * cs.x - x2[e] * cs.y) * 0.125f; o2[e] = (x2[e] * cs.x + x1[e] * cs.y) * 0.125f; } }
          else {
#pragma unroll
              for (int e = 0; e < 8; ++e) { o1[e] = x1[e] * 0.125f; o2[e] = x2[e] * 0.125f; } }
          const float df = __expf(lg0 * (float)(127 - row)), db = __expf(lg1 * (float)row);
          *(LAS u32x4*)(Kf + row * 72 + 8 * cp) = pack8(o1, df); *(LAS u32x4*)(Kf + row * 72 + 32 + 8 * cp) = pack8(o2, df);
          *(LAS u32x4*)(Kb + row * 72 + 8 * cp) = pack8(o1, db); *(LAS u32x4*)(Kb + row * 72 + 32 + 8 * cp) = pack8(o2, db); }
#pragma unroll
        for (int i = 0; i < 4; ++i) { const int t = tid + 512 * i; *(LAS u32x4*)(Vs + (t >> 4) * 136 + 8 * (t & 15)) = vv[i]; }
        LDS_BARRIER();
        if (u + F.G < 64 * 34) R1_LOAD(u + F.G);
        f32x4 acc[2][4];
#pragma unroll
        for (int eb = 0; eb < 2; ++eb)
#pragma unroll
            for (int db = 0; db < 4; ++db) acc[eb][db] = (f32x4){0.f, 0.f, 0.f, 0.f};
#pragma unroll
        for (int ks = 0; ks < 4; ++ks) { bf16x8 av[4], bk[4];
            tr_frags4<272>(vlane + ks * 32 * 272, av);
            tr_frags4<144>(klane + ks * 32 * 144, bk);
#pragma unroll
            for (int eb = 0; eb < 2; ++eb)
#pragma unroll
                for (int db = 0; db < 4; ++db) acc[eb][db] = MFMA16(bk[db], av[eb], acc[eb][db]); }
        bf16* kv = (bf16*)(F.ws + WS_KV) + ((((size_t)(b * 8 + h) * 34 + cidx) * 2) + dir) * 8192;
#pragma unroll
        for (int eb = 0; eb < 2; ++eb)
#pragma unroll
            for (int db = 0; db < 4; ++db) { u32x2 o; o.x = pk2(acc[eb][db][0], acc[eb][db][1]); o.y = pk2(acc[eb][db][2], acc[eb][db][3]);
                *(u32x2*)(kv + (e0 + 16 * eb + fr) * 64 + 16 * db + 4 * q) = o; }
    }
#undef R1_LOAD
}
__device__ __forceinline__ void ret_scan(Frame& F, int l) {
    unsigned* kvw = (unsigned*)(F.ws + WS_KV);
    for (int i = F.bid * 512 + F.tid; i < 64 * 2 * 4096; i += F.G * 512) { const int pr = i & 4095, dir = (i >> 12) & 1, bh = i >> 13, h = bh & 7;
        const float gC = __expf(ret_logg(F, l, dir, h) * 128.0f);
        unsigned* base = kvw + ((size_t)bh * 34 * 2 + dir) * 4096 + pr;
        unsigned v[34];
#pragma unroll
        for (int k = 0; k < 34; ++k) v[k] = base[(size_t)k * 8192];
        float s0 = 0.f, s1 = 0.f;
        if (dir == 0) {
#pragma unroll
            for (int k = 0; k < 34; ++k) { const unsigned x = v[k]; v[k] = pk2(s0, s1); s0 = gC * s0 + bflo(x); s1 = gC * s1 + bfhi(x); }
        } else {
#pragma unroll
            for (int k = 0; k < 34; ++k) { const int c = k < 2 ? 1 - k : 35 - k; const unsigned x = v[c]; v[c] = pk2(s0, s1); s0 = gC * s0 + bflo(x); s1 = gC * s1 + bfhi(x); }
        }
        if (F.wr) {
#pragma unroll
            for (int k = 0; k < 34; ++k) base[(size_t)k * 8192] = v[k]; }
    }
}
__device__ __forceinline__ void ph_ret_r2(Frame& F, int l, bool lastl) {
    LAS bf16* Qs = (LAS bf16*)F.lds;
    LAS bf16* Ks = Qs + 128 * 72;
    LAS bf16* Vs = Ks + 128 * 72;
    LAS bf16* Ps = Vs + 128 * 136 + F.wave * (16 * 136);
    LAS bf16* Ss = Vs + 128 * 136 + 8 * (16 * 136);
    const int tid = F.tid, lane = F.lane, w = F.wave, q = lane >> 4, fr = lane & 15;
    const bf16* proj = F_PROJ(F);
    const int nch = lastl ? 32 : 34, nunits = 64 * nch;
    const int row = tid >> 2, cp = tid & 3;
    u32x4 qa, qb_, ka, kb, vv[4], sv[4];
#define R2_DECODE(u, bh_, cidx_) const int bh_ = (u) / nch, cidx_ = (u) % nch + (lastl ? 2 : 0)
#define R2_LOAD(u) do { R2_DECODE(u, bh__, ci__); const size_t rb__ = ret_rowbase(bh__ >> 3, ci__); const int h__ = bh__ & 7; \
        const bf16* qs_ = proj + (rb__ + row) * LDP + C_BQ + h__ * 64 + 8 * cp; qa = *(const u32x4*)qs_; qb_ = *(const u32x4*)(qs_ + 32); \
        const bf16* ks_ = proj + (rb__ + row) * LDP + C_BK + h__ * 64 + 8 * cp; ka = *(const u32x4*)ks_; kb = *(const u32x4*)(ks_ + 32); \
        _Pragma("unroll") for (int i = 0; i < 4; ++i) { const int t_ = tid + 512 * i; vv[i] = *(const u32x4*)(proj + (rb__ + (t_ >> 4)) * LDP + C_BV + h__ * 128 + 8 * (t_ & 15)); \
            sv[i] = *(const u32x4*)((const bf16*)(F.ws + WS_KV) + (((size_t)bh__ * 34 + ci__) * 2) * 8192 + (size_t)t_ * 8); } } while (0)
    int u = F.bid;
    if (u < nunits) R2_LOAD(u);
    const unsigned vlane = (unsigned)(size_t)Vs + (unsigned)((8 * q + (fr >> 2)) * 272 + (fr & 3) * 8);
#pragma unroll 1
    for (; u < nunits; u += F.G) {
        R2_DECODE(u, bh, cidx); const int b = bh >> 3, h = bh & 7; const size_t rb = ret_rowbase(b, cidx); const bool lat = cidx >= 2;
        const float lg0 = ret_logg(F, l, 0, h), lg1 = ret_logg(F, l, 1, h);
        LDS_BARRIER();
        { float x1[8], x2[8], o1[8], o2[8];
          unpack8(qa, x1); unpack8(qb_, x2);
          if (lat) { const f32x2* rt = (const f32x2*)(F.ws + WS_ROPE) + (size_t)((cidx - 2) * 128 + row) * 32 + 8 * cp;
#pragma unroll
              for (int e = 0; e < 8; ++e) { const f32x2 cs = rt[e]; o1[e] = x1[e] * cs.x - x2[e] * cs.y; o2[e] = x2[e] * cs.x + x1[e] * cs.y; } }
          else {
#pragma unroll
              for (int e = 0; e < 8; ++e) { o1[e] = x1[e]; o2[e] = x2[e]; } }
          *(LAS u32x4*)(Qs + row * 72 + 8 * cp) = pack8(o1, 1.0f); *(LAS u32x4*)(Qs + row * 72 + 32 + 8 * cp) = pack8(o2, 1.0f);
          unpack8(ka, x1); unpack8(kb, x2);
          if (lat) { const f32x2* rt = (const f32x2*)(F.ws + WS_ROPE) + (size_t)((cidx - 2) * 128 + row) * 32 + 8 * cp;
#pragma unroll
              for (int e = 0; e < 8; ++e) { const f32x2 cs = rt[e]; o1[e] = x1[e] * cs.x - x2[e] * cs.y; o2[e] = x2[e] * cs.x + x1[e] * cs.y; } }
          else {
#pragma unroll
              for (int e = 0; e < 8; ++e) { o1[e] = x1[e]; o2[e] = x2[e]; } }
          *(LAS u32x4*)(Ks + row * 72 + 8 * cp) = pack8(o1, 0.125f); *(LAS u32x4*)(Ks + row * 72 + 32 + 8 * cp) = pack8(o2, 0.125f); }
#pragma unroll
        for (int i = 0; i < 4; ++i) { const int t = tid + 512 * i; *(LAS u32x4*)(Vs + (t >> 4) * 136 + 8 * (t & 15)) = vv[i]; *(LAS u32x4*)(Ss + (t >> 3) * 72 + 8 * (t & 7)) = sv[i]; }
        LDS_BARRIER();
        if (u + F.G < nunits) R2_LOAD(u + F.G);
        const int il = 16 * w + fr;
        const bf16x8 Bq0 = ldfrag(Qs, 16 * w, 0, 72, lane), Bq1 = ldfrag(Qs, 16 * w, 32, 72, lane);
        const float l2g0 = lg0 * 1.4426950408889634f, l2g1 = lg1 * 1.4426950408889634f;
#pragma unroll
        for (int jb = 0; jb < 8; ++jb) { f32x4 acc = (f32x4){0.f, 0.f, 0.f, 0.f};
            acc = MFMA16(ldfrag(Ks, 16 * jb, 0, 72, lane), Bq0, acc); acc = MFMA16(ldfrag(Ks, 16 * jb, 32, 72, lane), Bq1, acc);
            float pv[4];
#pragma unroll
            for (int r = 0; r < 4; ++r) { const int j = 16 * jb + 4 * q + r; const int dd = il - j;
                const float df = dd >= 0 ? __builtin_amdgcn_exp2f(l2g0 * (float)dd) : 0.f, dbk = dd <= 0 ? __builtin_amdgcn_exp2f(l2g1 * (float)(-dd)) : 0.f;
                pv[r] = acc[r] * (df + dbk); }
            u32x2 pw; pw.x = pg8::cvt_pk_bf16(pv[0], pv[1]); pw.y = pg8::cvt_pk_bf16(pv[2], pv[3]); *(LAS u32x2*)(Ps + fr * 136 + 16 * jb + 4 * q) = pw; }
        LDS_WAIT(); asm volatile("" ::: "memory");
        const bf16* gp = proj + (rb + il) * LDP + C_BG + h * 128 + 4 * q;
        u32x2 gwv[4];
#pragma unroll
        for (int eb = 0; eb < 4; ++eb) gwv[eb] = *(const u32x2*)(gp + 16 * eb);
        f32x4 Y[8];
#pragma unroll
        for (int eb = 0; eb < 8; ++eb) Y[eb] = (f32x4){0.f, 0.f, 0.f, 0.f};
#pragma unroll
        for (int ks = 0; ks < 4; ++ks) { const bf16x8 bp = ldfrag(Ps, 0, 32 * ks, 136, lane); bf16x8 av[4];
            tr_frags4<272>(vlane + ks * 32 * 272, av);
#pragma unroll
            for (int eb = 0; eb < 4; ++eb) Y[eb] = MFMA16(av[eb], bp, Y[eb]);
            tr_frags4<272>(vlane + ks * 32 * 272 + 128, av);
#pragma unroll
            for (int eb = 0; eb < 4; ++eb) Y[4 + eb] = MFMA16(av[eb], bp, Y[4 + eb]); }
        const float qf = __builtin_amdgcn_exp2f(l2g0 * (float)(il + 1)), qbw = __builtin_amdgcn_exp2f(l2g1 * (float)(128 - il));
#pragma unroll
        for (int eb = 0; eb < 8; ++eb) { f32x4 zf = (f32x4){0.f, 0.f, 0.f, 0.f}, zb = zf;
            zf = MFMA16(ldfrag(Ss, 16 * eb, 0, 72, lane), Bq0, zf); zf = MFMA16(ldfrag(Ss, 16 * eb, 32, 72, lane), Bq1, zf);
            zb = MFMA16(ldfrag(Ss, 128 + 16 * eb, 0, 72, lane), Bq0, zb); zb = MFMA16(ldfrag(Ss, 128 + 16 * eb, 32, 72, lane), Bq1, zb);
            Y[eb] = Y[eb] + zf * qf + zb * qbw; }
        float s = 0.f;
#pragma unroll
        for (int eb = 0; eb < 8; ++eb) s += (Y[eb][0] + Y[eb][1]) + (Y[eb][2] + Y[eb][3]);
        s += __shfl_xor(s, 16); s += __shfl_xor(s, 32);
        const float mu = s * (1.0f / 128.0f); float vq = 0.f;
#pragma unroll
        for (int eb = 0; eb < 8; ++eb) { const f32x4 d = Y[eb] - mu; vq += (d[0] * d[0] + d[1] * d[1]) + (d[2] * d[2] + d[3] * d[3]); }
        vq += __shfl_xor(vq, 16); vq += __shfl_xor(vq, 32);
        const float rstd = __builtin_amdgcn_rsqf(vq * (1.0f / 128.0f) + EPS);
        bf16* yo = F_YB(F) + (rb + il) * 3072 + 1024 + h * 128 + 4 * q;
        u32x2 gw2[4];
#pragma unroll
        for (int eb = 0; eb < 4; ++eb) gw2[eb] = *(const u32x2*)(gp + 16 * (4 + eb));
#pragma unroll
        for (int eb = 0; eb < 8; ++eb) { const u32x2 gw = eb < 4 ? gwv[eb & 3] : gw2[eb & 3]; const f32x4 yn = (Y[eb] - mu) * rstd;
            u32x2 o; o.x = pg8::cvt_pk_bf16(gm::fsilu_(bflo(gw.x)) * yn[0], gm::fsilu_(bfhi(gw.x)) * yn[1]); o.y = pg8::cvt_pk_bf16(gm::fsilu_(bflo(gw.y)) * yn[2], gm::fsilu_(bfhi(gw.y)) * yn[3]);
            if (F.wr) *(u32x2*)(yo + 16 * eb) = o; }
    }
#undef R2_LOAD
#undef R2_DECODE
}
__device__ __forceinline__ void att_rope_keys(Frame& F) {
    bf16* proj = F_PROJ(F); const f32x2* atab = (const f32x2*)(F.ws + WS_ROPE + 1 * MiB);
    for (int i = F.bid * 512 + F.tid; i < NLAT * 16; i += F.G * 512) { const int pr = i & 3, g = (i >> 2) & 3, row = i >> 4; const int c = (pr & 1) + 4 * (pr >> 1);
        bf16* src = proj + (size_t)row * LDP + C_CK + g * 64 + 8 * c;
        float x1[8], x2[8], o1[8], o2[8]; unpack8(*(const u32x4*)src, x1); unpack8(*(const u32x4*)(src + 16), x2);
        const int pos = row & (SEQ - 1); const int ap = (pr >> 1) ? (pos & 63) : (pos >> 6); att_rope8(atab + ap * 16 + 8 * (pr & 1), x1, x2, o1, o2);
        if (F.wr) { *(u32x4*)src = pack8(o1, 1.0f); *(u32x4*)(src + 16) = pack8(o2, 1.0f); } }
}
__device__ __forceinline__ void att_unit(Frame& F, int l, int b, int g, int qb, bool isctxq) {
    LAS bf16* Kt = (LAS bf16*)F.lds;
    LAS bf16* Vt = Kt + 64 * 72;
    LAS bf16* Pw = Vt + 64 * 72 + F.wave * (64 * 72);
    const int tid = F.tid, lane = F.lane, w = F.wave, q = lane >> 4, fr = lane & 15;
    const bf16* proj = F_PROJ(F); const f32x2* atab = (const f32x2*)(F.ws + WS_ROPE + 1 * MiB);
    const int hq = 4 * g + (w >> 1);
    const size_t qrow0 = (isctxq ? (size_t)NLAT + b * LCX : (size_t)b * SEQ) + qb * 128 + (w & 1) * 64;
    const int qpos0 = qb * 128 + (w & 1) * 64;
    constexpr float QS = 0.125f * 1.4426950408889634f;
    unsigned vmask = 0xFu;
    if (!isctxq) {
#pragma unroll
        for (int t = 4; t < 10; ++t) { const int kp = qb * 128 - 128 + 64 * (t - 4); if (kp >= 0 && kp < SEQ) vmask |= 1u << t; } }
    const int vrow = tid >> 3, vc8 = tid & 7;
    u32x4 kx = (u32x4){0u, 0u, 0u, 0u}, vx = kx;
#define ATT_KROW0(t) ((t) >= 4 ? (size_t)b * SEQ + (qb * 128 - 128 + 64 * ((t) - 4)) : (size_t)NLAT + b * LCX + 64 * (t))
#define ATT_LOAD(t) do { const size_t kr0_ = ATT_KROW0(t); kx = *(const u32x4*)(proj + (kr0_ + vrow) * LDP + C_CK + g * 64 + 8 * vc8); \
        vx = *(const u32x4*)(proj + (kr0_ + vrow) * LDP + C_CV + g * 64 + 8 * vc8); } while (0)
    int t = __builtin_ctz(vmask); vmask &= vmask - 1;
    ATT_LOAD(t);
    LDS_BARRIER();
#pragma unroll
    for (int i = 0; i < 4; ++i) { const int tt = lane + 64 * i, row = tt >> 2, pr = tt & 3;
        const int c = (pr & 1) + 4 * (pr >> 1); const bf16* src = proj + (qrow0 + row) * LDP + C_CQ + hq * 64;
        float x1[8], x2[8], o1[8], o2[8]; unpack8(*(const u32x4*)(src + 8 * c), x1); unpack8(*(const u32x4*)(src + 8 * c + 16), x2);
        if (!isctxq) { const int pos = qpos0 + row; const int ap = (pr >> 1) ? (pos & 63) : (pos >> 6); att_rope8(atab + ap * 16 + 8 * (pr & 1), x1, x2, o1, o2); }
        else {
#pragma unroll
            for (int e = 0; e < 8; ++e) { o1[e] = x1[e]; o2[e] = x2[e]; } }
        *(LAS u32x4*)(Pw + row * 72 + 8 * c) = pack8(o1, QS); *(LAS u32x4*)(Pw + row * 72 + 8 * c + 16) = pack8(o2, QS); }
    LDS_WAIT(); asm volatile("" ::: "memory");
    bf16x8 Bq[4][2];
#pragma unroll
    for (int ib = 0; ib < 4; ++ib)
#pragma unroll
        for (int ks = 0; ks < 2; ++ks) Bq[ib][ks] = ldfrag(Pw, 16 * ib, 32 * ks, 72, lane);
    LDS_WAIT(); asm volatile("" ::: "memory");
    const float sink = FIN(I_SINK)[l * 16 + hq] * 1.4426950408889634f;
    float mrow[4], lrow[4], aprev[4]; f32x4 O[4][4];
#pragma unroll
    for (int ib = 0; ib < 4; ++ib) { mrow[ib] = sink; aprev[ib] = 1.0f; lrow[ib] = (q == 0) ? 1.0f : 0.0f;
#pragma unroll
        for (int db = 0; db < 4; ++db) O[db][ib] = (f32x4){0.f, 0.f, 0.f, 0.f}; }
    const unsigned vt_lane = (unsigned)(size_t)Vt + (unsigned)((8 * q + (fr >> 2)) * 144 + (fr & 3) * 8);
#pragma unroll 1
    for (;;) {
        const int kpos0 = t >= 4 ? (qb * 128 - 128 + 64 * (t - 4)) : 0;
        LDS_BARRIER();
        *(LAS u32x4*)(Kt + vrow * 72 + 8 * vc8) = kx;
        *(LAS u32x4*)(Vt + vrow * 72 + 8 * vc8) = vx;
        LDS_BARRIER();
        const int tcur = t; const bool more = vmask != 0u;
        if (more) { t = __builtin_ctz(vmask); vmask &= vmask - 1; ATT_LOAD(t); }
        const bool skipt = !isctxq && tcur == ((w & 1) ? 4 : 9);
        const bool maskt = !isctxq && (tcur == ((w & 1) ? 5 : 4) || tcur == ((w & 1) ? 9 : 8));
        if (!skipt) {
#pragma unroll
        for (int hf = 0; hf < 2; ++hf) {
            f32x4 S[4][2];
#pragma unroll
            for (int jb = 0; jb < 4; ++jb) { const bf16x8 a0 = ldfrag(Kt, 16 * jb, 0, 72, lane), a1 = ldfrag(Kt, 16 * jb, 32, 72, lane);
#pragma unroll
                for (int i2 = 0; i2 < 2; ++i2) { const float nm = -mrow[2 * hf + i2]; f32x4 acc = (f32x4){nm, nm, nm, nm};
                    acc = MFMA16(a0, Bq[2 * hf + i2][0], acc); acc = MFMA16(a1, Bq[2 * hf + i2][1], acc); S[jb][i2] = acc; } }
            if (maskt) {
#pragma unroll
                for (int jb = 0; jb < 4; ++jb)
#pragma unroll
                    for (int i2 = 0; i2 < 2; ++i2)
#pragma unroll
                        for (int r = 0; r < 4; ++r) { const int dd = (qpos0 + 16 * (2 * hf + i2) + fr) - (kpos0 + 16 * jb + 4 * q + r); if (dd > 128 || dd < -128) S[jb][i2][r] = -1.0e30f; }
            }
#pragma unroll
            for (int i2 = 0; i2 < 2; ++i2) { const int ib = 2 * hf + i2;
                float mx = -1.0e30f;
#pragma unroll
                for (int jb = 0; jb < 4; ++jb) mx = fmaxf(mx, fmaxf(fmaxf(S[jb][i2][0], S[jb][i2][1]), fmaxf(S[jb][i2][2], S[jb][i2][3])));
                mx = fmaxf(mx, __shfl_xor(mx, 16)); mx = fmaxf(mx, __shfl_xor(mx, 32));
                const float alpha = aprev[ib]; const float dm = fmaxf(mx, 0.f); aprev[ib] = __builtin_amdgcn_exp2f(-dm); mrow[ib] += dm;
                float ps = 0.f;
#pragma unroll
                for (int jb = 0; jb < 4; ++jb) { float p[4];
#pragma unroll
                    for (int r = 0; r < 4; ++r) { p[r] = __builtin_amdgcn_exp2f(S[jb][i2][r]); ps += p[r]; }
                    u32x2 pw; pw.x = pk2(p[0], p[1]); pw.y = pk2(p[2], p[3]); *(LAS u32x2*)(Pw + (16 * ib + fr) * 72 + 16 * jb + 4 * q) = pw; }
                lrow[ib] = lrow[ib] * alpha + ps;
#pragma unroll
                for (int db = 0; db < 4; ++db) O[db][ib] = O[db][ib] * alpha;
            }
        }
        LDS_WAIT(); asm volatile("" ::: "memory");
#pragma unroll
        for (int ks = 0; ks < 2; ++ks) { bf16x8 av[4], bp[4];
            tr_frags4<144>(vt_lane + ks * 32 * 144, av); __builtin_amdgcn_sched_barrier(0);
#pragma unroll
            for (int ib = 0; ib < 4; ++ib) bp[ib] = ldfrag(Pw, 16 * ib, 32 * ks, 72, lane);
#pragma unroll
            for (int db = 0; db < 4; ++db)
#pragma unroll
                for (int ib = 0; ib < 4; ++ib) O[db][ib] = MFMA16(av[db], bp[ib], O[db][ib]); }
        LDS_WAIT(); asm volatile("" ::: "memory");
        }
        if (!more) break;
    }
#undef ATT_LOAD
#undef ATT_KROW0
#pragma unroll
    for (int ib = 0; ib < 4; ++ib) { float lt = lrow[ib]; lt += __shfl_xor(lt, 16); lt += __shfl_xor(lt, 32); const float inv = __builtin_amdgcn_rcpf(lt);
        bf16* dst = F_YB(F) + (qrow0 + 16 * ib + fr) * 3072 + 2048 + hq * 64 + 4 * q;
#pragma unroll
        for (int db = 0; db < 4; ++db) { const f32x4 o = O[db][ib] * inv; u32x2 ow; ow.x = pg8::cvt_pk_bf16(o[0], o[1]); ow.y = pg8::cvt_pk_bf16(o[2], o[3]); if (F.wr) *(u32x2*)(dst + 16 * db) = ow; } }
}
#ifndef PROBE_MASK
#define PROBE_MASK 0
#endif
#ifndef PROBE_SUB
#define PROBE_SUB 0
#endif
#ifdef PROBE_REAL
#define WR_DRY wr_true
#else
#define WR_DRY wr_false
#endif
#define NREP(n) (((PROBE_MASK >> (n)) & 1) ? 2 : 1)
#ifndef DIAG_PH
#define PHON(n) true
#else
#define PHON(n) ((n) == DIAG_PH)
#endif
constexpr int N_PHASES = 2 + 10 * DEPTH;
__global__ void __launch_bounds__(512, 2) fwd_kernel(Args args) {
    extern __shared__ __attribute__((aligned(16))) unsigned char lds_raw[];
    Frame F; F.lds = (LAS unsigned char*)lds_raw; F.tid = threadIdx.x; F.lane = F.tid & 63; F.wave = __builtin_amdgcn_readfirstlane(F.tid >> 6);
    F.G = gridDim.x; F.bid = blockIdx.x; F.gw = F.bid * 8 + F.wave; F.NGW = F.G * 8; F.in = (const __attribute__((address_space(4))) cfp_t*)__builtin_amdgcn_kernarg_segment_ptr(); F.out = args.out; F.ws = args.ws;
    volatile LAS unsigned* MISC = (volatile LAS unsigned*)(F.lds + MISC_OFF);
    for (int u = F.tid; u < (LDS_BYTES - LDS_CTL) / 4; u += 512) ((LAS unsigned*)(F.lds + LDS_CTL))[u] = 0u;
    __syncthreads();
    unsigned* ctl = (unsigned*)(F.ws + WS_CTL);
#if MK_N_LAUNCHES == 1
    XcdBarrier bar = xcd_barrier_post(ctl + CW_BAR, MISC + 8, gridDim.x);
    XcdBarrier sbar = xcd_barrier_post(ctl + (blockIdx.x < 32 ? CW_BAR_C : CW_BAR_L), MISC + 12, blockIdx.x < 32 ? 32u : gridDim.x - 32u);
#define SUB_BAR() do { GAS unsigned* _bp = (GAS unsigned*)sbar.bar; asm volatile("" : "+s"(_bp)); XcdBarrier _b2 = sbar; _b2.bar = (unsigned*)_bp; xcd_barrier(_b2); } while (0)
#define GRID_BAR() do { GAS unsigned* _bp = (GAS unsigned*)bar.bar; asm volatile("" : "+s"(_bp)); XcdBarrier _b2 = bar; _b2.bar = (unsigned*)_bp; xcd_barrier(_b2); } while (0)
#else
#define GRID_BAR() do {} while (0)
#define SUB_BAR() do {} while (0)
#endif
    const int wave0 = F.wave; const bool wr_true = args.ph_hi > 0, wr_false = args.ph_hi < 0; F.wr = wr_true;
    const int lo = args.ph_lo, hi = args.ph_hi;
#define FRESH() do { LAS unsigned char* _l = (LAS unsigned char*)lds_raw; asm volatile("" : "+s"(_l)); F.lds = _l; int _ln; asm volatile("v_mbcnt_lo_u32_b32 %0, -1, 0\n\tv_mbcnt_hi_u32_b32 %0, -1, %0" : "=v"(_ln)); F.tid = wave0 * 64 + _ln; F.lane = _ln; F.wave = wave0; F.gw = F.bid * 8 + F.wave; \
        GAS unsigned char* _ws = (GAS unsigned char*)args.ws; asm volatile("" : "+s"(_ws)); F.ws = (unsigned char*)_ws; GAS float* _out = (GAS float*)args.out; asm volatile("" : "+s"(_out)); F.out = (float*)_out; \
        const __attribute__((address_space(4))) cfp_t* _in = (const __attribute__((address_space(4))) cfp_t*)__builtin_amdgcn_kernarg_segment_ptr(); asm volatile("" : "+s"(_in)); F.in = _in; } while (0)
#define IN(k) (lo <= (k) && (k) < hi)
#define SEAM(k) do { if (IN(k) && IN((k) + 1)) GRID_BAR(); } while (0)
    if (PHON(0) && IN(0)) for (int rep_ = NREP(0); rep_ > 0; --rep_) { FRESH(); F.wr = (rep_ == 1) ? wr_true : WR_DRY; if (NREP(0) > 1) GRID_BAR(); ph_prologue(F); } SEAM(0);
    if (PHON(1) && IN(1)) for (int rep_ = NREP(1); rep_ > 0; --rep_) { FRESH(); F.wr = (rep_ == 1) ? wr_true : WR_DRY; if (NREP(1) > 1) GRID_BAR(); ph_convert(F, 0); ph_rows_u(F, 0, true); ph_router_fold(F); } SEAM(1);
#pragma unroll 1
    for (int l = 0; l < DEPTH; ++l) {
        const int pb = 2 + 10 * l; const bool lastl = (l == DEPTH - 1); const int nM2 = lastl ? 128 : 136; const int ntok = lastl ? NLAT : NTOK;
        unsigned char* wt = F.ws + WS_WT;
        if (PHON(2) && IN(pb + 0)) for (int rep_ = NREP(2); rep_ > 0; --rep_) { FRESH(); F.wr = (rep_ == 1) ? wr_true : WR_DRY; if (NREP(2) > 1) GRID_BAR();
            gm::SchedPlain<16, 1024> S; S.init(136, 38, F.G, F.bid); S.A = (const char*)(F.ws + WS_X); S.Bt = (const char*)(wt + WT_IN);
            gm::EpiProj E{F_PROJ(F), F.ws + WS_GT}; pg8::gemm_phase(F.lds, S, E, F.tid);
        } SEAM(pb + 0);
        if (PHON(3) && IN(pb + 1)) for (int rep_ = NREP(3); rep_ > 0; --rep_) { FRESH(); F.wr = (rep_ == 1) ? wr_true : WR_DRY; if (NREP(3) > 1) GRID_BAR();
            if (!(rep_ > 1 && PROBE_SUB == 2)) for (int u = F.bid; u < 256; u += F.G) { const int hu = ((u >> 4) << 3) + (u & 7); lru_unit(F, l, hu >> 4, hu & 15, (u >> 3) & 1); }
            if (!(rep_ > 1 && PROBE_SUB == 1)) { __syncthreads(); ph_ret_r1(F, l); __syncthreads(); }
            att_rope_keys(F);
        } SEAM(pb + 1);
        if (PHON(4) && IN(pb + 2)) for (int rep_ = NREP(4); rep_ > 0; --rep_) { FRESH(); F.wr = (rep_ == 1) ? wr_true : WR_DRY; if (NREP(4) > 1) GRID_BAR();
            if (!(rep_ > 1 && PROBE_SUB == 2)) ret_scan(F, l);
            if (!(rep_ > 1 && PROBE_SUB == 1))
            for (int u = F.bid; u < (lastl ? 1024 : 1088); u += F.G) { const bool cq = u >= 1024; const int v = u - 1024;
                int ab = cq ? (v >> 3) : (u >> 7), ag = cq ? ((v >> 1) & 3) : ((u >> 5) & 3), aq = cq ? (v & 1) : (u & 31);
                if (F.G == 256) { const int x = F.bid & 7, y = F.bid >> 3;
                    ab = x; ag = cq ? (y >> 1) : (u >> 8); aq = cq ? (y & 1) : y; }
                att_unit(F, l, ab, ag, aq, cq); }
        } SEAM(pb + 2);
        if (PHON(5) && IN(pb + 3)) for (int rep_ = NREP(5); rep_ > 0; --rep_) { FRESH(); F.wr = (rep_ == 1) ? wr_true : WR_DRY; if (NREP(5) > 1) GRID_BAR();
            ph_ret_r2(F, l, lastl);
        } SEAM(pb + 3);
#ifdef PROBE_MERGE_K
        if (IN(pb + 4)) { FRESH(); GRID_BAR();
            gm::SchedPlain<PROBE_MERGE_K, 3072> S; S.init(nM2, 4, F.G, F.bid); S.A = (const char*)(F.ws + WS_YB); S.Bt = (const char*)(wt + WT_BR);
            gm::EpiPlain E{(bf16*)(F.ws + WS_KV)}; pg8::gemm_phase(F.lds, S, E, F.tid); GRID_BAR(); }
#endif
        const bool split = !lastl && gridDim.x == 256 && MK_N_LAUNCHES == 1;
        if (PHON(6) && IN(pb + 4)) for (int rep_ = NREP(6); rep_ > 0; --rep_) { FRESH(); F.wr = (rep_ == 1) ? wr_true : WR_DRY; if (NREP(6) > 1) GRID_BAR();
            gm::SchedPlain<48, 3072> S; S.init(split ? 128 : nM2, 4, F.G, F.bid); S.A = (const char*)(F.ws + WS_YB); S.Bt = (const char*)(wt + WT_BR);
            gm::EpiMerge E{F.ws + WS_GT, F_X(F)}; pg8::gemm_phase(F.lds, S, E, F.tid);
        } SEAM(pb + 4);
        if (IN(pb + 5)) { FRESH(); F.wr = wr_true;
            const bool cgrp = split && F.bid < 32;
            if (cgrp) {
                gm::SchedPlain<48, 3072, gm::OrderSub> S; S.init(8, 4, 32, F.bid, 128, true); S.A = (const char*)(F.ws + WS_YB); S.Bt = (const char*)(wt + WT_BR);
                gm::EpiMerge E{F.ws + WS_GT, F_X(F)}; pg8::gemm_phase(F.lds, S, E, F.tid);
                SUB_BAR(); FRESH();
            }
            {
                gm::SchedPlain<16, 1024, gm::OrderSub> S; S.init(split ? (cgrp ? 8 : 128) : nM2, 4, split ? (cgrp ? 32 : 224) : F.G, split && !cgrp ? F.bid - 32 : F.bid, cgrp ? 128 : 0, true);
                S.A = (const char*)(F.ws + WS_X); S.Bt = (const char*)(wt + WT_WO);
                gm::EpiWo E{F.out, F_HC(F), F_MOD(F) + (size_t)l * 9 * 6144, F.wr, l == 0 ? (const float*)FIN(I_X) : (const float*)F.out, l == 0 ? (const float*)FIN(I_CTX) : (const float*)F_HC(F)}; pg8::gemm_phase(F.lds, S, E, F.tid);
            }
        }
        if (split) { if (IN(pb + 5) && IN(pb + 6)) SUB_BAR(); } else SEAM(pb + 5);
        if (PHON(8) && IN(pb + 6)) for (int rep_ = NREP(8); rep_ > 0; --rep_) { FRESH(); F.wr = (rep_ == 1) ? wr_true : WR_DRY; if (NREP(8) > 1) GRID_BAR();
            const bool cgrp = split && F.bid < 32;
            const int row0 = cgrp ? NLAT : 0, row1 = split && !cgrp ? NLAT : ntok, gc = split && !cgrp ? F.bid - 32 : F.bid, gn = split ? (cgrp ? 32 : 224) : F.G;
            if (!(rep_ > 1 && PROBE_SUB == 2)) ph_rows_v(F, l, row0, row1, gc * 8 + F.wave, gn * 8);
            if (!(rep_ > 1 && PROBE_SUB == 1)) ph_router(F, l, row0 / 128, row1 / 128, gc, gn);
        } SEAM(pb + 6);
        if (PHON(9) && IN(pb + 7)) for (int rep_ = NREP(9); rep_ > 0; --rep_) { FRESH(); F.wr = (rep_ == 1) ? wr_true : WR_DRY; if (NREP(9) > 1) GRID_BAR();
            volatile LAS int* tileoff; volatile LAS int* cntl; moe_tables(F, l, tileoff, cntl);
            gm::SchedMoe<16, true> S; S.tileoff = tileoff; S.cnt = cntl; S.G = F.G; S.c = F.bid; S.nunits = tileoff[32] * 4; S.wsbase = (const char*)F.ws; S.rowtok = (const int*)(F.ws + WS_ROWTOK);
            S.A = nullptr; S.Bt = (const char*)(wt + WT_GU);
            gm::EpiGU E{(bf16*)(F.ws + WS_HROWS)}; pg8::gemm_phase(F.lds, S, E, F.tid);
        } SEAM(pb + 7);
        if (PHON(10) && IN(pb + 8)) for (int rep_ = NREP(10); rep_ > 0; --rep_) { FRESH(); F.wr = (rep_ == 1) ? wr_true : WR_DRY; if (NREP(10) > 1) GRID_BAR();
            volatile LAS int* tileoff; volatile LAS int* cntl; moe_tables(F, l, tileoff, cntl);
            gm::SchedMoe<8, false> S; S.tileoff = tileoff; S.cnt = cntl; S.G = F.G; S.c = F.bid; S.nunits = tileoff[32] * 4; S.wsbase = (const char*)F.ws; S.rowtok = nullptr;
            S.A = (const char*)(F.ws + WS_HROWS); S.Bt = (const char*)(wt + WT_DN);
            gm::EpiDN E{(bf16*)(F.ws + WS_YROWS)}; pg8::gemm_phase(F.lds, S, E, F.tid);
        } SEAM(pb + 8);
        if (PHON(11) && IN(pb + 9)) for (int rep_ = NREP(11); rep_ > 0; --rep_) { FRESH(); F.wr = (rep_ == 1) ? wr_true : WR_DRY; if (NREP(11) > 1) GRID_BAR();
            if (!(rep_ > 1 && PROBE_SUB == 2)) ph_combine(F, l, ntok);
            if (!lastl && !(rep_ > 1 && PROBE_SUB == 1)) ph_convert(F, l + 1);
        } if (!lastl) SEAM(pb + 9);
    }
#undef IN
#undef SEAM
}

extern "C" void kernel_launch(void* const* d_in, const int* in_sizes, int n_in, void* d_out, int out_size, void* d_ws, size_t ws_size, hipStream_t stream) {
    static int grid = 0;
    if (grid == 0) {
        if (n_in != 30 || out_size != NLAT * D || ws_size < WS_END) { fprintf(stderr, "kernel_launch: unexpected shapes (n_in %d out %d ws %zu, need %zu)\n", n_in, out_size, ws_size, (size_t)WS_END); grid = -1; return; }
        int dev = 0, cus = 0;
        if (hipGetDevice(&dev) != hipSuccess || hipDeviceGetAttribute(&cus, hipDeviceAttributeMultiprocessorCount, dev) != hipSuccess) { grid = -1; return; }
        if (hipFuncSetAttribute((const void*)fwd_kernel, hipFuncAttributeMaxDynamicSharedMemorySize, LDS_BYTES) != hipSuccess) { fprintf(stderr, "kernel_launch: hipFuncSetAttribute failed\n"); grid = -1; return; }
        int per_cu = 0;
        if (hipOccupancyMaxActiveBlocksPerMultiprocessor(&per_cu, (const void*)fwd_kernel, 512, LDS_BYTES) != hipSuccess || per_cu < 1) { fprintf(stderr, "kernel_launch: occupancy query says %d\n", per_cu); }
        (void)hipGetLastError();
        grid = cus;
    }
    if (grid < 0) return;
    (void)hipMemsetAsync((char*)d_ws + WS_CTL, 0, CTL_BYTES, stream);
#ifdef DIAG_ZERO_GT
    (void)hipMemsetAsync((char*)d_ws + WS_GT, 0x3f, (size_t)204 * MiB, stream);
#endif
    Args a{};
    for (int i = 0; i < 30; ++i) a.in[i] = (const float*)d_in[i];
    a.out = (float*)d_out; a.ws = (unsigned char*)d_ws;
#if MK_N_LAUNCHES == 1
    a.ph_lo = 0; a.ph_hi = N_PHASES;
    hipLaunchKernelGGL(fwd_kernel, dim3(grid), dim3(512), LDS_BYTES, stream, a);
#else
    for (int p = 0; p < N_PHASES; ++p) { a.ph_lo = p; a.ph_hi = p + 1; hipLaunchKernelGGL(fwd_kernel, dim3(grid), dim3(512), LDS_BYTES, stream, a); }
#endif
}
```

```cpp
#include <hip/hip_runtime.h>
#include <cstdio>
#include <cstdint>

#define LAS __attribute__((address_space(3)))
#define GAS __attribute__((address_space(1)))
typedef unsigned short bf16;
typedef short bf16x8 __attribute__((ext_vector_type(8)));
typedef float f32x4 __attribute__((ext_vector_type(4)));
typedef float f32x2 __attribute__((ext_vector_type(2)));
typedef unsigned u32x4 __attribute__((ext_vector_type(4)));
typedef unsigned u32x2 __attribute__((ext_vector_type(2)));

#ifndef MK_N_LAUNCHES
#define MK_N_LAUNCHES 1
#endif

constexpr int D = 1024, NB = 8, SEQ = 4096, LCX = 256, DEPTH = 4;
constexpr int NLAT = NB * SEQ, NCTX = NB * LCX, NTOK = NLAT + NCTX;
constexpr int DIN = 9728;
constexpr int LDP = 6720;
constexpr int C_AX = 0, C_AY = 1024, C_BQ = 2048, C_BK = 2560, C_BV = 3072, C_BG = 4096, C_CQ = 5120, C_CK = 6144, C_CV = 6400, C_GA = 6656;
constexpr int NMOD = 6, NMB = 9;
constexpr int NEXP = 32, DEXP = 512, RCOLS = 36;
constexpr int PMAX = 77824;
constexpr float EPS = 1e-6f;

constexpr size_t MiB = 1u << 20;
constexpr size_t WS_CTL = 0, CTL_BYTES = 1 * MiB;
constexpr size_t WS_MOD = 1 * MiB;
constexpr size_t WS_ROPE = 2 * MiB;
constexpr size_t WS_RW = 4 * MiB;
constexpr size_t WS_HC = 12 * MiB;
constexpr size_t WS_TOKINFO = 20 * MiB;
constexpr size_t WS_ROWTOK = 22 * MiB;
constexpr size_t WS_WT = 28 * MiB;
constexpr size_t WT_IN = 0, WT_BR = 19 * MiB, WT_WO = 25 * MiB, WT_GU = 27 * MiB, WT_DN = 91 * MiB, WT_BYTES = 123 * MiB;
constexpr size_t WS_X = 152 * MiB;
constexpr size_t WS_KV = 220 * MiB;
constexpr size_t WS_PROJ = 288 * MiB;
constexpr size_t WS_HROWS = WS_PROJ;
constexpr size_t WS_YROWS = WS_PROJ + 80 * MiB;
constexpr size_t WS_GT = 736 * MiB;
constexpr size_t WS_YB = 940 * MiB;
constexpr size_t WS_END = 1144 * MiB;
static_assert(WS_PROJ + (size_t)NTOK * LDP * 2 <= WS_GT && WS_GT + (size_t)3 * NTOK * 1024 * 2 <= WS_YB, "ws map");
constexpr int CW_BAR = 1024;
constexpr int CW_BAR_L = 20480, CW_BAR_C = 24576;
constexpr int CW_CNT = 8192;
constexpr size_t CTL_ZROW = 64 * 1024;

constexpr int LDS_BYTES = 163840;
constexpr int LDS_CTL = 155648;
constexpr int MISC_OFF = LDS_CTL + 320;

__device__ __forceinline__ unsigned f2bf(float f) { unsigned u = __builtin_bit_cast(unsigned, f); return (u + 0x7fffu + ((u >> 16) & 1u)) >> 16; }
typedef __bf16 bf16x2_t __attribute__((ext_vector_type(2)));
__device__ __forceinline__ unsigned pk2(float lo, float hi) { const f32x2 v = {lo, hi}; return __builtin_bit_cast(unsigned, __builtin_convertvector(v, bf16x2_t)); }
__device__ __forceinline__ float bf2f(unsigned b) { return __builtin_bit_cast(float, b << 16); }
__device__ __forceinline__ float bflo(unsigned w) { return __builtin_bit_cast(float, w << 16); }
__device__ __forceinline__ float bfhi(unsigned w) { return __builtin_bit_cast(float, w & 0xffff0000u); }
__device__ __forceinline__ float wave_sum(float v) {
#pragma unroll
    for (int o = 1; o < 64; o <<= 1) v += __shfl_xor(v, o);
    return v;
}
__device__ __forceinline__ float sigmoidf_(float x) { return 1.0f / (1.0f + __expf(-x)); }
__device__ __forceinline__ float siluf_(float x) { return x / (1.0f + __expf(-x)); }
__device__ __forceinline__ float gelu_tanh(float x) {
    const float u = 0.7978845608028654f * (x + 0.044715f * x * x * x);
    return x / (1.0f + __expf(-2.0f * u));
}
__device__ __forceinline__ float log1p_fast(float x) { const float u = 1.0f + x; const float d = u - 1.0f; return d == 0.f ? x : __logf(u) * (x / d); }
__device__ __forceinline__ float expm1_fast(float x) { const float u = __expf(x); const float um1 = u - 1.0f; if (um1 == 0.f) return x; const float lu = __logf(u); return um1 == -1.0f ? -1.0f : um1 * (x / lu); }
#define LDS_BARRIER() do { asm volatile("s_waitcnt lgkmcnt(0)" ::: "memory"); __builtin_amdgcn_s_barrier(); asm volatile("" ::: "memory"); } while (0)
#define LDS_WAIT() asm volatile("s_waitcnt lgkmcnt(0)" ::: "memory")
#define VM_WAIT() asm volatile("s_waitcnt vmcnt(0)" ::: "memory")

#define XB_TMO      128
#define XB_XCNT(j)  (256  + 64 * (j))
#define XB_XSUB(j)  (1280 + 64 * (j))
#define XB_XGEN(j)  (2304 + 64 * (j))
#define XB_TOP      3328
#define XB_TOPGEN   3392
#define XCD_BAR_WORDS 3456
#define XB_SPIN_CAP (1u << 22)
__device__ __forceinline__ unsigned xb_ld(unsigned* p)              { return __hip_atomic_load(p, __ATOMIC_RELAXED, __HIP_MEMORY_SCOPE_AGENT); }
__device__ __forceinline__ unsigned xb_add(unsigned* p, unsigned v) { return __hip_atomic_fetch_add(p, v, __ATOMIC_RELAXED, __HIP_MEMORY_SCOPE_AGENT); }
__device__ __forceinline__ unsigned xb_xcc_id() { return (unsigned)__builtin_amdgcn_s_getreg((3 << 11) | 20) & 0xFu; }
#define XB_SPIN(cond, bar) do { unsigned _sp = 0; while (cond) { __builtin_amdgcn_s_sleep(1); \
    if ((++_sp & 255u) == 0u) { if (xb_ld(&(bar)[XB_TMO])) break; if (_sp > XB_SPIN_CAP) { atomicAdd(&(bar)[XB_TMO], 1u); break; } } } } while (0)
struct XcdBarrier { unsigned* bar; unsigned x; volatile LAS unsigned* st; unsigned G; };
__device__ __forceinline__ XcdBarrier xcd_barrier_post(unsigned* bar, volatile LAS unsigned* st, unsigned G) {
    XcdBarrier b; b.bar = bar; b.x = xb_xcc_id(); b.st = st; b.G = G;
    if (threadIdx.x == 0) (void)xb_add(&bar[XB_XCNT(b.x)], 1u);
    return b;
}
__device__ __forceinline__ void xcd_barrier_complete(unsigned* bar, unsigned x, unsigned G, unsigned& nloc, unsigned& nx) {
    unsigned sum, cnt, mine, sp = 0u;
    for (;;) {
        sum = 0u; cnt = 0u; mine = 0u;
#pragma unroll
        for (unsigned j = 0; j < 16; ++j) { const unsigned c = xb_ld(&bar[XB_XCNT(j)]); sum += c; cnt += (c > 0u) ? 1u : 0u; mine = (j == x) ? c : mine; }
        if (sum == G) break;
        __builtin_amdgcn_s_sleep(1);
        if ((++sp & 255u) == 0u) { if (xb_ld(&bar[XB_TMO])) break; if (sp > XB_SPIN_CAP) { atomicAdd(&bar[XB_TMO], 1u); break; } }
    }
    nloc = mine > 0u ? mine : 1u; nx = cnt > 0u ? cnt : 1u;
}
__device__ __forceinline__ void xcd_barrier(const XcdBarrier& b) {
    asm volatile("s_waitcnt vmcnt(0)" ::: "memory");
    __syncthreads();
    if (threadIdx.x == 0) {
        unsigned* bar = b.bar;
        __builtin_amdgcn_s_waitcnt(0);
        unsigned nloc = b.st[0], nx = b.st[1];
        if (nloc == 0u) { xcd_barrier_complete(bar, b.x, b.G, nloc, nx); b.st[0] = nloc; b.st[1] = nx; }
        const unsigned old = xb_add(&bar[XB_XSUB(b.x)], 1u);
        const unsigned gen = old / nloc;
        if (old + 1u == (gen + 1u) * nloc) {
            __builtin_amdgcn_fence(__ATOMIC_RELEASE, "agent");
            asm volatile("s_waitcnt vmcnt(0)" ::: "memory");
            const unsigned og = xb_add(&bar[XB_TOP], 1u);
            const unsigned tg = og / nx;
            if (og + 1u == (tg + 1u) * nx) xb_add(&bar[XB_TOPGEN], 1u);
            else XB_SPIN(xb_ld(&bar[XB_TOPGEN]) == tg, bar);
            __builtin_amdgcn_fence(__ATOMIC_ACQUIRE, "agent");
            xb_add(&bar[XB_XGEN(b.x)], 1u);
            asm volatile("s_waitcnt vmcnt(0)" ::: "memory");
        } else {
            XB_SPIN(xb_ld(&bar[XB_XGEN(b.x)]) == gen, bar);
            __builtin_amdgcn_fence(__ATOMIC_ACQUIRE, "agent");
            asm volatile("s_waitcnt vmcnt(0)" ::: "memory");
        }
    }
    __syncthreads();
}

namespace pg8 {
constexpr int BM = 256, BK = 64, HALF = 128, HTB = HALF * BK * 2, STAGE_BYTES = 8 * HTB;
__device__ __forceinline__ int lds_byte(int r, int c) { const int st = (r >> 4) * 2 + (c >> 5), rr = r & 15, cc = c & 31, ob = rr * 64 + cc * 2; return st * 1024 + (ob ^ (((ob >> 9) & 1) << 5)); }
__device__ __forceinline__ void stage_rc(int b, int& R, int& C) { const int st = b / 1024, sb = b % 1024, swz = sb ^ (((sb >> 9) & 1) << 5); R = (st >> 1) * 16 + swz / 64; C = (st & 1) * 32 + (swz % 64) / 2; }
__device__ __forceinline__ int perm32(int rho) { const int n = rho >> 4, i = rho & 15; return 8 * (i >> 2) + 4 * n + (i & 3); }
__device__ __forceinline__ unsigned cvt_pk_bf16(float lo, float hi) { return pk2(lo, hi); }

template <class Epi, class Sched>
__device__ __forceinline__ void gemm_phase(LAS unsigned char* lds, const Sched& S, const Epi& E, const int tid) {
    typedef typename Sched::Unit Unit;
    const int wid = __builtin_amdgcn_readfirstlane(tid >> 6), lane = tid & 63, wr = wid >> 2, wc = wid & 3, fr = lane & 15, fq = lane >> 4;
    constexpr int nt = Sched::KT; constexpr int K = nt * BK;
    int R[2], C[2]; unsigned voffB[2];
#pragma unroll
    for (int i = 0; i < 2; ++i) { stage_rc(tid * 16 + i * 8192, R[i], C[i]); const int Rb = Epi::PERM ? ((R[i] & ~31) + perm32(R[i] & 31)) : R[i]; voffB[i] = (unsigned)(Rb * K + C[i]) * 2u; }
    constexpr size_t kstep = (size_t)(BK * 2);
    constexpr size_t hstepB = (size_t)HALF * K * 2;
    const unsigned ldsw = (unsigned)wid * 1024u;
    const int aoff = lds_byte(wr * 64 + fr, fq * 8), boff = lds_byte(wc * 32 + fr, fq * 8);
#define PG8_SA(b, h) (((b) * 2 + (h)) * HTB)
#define PG8_SB(b, h) ((4 + (b) * 2 + (h)) * HTB)
#define PG8_STAGEA(bufoff, gbase, vv, h) do { _Pragma("unroll") for (int _i = 0; _i < 2; ++_i) \
        __builtin_amdgcn_global_load_lds((const unsigned*)((const char*)(gbase) + (vv)[h][_i]), (LAS unsigned*)(lds + (bufoff) + ldsw + _i * 8192), 16, 0, 0); } while (0)
#define PG8_STAGEB(bufoff, gbase) do { _Pragma("unroll") for (int _i = 0; _i < 2; ++_i) \
        __builtin_amdgcn_global_load_lds((const unsigned*)((const char*)(gbase) + voffB[_i]), (LAS unsigned*)(lds + (bufoff) + ldsw + _i * 8192), 16, 0, 0); } while (0)
#define PG8_LDA(dst, b, h) do { _Pragma("unroll") for (int m = 0; m < 4; ++m) _Pragma("unroll") for (int k = 0; k < 2; ++k) dst[m][k] = *(const LAS bf16x8*)(lds + PG8_SA(b, h) + aoff + m * 2048 + k * 1024); } while (0)
#define PG8_LDB(dst, b, h) do { _Pragma("unroll") for (int n = 0; n < 2; ++n) _Pragma("unroll") for (int k = 0; k < 2; ++k) dst[n][k] = *(const LAS bf16x8*)(lds + PG8_SB(b, h) + boff + n * 2048 + k * 1024); } while (0)
#define PG8_MMA(ai, bj, At, Bt) do { __builtin_amdgcn_s_setprio(1); _Pragma("unroll") for (int m = 0; m < 4; ++m) _Pragma("unroll") for (int n = 0; n < 2; ++n) _Pragma("unroll") for (int k = 0; k < 2; ++k) \
        acc[ai][bj][m][n] = __builtin_amdgcn_mfma_f32_16x16x32_bf16(Bt[n][k], At[m][k], acc[ai][bj][m][n], 0, 0, 0); __builtin_amdgcn_s_setprio(0); } while (0)
#define PG8_WAIT_V(n) asm volatile("s_waitcnt vmcnt(" #n ")" ::: "memory")
#define PG8_WAIT_L(n) asm volatile("s_waitcnt lgkmcnt(" #n ")" ::: "memory")
#define PG8_BAR __builtin_amdgcn_s_barrier()
#define PG8_SCHED __builtin_amdgcn_sched_barrier(0)
    Unit cur, nxt; int ui = 0;
    if (!S.next(0, cur)) return;
    f32x4 acc[2][2][4][2];
#pragma unroll
    for (int a = 0; a < 2; ++a)
#pragma unroll
        for (int b = 0; b < 2; ++b)
#pragma unroll
            for (int m = 0; m < 4; ++m)
#pragma unroll
                for (int n = 0; n < 2; ++n) acc[a][b][m][n] = (f32x4){0.f, 0.f, 0.f, 0.f};
    bf16x8 At[4][2], B0[2][2], B1[2][2];
    unsigned vA[2][2], vAn[2][2];
    S.a_voff(cur, tid, vA);
#pragma unroll
    for (int h = 0; h < 2; ++h)
#pragma unroll
        for (int i = 0; i < 2; ++i) vAn[h][i] = vA[h][i];
    const char* cA = S.a_base(cur); const char* cB = S.b_base(cur);
    { const char* a0 = cA + S.a_koff(0); const char* a1p = cA + S.a_koff(1);
      PG8_STAGEB(PG8_SB(0, 0), cB); PG8_STAGEB(PG8_SB(0, 1), cB + hstepB); PG8_STAGEA(PG8_SA(0, 0), a0, vA, 0); PG8_STAGEA(PG8_SA(0, 1), a0, vA, 1);
      if (wr == 1) PG8_BAR;
      PG8_WAIT_V(2); PG8_BAR;
      PG8_STAGEB(PG8_SB(1, 0), cB + kstep); PG8_STAGEA(PG8_SA(1, 0), a1p, vA, 0); PG8_STAGEB(PG8_SB(1, 1), cB + hstepB + kstep);
      PG8_WAIT_V(6); PG8_BAR; }
    for (;;) {
        const bool has_next = S.next(ui + 1, nxt);
        const char* nA = cA; const char* nB = cB;
        if (has_next) { nA = S.a_base(nxt); nB = S.b_base(nxt); }
#pragma unroll 1
        for (int t = 0; t < nt; t += 2) {
            const bool last = (t == nt - 2);
            if constexpr (Epi::MIDK) { if (t == 16 || t == 32) E.mid(acc, cur, t, wr, wc, fr, fq); }
            if constexpr (Sched::GATHER) { if (t == nt - 4 && has_next) S.a_voff(nxt, tid, vAn); }
            const char* a1 = cA + S.a_koff(t + 1);
            const char* a2 = last ? nA + S.a_koff(0) : cA + S.a_koff(t + 2);
            const char* a3 = last ? nA + S.a_koff(1) : cA + S.a_koff(t + 3);
            const char* b2 = last ? nB : cB + (size_t)(t + 2) * kstep; const char* b3 = b2 + kstep;
            PG8_LDB(B0, 0, 0); PG8_LDB(B1, 0, 1); PG8_SCHED; PG8_LDA(At, 0, 0); PG8_STAGEA(PG8_SA(1, 1), a1, vA, 1);
            PG8_WAIT_V(8); PG8_WAIT_L(0); PG8_BAR; PG8_MMA(0, 0, At, B0); PG8_MMA(0, 1, At, B1); PG8_BAR; PG8_SCHED;
            PG8_LDA(At, 0, 1); PG8_STAGEB(PG8_SB(0, 0), b2); PG8_STAGEB(PG8_SB(0, 1), b2 + hstepB);
            if (last) { PG8_STAGEA(PG8_SA(0, 0), a2, vAn, 0); } else { PG8_STAGEA(PG8_SA(0, 0), a2, vA, 0); }
            PG8_WAIT_V(8); PG8_WAIT_L(0); PG8_BAR; PG8_MMA(1, 0, At, B0); PG8_MMA(1, 1, At, B1); PG8_BAR; PG8_SCHED;
            PG8_LDB(B0, 1, 0); PG8_LDB(B1, 1, 1); PG8_SCHED; PG8_LDA(At, 1, 0);
            if (last) { PG8_STAGEA(PG8_SA(0, 1), a2, vAn, 1); } else { PG8_STAGEA(PG8_SA(0, 1), a2, vA, 1); }
            PG8_WAIT_V(8); PG8_WAIT_L(0); PG8_BAR; PG8_MMA(0, 0, At, B0); PG8_MMA(0, 1, At, B1); PG8_BAR; PG8_SCHED;
            PG8_LDA(At, 1, 1); PG8_STAGEB(PG8_SB(1, 0), b3); PG8_STAGEB(PG8_SB(1, 1), b3 + hstepB);
            if (last) { PG8_STAGEA(PG8_SA(1, 0), a3, vAn, 0); } else { PG8_STAGEA(PG8_SA(1, 0), a3, vA, 0); }
            PG8_WAIT_V(8); PG8_WAIT_L(0); PG8_BAR; PG8_MMA(1, 0, At, B0); PG8_MMA(1, 1, At, B1); PG8_BAR; PG8_SCHED;
        }
        if (wr == 0) PG8_BAR;
        E(acc, cur, wr, wc, fr, fq);
        if (!has_next) break;
#pragma unroll
        for (int a = 0; a < 2; ++a)
#pragma unroll
            for (int b = 0; b < 2; ++b)
#pragma unroll
                for (int m = 0; m < 4; ++m)
#pragma unroll
                    for (int n = 0; n < 2; ++n) acc[a][b][m][n] = (f32x4){0.f, 0.f, 0.f, 0.f};
        cur = nxt; cA = nA; cB = nB; ++ui;
        if constexpr (Sched::GATHER) {
#pragma unroll
            for (int h = 0; h < 2; ++h)
#pragma unroll
                for (int i = 0; i < 2; ++i) vA[h][i] = vAn[h][i];
        }
        if (wr == 1) PG8_BAR;
    }
    PG8_WAIT_V(0);
    PG8_BAR;
#undef PG8_SA
#undef PG8_SB
#undef PG8_STAGEA
#undef PG8_STAGEB
#undef PG8_LDA
#undef PG8_LDB
#undef PG8_MMA
#undef PG8_WAIT_V
#undef PG8_WAIT_L
#undef PG8_BAR
#undef PG8_SCHED
}
}
namespace gm {
using pg8::cvt_pk_bf16;
__device__ __forceinline__ float fexp_(float x) { return __builtin_amdgcn_exp2f(1.4426950408889634f * x); }
__device__ __forceinline__ float fsig_(float x) { return __builtin_amdgcn_rcpf(1.0f + fexp_(-x)); }
__device__ __forceinline__ float fsilu_(float x) { return x * fsig_(x); }
struct Unit { int pm, pn; };
struct OrderBase {
    int nM, nN, nwg, G, c;
    __device__ __forceinline__ void init(int nM_, int nN_, int G_, int c_) { nM = nM_; nN = nN_; nwg = nM * nN; G = G_; c = c_; }
    __device__ __forceinline__ bool next(int i, Unit& u) const {
        const int L = i * G + c; if (L >= nwg) return false;
        int wgid = L; { const int q = nwg / 8, r = nwg % 8, xcd = wgid % 8, off = wgid / 8; wgid = (xcd < r ? xcd * (q + 1) : r * (q + 1) + (xcd - r) * q) + off; }
        const int nig = 8 * nN, gid = wgid / nig, fm = gid * 8, gsz = (nM - fm) < 8 ? (nM - fm) : 8;
        u.pm = fm + ((wgid % nig) % gsz); u.pn = (wgid % nig) / gsz; return true;
    }
};
struct OrderColAffine {
    int nM, nN, nwg, G, c;
    __device__ __forceinline__ void init(int nM_, int nN_, int G_, int c_) { nM = nM_; nN = nN_; nwg = nM * nN; G = G_; c = c_; }
    __device__ __forceinline__ bool next(int i, Unit& u) const {
        if (G != 256 || nN != 4) { const int L = i * G + c; if (L >= nwg) return false; u.pm = L / nN; u.pn = L % nN; return true; }
        const int x = c & 7, k = c >> 3, j = i * 32 + k; if (2 * j + (x >> 2) >= nM) return false;
        u.pm = 2 * j + (x >> 2); u.pn = x & 3; return true;
    }
};
struct OrderSub : OrderBase {
    int pm0; bool on;
    __device__ __forceinline__ void init(int nM_, int nN_, int Gs, int cs, int pm0_, bool on_) { OrderBase::init(nM_, nN_, Gs, cs); pm0 = pm0_; on = on_; }
    __device__ __forceinline__ bool next(int i, Unit& u) const { if (!on || !OrderBase::next(i, u)) return false; u.pm += pm0; return true; }
};
template <int KT_, int LDA, class Order = OrderBase> struct SchedPlain : Order {
    typedef gm::Unit Unit; static constexpr int KT = KT_; static constexpr bool GATHER = false;
    const char* A; const char* Bt;
    __device__ __forceinline__ const char* a_base(const Unit& u) const { return A + (size_t)u.pm * 256 * LDA * 2; }
    __device__ __forceinline__ void a_voff(const Unit&, int tid, unsigned (&v)[2][2]) const {
#pragma unroll
        for (int i = 0; i < 2; ++i) { int R, C; pg8::stage_rc(tid * 16 + i * 8192, R, C);
#pragma unroll
            for (int h = 0; h < 2; ++h) v[h][i] = (unsigned)((h * 128 + R) * LDA + C) * 2u; }
    }
    __device__ __forceinline__ size_t a_koff(int kt) const { return (size_t)kt * 128; }
    __device__ __forceinline__ const char* b_base(const Unit& u) const { return Bt + (size_t)u.pn * 256 * (KT * 64) * 2; }
};
struct SchedMerge : OrderBase {
    typedef gm::Unit Unit; static constexpr int KT = 48; static constexpr bool GATHER = false;
    const char* A; const char* Bt;
    __device__ __forceinline__ const char* a_base(const Unit& u) const { return A + (size_t)u.pm * 256 * LDP * 2; }
    __device__ __forceinline__ void a_voff(const Unit&, int tid, unsigned (&v)[2][2]) const {
#pragma unroll
        for (int i = 0; i < 2; ++i) { int R, C; pg8::stage_rc(tid * 16 + i * 8192, R, C);
#pragma unroll
            for (int h = 0; h < 2; ++h) v[h][i] = (unsigned)((h * 128 + R) * LDP + C) * 2u; }
    }
    __device__ __forceinline__ size_t a_koff(int kt) const { return (size_t)(kt < 16 ? (C_AY + 64 * kt) : (C_BG - 1024 + 64 * kt)) * 2; }
    __device__ __forceinline__ const char* b_base(const Unit& u) const { return Bt + (size_t)u.pn * 256 * 3072 * 2; }
};
struct MUnit { int e, tile, pn, slot0; };
template <int KT_, bool GATHER_> struct SchedMoe {
    typedef gm::MUnit Unit; static constexpr int KT = KT_; static constexpr bool GATHER = GATHER_;
    const volatile LAS int* tileoff; const volatile LAS int* cnt;
    int G, c, nunits;
    const char* wsbase; const int* rowtok; const char* A; const char* Bt;
    __device__ __forceinline__ bool next(int i, Unit& u) const {
        const int L = i * G + c; if (L >= nunits) return false;
        const int rt = L >> 2; u.pn = L & 3;
        int e = 0;
#pragma unroll 1
        for (int k = 1; k < 32; ++k) e = (rt >= tileoff[k]) ? k : e;
        u.e = e; u.tile = rt - tileoff[e]; u.slot0 = rt * 256; return true;
    }
    __device__ __forceinline__ const char* a_base(const Unit& u) const { if constexpr (GATHER) return wsbase; else return A + (size_t)u.slot0 * DEXP * 2; }
    __device__ __forceinline__ void a_voff(const Unit& u, int tid, unsigned (&v)[2][2]) const {
        if constexpr (GATHER) {
            asm volatile("" : "+v"(tid));
            const int n = cnt[u.e]; const int* rt = rowtok + (size_t)u.e * NTOK + u.tile * 256;
#pragma unroll
            for (int i = 0; i < 2; ++i) { int R, C; pg8::stage_rc(tid * 16 + i * 8192, R, C);
#pragma unroll
                for (int h = 0; h < 2; ++h) { const int r = h * 128 + R; const bool ok = (u.tile * 256 + r) < n; const int tok = ok ? rt[r] : 0;
                    v[h][i] = ok ? (unsigned)(WS_X + (size_t)tok * 2048 + C * 2) : (unsigned)(CTL_ZROW + C * 2); } }
        } else {
#pragma unroll
            for (int i = 0; i < 2; ++i) { int R, C; pg8::stage_rc(tid * 16 + i * 8192, R, C);
#pragma unroll
                for (int h = 0; h < 2; ++h) v[h][i] = (unsigned)((h * 128 + R) * DEXP + C) * 2u; }
        }
    }
    __device__ __forceinline__ size_t a_koff(int kt) const { return (size_t)kt * 128; }
    __device__ __forceinline__ const char* b_base(const Unit& u) const { return Bt + ((size_t)u.e * 1024 + u.pn * 256) * (KT * 64) * 2; }
};

struct EpiProj {
    static constexpr bool PERM = true, MIDK = false; bf16* O; unsigned char* GT;
    static __device__ __forceinline__ unsigned gq8_(float z) { return (unsigned)fmaxf(fsig_(z) * 255.0f + 0.5f, 1.0f); }
    __device__ __forceinline__ void operator()(const f32x4 (&acc)[2][2][4][2], const Unit& u, int wr, int wc, int fr, int fq) const {
        if (u.pn >= 26) {
            const int br = (u.pn - 26) >> 2, pq = (u.pn - 26) & 3; const int wave = wr * 4 + wc, lane = fq * 16 + fr;
            unsigned char* t = GT + (((size_t)(br * 136 + u.pm) * 4 + pq) << 16) + (size_t)(wave * 64 + lane) * 16;
#pragma unroll
            for (int ai = 0; ai < 2; ++ai)
#pragma unroll
                for (int m = 0; m < 4; ++m) { u32x4 w;
#pragma unroll
                    for (int bj = 0; bj < 2; ++bj) { const f32x4 v0 = acc[ai][bj][m][0], v1 = acc[ai][bj][m][1];
                        w[2 * bj] = gq8_(v0[0]) | (gq8_(v0[1]) << 8) | (gq8_(v0[2]) << 16) | (gq8_(v0[3]) << 24);
                        w[2 * bj + 1] = gq8_(v1[0]) | (gq8_(v1[1]) << 8) | (gq8_(v1[2]) << 16) | (gq8_(v1[3]) << 24); }
                    *(u32x4*)(t + (ai * 4 + m) * 8192) = w; }
            return;
        }
        bf16* base = O + (size_t)(u.pm * 256 + wr * 64 + fr) * LDP + u.pn * 256 + wc * 32 + 8 * fq;
#pragma unroll
        for (int ai = 0; ai < 2; ++ai)
#pragma unroll
            for (int m = 0; m < 4; ++m) { bf16* rowp = base + (size_t)(ai * 128 + m * 16) * LDP;
#pragma unroll
                for (int bj = 0; bj < 2; ++bj) { const f32x4 v0 = acc[ai][bj][m][0], v1 = acc[ai][bj][m][1];
                    u32x4 w; w.x = cvt_pk_bf16(v0[0], v0[1]); w.y = cvt_pk_bf16(v0[2], v0[3]); w.z = cvt_pk_bf16(v1[0], v1[1]); w.w = cvt_pk_bf16(v1[2], v1[3]);
                    *(u32x4*)(rowp + bj * 128) = w; } }
    }
};
struct EpiPlain {
    static constexpr bool PERM = true, MIDK = false; bf16* O;
    __device__ __forceinline__ void operator()(const f32x4 (&acc)[2][2][4][2], const Unit& u, int wr, int wc, int fr, int fq) const {
        bf16* base = O + (size_t)(u.pm * 256 + wr * 64 + fr) * 1024 + u.pn * 256 + wc * 32 + 8 * fq;
#pragma unroll
        for (int ai = 0; ai < 2; ++ai)
#pragma unroll
            for (int m = 0; m < 4; ++m) { bf16* rowp = base + (size_t)(ai * 128 + m * 16) * 1024;
#pragma unroll
                for (int bj = 0; bj < 2; ++bj) { const f32x4 v0 = acc[ai][bj][m][0], v1 = acc[ai][bj][m][1];
                    u32x4 w; w.x = cvt_pk_bf16(v0[0], v0[1]); w.y = cvt_pk_bf16(v0[2], v0[3]); w.z = cvt_pk_bf16(v1[0], v1[1]); w.w = cvt_pk_bf16(v1[2], v1[3]);
                    *(u32x4*)(rowp + bj * 128) = w; } }
    }
};
struct EpiMerge {
    static constexpr bool PERM = true, MIDK = true; const unsigned char* GT; bf16* O;
    __device__ __forceinline__ const unsigned char* tile(const Unit& u, int br, int wr, int wc, int fr, int fq) const {
        return GT + (((size_t)(br * 136 + u.pm) * 4 + u.pn) << 16) + (size_t)((wr * 4 + wc) * 64 + fq * 16 + fr) * 16; }
    static __device__ __forceinline__ float b8_(unsigned w, int k) { return (float)((w >> (8 * k)) & 0xffu); }
    __device__ __forceinline__ void mid(f32x4 (&acc)[2][2][4][2], const Unit& u, int t, int wr, int wc, int fr, int fq) const {
        const int br = (t == 16) ? 0 : 1; const unsigned char* ta = tile(u, br, wr, wc, fr, fq); const unsigned char* tb = tile(u, br + 1, wr, wc, fr, fq);
        u32x4 ga[8], gb[8];
#pragma unroll
        for (int j = 0; j < 8; ++j) { ga[j] = *(const u32x4*)(ta + 8192 * j); gb[j] = *(const u32x4*)(tb + 8192 * j); }
#pragma unroll
        for (int ai = 0; ai < 2; ++ai)
#pragma unroll
            for (int m = 0; m < 4; ++m)
#pragma unroll
                for (int bj = 0; bj < 2; ++bj)
#pragma unroll
                    for (int hw = 0; hw < 2; ++hw) { const unsigned wa = ga[ai * 4 + m][2 * bj + hw], wb = gb[ai * 4 + m][2 * bj + hw];
#pragma unroll
                        for (int k = 0; k < 4; ++k) acc[ai][bj][m][hw][k] *= b8_(wa, k) * __builtin_amdgcn_rcpf(b8_(wb, k)); }
    }
    __device__ __forceinline__ void operator()(const f32x4 (&acc)[2][2][4][2], const Unit& u, int wr, int wc, int fr, int fq) const {
        const unsigned char* tc = tile(u, 2, wr, wc, fr, fq);
        u32x4 gc[8];
#pragma unroll
        for (int j = 0; j < 8; ++j) gc[j] = *(const u32x4*)(tc + 8192 * j);
        const size_t row0 = (size_t)(u.pm * 256 + wr * 64 + fr); const int col0 = u.pn * 256 + wc * 32 + 8 * fq;
        constexpr float S = 1.0f / 255.0f;
#pragma unroll
        for (int ai = 0; ai < 2; ++ai)
#pragma unroll
            for (int m = 0; m < 4; ++m) { const size_t row = row0 + ai * 128 + m * 16;
#pragma unroll
                for (int bj = 0; bj < 2; ++bj) { const unsigned g0 = gc[ai * 4 + m][2 * bj], g1 = gc[ai * 4 + m][2 * bj + 1];
                    const f32x4 v0 = acc[ai][bj][m][0] * S, v1 = acc[ai][bj][m][1] * S; u32x4 w;
                    w.x = cvt_pk_bf16(v0[0] * b8_(g0, 0), v0[1] * b8_(g0, 1)); w.y = cvt_pk_bf16(v0[2] * b8_(g0, 2), v0[3] * b8_(g0, 3));
                    w.z = cvt_pk_bf16(v1[0] * b8_(g1, 0), v1[1] * b8_(g1, 1)); w.w = cvt_pk_bf16(v1[2] * b8_(g1, 2), v1[3] * b8_(g1, 3));
                    *(u32x4*)(O + row * 1024 + col0 + bj * 128) = w; } }
    }
};
struct EpiWo {
    static constexpr bool PERM = false, MIDK = false; float* h; float* hc; const float* mod; bool wen; const float* hsrc; const float* hcsrc;
    __device__ __forceinline__ void operator()(const f32x4 (&acc)[2][2][4][2], const Unit& u, int wr, int wc, int fr, int fq) const {
        const bool lat = u.pm < 128; const int mb = lat ? (u.pm >> 4) : 8;
        float* hb = lat ? h + (size_t)u.pm * 256 * 1024 : hc + (size_t)(u.pm - 128) * 256 * 1024;
        const float* sb = lat ? hsrc + (size_t)u.pm * 256 * 1024 : hcsrc + (size_t)(u.pm - 128) * 256 * 1024;
        const int col0 = u.pn * 256 + wc * 32 + 4 * fq; const float* mp = mod + (size_t)mb * 6144 + 2 * 1024 + col0;
        f32x4 mv[2][2];
#pragma unroll
        for (int bj = 0; bj < 2; ++bj)
#pragma unroll
            for (int n = 0; n < 2; ++n) mv[bj][n] = *(const f32x4*)(mp + bj * 128 + n * 16);
#pragma unroll
        for (int ai = 0; ai < 2; ++ai)
#pragma unroll
            for (int m = 0; m < 4; ++m) { const size_t ro = (size_t)(ai * 128 + wr * 64 + m * 16 + fr) * 1024 + col0; float* rowp = hb + ro; const float* srcp = sb + ro;
#pragma unroll
                for (int bj = 0; bj < 2; ++bj)
#pragma unroll
                    for (int n = 0; n < 2; ++n) { f32x4 hv = *(const f32x4*)(srcp + bj * 128 + n * 16); hv = hv + mv[bj][n] * acc[ai][bj][m][n]; if (wen) *(f32x4*)(rowp + bj * 128 + n * 16) = hv; } }
    }
};
struct EpiGU {
    static constexpr bool PERM = true, MIDK = false; bf16* H;
    __device__ __forceinline__ void operator()(const f32x4 (&acc)[2][2][4][2], const MUnit& u, int wr, int wc, int fr, int fq) const {
        bf16* base = H + (size_t)(u.slot0 + wr * 64 + fr) * DEXP + u.pn * 128 + wc * 32 + 8 * fq;
#pragma unroll
        for (int ai = 0; ai < 2; ++ai)
#pragma unroll
            for (int m = 0; m < 4; ++m) { const f32x4 g0 = acc[ai][0][m][0], g1 = acc[ai][0][m][1], u0 = acc[ai][1][m][0], u1 = acc[ai][1][m][1]; u32x4 w;
                w.x = cvt_pk_bf16(fsilu_(g0[0]) * u0[0], fsilu_(g0[1]) * u0[1]); w.y = cvt_pk_bf16(fsilu_(g0[2]) * u0[2], fsilu_(g0[3]) * u0[3]);
                w.z = cvt_pk_bf16(fsilu_(g1[0]) * u1[0], fsilu_(g1[1]) * u1[1]); w.w = cvt_pk_bf16(fsilu_(g1[2]) * u1[2], fsilu_(g1[3]) * u1[3]);
                *(u32x4*)(base + (size_t)(ai * 128 + m * 16) * DEXP) = w; }
    }
};
struct EpiDN {
    static constexpr bool PERM = true, MIDK = false; bf16* Y;
    __device__ __forceinline__ void operator()(const f32x4 (&acc)[2][2][4][2], const MUnit& u, int wr, int wc, int fr, int fq) const {
        bf16* base = Y + (size_t)(u.slot0 + wr * 64 + fr) * 1024 + u.pn * 256 + wc * 32 + 8 * fq;
#pragma unroll
        for (int ai = 0; ai < 2; ++ai)
#pragma unroll
            for (int m = 0; m < 4; ++m) { bf16* rowp = base + (size_t)(ai * 128 + m * 16) * 1024;
#pragma unroll
                for (int bj = 0; bj < 2; ++bj) { const f32x4 v0 = acc[ai][bj][m][0], v1 = acc[ai][bj][m][1];
                    u32x4 w; w.x = cvt_pk_bf16(v0[0], v0[1]); w.y = cvt_pk_bf16(v0[2], v0[3]); w.z = cvt_pk_bf16(v1[0], v1[1]); w.w = cvt_pk_bf16(v1[2], v1[3]);
                    *(u32x4*)(rowp + bj * 128) = w; } }
    }
};
}
struct Args { const float* in[30]; float* out; unsigned char* ws; int ph_lo, ph_hi; };
enum { I_X = 0, I_C, I_CTX, I_CCTX, I_WMOD, I_BMOD, I_N1G, I_N2G, I_WIN, I_CONVW, I_CONVB, I_WA, I_BA, I_WX, I_BX, I_LAM, I_RLAM, I_SINK,
       I_WBA, I_WBB, I_WBC, I_WOUT, I_RGW, I_RGB, I_REW, I_REB, I_EWG, I_EWU, I_EWD, I_FNG };
typedef const GAS float* cfp_t;
struct Frame {
    LAS unsigned char* lds; int tid, lane, wave, G, bid, gw, NGW; bool wr;
    const __attribute__((address_space(4))) cfp_t* in; float* out; unsigned char* ws;
};
#define FIN(i)     ((const float*)F.in[i])
#define F_MOD(F)   ((float*)((F).ws + WS_MOD))
#define F_HC(F)    ((float*)((F).ws + WS_HC))
#define F_X(F)     ((bf16*)((F).ws + WS_X))
#define F_PROJ(F)  ((bf16*)((F).ws + WS_PROJ))
#define F_YB(F)    ((bf16*)((F).ws + WS_YB))
#define F_CNT(F)   ((int*)((F).ws + WS_CTL) + CW_CNT)

__device__ __forceinline__ void ph_prologue(Frame& F) {
    LAS float* sc = (LAS float*)F.lds;
    LAS float* part = (LAS float*)(F.lds + 40960);
    for (int i = F.tid; i < 9 * 1024; i += 512) { const int mb = i >> 10, k = i & 1023; const float cv = mb < 8 ? FIN(I_C)[mb * 1024 + k] : FIN(I_CCTX)[k]; sc[i] = siluf_(cv); }
    __syncthreads();
    for (int item = F.bid; item < 4 * 96; item += F.G) {
        const int l = item / 96, n0 = (item % 96) * 64;
        const float* wp = FIN(I_WMOD) + ((size_t)l * 1024 + F.wave * 128) * 6144 + n0 + F.lane;
        float acc[9];
#pragma unroll
        for (int mb = 0; mb < 9; ++mb) acc[mb] = 0.f;
#pragma unroll 32
        for (int k = 0; k < 128; ++k) { const float wv = wp[(size_t)k * 6144];
#pragma unroll
            for (int mb = 0; mb < 9; ++mb) acc[mb] += sc[mb * 1024 + F.wave * 128 + k] * wv; }
#pragma unroll
        for (int mb = 0; mb < 9; ++mb) part[(F.wave * 9 + mb) * 64 + F.lane] = acc[mb];
        __syncthreads();
        for (int t = F.tid; t < 576; t += 512) { const int mb = t >> 6, ln = t & 63; float s = FIN(I_BMOD)[l * 6144 + n0 + ln];
#pragma unroll
            for (int w = 0; w < 8; ++w) s += part[(w * 9 + mb) * 64 + ln];
            F_MOD(F)[((size_t)l * 9 + mb) * 6144 + n0 + ln] = s; }
        __syncthreads();
    }
    f32x2* rt = (f32x2*)(F.ws + WS_ROPE);
    for (int i = F.bid * 512 + F.tid; i < 4096 * 32; i += F.G * 512) { const int pos = i >> 5, f = i & 31;
        const float inv = (float)pow(10000.0, -(double)(2 * f) / 64.0); const float ang = (float)pos * inv;
        rt[i] = (f32x2){(float)cos((double)ang), (float)sin((double)ang)}; }
    f32x2* at = (f32x2*)(F.ws + WS_ROPE + 1 * MiB);
    for (int i = F.bid * 512 + F.tid; i < 64 * 16; i += F.G * 512) { const int pos = i >> 4, f = i & 15;
        const float inv = (float)pow(10000.0, -(double)(2 * f) / 32.0); const float ang = (float)pos * inv;
        at[i] = (f32x2){(float)cos((double)ang), (float)sin((double)ang)}; }
}

__device__ __forceinline__ void tr_item(const float* W, int ldw, int k0, int n0, bf16* dst  , int ldk, LAS float* scr, int lane) {
    float wv[32];
#pragma unroll
    for (int i = 0; i < 32; ++i) { const int kk = 2 * i + (lane >> 5); wv[i] = W[(size_t)(k0 + kk) * ldw + n0 + (lane & 31)]; }
#pragma unroll
    for (int i = 0; i < 32; ++i) { const int kk = 2 * i + (lane >> 5); scr[kk * 33 + (lane & 31)] = wv[i]; }
    LDS_WAIT(); asm volatile("" ::: "memory");
    const int c = lane & 7;
#pragma unroll
    for (int j = 0; j < 4; ++j) { const int n = (lane >> 3) + 8 * j; const LAS float* s = scr + (8 * c) * 33 + n;
        u32x4 o; o.x = pk2(s[0 * 33], s[1 * 33]); o.y = pk2(s[2 * 33], s[3 * 33]); o.z = pk2(s[4 * 33], s[5 * 33]); o.w = pk2(s[6 * 33], s[7 * 33]);
        *(u32x4*)(dst + (size_t)n * ldk + 8 * c) = o; }
    LDS_WAIT(); asm volatile("" ::: "memory");
}
__device__ __forceinline__ void ph_convert(Frame& F, int l) {
    LAS float* scr = (LAS float*)(F.lds + F.wave * 16384);
    bf16* wt = (bf16*)(F.ws + WS_WT);
    constexpr int I_IN = 16 * 304, I_BRN = 16 * 32, I_GU1 = 16 * 16, I_DN1 = 8 * 32;
    constexpr int NITEMS = I_IN + 4 * I_BRN + 32 * 2 * I_GU1 + 32 * I_DN1;
    for (int it = F.gw; it < NITEMS; it += F.NGW) {
        int r = it;
        if (r < I_IN) { const int kb = r / 304, nb = r % 304; tr_item(FIN(I_WIN) + (size_t)l * 1024 * DIN, DIN, 64 * kb, 32 * nb, wt + WT_IN / 2 + (size_t)(32 * nb) * 1024 + 64 * kb, 1024, scr, F.lane); continue; }
        r -= I_IN;
        if (r < 3 * I_BRN) { const int br = r / I_BRN, q = r % I_BRN, kb = q / 32, nb = q % 32; const float* W = FIN(I_WBA + br) + (size_t)l * 1024 * 1024;
            tr_item(W, 1024, 64 * kb, 32 * nb, wt + WT_BR / 2 + (size_t)(32 * nb) * 3072 + br * 1024 + 64 * kb, 3072, scr, F.lane); continue; }
        r -= 3 * I_BRN;
        if (r < I_BRN) { const int kb = r / 32, nb = r % 32; tr_item(FIN(I_WOUT) + (size_t)l * 1024 * 1024, 1024, 64 * kb, 32 * nb, wt + WT_WO / 2 + (size_t)(32 * nb) * 1024 + 64 * kb, 1024, scr, F.lane); continue; }
        r -= I_BRN;
        if (r < 32 * 2 * I_GU1) { const int e = r / (2 * I_GU1), q = r % (2 * I_GU1), up = q / I_GU1, q2 = q % I_GU1, kb = q2 / 16, nb = q2 % 16;
            const float* W = FIN(up ? I_EWU : I_EWG) + ((size_t)l * 32 + e) * 1024 * 512; const int n0 = 32 * nb;
            const int drow = e * 1024 + (n0 >> 7) * 256 + up * 128 + (n0 & 127);
            tr_item(W, 512, 64 * kb, n0, wt + WT_GU / 2 + (size_t)drow * 1024 + 64 * kb, 1024, scr, F.lane); continue; }
        r -= 32 * 2 * I_GU1;
        { const int e = r / I_DN1, q = r % I_DN1, kb = q / 32, nb = q % 32; const float* W = FIN(I_EWD) + ((size_t)l * 32 + e) * 512 * 1024;
            tr_item(W, 1024, 64 * kb, 32 * nb, wt + WT_DN / 2 + (size_t)(e * 1024 + 32 * nb) * 512 + 64 * kb, 512, scr, F.lane); }
    }
}
constexpr size_t RW_ELEMS = (size_t)4 * 9 * 48 * 1024;
__device__ __forceinline__ void ph_router_fold(Frame& F) {
    float* Wp = (float*)(F.ws + WS_RW); float* rc = Wp + RW_ELEMS;
    for (int i = F.bid * 512 + F.tid; i < (int)RW_ELEMS; i += F.G * 512) {
        const int k = i & 1023, j = (i >> 10) % 48, mb = (i / (48 * 1024)) % 9, l = i / (48 * 1024 * 9);
        float v = 0.f;
        if (j < RCOLS) { const float w = j < 4 ? FIN(I_RGW)[((size_t)l * 1024 + k) * 4 + j] : FIN(I_REW)[((size_t)l * 1024 + k) * 32 + (j - 4)];
            v = FIN(I_N2G)[l * 1024 + k] * (1.0f + F_MOD(F)[((size_t)l * 9 + mb) * 6144 + 4 * 1024 + k]) * w; }
        Wp[i] = v;
    }
    for (int it = F.gw; it < 4 * 9 * RCOLS; it += F.NGW) { const int j = it % RCOLS, mb = (it / RCOLS) % 9, l = it / (RCOLS * 9);
        float s = 0.f;
        for (int k = F.lane; k < 1024; k += 64) { const float w = j < 4 ? FIN(I_RGW)[((size_t)l * 1024 + k) * 4 + j] : FIN(I_REW)[((size_t)l * 1024 + k) * 32 + (j - 4)];
            s += F_MOD(F)[((size_t)l * 9 + mb) * 6144 + 3 * 1024 + k] * w; }
        s = wave_sum(s);
        if (F.lane == 0) rc[(l * 9 + mb) * 64 + j] = s + (j < 4 ? FIN(I_RGB)[l * 4 + j] : FIN(I_REB)[l * 32 + (j - 4)]);
    }
}

struct RowJob { const float* src; float* copy_to; int mb; };
template <class RowFn> __device__ __forceinline__ void rows_norm_loop(Frame& F, int row0, int nrows, int w, int NW, const float* gain, const float* mod, int shift_i, int scale_i, bf16* dst, RowFn rowfn) {
    const int lane = F.lane;
    f32x4 nv[4]; RowJob nj = {nullptr, nullptr, 0};
    int r = row0 + w;
    if (r < nrows) { nj = rowfn(r);
#pragma unroll
        for (int j = 0; j < 4; ++j) nv[j] = *(const f32x4*)(nj.src + 4 * lane + 256 * j); }
    for (; r < nrows; r += NW) {
        f32x4 v[4]; const RowJob cj = nj;
#pragma unroll
        for (int j = 0; j < 4; ++j) v[j] = nv[j];
        const int rn = r + NW;
        if (rn < nrows) { nj = rowfn(rn);
#pragma unroll
            for (int j = 0; j < 4; ++j) nv[j] = *(const f32x4*)(nj.src + 4 * lane + 256 * j); }
        f32x4 g[4], sh[4], sc[4];
#pragma unroll
        for (int j = 0; j < 4; ++j) { g[j] = *(const f32x4*)(gain + 4 * lane + 256 * j); sh[j] = *(const f32x4*)(mod + cj.mb * 6144 + shift_i * 1024 + 4 * lane + 256 * j); sc[j] = *(const f32x4*)(mod + cj.mb * 6144 + scale_i * 1024 + 4 * lane + 256 * j); }
        float ss = 0.f;
#pragma unroll
        for (int j = 0; j < 4; ++j) ss += (v[j].x * v[j].x + v[j].y * v[j].y) + (v[j].z * v[j].z + v[j].w * v[j].w);
        if (cj.copy_to) {
#pragma unroll
            for (int j = 0; j < 4; ++j) *(f32x4*)(cj.copy_to + 4 * lane + 256 * j) = v[j]; }
        const float rstd = 1.0f / sqrtf(wave_sum(ss) * (1.0f / 1024.0f) + EPS);
#pragma unroll
        for (int j = 0; j < 4; ++j) { const f32x4 y = (v[j] * rstd) * g[j] * (sc[j] + 1.0f) + sh[j];
            u32x2 w; w.x = pk2(y.x, y.y); w.y = pk2(y.z, y.w); *(u32x2*)(dst + (size_t)r * 1024 + 4 * lane + 256 * j) = w; }
    }
}
__device__ __forceinline__ void ph_rows_u(Frame& F, int l, bool first) {
    const float* mod = F_MOD(F) + (size_t)l * 9 * 6144; const float* g = FIN(I_N1G) + l * 1024;
    float* out = F.out; float* hc = F_HC(F); const float* xin = FIN(I_X); const float* cin = FIN(I_CTX);
    rows_norm_loop(F, 0, NTOK, F.gw, F.NGW, g, mod, 0, 1, F_X(F), [=](int r) { const bool lat = r < NLAT; RowJob j; j.mb = lat ? (r >> 12) : 8;
        float* hrow = lat ? out + (size_t)r * 1024 : hc + (size_t)(r - NLAT) * 1024;
        j.src = first ? (lat ? xin + (size_t)r * 1024 : cin + (size_t)(r - NLAT) * 1024) : hrow; j.copy_to = nullptr; return j; });
}
__device__ __forceinline__ void ph_rows_v(Frame& F, int l, int row0, int ntok, int w, int NW) {
    const float* mod = F_MOD(F) + (size_t)l * 9 * 6144; const float* g = FIN(I_N2G) + l * 1024;
    float* out = F.out; float* hc = F_HC(F);
    rows_norm_loop(F, row0, ntok, w, NW, g, mod, 3, 4, F_X(F), [=](int r) { const bool lat = r < NLAT; RowJob j; j.mb = lat ? (r >> 12) : 8;
        j.src = lat ? out + (size_t)r * 1024 : hc + (size_t)(r - NLAT) * 1024; j.copy_to = nullptr; return j; });
}

__device__ __forceinline__ void ph_router(Frame& F, int l, int bt0, int bt1, int c, int G) {
    LAS float* Bs = (LAS float*)F.lds;
    LAS float* lgs = (LAS float*)(F.lds + 53248 + F.wave * 4096);
    const float* WpL = (const float*)(F.ws + WS_RW) + (size_t)l * 9 * 48 * 1024; const float* rcL = (const float*)(F.ws + WS_RW) + RW_ELEMS + l * 9 * 64;
    int* cnt = F_CNT(F) + l * 32; int* rowtok = (int*)(F.ws + WS_ROWTOK); unsigned* tinfo = (unsigned*)(F.ws + WS_TOKINFO);
    const int lane = F.lane, i16 = lane & 15, kq = lane >> 4, tid = F.tid;
    const int ntask = bt1 - bt0, nfull = (ntask / G) * G, rem = ntask - nfull;
    const int rtok0 = (bt0 + nfull) * 128, rtok1 = bt1 * 128 - 1;
    const bool minis = rem > 0 && ((rtok0 < NLAT ? (rtok0 >> 12) : 8) == (rtok1 < NLAT ? (rtok1 >> 12) : 8));
    const int npass = nfull / G + (rem > 0 ? (minis ? 1 : (c < rem ? 1 : 0)) : 0);
    for (int ps_ = 0; ps_ < npass; ++ps_) {
        const bool mini = minis && ps_ == nfull / G;
        const int mt = c + G * F.wave;
        const bool active = !mini || mt < rem * 8;
        const int tok0 = mini ? (active ? rtok0 + mt * 16 : rtok0) : (bt0 + c + ps_ * G) * 128 + F.wave * 16; const bool lat = tok0 < NLAT; const int mb = lat ? (tok0 >> 12) : 8;
        const float* hrow = (lat ? F.out + (size_t)(tok0 + i16) * 1024 : F_HC(F) + (size_t)(tok0 + i16 - NLAT) * 1024) + 4 * kq;
        const float* wsrc = WpL + (size_t)mb * 48 * 1024;
        f32x4 acc[3]; float ss = 0.f;
#pragma unroll
        for (int c = 0; c < 3; ++c) acc[c] = (f32x4){0.f, 0.f, 0.f, 0.f};
        f32x4 bnext[6];
#pragma unroll
        for (int j = 0; j < 6; ++j) { const int i = tid + 512 * j; bnext[j] = *(const f32x4*)(wsrc + (size_t)(i >> 6) * 1024 + 4 * (i & 63)); }
        f32x4 an[16];
        if (active) {
#pragma unroll
            for (int S = 0; S < 16; ++S) an[S] = *(const f32x4*)(hrow + 16 * S); }
#pragma unroll 1
        for (int kc = 0; kc < 4; ++kc) {
            LDS_BARRIER();
#pragma unroll
            for (int j = 0; j < 6; ++j) { const int i = tid + 512 * j; *(LAS f32x4*)(Bs + (i >> 6) * 260 + 4 * (i & 63)) = bnext[j]; }
            LDS_BARRIER();
            if (kc < 3) {
#pragma unroll
                for (int j = 0; j < 6; ++j) { const int i = tid + 512 * j; bnext[j] = *(const f32x4*)(wsrc + (size_t)(i >> 6) * 1024 + (kc + 1) * 256 + 4 * (i & 63)); } }
            const LAS float* bp = Bs + i16 * 260 + 4 * kq;
            f32x4 ac[16];
#pragma unroll
            for (int S = 0; S < 16; ++S) ac[S] = an[S];
            if (active && kc < 3) {
#pragma unroll
                for (int S = 0; S < 16; ++S) an[S] = *(const f32x4*)(hrow + (kc + 1) * 256 + 16 * S); }
            if (active)
#pragma unroll
            for (int S = 0; S < 16; ++S) {
                const f32x4 a = ac[S];
                const f32x4 b0 = *(const LAS f32x4*)(bp + 16 * S), b1 = *(const LAS f32x4*)(bp + 16 * 260 + 16 * S), b2 = *(const LAS f32x4*)(bp + 32 * 260 + 16 * S);
                ss += (a.x * a.x + a.y * a.y) + (a.z * a.z + a.w * a.w);
#pragma unroll
                for (int s = 0; s < 4; ++s) { acc[0] = __builtin_amdgcn_mfma_f32_16x16x4f32(a[s], b0[s], acc[0], 0, 0, 0); acc[1] = __builtin_amdgcn_mfma_f32_16x16x4f32(a[s], b1[s], acc[1], 0, 0, 0);
                    acc[2] = __builtin_amdgcn_mfma_f32_16x16x4f32(a[s], b2[s], acc[2], 0, 0, 0); }
            }
        }
        if (active) {
        ss += __shfl_xor(ss, 16); ss += __shfl_xor(ss, 32);
#pragma unroll
        for (int c = 0; c < 3; ++c)
#pragma unroll
            for (int r = 0; r < 4; ++r) lgs[(4 * kq + r) * 52 + 16 * c + i16] = acc[c][r];
        LDS_WAIT(); asm volatile("" ::: "memory");
        const float rstd = 1.0f / sqrtf(ss * (1.0f / 1024.0f) + EPS);
        float lg[RCOLS];
#pragma unroll
        for (int j4 = 0; j4 < RCOLS / 4; ++j4) { const f32x4 v = *(const LAS f32x4*)(lgs + i16 * 52 + 4 * j4); const f32x4 rcv = *(const f32x4*)(rcL + mb * 64 + 4 * j4);
            lg[4 * j4] = v.x * rstd + rcv.x; lg[4 * j4 + 1] = v.y * rstd + rcv.y; lg[4 * j4 + 2] = v.z * rstd + rcv.z; lg[4 * j4 + 3] = v.w * rstd + rcv.w; }
        LDS_WAIT(); asm volatile("" ::: "memory");
        const int tok = tok0 + i16;
        int g = 0; float gm = lg[0];
#pragma unroll
        for (int j = 1; j < 4; ++j) if (lg[j] > gm) { gm = lg[j]; g = j; }
        float gs = 0.f;
#pragma unroll
        for (int j = 0; j < 4; ++j) gs += __expf(lg[j] - gm);
        const float g_w = 1.0f / gs;
        float el[8];
#pragma unroll
        for (int i = 0; i < 8; ++i) { el[i] = lg[4 + i];
#pragma unroll
            for (int gg = 1; gg < 4; ++gg) el[i] = (g == gg) ? lg[4 + gg * 8 + i] : el[i]; }
        int i1 = 0; float m1 = el[0];
#pragma unroll
        for (int i = 1; i < 8; ++i) if (el[i] > m1) { m1 = el[i]; i1 = i; }
        int i2 = -1; float m2 = -3.0e38f;
#pragma unroll
        for (int i = 0; i < 8; ++i) if (i != i1 && el[i] > m2) { m2 = el[i]; i2 = i; }
        const float p2 = __expf(m2 - m1); const float w1 = g_w / (1.0f + p2), w2 = g_w * p2 / (1.0f + p2);
        const int e1 = g * 8 + i1, e2 = g * 8 + i2;
        int r1 = 0, r2 = 0;
        { unsigned long long todo = 0xFFFFull;
          while (todo) { const int ld = __builtin_ctzll(todo); const int x = __shfl(e1, ld); const unsigned long long m = __ballot(e1 == x) & todo;
              int base = 0; if (lane == ld && F.wr) base = atomicAdd(&cnt[x], (int)__builtin_popcountll(m)); base = __shfl(base, ld);
              if (e1 == x) r1 = base + (int)__builtin_popcountll(m & ((1ull << lane) - 1ull)); todo &= ~m; } }
        { unsigned long long todo = 0xFFFFull;
          while (todo) { const int ld = __builtin_ctzll(todo); const int x = __shfl(e2, ld); const unsigned long long m = __ballot(e2 == x) & todo;
              int base = 0; if (lane == ld && F.wr) base = atomicAdd(&cnt[x], (int)__builtin_popcountll(m)); base = __shfl(base, ld);
              if (e2 == x) r2 = base + (int)__builtin_popcountll(m & ((1ull << lane) - 1ull)); todo &= ~m; } }
        if (lane < 16 && F.wr) { rowtok[(size_t)e1 * NTOK + r1] = tok; rowtok[(size_t)e2 * NTOK + r2] = tok;
            u32x4 a; a.x = (unsigned)e1; a.y = (unsigned)r1; a.z = (unsigned)e2; a.w = (unsigned)r2;
            *(u32x4*)(tinfo + (size_t)tok * 8) = a; *(f32x2*)(tinfo + (size_t)tok * 8 + 4) = (f32x2){w1, w2}; }
        }
    }
}
__device__ __forceinline__ void moe_tables(Frame& F, int l, volatile LAS int*& tileoff, volatile LAS int*& cntl) {
    volatile LAS int* t = (volatile LAS int*)(F.lds + LDS_CTL + 512); cntl = t; tileoff = t + 32;
    if (F.tid < 32) t[F.tid] = __hip_atomic_load(F_CNT(F) + l * 32 + F.tid, __ATOMIC_RELAXED, __HIP_MEMORY_SCOPE_AGENT);
    __syncthreads();
    if (F.tid == 0) { int s = 0;
#pragma unroll 1
        for (int e = 0; e < 32; ++e) { t[32 + e] = s; s += (t[e] + 255) >> 8; } t[64] = s; }
    __syncthreads();
}
__device__ __forceinline__ void ph_combine(Frame& F, int l, int ntok) {
    volatile LAS int* tileoff; volatile LAS int* cntl; moe_tables(F, l, tileoff, cntl);
    const float* mod = F_MOD(F) + (size_t)l * 9 * 6144; const bool lastl = (l == DEPTH - 1);
    const float* modn = F_MOD(F) + (size_t)(lastl ? l : l + 1) * 9 * 6144; const float* gn = lastl ? FIN(I_FNG) : FIN(I_N1G) + (l + 1) * 1024;
    const bf16* Y = (const bf16*)(F.ws + WS_YROWS); const unsigned* tinfo = (const unsigned*)(F.ws + WS_TOKINFO);
    const int lane = F.lane;
    u32x4 ninf = (u32x4){0u, 0u, 0u, 0u}; f32x2 nwv = (f32x2){0.f, 0.f}; f32x4 nh[4];
    int r = F.gw;
#define CMB_HROW(rr) ((rr) < NLAT ? F.out + (size_t)(rr) * 1024 : F_HC(F) + (size_t)((rr) - NLAT) * 1024)
    if (r < ntok) { ninf = *(const u32x4*)(tinfo + (size_t)r * 8); nwv = *(const f32x2*)(tinfo + (size_t)r * 8 + 4); const float* hp = CMB_HROW(r);
#pragma unroll
        for (int j = 0; j < 4; ++j) nh[j] = *(const f32x4*)(hp + 4 * lane + 256 * j); }
    for (; r < ntok; r += F.NGW) {
        const u32x4 inf = ninf; const f32x2 wv = nwv; f32x4 hv[4];
#pragma unroll
        for (int j = 0; j < 4; ++j) hv[j] = nh[j];
        const bool lat = r < NLAT; const int mb = lat ? (r >> 12) : 8; float* hrow = CMB_HROW(r);
        const bf16* y1 = Y + ((size_t)tileoff[inf.x] * 256 + inf.y) * 1024; const bf16* y2 = Y + ((size_t)tileoff[inf.z] * 256 + inf.w) * 1024;
        u32x2 ya[4], yb[4];
#pragma unroll
        for (int j = 0; j < 4; ++j) { ya[j] = *(const u32x2*)(y1 + 4 * lane + 256 * j); yb[j] = *(const u32x2*)(y2 + 4 * lane + 256 * j); }
        const int rn = r + F.NGW;
        if (rn < ntok) { ninf = *(const u32x4*)(tinfo + (size_t)rn * 8); nwv = *(const f32x2*)(tinfo + (size_t)rn * 8 + 4); const float* hp = CMB_HROW(rn);
#pragma unroll
            for (int j = 0; j < 4; ++j) nh[j] = *(const f32x4*)(hp + 4 * lane + 256 * j); }
        f32x4 v[4]; float ss = 0.f;
#pragma unroll
        for (int j = 0; j < 4; ++j) { const int c = 4 * lane + 256 * j; const f32x4 m5 = *(const f32x4*)(mod + mb * 6144 + 5 * 1024 + c);
            const u32x2 a = ya[j], b = yb[j];
            f32x4 y; y.x = wv.x * bflo(a.x) + wv.y * bflo(b.x); y.y = wv.x * bfhi(a.x) + wv.y * bfhi(b.x); y.z = wv.x * bflo(a.y) + wv.y * bflo(b.y); y.w = wv.x * bfhi(a.y) + wv.y * bfhi(b.y);
            v[j] = hv[j] + m5 * y; ss += (v[j].x * v[j].x + v[j].y * v[j].y) + (v[j].z * v[j].z + v[j].w * v[j].w); }
        const float rstd = 1.0f / sqrtf(wave_sum(ss) * (1.0f / 1024.0f) + EPS);
        if (lastl) {
#pragma unroll
            for (int j = 0; j < 4; ++j) { const int c = 4 * lane + 256 * j; const f32x4 g = *(const f32x4*)(gn + c); if (F.wr) *(f32x4*)(hrow + c) = (v[j] * rstd) * g; }
        } else {
#pragma unroll
            for (int j = 0; j < 4; ++j) { const int c = 4 * lane + 256 * j; if (F.wr) *(f32x4*)(hrow + c) = v[j];
                const f32x4 g = *(const f32x4*)(gn + c), sh = *(const f32x4*)(modn + mb * 6144 + c), sc = *(const f32x4*)(modn + mb * 6144 + 1024 + c);
                const f32x4 y = (v[j] * rstd) * g * (sc + 1.0f) + sh; u32x2 w; w.x = pk2(y.x, y.y); w.y = pk2(y.z, y.w); if (F.wr) *(u32x2*)(F_X(F) + (size_t)r * 1024 + c) = w; }
        }
    }
#undef CMB_HROW
}
#define MFMA16(a, b, c) __builtin_amdgcn_mfma_f32_16x16x32_bf16((a), (b), (c), 0, 0, 0)
__device__ __forceinline__ bf16x8 ldfrag(const LAS bf16* base, int row0, int k0, int ld, int lane) {
    return *(const LAS bf16x8*)(base + (row0 + (lane & 15)) * ld + k0 + 8 * (lane >> 4));
}
__device__ __forceinline__ float fast_sigmoid(float x) { return __builtin_amdgcn_rcpf(1.0f + __builtin_amdgcn_exp2f(-1.4426950408889634f * x)); }
__device__ __forceinline__ float fast_gelu_tanh(float x) {
    const float u2 = 1.5957691216057308f * (x + 0.044715f * x * x * x);
    return x * __builtin_amdgcn_rcpf(1.0f + __builtin_amdgcn_exp2f(-1.4426950408889634f * u2));
}

__device__ __forceinline__ void att_rope8(const f32x2* tab, const float (&x1)[8], const float (&x2)[8], float (&o1)[8], float (&o2)[8]) {
#pragma unroll
    for (int e = 0; e < 8; ++e) { const f32x2 cs = tab[e]; o1[e] = x1[e] * cs.x - x2[e] * cs.y; o2[e] = x2[e] * cs.x + x1[e] * cs.y; }
}
__device__ __forceinline__ void unpack8(const u32x4 a, float (&x)[8]) { x[0] = bflo(a.x); x[1] = bfhi(a.x); x[2] = bflo(a.y); x[3] = bfhi(a.y); x[4] = bflo(a.z); x[5] = bfhi(a.z); x[6] = bflo(a.w); x[7] = bfhi(a.w); }
__device__ __forceinline__ u32x4 pack8(const float (&x)[8], float s) { u32x4 r; r.x = pk2(x[0] * s, x[1] * s); r.y = pk2(x[2] * s, x[3] * s); r.z = pk2(x[4] * s, x[5] * s); r.w = pk2(x[6] * s, x[7] * s); return r; }

template <int RS> __device__ __forceinline__ void tr_frags4(unsigned addr, bf16x8 (&f)[4]) {
    u32x2 a0, a1, b0, b1, c0, c1, d0, d1;
    asm volatile("ds_read_b64_tr_b16 %0, %8\n\tds_read_b64_tr_b16 %1, %8 offset:%9\n\tds_read_b64_tr_b16 %2, %8 offset:32\n\tds_read_b64_tr_b16 %3, %8 offset:%10\n\t"
                 "ds_read_b64_tr_b16 %4, %8 offset:64\n\tds_read_b64_tr_b16 %5, %8 offset:%11\n\tds_read_b64_tr_b16 %6, %8 offset:96\n\tds_read_b64_tr_b16 %7, %8 offset:%12\n\ts_waitcnt lgkmcnt(0)"
                 : "=&v"(a0), "=&v"(a1), "=&v"(b0), "=&v"(b1), "=&v"(c0), "=&v"(c1), "=&v"(d0), "=&v"(d1)
                 : "v"(addr), "i"(4 * RS), "i"(32 + 4 * RS), "i"(64 + 4 * RS), "i"(96 + 4 * RS) : "memory");
    u32x4 t; t.x = a0.x; t.y = a0.y; t.z = a1.x; t.w = a1.y; f[0] = __builtin_bit_cast(bf16x8, t);
    t.x = b0.x; t.y = b0.y; t.z = b1.x; t.w = b1.y; f[1] = __builtin_bit_cast(bf16x8, t);
    t.x = c0.x; t.y = c0.y; t.z = c1.x; t.w = c1.y; f[2] = __builtin_bit_cast(bf16x8, t);
    t.x = d0.x; t.y = d0.y; t.z = d1.x; t.w = d1.y; f[3] = __builtin_bit_cast(bf16x8, t);
}


__device__ __forceinline__ float xor16_max(float x) { const unsigned xi = __builtin_bit_cast(unsigned, x); const auto r = __builtin_amdgcn_permlane16_swap(xi, xi, false, false); return fmaxf(__builtin_bit_cast(float, (unsigned)r[0]), __builtin_bit_cast(float, (unsigned)r[1])); }
__device__ __forceinline__ float xor32_max(float x) { const unsigned xi = __builtin_bit_cast(unsigned, x); const auto r = __builtin_amdgcn_permlane32_swap(xi, xi, false, false); return fmaxf(__builtin_bit_cast(float, (unsigned)r[0]), __builtin_bit_cast(float, (unsigned)r[1])); }
__device__ __forceinline__ float xor16_sum(float x) { const unsigned xi = __builtin_bit_cast(unsigned, x); const auto r = __builtin_amdgcn_permlane16_swap(xi, xi, false, false); return __builtin_bit_cast(float, (unsigned)r[0]) + __builtin_bit_cast(float, (unsigned)r[1]); }
__device__ __forceinline__ float xor32_sum(float x) { const unsigned xi = __builtin_bit_cast(unsigned, x); const auto r = __builtin_amdgcn_permlane32_swap(xi, xi, false, false); return __builtin_bit_cast(float, (unsigned)r[0]) + __builtin_bit_cast(float, (unsigned)r[1]); }

#ifndef LRU_ABL
#define LRU_ABL 0
#endif
__device__ __forceinline__ void lru_unit(Frame& F, int l, int b, int hd, int half) {
    LAS bf16* ub = (LAS bf16*)F.lds;
    LAS bf16* waT = (LAS bf16*)(F.lds + 36864);
    LAS bf16* wxT = (LAS bf16*)(F.lds + 36864 + 4608);
    LAS f32x2* wcomp = (LAS f32x2*)(F.lds + 92800);
    LAS bf16* ho = (LAS bf16*)(F.lds + 46080 + 3 * 8192 + 256);
    const int tid = F.tid, lane = F.lane, w = F.wave, q = lane >> 4, fr = lane & 15;
    bf16* proj = F_PROJ(F); bf16* X = F_X(F);
    const int chh = hd * 64;
    const int c8 = tid & 7, rg = tid >> 3;
    LAS float* cwl = (LAS float*)(F.lds + 91392 + 128);
    __syncthreads();
    if (tid < 320) { const int j = tid >> 6, c = tid & 63; cwl[tid] = j < 4 ? FIN(I_CONVW)[((size_t)l * 4 + j) * 1024 + chh + c] : FIN(I_CONVB)[l * 1024 + chh + c]; }
    const int orow = tid >> 1, ohh = tid & 1;
#pragma unroll 1
    for (int dir = 0; dir < 2; ++dir) {
        __syncthreads();
        for (int i = tid; i < 2048; i += 512) { const int k = i >> 5, c = i & 31; const size_t gi = ((((size_t)l * 2 + dir) * 16 + hd) * 64 + k) * 64 + half * 32 + c;
            waT[c * 72 + k] = (bf16)f2bf(FIN(I_WA)[gi]); wxT[c * 72 + k] = (bf16)f2bf(FIN(I_WX)[gi]); }
        float ba_[2], bx_[2], sp8_[2], carry[2] = {0.f, 0.f};
#pragma unroll
        for (int cb = 0; cb < 2; ++cb) { const int ch = chh + half * 32 + cb * 16 + fr; const size_t gi = ((size_t)l * 2 + dir) * 1024 + ch;
            ba_[cb] = FIN(I_BA)[gi]; bx_[cb] = FIN(I_BX)[gi]; const float lam = FIN(I_LAM)[gi]; sp8_[cb] = -8.0f * 1.4426950408889634f * log1p_fast(__expf(-lam)); }
        __syncthreads();
        const int rgd = dir ? 63 - rg : rg;
        u32x4 axr[7]; u32x4 pf[4];
#define LRU_CHUNK(ci, isctx_, T0_, rowbase_) const bool isctx_ = (ci) == 0; const int T0_ = isctx_ ? 0 : 256 * (dir ? (16 - (ci)) : ((ci) - 1)); const size_t rowbase_ = isctx_ ? (size_t)NLAT + b * LCX : (size_t)b * SEQ
#define LRU_PREFETCH(ci) do { LRU_CHUNK(ci, ic_, t0_, rb_); const int Ls_ = ic_ ? LCX : SEQ; \
            _Pragma("unroll") for (int j = 0; j < 7; ++j) { const int tt = t0_ + 4 * rgd - 2 + j; const int tc_ = (tt >= 0 && tt < Ls_) ? tt : 0; \
                const GAS bf16* p_ = (const GAS bf16*)(proj + (rb_ + tc_) * LDP + C_AX + chh + 8 * c8); \
                asm volatile("global_load_dwordx4 %0, %1, off" : "=v"(axr[j]) : "v"(p_) : "memory"); } } while (0)
#define LRU_AX_WAIT(ci) do { if (dir == 0) asm volatile("s_waitcnt vmcnt(2)" : "+v"(axr[0]), "+v"(axr[1]), "+v"(axr[2]), "+v"(axr[3]), "+v"(axr[4]), "+v"(axr[5]), "+v"(axr[6]) :: "memory"); \
            else asm volatile("s_waitcnt vmcnt(6)" : "+v"(axr[0]), "+v"(axr[1]), "+v"(axr[2]), "+v"(axr[3]), "+v"(axr[4]), "+v"(axr[5]), "+v"(axr[6]) :: "memory"); \
            LRU_CHUNK(ci, ic_, t0_, rb_); (void)rb_; const int Ls_ = ic_ ? LCX : SEQ; \
            _Pragma("unroll") for (int j = 0; j < 7; ++j) { const int tt = t0_ + 4 * rgd - 2 + j; if (!(tt >= 0 && tt < Ls_)) axr[j] = (u32x4){0u, 0u, 0u, 0u}; } } while (0)
#define LRU_PREFETCH_OUT(ci) do { if (dir == 1) { LRU_CHUNK(ci, ic_, t0_, rb_); const size_t orow_g = rb_ + t0_ + (255 - orow); \
                pf[0] = *(const u32x4*)(X + orow_g * 1024 + chh + half * 32 + ohh * 16); pf[1] = *(const u32x4*)(X + orow_g * 1024 + chh + half * 32 + ohh * 16 + 8); \
                pf[2] = *(const u32x4*)(proj + orow_g * LDP + C_AY + chh + half * 32 + ohh * 16); pf[3] = *(const u32x4*)(proj + orow_g * LDP + C_AY + chh + half * 32 + ohh * 16 + 8); } } while (0)
        LRU_PREFETCH(0); LRU_PREFETCH_OUT(0);
        asm volatile("s_waitcnt vmcnt(0)" : "+v"(axr[0]), "+v"(axr[1]), "+v"(axr[2]), "+v"(axr[3]), "+v"(axr[4]), "+v"(axr[5]), "+v"(axr[6]) :: "memory");
#pragma unroll 1
        for (int ci = 0; ci < 17; ++ci) {
            LRU_CHUNK(ci, isctx, T0, rowbase);
            if (ci > 0) { LRU_AX_WAIT(ci); } else {
#pragma unroll
                for (int j = 0; j < 7; ++j) { const int tt = 4 * rgd - 2 + j; if (!(tt >= 0 && tt < LCX)) axr[j] = (u32x4){0u, 0u, 0u, 0u}; } }
            { float u[4][8];
#pragma unroll
              for (int r = 0; r < 4; ++r) { const f32x4 b0 = *(const LAS f32x4*)(cwl + 256 + 8 * c8), b1 = *(const LAS f32x4*)(cwl + 256 + 8 * c8 + 4);
                  u[r][0] = b0.x; u[r][1] = b0.y; u[r][2] = b0.z; u[r][3] = b0.w; u[r][4] = b1.x; u[r][5] = b1.y; u[r][6] = b1.z; u[r][7] = b1.w; }
#pragma unroll
              for (int j = 0; j < 7; ++j) { float x[8]; x[0] = bflo(axr[j].x); x[1] = bfhi(axr[j].x); x[2] = bflo(axr[j].y); x[3] = bfhi(axr[j].y); x[4] = bflo(axr[j].z); x[5] = bfhi(axr[j].z); x[6] = bflo(axr[j].w); x[7] = bfhi(axr[j].w);
#pragma unroll
                  for (int t = 0; t < 4; ++t) { const int r = j - t; if (r >= 0 && r < 4) {
                      const f32x4 w0 = *(const LAS f32x4*)(cwl + 64 * t + 8 * c8), w1 = *(const LAS f32x4*)(cwl + 64 * t + 8 * c8 + 4);
                      u[r][0] += w0.x * x[0]; u[r][1] += w0.y * x[1]; u[r][2] += w0.z * x[2]; u[r][3] += w0.w * x[3]; u[r][4] += w1.x * x[4]; u[r][5] += w1.y * x[5]; u[r][6] += w1.z * x[6]; u[r][7] += w1.w * x[7]; } } }
#pragma unroll
              for (int r = 0; r < 4; ++r) { const int tl = 4 * rgd + r, p = dir ? (255 - tl) : tl;
                  u32x4 o; o.x = pk2(u[r][0], u[r][1]); o.y = pk2(u[r][2], u[r][3]); o.z = pk2(u[r][4], u[r][5]); o.w = pk2(u[r][6], u[r][7]); *(LAS u32x4*)(ub + p * 72 + 8 * c8) = o; } }
            if (ci + 1 < 17) LRU_PREFETCH(ci + 1);
            LDS_WAIT(); asm volatile("" ::: "memory");
            float hl[2][2][4], Ac[2][2][4], sa[2][2], sb[2][2];
            bf16x8 Ba[2][2], Bx[2][2];
#pragma unroll
            for (int cb = 0; cb < 2; ++cb)
#pragma unroll
                for (int ks = 0; ks < 2; ++ks) { Ba[cb][ks] = ldfrag(waT, cb * 16, ks * 32, 72, lane); Bx[cb][ks] = ldfrag(wxT, cb * 16, ks * 32, 72, lane); }
#pragma unroll
            for (int rb = 0; rb < 2; ++rb) { const bf16x8 A0 = ldfrag(ub, 32 * w + 16 * rb, 0, 72, lane), A1 = ldfrag(ub, 32 * w + 16 * rb, 32, 72, lane);
#pragma unroll
                for (int cb = 0; cb < 2; ++cb) {
                    f32x4 ra = (f32x4){0.f, 0.f, 0.f, 0.f}, rx = ra;
                    ra = MFMA16(A0, Ba[cb][0], ra); ra = MFMA16(A1, Ba[cb][1], ra); rx = MFMA16(A0, Bx[cb][0], rx); rx = MFMA16(A1, Bx[cb][1], rx);
                    float hprev = 0.f, aprev = 1.f;
#pragma unroll
                    for (int r = 0; r < 4; ++r) { const int p = 32 * w + 16 * rb + 4 * q + r; const float u = bf2f(ub[p * 72 + half * 32 + cb * 16 + fr]);
                        const float rgt = fast_sigmoid(ra[r] + ba_[cb]), igt = fast_sigmoid(rx[r] + bx_[cb]);
                        const float a = __builtin_amdgcn_exp2f(sp8_[cb] * rgt), bb = __builtin_amdgcn_sqrtf(fmaxf((1.0f - a) * (1.0f + a), 0.f)) * (igt * u);
                        hprev = a * hprev + bb; aprev = a * aprev; hl[rb][cb][r] = hprev; Ac[rb][cb][r] = aprev; }
                    sa[rb][cb] = aprev; sb[rb][cb] = hprev; } }
            float ea[2][2], eb[2][2];
            const int par = ci & 1;
#pragma unroll
            for (int cb = 0; cb < 2; ++cb) { float ia[2], ib[2];
#pragma unroll
                for (int rb = 0; rb < 2; ++rb) { float a = sa[rb][cb], bq = sb[rb][cb];
                    float a1 = __shfl_up(a, 16), b1 = __shfl_up(bq, 16); if (q >= 1) { bq = a * b1 + bq; a = a * a1; }
                    a1 = __shfl_up(a, 32); b1 = __shfl_up(bq, 32); if (q >= 2) { bq = a * b1 + bq; a = a * a1; }
                    ia[rb] = a; ib[rb] = bq;
                    a1 = __shfl_up(a, 16); b1 = __shfl_up(bq, 16); ea[rb][cb] = q ? a1 : 1.0f; eb[rb][cb] = q ? b1 : 0.0f; }
                const float t0a = __shfl(ia[0], 48 + fr), t0b = __shfl(ib[0], 48 + fr);
                eb[1][cb] = ea[1][cb] * t0b + eb[1][cb]; ea[1][cb] = ea[1][cb] * t0a;
                if (q == 3) wcomp[(par * 8 + w) * 32 + cb * 16 + fr] = (f32x2){ia[1] * t0a, ia[1] * t0b + ib[1]}; }
            LDS_BARRIER();
#pragma unroll
            for (int cb = 0; cb < 2; ++cb) { float h = carry[cb], hin = h;
#pragma unroll
                for (int k = 0; k < 8; ++k) { const f32x2 c = wcomp[(par * 8 + k) * 32 + cb * 16 + fr]; h = c.x * h + c.y; hin = (k + 1 == w) ? h : hin; }
                carry[cb] = h;
#pragma unroll
                for (int rb = 0; rb < 2; ++rb) { const float hs = ea[rb][cb] * hin + eb[rb][cb];
#pragma unroll
                    for (int r = 0; r < 4; ++r) { const int p = 32 * w + 16 * rb + 4 * q + r; ho[p * 40 + cb * 16 + fr] = (bf16)f2bf(Ac[rb][cb][r] * hs + hl[rb][cb][r]); } } }
            LDS_WAIT(); asm volatile("" ::: "memory");
            { const int tl = dir ? (255 - orow) : orow; const size_t row = rowbase + T0 + tl;
              const u32x4 h0 = *(const LAS u32x4*)(ho + orow * 40 + ohh * 16), h1 = *(const LAS u32x4*)(ho + orow * 40 + ohh * 16 + 8);
              if (dir == 0) { *(u32x4*)(X + row * 1024 + chh + half * 32 + ohh * 16) = h0; *(u32x4*)(X + row * 1024 + chh + half * 32 + ohh * 16 + 8) = h1; }
              else { u32x4 o0, o1;
#define LRU_Y(hb, hf, ay) pk2((bflo(hf) + bflo(hb)) * fast_gelu_tanh(bflo(ay)), (bfhi(hf) + bfhi(hb)) * fast_gelu_tanh(bfhi(ay)))
                  o0.x = LRU_Y(h0.x, pf[0].x, pf[2].x); o0.y = LRU_Y(h0.y, pf[0].y, pf[2].y); o0.z = LRU_Y(h0.z, pf[0].z, pf[2].z); o0.w = LRU_Y(h0.w, pf[0].w, pf[2].w);
                  o1.x = LRU_Y(h1.x, pf[1].x, pf[3].x); o1.y = LRU_Y(h1.y, pf[1].y, pf[3].y); o1.z = LRU_Y(h1.z, pf[1].z, pf[3].z); o1.w = LRU_Y(h1.w, pf[1].w, pf[3].w);
#undef LRU_Y
                  { bf16* yb_ = F_YB(F) + row * 3072 + chh + half * 32 + ohh * 16; *(u32x4*)yb_ = o0; *(u32x4*)(yb_ + 8) = o1; } } }
            if (ci + 1 < 17) LRU_PREFETCH_OUT(ci + 1);
        }
#undef LRU_AX_WAIT
#undef LRU_PREFETCH_OUT
#undef LRU_PREFETCH
#undef LRU_CHUNK
    }
}
__device__ __forceinline__ size_t ret_rowbase(int b, int cidx) { return cidx < 2 ? (size_t)NLAT + b * LCX + cidx * 128 : (size_t)b * SEQ + (cidx - 2) * 128; }
__device__ __forceinline__ float ret_logg(Frame& F, int l, int dir, int h) { const float lam = FIN(I_RLAM)[(l * 2 + dir) * 8 + h]; return -log1p_fast(__expf(-lam)); }

__device__ __forceinline__ void ret_load_qk(Frame& F, const bf16* src  , bool rope, int pos0, float scale, float (&o1)[8], float (&o2)[8]) {
    const int row = F.tid >> 2, cp = F.tid & 3;
    const u32x4 a = *(const u32x4*)(src + (size_t)row * LDP + 8 * cp), b = *(const u32x4*)(src + (size_t)row * LDP + 32 + 8 * cp);
    float x1[8] = {bflo(a.x), bfhi(a.x), bflo(a.y), bfhi(a.y), bflo(a.z), bfhi(a.z), bflo(a.w), bfhi(a.w)};
    float x2[8] = {bflo(b.x), bfhi(b.x), bflo(b.y), bfhi(b.y), bflo(b.z), bfhi(b.z), bflo(b.w), bfhi(b.w)};
    if (rope) { const f32x2* rt = (const f32x2*)(F.ws + WS_ROPE) + (size_t)(pos0 + row) * 32 + 8 * cp;
#pragma unroll
        for (int e = 0; e < 8; ++e) { const f32x2 cs = rt[e]; o1[e] = (x1[e] * cs.x - x2[e] * cs.y) * scale; o2[e] = (x2[e] * cs.x + x1[e] * cs.y) * scale; }
    } else {
#pragma unroll
        for (int e = 0; e < 8; ++e) { o1[e] = x1[e] * scale; o2[e] = x2[e] * scale; }
    }
}
__device__ __forceinline__ void ph_ret_r1(Frame& F, int l) {
    LAS bf16* Kf = (LAS bf16*)F.lds;
    LAS bf16* Kb = Kf + 128 * 72;
    LAS bf16* Vs = Kb + 128 * 72;
    const int tid = F.tid, lane = F.lane, w = F.wave, q = lane >> 4, fr = lane & 15;
    const bf16* proj = F_PROJ(F);
    const int row = tid >> 2, cp = tid & 3;
    u32x4 ka, kb, vv[4];
#define R1_LOAD(u) do { const int bh__ = (u) / 34, ci__ = (u) % 34; const size_t rb__ = ret_rowbase(bh__ >> 3, ci__); const int h__ = bh__ & 7; \
        const bf16* ks_ = proj + (rb__ + row) * LDP + C_BK + h__ * 64 + 8 * cp; ka = *(const u32x4*)ks_; kb = *(const u32x4*)(ks_ + 32); \
        _Pragma("unroll") for (int i = 0; i < 4; ++i) { const int t_ = tid + 512 * i; vv[i] = *(const u32x4*)(proj + (rb__ + (t_ >> 4)) * LDP + C_BV + h__ * 128 + 8 * (t_ & 15)); } } while (0)
    int u = F.bid;
    if (u < 64 * 34) R1_LOAD(u);
    const int dir = w >> 2, e0 = 32 * (w & 3);
    const unsigned vlane = (unsigned)(size_t)Vs + (unsigned)((8 * q + (fr >> 2)) * 272 + (fr & 3) * 8 + e0 * 2);
    const unsigned klane = (unsigned)(size_t)(dir ? Kb : Kf) + (unsigned)((8 * q + (fr >> 2)) * 144 + (fr & 3) * 8);
#pragma unroll 1
    for (; u < 64 * 34; u += F.G) {
        const int bh = u / 34, cidx = u % 34, b = bh >> 3, h = bh & 7; const bool lat = cidx >= 2;
        const float lg0 = ret_logg(F, l, 0, h), lg1 = ret_logg(F, l, 1, h);
        LDS_BARRIER();
        { float x1[8], x2[8], o1[8], o2[8]; unpack8(ka, x1); unpack8(kb, x2);
          if (lat) { const f32x2* rt = (const f32x2*)(F.ws + WS_ROPE) + (size_t)((cidx - 2) * 128 + row) * 32 + 8 * cp;
#pragma unroll
              for (int e = 0; e < 8; ++e) { const f32x2 cs = rt[e]; o1[e] = (x1[e] * cs.x - x2[e] * cs.y) * 0.125f; o2[e] = (x2[e] * cs.x + x1[e] * cs.y) * 0.125f; } }
          else {
#pragma unroll
              for (int e = 0; e < 8; ++e) { o1[e] = x1[e] * 0.125f; o2[e] = x2[e] * 0.125f; } }
          const float df = __expf(lg0 * (float)(127 - row)), db = __expf(lg1 * (float)row);
          *(LAS u32x4*)(Kf + row * 72 + 8 * cp) = pack8(o1, df); *(LAS u32x4*)(Kf + row * 72 + 32 + 8 * cp) = pack8(o2, df);
          *(LAS u32x4*)(Kb + row * 72 + 8 * cp) = pack8(o1, db); *(LAS u32x4*)(Kb + row * 72 + 32 + 8 * cp) = pack8(o2, db); }
#pragma unroll
        for (int i = 0; i < 4; ++i) { const int t = tid + 512 * i; *(LAS u32x4*)(Vs + (t >> 4) * 136 + 8 * (t & 15)) = vv[i]; }
        LDS_BARRIER();
        if (u + F.G < 64 * 34) R1_LOAD(u + F.G);
        f32x4 acc[2][4];
#pragma unroll
        for (int eb = 0; eb < 2; ++eb)
#pragma unroll
            for (int db = 0; db < 4; ++db) acc[eb][db] = (f32x4){0.f, 0.f, 0.f, 0.f};
#pragma unroll
        for (int ks = 0; ks < 4; ++ks) { bf16x8 av[4], bk[4];
            tr_frags4<272>(vlane + ks * 32 * 272, av);
            tr_frags4<144>(klane + ks * 32 * 144, bk);
#pragma unroll
            for (int eb = 0; eb < 2; ++eb)
#pragma unroll
                for (int db = 0; db < 4; ++db) acc[eb][db] = MFMA16(bk[db], av[eb], acc[eb][db]); }
        bf16* kv = (bf16*)(F.ws + WS_KV) + ((((size_t)(b * 8 + h) * 34 + cidx) * 2) + dir) * 8192;
#pragma unroll
        for (int eb = 0; eb < 2; ++eb)
#pragma unroll
            for (int db = 0; db < 4; ++db) { u32x2 o; o.x = pk2(acc[eb][db][0], acc[eb][db][1]); o.y = pk2(acc[eb][db][2], acc[eb][db][3]);
                *(u32x2*)(kv + (e0 + 16 * eb + fr) * 64 + 16 * db + 4 * q) = o; }
    }
#undef R1_LOAD
}
__device__ __forceinline__ void ret_scan(Frame& F, int l) {
    unsigned* kvw = (unsigned*)(F.ws + WS_KV);
    for (int i = F.bid * 512 + F.tid; i < 64 * 2 * 4096; i += F.G * 512) { const int pr = i & 4095, dir = (i >> 12) & 1, bh = i >> 13, h = bh & 7;
        const float gC = __expf(ret_logg(F, l, dir, h) * 128.0f);
        unsigned* base = kvw + ((size_t)bh * 34 * 2 + dir) * 4096 + pr;
        unsigned v[34];
#pragma unroll
        for (int k = 0; k < 34; ++k) v[k] = base[(size_t)k * 8192];
        float s0 = 0.f, s1 = 0.f;
        if (dir == 0) {
#pragma unroll
            for (int k = 0; k < 34; ++k) { const unsigned x = v[k]; v[k] = pk2(s0, s1); s0 = gC * s0 + bflo(x); s1 = gC * s1 + bfhi(x); }
        } else {
#pragma unroll
            for (int k = 0; k < 34; ++k) { const int c = k < 2 ? 1 - k : 35 - k; const unsigned x = v[c]; v[c] = pk2(s0, s1); s0 = gC * s0 + bflo(x); s1 = gC * s1 + bfhi(x); }
        }
        if (F.wr) {
#pragma unroll
            for (int k = 0; k < 34; ++k) base[(size_t)k * 8192] = v[k]; }
    }
}
__device__ __forceinline__ void ph_ret_r2(Frame& F, int l, bool lastl) {
    LAS bf16* Qs = (LAS bf16*)F.lds;
    LAS bf16* Ks = Qs + 128 * 72;
    LAS bf16* Vs = Ks + 128 * 72;
    LAS bf16* Ps = Vs + 128 * 136 + F.wave * (16 * 136);
    LAS bf16* Ss = Vs + 128 * 136 + 8 * (16 * 136);
    const int tid = F.tid, lane = F.lane, w = F.wave, q = lane >> 4, fr = lane & 15;
    const bf16* proj = F_PROJ(F);
    const int nch = lastl ? 32 : 34, nunits = 64 * nch;
    const int row = tid >> 2, cp = tid & 3;
    u32x4 qa, qb_, ka, kb, vv[4], sv[4];
#define R2_DECODE(u, bh_, cidx_) const int bh_ = (u) / nch, cidx_ = (u) % nch + (lastl ? 2 : 0)
#define R2_LOAD(u) do { R2_DECODE(u, bh__, ci__); const size_t rb__ = ret_rowbase(bh__ >> 3, ci__); const int h__ = bh__ & 7; \
        const bf16* qs_ = proj + (rb__ + row) * LDP + C_BQ + h__ * 64 + 8 * cp; qa = *(const u32x4*)qs_; qb_ = *(const u32x4*)(qs_ + 32); \
        const bf16* ks_ = proj + (rb__ + row) * LDP + C_BK + h__ * 64 + 8 * cp; ka = *(const u32x4*)ks_; kb = *(const u32x4*)(ks_ + 32); \
        _Pragma("unroll") for (int i = 0; i < 4; ++i) { const int t_ = tid + 512 * i; vv[i] = *(const u32x4*)(proj + (rb__ + (t_ >> 4)) * LDP + C_BV + h__ * 128 + 8 * (t_ & 15)); \
            sv[i] = *(const u32x4*)((const bf16*)(F.ws + WS_KV) + (((size_t)bh__ * 34 + ci__) * 2) * 8192 + (size_t)t_ * 8); } } while (0)
    int u = F.bid;
    if (u < nunits) R2_LOAD(u);
    const unsigned vlane = (unsigned)(size_t)Vs + (unsigned)((8 * q + (fr >> 2)) * 272 + (fr & 3) * 8);
#pragma unroll 1
    for (; u < nunits; u += F.G) {
        R2_DECODE(u, bh, cidx); const int b = bh >> 3, h = bh & 7; const size_t rb = ret_rowbase(b, cidx); const bool lat = cidx >= 2;
        const float lg0 = ret_logg(F, l, 0, h), lg1 = ret_logg(F, l, 1, h);
        LDS_BARRIER();
        { float x1[8], x2[8], o1[8], o2[8];
          unpack8(qa, x1); unpack8(qb_, x2);
          if (lat) { const f32x2* rt = (const f32x2*)(F.ws + WS_ROPE) + (size_t)((cidx - 2) * 128 + row) * 32 + 8 * cp;
#pragma unroll
              for (int e = 0; e < 8; ++e) { const f32x2 cs = rt[e]; o1[e] = x1[e] * cs.x - x2[e] * cs.y; o2[e] = x2[e] * cs.x + x1[e] * cs.y; } }
          else {
#pragma unroll
              for (int e = 0; e < 8; ++e) { o1[e] = x1[e]; o2[e] = x2[e]; } }
          *(LAS u32x4*)(Qs + row * 72 + 8 * cp) = pack8(o1, 1.0f); *(LAS u32x4*)(Qs + row * 72 + 32 + 8 * cp) = pack8(o2, 1.0f);
          unpack8(ka, x1); unpack8(kb, x2);
          if (lat) { const f32x2* rt = (const f32x2*)(F.ws + WS_ROPE) + (size_t)((cidx - 2) * 128 + row) * 32 + 8 * cp;
#pragma unroll
              for (int e = 0; e < 8; ++e) { const f32x2 cs = rt[e]; o1[e] = x1[e] * cs.x - x2[e] * cs.y; o2[e] = x2[e] * cs.x + x1[e] * cs.y; } }
          else {
#pragma unroll
              for (int e = 0; e < 8; ++e) { o1[e] = x1[e]; o2[e] = x2[e]; } }
          *(LAS u32x4*)(Ks + row * 72 + 8 * cp) = pack8(o1, 0.125f); *(LAS u32x4*)(Ks + row * 72 + 32 + 8 * cp) = pack8(o2, 0.125f); }
#pragma unroll
        for (int i = 0; i < 4; ++i) { const int t = tid + 512 * i; *(LAS u32x4*)(Vs + (t >> 4) * 136 + 8 * (t & 15)) = vv[i]; *(LAS u32x4*)(Ss + (t >> 3) * 72 + 8 * (t & 7)) = sv[i]; }
        LDS_BARRIER();
        if (u + F.G < nunits) R2_LOAD(u + F.G);
        const int il = 16 * w + fr;
        const bf16x8 Bq0 = ldfrag(Qs, 16 * w, 0, 72, lane), Bq1 = ldfrag(Qs, 16 * w, 32, 72, lane);
        const float l2g0 = lg0 * 1.4426950408889634f, l2g1 = lg1 * 1.4426950408889634f;
#pragma unroll
        for (int jb = 0; jb < 8; ++jb) { f32x4 acc = (f32x4){0.f, 0.f, 0.f, 0.f};
            acc = MFMA16(ldfrag(Ks, 16 * jb, 0, 72, lane), Bq0, acc); acc = MFMA16(ldfrag(Ks, 16 * jb, 32, 72, lane), Bq1, acc);
            float pv[4];
#pragma unroll
            for (int r = 0; r < 4; ++r) { const int j = 16 * jb + 4 * q + r; const int dd = il - j;
                const float df = dd >= 0 ? __builtin_amdgcn_exp2f(l2g0 * (float)dd) : 0.f, dbk = dd <= 0 ? __builtin_amdgcn_exp2f(l2g1 * (float)(-dd)) : 0.f;
                pv[r] = acc[r] * (df + dbk); }
            u32x2 pw; pw.x = pg8::cvt_pk_bf16(pv[0], pv[1]); pw.y = pg8::cvt_pk_bf16(pv[2], pv[3]); *(LAS u32x2*)(Ps + fr * 136 + 16 * jb + 4 * q) = pw; }
        LDS_WAIT(); asm volatile("" ::: "memory");
        const bf16* gp = proj + (rb + il) * LDP + C_BG + h * 128 + 4 * q;
        u32x2 gwv[4];
#pragma unroll
        for (int eb = 0; eb < 4; ++eb) gwv[eb] = *(const u32x2*)(gp + 16 * eb);
        f32x4 Y[8];
#pragma unroll
        for (int eb = 0; eb < 8; ++eb) Y[eb] = (f32x4){0.f, 0.f, 0.f, 0.f};
#pragma unroll
        for (int ks = 0; ks < 4; ++ks) { const bf16x8 bp = ldfrag(Ps, 0, 32 * ks, 136, lane); bf16x8 av[4];
            tr_frags4<272>(vlane + ks * 32 * 272, av);
#pragma unroll
            for (int eb = 0; eb < 4; ++eb) Y[eb] = MFMA16(av[eb], bp, Y[eb]);
            tr_frags4<272>(vlane + ks * 32 * 272 + 128, av);
#pragma unroll
            for (int eb = 0; eb < 4; ++eb) Y[4 + eb] = MFMA16(av[eb], bp, Y[4 + eb]); }
        const float qf = __builtin_amdgcn_exp2f(l2g0 * (float)(il + 1)), qbw = __builtin_amdgcn_exp2f(l2g1 * (float)(128 - il));
#pragma unroll
        for (int eb = 0; eb < 8; ++eb) { f32x4 zf = (f32x4){0.f, 0.f, 0.f, 0.f}, zb = zf;
            zf = MFMA16(ldfrag(Ss, 16 * eb, 0, 72, lane), Bq0, zf); zf = MFMA16(ldfrag(Ss, 16 * eb, 32, 72, lane), Bq1, zf);
            zb = MFMA16(ldfrag(Ss, 128 + 16 * eb, 0, 72, lane), Bq0, zb); zb = MFMA16(ldfrag(Ss, 128 + 16 * eb, 32, 72, lane), Bq1, zb);
            Y[eb] = Y[eb] + zf * qf + zb * qbw; }
        float s = 0.f;
#pragma unroll
        for (int eb = 0; eb < 8; ++eb) s += (Y[eb][0] + Y[eb][1]) + (Y[eb][2] + Y[eb][3]);
        s += __shfl_xor(s, 16); s += __shfl_xor(s, 32);
        const float mu = s * (1.0f / 128.0f); float vq = 0.f;
#pragma unroll
        for (int eb = 0; eb < 8; ++eb) { const f32x4 d = Y[eb] - mu; vq += (d[0] * d[0] + d[1] * d[1]) + (d[2] * d[2] + d[3] * d[3]); }
        vq += __shfl_xor(vq, 16); vq += __shfl_xor(vq, 32);
        const float rstd = __builtin_amdgcn_rsqf(vq * (1.0f / 128.0f) + EPS);
        bf16* yo = F_YB(F) + (rb + il) * 3072 + 1024 + h * 128 + 4 * q;
        u32x2 gw2[4];
#pragma unroll
        for (int eb = 0; eb < 4; ++eb) gw2[eb] = *(const u32x2*)(gp + 16 * (4 + eb));
#pragma unroll
        for (int eb = 0; eb < 8; ++eb) { const u32x2 gw = eb < 4 ? gwv[eb & 3] : gw2[eb & 3]; const f32x4 yn = (Y[eb] - mu) * rstd;
            u32x2 o; o.x = pg8::cvt_pk_bf16(gm::fsilu_(bflo(gw.x)) * yn[0], gm::fsilu_(bfhi(gw.x)) * yn[1]); o.y = pg8::cvt_pk_bf16(gm::fsilu_(bflo(gw.y)) * yn[2], gm::fsilu_(bfhi(gw.y)) * yn[3]);
            if (F.wr) *(u32x2*)(yo + 16 * eb) = o; }
    }
#undef R2_LOAD
#undef R2_DECODE
}
__device__ __forceinline__ void att_rope_keys(Frame& F) {
    bf16* proj = F_PROJ(F); const f32x2* atab = (const f32x2*)(F.ws + WS_ROPE + 1 * MiB);
    for (int i = F.bid * 512 + F.tid; i < NLAT * 16; i += F.G * 512) { const int pr = i & 3, g = (i >> 2) & 3, row = i >> 4; const int c = (pr & 1) + 4 * (pr >> 1);
        bf16* src = proj + (size_t)row * LDP + C_CK + g * 64 + 8 * c;
        float x1[8], x2[8], o1[8], o2[8]; unpack8(*(const u32x4*)src, x1); unpack8(*(const u32x4*)(src + 16), x2);
        const int pos = row & (SEQ - 1); const int ap = (pr >> 1) ? (pos & 63) : (pos >> 6); att_rope8(atab + ap * 16 + 8 * (pr & 1), x1, x2, o1, o2);
        if (F.wr) { *(u32x4*)src = pack8(o1, 1.0f); *(u32x4*)(src + 16) = pack8(o2, 1.0f); } }
}
__device__ __forceinline__ void att_unit(Frame& F, int l, int b, int g, int qb, bool isctxq) {
    LAS bf16* Kt = (LAS bf16*)F.lds;
    LAS bf16* Vt = Kt + 64 * 72;
    LAS bf16* Pw = Vt + 64 * 72 + F.wave * (64 * 72);
    const int tid = F.tid, lane = F.lane, w = F.wave, q = lane >> 4, fr = lane & 15;
    const bf16* proj = F_PROJ(F); const f32x2* atab = (const f32x2*)(F.ws + WS_ROPE + 1 * MiB);
    const int hq = 4 * g + (w >> 1);
    const size_t qrow0 = (isctxq ? (size_t)NLAT + b * LCX : (size_t)b * SEQ) + qb * 128 + (w & 1) * 64;
    const int qpos0 = qb * 128 + (w & 1) * 64;
    constexpr float QS = 0.125f * 1.4426950408889634f;
    unsigned vmask = 0xFu;
    if (!isctxq) {
#pragma unroll
        for (int t = 4; t < 10; ++t) { const int kp = qb * 128 - 128 + 64 * (t - 4); if (kp >= 0 && kp < SEQ) vmask |= 1u << t; } }
    const int vrow = tid >> 3, vc8 = tid & 7;
    u32x4 kx = (u32x4){0u, 0u, 0u, 0u}, vx = kx;
#define ATT_KROW0(t) ((t) >= 4 ? (size_t)b * SEQ + (qb * 128 - 128 + 64 * ((t) - 4)) : (size_t)NLAT + b * LCX + 64 * (t))
#define ATT_LOAD(t) do { const size_t kr0_ = ATT_KROW0(t); kx = *(const u32x4*)(proj + (kr0_ + vrow) * LDP + C_CK + g * 64 + 8 * vc8); \
        vx = *(const u32x4*)(proj + (kr0_ + vrow) * LDP + C_CV + g * 64 + 8 * vc8); } while (0)
    int t = __builtin_ctz(vmask); vmask &= vmask - 1;
    ATT_LOAD(t);
    LDS_BARRIER();
#pragma unroll
    for (int i = 0; i < 4; ++i) { const int tt = lane + 64 * i, row = tt >> 2, pr = tt & 3;
        const int c = (pr & 1) + 4 * (pr >> 1); const bf16* src = proj + (qrow0 + row) * LDP + C_CQ + hq * 64;
        float x1[8], x2[8], o1[8], o2[8]; unpack8(*(const u32x4*)(src + 8 * c), x1); unpack8(*(const u32x4*)(src + 8 * c + 16), x2);
        if (!isctxq) { const int pos = qpos0 + row; const int ap = (pr >> 1) ? (pos & 63) : (pos >> 6); att_rope8(atab + ap * 16 + 8 * (pr & 1), x1, x2, o1, o2); }
        else {
#pragma unroll
            for (int e = 0; e < 8; ++e) { o1[e] = x1[e]; o2[e] = x2[e]; } }
        *(LAS u32x4*)(Pw + row * 72 + 8 * c) = pack8(o1, QS); *(LAS u32x4*)(Pw + row * 72 + 8 * c + 16) = pack8(o2, QS); }
    LDS_WAIT(); asm volatile("" ::: "memory");
    bf16x8 Bq[4][2];
#pragma unroll
    for (int ib = 0; ib < 4; ++ib)
#pragma unroll
        for (int ks = 0; ks < 2; ++ks) Bq[ib][ks] = ldfrag(Pw, 16 * ib, 32 * ks, 72, lane);
    LDS_WAIT(); asm volatile("" ::: "memory");
    const float sink = FIN(I_SINK)[l * 16 + hq] * 1.4426950408889634f;
    float mrow[4], lrow[4], aprev[4]; f32x4 O[4][4];
#pragma unroll
    for (int ib = 0; ib < 4; ++ib) { mrow[ib] = sink; aprev[ib] = 1.0f; lrow[ib] = (q == 0) ? 1.0f : 0.0f;
#pragma unroll
        for (int db = 0; db < 4; ++db) O[db][ib] = (f32x4){0.f, 0.f, 0.f, 0.f}; }
    const unsigned vt_lane = (unsigned)(size_t)Vt + (unsigned)((8 * q + (fr >> 2)) * 144 + (fr & 3) * 8);
#pragma unroll 1
    for (;;) {
        const int kpos0 = t >= 4 ? (qb * 128 - 128 + 64 * (t - 4)) : 0;
        LDS_BARRIER();
        *(LAS u32x4*)(Kt + vrow * 72 + 8 * vc8) = kx;
        *(LAS u32x4*)(Vt + vrow * 72 + 8 * vc8) = vx;
        LDS_BARRIER();
        const int tcur = t; const bool more = vmask != 0u;
        if (more) { t = __builtin_ctz(vmask); vmask &= vmask - 1; ATT_LOAD(t); }
        const bool skipt = !isctxq && tcur == ((w & 1) ? 4 : 9);
        const bool maskt = !isctxq && (tcur == ((w & 1) ? 5 : 4) || tcur == ((w & 1) ? 9 : 8));
        if (!skipt) {
#pragma unroll
        for (int hf = 0; hf < 2; ++hf) {
            f32x4 S[4][2];
#pragma unroll
            for (int jb = 0; jb < 4; ++jb) { const bf16x8 a0 = ldfrag(Kt, 16 * jb, 0, 72, lane), a1 = ldfrag(Kt, 16 * jb, 32, 72, lane);
#pragma unroll
                for (int i2 = 0; i2 < 2; ++i2) { const float nm = -mrow[2 * hf + i2]; f32x4 acc = (f32x4){nm, nm, nm, nm};
                    acc = MFMA16(a0, Bq[2 * hf + i2][0], acc); acc = MFMA16(a1, Bq[2 * hf + i2][1], acc); S[jb][i2] = acc; } }
            if (maskt) {
#pragma unroll
                for (int jb = 0; jb < 4; ++jb)
#pragma unroll
                    for (int i2 = 0; i2 < 2; ++i2)
#pragma unroll
                        for (int r = 0; r < 4; ++r) { const int dd = (qpos0 + 16 * (2 * hf + i2) + fr) - (kpos0 + 16 * jb + 4 * q + r); if (dd > 128 || dd < -128) S[jb][i2][r] = -1.0e30f; }
            }
#pragma unroll
            for (int i2 = 0; i2 < 2; ++i2) { const int ib = 2 * hf + i2;
                float mx = -1.0e30f;
#pragma unroll
                for (int jb = 0; jb < 4; ++jb) mx = fmaxf(mx, fmaxf(fmaxf(S[jb][i2][0], S[jb][i2][1]), fmaxf(S[jb][i2][2], S[jb][i2][3])));
                mx = fmaxf(mx, __shfl_xor(mx, 16)); mx = fmaxf(mx, __shfl_xor(mx, 32));
                const float alpha = aprev[ib]; const float dm = fmaxf(mx, 0.f); aprev[ib] = __builtin_amdgcn_exp2f(-dm); mrow[ib] += dm;
                float ps = 0.f;
#pragma unroll
                for (int jb = 0; jb < 4; ++jb) { float p[4];
#pragma unroll
                    for (int r = 0; r < 4; ++r) { p[r] = __builtin_amdgcn_exp2f(S[jb][i2][r]); ps += p[r]; }
                    u32x2 pw; pw.x = pk2(p[0], p[1]); pw.y = pk2(p[2], p[3]); *(LAS u32x2*)(Pw + (16 * ib + fr) * 72 + 16 * jb + 4 * q) = pw; }
                lrow[ib] = lrow[ib] * alpha + ps;
#pragma unroll
                for (int db = 0; db < 4; ++db) O[db][ib] = O[db][ib] * alpha;
            }
        }
        LDS_WAIT(); asm volatile("" ::: "memory");
#pragma unroll
        for (int ks = 0; ks < 2; ++ks) { bf16x8 av[4], bp[4];
            tr_frags4<144>(vt_lane + ks * 32 * 144, av); __builtin_amdgcn_sched_barrier(0);
#pragma unroll
            for (int ib = 0; ib < 4; ++ib) bp[ib] = ldfrag(Pw, 16 * ib, 32 * ks, 72, lane);
#pragma unroll
            for (int db = 0; db < 4; ++db)
#pragma unroll
                for (int ib = 0; ib < 4; ++ib) O[db][ib] = MFMA16(av[db], bp[ib], O[db][ib]); }
        LDS_WAIT(); asm volatile("" ::: "memory");
        }
        if (!more) break;
    }
#undef ATT_LOAD
#undef ATT_KROW0
#pragma unroll
    for (int ib = 0; ib < 4; ++ib) { float lt = lrow[ib]; lt += __shfl_xor(lt, 16); lt += __shfl_xor(lt, 32); const float inv = __builtin_amdgcn_rcpf(lt);
        bf16* dst = F_YB(F) + (qrow0 + 16 * ib + fr) * 3072 + 2048 + hq * 64 + 4 * q;
#pragma unroll
        for (int db = 0; db < 4; ++db) { const f32x4 o = O[db][ib] * inv; u32x2 ow; ow.x = pg8::cvt_pk_bf16(o[0], o[1]); ow.y = pg8::cvt_pk_bf16(o[2], o[3]); if (F.wr) *(u32x2*)(dst + 16 * db) = ow; } }
}
#ifndef PROBE_MASK
#define PROBE_MASK 0
#endif
#ifndef PROBE_SUB
#define PROBE_SUB 0
#endif
#ifdef PROBE_REAL
#define WR_DRY wr_true
#else
#define WR_DRY wr_false
#endif
#define NREP(n) (((PROBE_MASK >> (n)) & 1) ? 2 : 1)
#ifndef DIAG_PH
#define PHON(n) true
#else
#define PHON(n) ((n) == DIAG_PH)
#endif
constexpr int N_PHASES = 2 + 10 * DEPTH;
__global__ void __launch_bounds__(512, 2) fwd_kernel(Args args) {
    extern __shared__ __attribute__((aligned(16))) unsigned char lds_raw[];
    Frame F; F.lds = (LAS unsigned char*)lds_raw; F.tid = threadIdx.x; F.lane = F.tid & 63; F.wave = __builtin_amdgcn_readfirstlane(F.tid >> 6);
    F.G = gridDim.x; F.bid = blockIdx.x; F.gw = F.bid * 8 + F.wave; F.NGW = F.G * 8; F.in = (const __attribute__((address_space(4))) cfp_t*)__builtin_amdgcn_kernarg_segment_ptr(); F.out = args.out; F.ws = args.ws;
    volatile LAS unsigned* MISC = (volatile LAS unsigned*)(F.lds + MISC_OFF);
    for (int u = F.tid; u < (LDS_BYTES - LDS_CTL) / 4; u += 512) ((LAS unsigned*)(F.lds + LDS_CTL))[u] = 0u;
    __syncthreads();
    unsigned* ctl = (unsigned*)(F.ws + WS_CTL);
#if MK_N_LAUNCHES == 1
    XcdBarrier bar = xcd_barrier_post(ctl + CW_BAR, MISC + 8, gridDim.x);
    XcdBarrier sbar = xcd_barrier_post(ctl + (blockIdx.x < 32 ? CW_BAR_C : CW_BAR_L), MISC + 12, blockIdx.x < 32 ? 32u : gridDim.x - 32u);
#define SUB_BAR() do { GAS unsigned* _bp = (GAS unsigned*)sbar.bar; asm volatile("" : "+s"(_bp)); XcdBarrier _b2 = sbar; _b2.bar = (unsigned*)_bp; xcd_barrier(_b2); } while (0)
#define GRID_BAR() do { GAS unsigned* _bp = (GAS unsigned*)bar.bar; asm volatile("" : "+s"(_bp)); XcdBarrier _b2 = bar; _b2.bar = (unsigned*)_bp; xcd_barrier(_b2); } while (0)
#else
#define GRID_BAR() do {} while (0)
#define SUB_BAR() do {} while (0)
#endif
    const int wave0 = F.wave; const bool wr_true = args.ph_hi > 0, wr_false = args.ph_hi < 0; F.wr = wr_true;
    const int lo = args.ph_lo, hi = args.ph_hi;
#define FRESH() do { LAS unsigned char* _l = (LAS unsigned char*)lds_raw; asm volatile("" : "+s"(_l)); F.lds = _l; int _ln; asm volatile("v_mbcnt_lo_u32_b32 %0, -1, 0\n\tv_mbcnt_hi_u32_b32 %0, -1, %0" : "=v"(_ln)); F.tid = wave0 * 64 + _ln; F.lane = _ln; F.wave = wave0; F.gw = F.bid * 8 + F.wave; \
        GAS unsigned char* _ws = (GAS unsigned char*)args.ws; asm volatile("" : "+s"(_ws)); F.ws = (unsigned char*)_ws; GAS float* _out = (GAS float*)args.out; asm volatile("" : "+s"(_out)); F.out = (float*)_out; \
        const __attribute__((address_space(4))) cfp_t* _in = (const __attribute__((address_space(4))) cfp_t*)__builtin_amdgcn_kernarg_segment_ptr(); asm volatile("" : "+s"(_in)); F.in = _in; } while (0)
#define IN(k) (lo <= (k) && (k) < hi)
#define SEAM(k) do { if (IN(k) && IN((k) + 1)) GRID_BAR(); } while (0)
    if (PHON(0) && IN(0)) for (int rep_ = NREP(0); rep_ > 0; --rep_) { FRESH(); F.wr = (rep_ == 1) ? wr_true : WR_DRY; if (NREP(0) > 1) GRID_BAR(); ph_prologue(F); } SEAM(0);
    if (PHON(1) && IN(1)) for (int rep_ = NREP(1); rep_ > 0; --rep_) { FRESH(); F.wr = (rep_ == 1) ? wr_true : WR_DRY; if (NREP(1) > 1) GRID_BAR(); ph_convert(F, 0); ph_rows_u(F, 0, true); ph_router_fold(F); } SEAM(1);
#pragma unroll 1
    for (int l = 0; l < DEPTH; ++l) {
        const int pb = 2 + 10 * l; const bool lastl = (l == DEPTH - 1); const int nM2 = lastl ? 128 : 136; const int ntok = lastl ? NLAT : NTOK;
        unsigned char* wt = F.ws + WS_WT;
        if (PHON(2) && IN(pb + 0)) for (int rep_ = NREP(2); rep_ > 0; --rep_) { FRESH(); F.wr = (rep_ == 1) ? wr_true : WR_DRY; if (NREP(2) > 1) GRID_BAR();
            gm::SchedPlain<16, 1024> S; S.init(136, 38, F.G, F.bid); S.A = (const char*)(F.ws + WS_X); S.Bt = (const char*)(wt + WT_IN);
            gm::EpiProj E{F_PROJ(F), F.ws + WS_GT}; pg8::gemm_phase(F.lds, S, E, F.tid);
        } SEAM(pb + 0);
        if (PHON(3) && IN(pb + 1)) for (int rep_ = NREP(3); rep_ > 0; --rep_) { FRESH(); F.wr = (rep_ == 1) ? wr_true : WR_DRY; if (NREP(3) > 1) GRID_BAR();
            if (!(rep_ > 1 && PROBE_SUB == 2)) for (int u = F.bid; u < 256; u += F.G) { const int hu = ((u >> 4) << 3) + (u & 7); lru_unit(F, l, hu >> 4, hu & 15, (u >> 3) & 1); }
            if (!(rep_ > 1 && PROBE_SUB == 1)) { __syncthreads(); ph_ret_r1(F, l); __syncthreads(); }
            att_rope_keys(F);
        } SEAM(pb + 1);
        if (PHON(4) && IN(pb + 2)) for (int rep_ = NREP(4); rep_ > 0; --rep_) { FRESH(); F.wr = (rep_ == 1) ? wr_true : WR_DRY; if (NREP(4) > 1) GRID_BAR();
            if (!(rep_ > 1 && PROBE_SUB == 2)) ret_scan(F, l);
            if (!(rep_ > 1 && PROBE_SUB == 1))
            for (int u = F.bid; u < (lastl ? 1024 : 1088); u += F.G) { const bool cq = u >= 1024; const int v = u - 1024;
                int ab = cq ? (v >> 3) : (u >> 7), ag = cq ? ((v >> 1) & 3) : ((u >> 5) & 3), aq = cq ? (v & 1) : (u & 31);
                if (F.G == 256) { const int x = F.bid & 7, y = F.bid >> 3;
                    ab = x; ag = cq ? (y >> 1) : (u >> 8); aq = cq ? (y & 1) : y; }
                att_unit(F, l, ab, ag, aq, cq); }
        } SEAM(pb + 2);
        if (PHON(5) && IN(pb + 3)) for (int rep_ = NREP(5); rep_ > 0; --rep_) { FRESH(); F.wr = (rep_ == 1) ? wr_true : WR_DRY; if (NREP(5) > 1) GRID_BAR();
            ph_ret_r2(F, l, lastl);
        } SEAM(pb + 3);
#ifdef PROBE_MERGE_K
        if (IN(pb + 4)) { FRESH(); GRID_BAR();
            gm::SchedPlain<PROBE_MERGE_K, 3072> S; S.init(nM2, 4, F.G, F.bid); S.A = (const char*)(F.ws + WS_YB); S.Bt = (const char*)(wt + WT_BR);
            gm::EpiPlain E{(bf16*)(F.ws + WS_KV)}; pg8::gemm_phase(F.lds, S, E, F.tid); GRID_BAR(); }
#endif
        const bool split = !lastl && gridDim.x == 256 && MK_N_LAUNCHES == 1;
        if (PHON(6) && IN(pb + 4)) for (int rep_ = NREP(6); rep_ > 0; --rep_) { FRESH(); F.wr = (rep_ == 1) ? wr_true : WR_DRY; if (NREP(6) > 1) GRID_BAR();
            gm::SchedPlain<48, 3072> S; S.init(split ? 128 : nM2, 4, F.G, F.bid); S.A = (const char*)(F.ws + WS_YB); S.Bt = (const char*)(wt + WT_BR);
            gm::EpiMerge E{F.ws + WS_GT, F_X(F)}; pg8::gemm_phase(F.lds, S, E, F.tid);
        } SEAM(pb + 4);
        if (IN(pb + 5)) { FRESH(); F.wr = wr_true;
            const bool cgrp = split && F.bid < 32;
            if (cgrp) {
                gm::SchedPlain<48, 3072, gm::OrderSub> S; S.init(8, 4, 32, F.bid, 128, true); S.A = (const char*)(F.ws + WS_YB); S.Bt = (const char*)(wt + WT_BR);
                gm::EpiMerge E{F.ws + WS_GT, F_X(F)}; pg8::gemm_phase(F.lds, S, E, F.tid);
                SUB_BAR(); FRESH();
            }
            {
                gm::SchedPlain<16, 1024, gm::OrderSub> S; S.init(split ? (cgrp ? 8 : 128) : nM2, 4, split ? (cgrp ? 32 : 224) : F.G, split && !cgrp ? F.bid - 32 : F.bid, cgrp ? 128 : 0, true);
                S.A = (const char*)(F.ws + WS_X); S.Bt = (const char*)(wt + WT_WO);
                gm::EpiWo E{F.out, F_HC(F), F_MOD(F) + (size_t)l * 9 * 6144, F.wr, l == 0 ? (const float*)FIN(I_X) : (const float*)F.out, l == 0 ? (const float*)FIN(I_CTX) : (const float*)F_HC(F)}; pg8::gemm_phase(F.lds, S, E, F.tid);
            }
        }
        if (split) { if (IN(pb + 5) && IN(pb + 6)) SUB_BAR(); } else SEAM(pb + 5);
        if (PHON(8) && IN(pb + 6)) for (int rep_ = NREP(8); rep_ > 0; --rep_) { FRESH(); F.wr = (rep_ == 1) ? wr_true : WR_DRY; if (NREP(8) > 1) GRID_BAR();
            const bool cgrp = split && F.bid < 32;
            const int row0 = cgrp ? NLAT : 0, row1 = split && !cgrp ? NLAT : ntok, gc = split && !cgrp ? F.bid - 32 : F.bid, gn = split ? (cgrp ? 32 : 224) : F.G;
            if (!(rep_ > 1 && PROBE_SUB == 2)) ph_rows_v(F, l, row0, row1, gc * 8 + F.wave, gn * 8);
            if (!(rep_ > 1 && PROBE_SUB == 1)) ph_router(F, l, row0 / 128, row1 / 128, gc, gn);
        } SEAM(pb + 6);
        if (PHON(9) && IN(pb + 7)) for (int rep_ = NREP(9); rep_ > 0; --rep_) { FRESH(); F.wr = (rep_ == 1) ? wr_true : WR_DRY; if (NREP(9) > 1) GRID_BAR();
            volatile LAS int* tileoff; volatile LAS int* cntl; moe_tables(F, l, tileoff, cntl);
            gm::SchedMoe<16, true> S; S.tileoff = tileoff; S.cnt = cntl; S.G = F.G; S.c = F.bid; S.nunits = tileoff[32] * 4; S.wsbase = (const char*)F.ws; S.rowtok = (const int*)(F.ws + WS_ROWTOK);
            S.A = nullptr; S.Bt = (const char*)(wt + WT_GU);
            gm::EpiGU E{(bf16*)(F.ws + WS_HROWS)}; pg8::gemm_phase(F.lds, S, E, F.tid);
        } SEAM(pb + 7);
        if (PHON(10) && IN(pb + 8)) for (int rep_ = NREP(10); rep_ > 0; --rep_) { FRESH(); F.wr = (rep_ == 1) ? wr_true : WR_DRY; if (NREP(10) > 1) GRID_BAR();
            volatile LAS int* tileoff; volatile LAS int* cntl; moe_tables(F, l, tileoff, cntl);
            gm::SchedMoe<8, false> S; S.tileoff = tileoff; S.cnt = cntl; S.G = F.G; S.c = F.bid; S.nunits = tileoff[32] * 4; S.wsbase = (const char*)F.ws; S.rowtok = nullptr;
            S.A = (const char*)(F.ws + WS_HROWS); S.Bt = (const char*)(wt + WT_DN);
            gm::EpiDN E{(bf16*)(F.ws + WS_YROWS)}; pg8::gemm_phase(F.lds, S, E, F.tid);
        } SEAM(pb + 8);
        if (PHON(11) && IN(pb + 9)) for (int rep_ = NREP(11); rep_ > 0; --rep_) { FRESH(); F.wr = (rep_ == 1) ? wr_true : WR_DRY; if (NREP(11) > 1) GRID_BAR();
            if (!(rep_ > 1 && PROBE_SUB == 2)) ph_combine(F, l, ntok);
            if (!lastl && !(rep_ > 1 && PROBE_SUB == 1)) ph_convert(F, l + 1);
        } if (!lastl) SEAM(pb + 9);
    }
#undef IN
#undef SEAM
}

extern "C" void kernel_launch(void* const* d_in, const int* in_sizes, int n_in, void* d_out, int out_size, void* d_ws, size_t ws_size, hipStream_t stream) {
    static int grid = 0;
    if (grid == 0) {
        if (n_in != 30 || out_size != NLAT * D || ws_size < WS_END) { fprintf(stderr, "kernel_launch: unexpected shapes (n_in %d out %d ws %zu, need %zu)\n", n_in, out_size, ws_size, (size_t)WS_END); grid = -1; return; }
        int dev = 0, cus = 0;
        if (hipGetDevice(&dev) != hipSuccess || hipDeviceGetAttribute(&cus, hipDeviceAttributeMultiprocessorCount, dev) != hipSuccess) { grid = -1; return; }
        if (hipFuncSetAttribute((const void*)fwd_kernel, hipFuncAttributeMaxDynamicSharedMemorySize, LDS_BYTES) != hipSuccess) { fprintf(stderr, "kernel_launch: hipFuncSetAttribute failed\n"); grid = -1; return; }
        int per_cu = 0;
        if (hipOccupancyMaxActiveBlocksPerMultiprocessor(&per_cu, (const void*)fwd_kernel, 512, LDS_BYTES) != hipSuccess || per_cu < 1) { fprintf(stderr, "kernel_launch: occupancy query says %d\n", per_cu); }
        (void)hipGetLastError();
        grid = cus;
    }
    if (grid < 0) return;
    (void)hipMemsetAsync((char*)d_ws + WS_CTL, 0, CTL_BYTES, stream);
#ifdef DIAG_ZERO_GT
    (void)hipMemsetAsync((char*)d_ws + WS_GT, 0x3f, (size_t)204 * MiB, stream);
#endif
    Args a{};
    for (int i = 0; i < 30; ++i) a.in[i] = (const float*)d_in[i];
    a.out = (float*)d_out; a.ws = (unsigned char*)d_ws;
#if MK_N_LAUNCHES == 1
    a.ph_lo = 0; a.ph_hi = N_PHASES;
    hipLaunchKernelGGL(fwd_kernel, dim3(grid), dim3(512), LDS_BYTES, stream, a);
#else
    for (int p = 0; p < N_PHASES; ++p) { a.ph_lo = p; a.ph_hi = p + 1; hipLaunchKernelGGL(fwd_kernel, dim3(grid), dim3(512), LDS_BYTES, stream, a); }
#endif
}
```

```cpp
#include <hip/hip_runtime.h>
#include <cstdio>
#include <cstdint>

#define LAS __attribute__((address_space(3)))
#define GAS __attribute__((address_space(1)))
typedef unsigned short bf16;
typedef short bf16x8 __attribute__((ext_vector_type(8)));
typedef float f32x4 __attribute__((ext_vector_type(4)));
typedef float f32x2 __attribute__((ext_vector_type(2)));
typedef unsigned u32x4 __attribute__((ext_vector_type(4)));
typedef unsigned u32x2 __attribute__((ext_vector_type(2)));

#ifndef MK_N_LAUNCHES
#define MK_N_LAUNCHES 1
#endif

constexpr int D = 1024, NB = 8, SEQ = 4096, LCX = 256, DEPTH = 4;
constexpr int NLAT = NB * SEQ, NCTX = NB * LCX, NTOK = NLAT + NCTX;
constexpr int DIN = 9728;
constexpr int LDP = 6720;
constexpr int C_AX = 0, C_AY = 1024, C_BQ = 2048, C_BK = 2560, C_BV = 3072, C_BG = 4096, C_CQ = 5120, C_CK = 6144, C_CV = 6400, C_GA = 6656;
constexpr int NMOD = 6, NMB = 9;
constexpr int NEXP = 32, DEXP = 512, RCOLS = 36;
constexpr int PMAX = 77824;
constexpr float EPS = 1e-6f;

constexpr size_t MiB = 1u << 20;
constexpr size_t WS_CTL = 0, CTL_BYTES = 1 * MiB;
constexpr size_t WS_MOD = 1 * MiB;
constexpr size_t WS_ROPE = 2 * MiB;
constexpr size_t WS_RW = 4 * MiB;
constexpr size_t WS_HC = 12 * MiB;
constexpr size_t WS_TOKINFO = 20 * MiB;
constexpr size_t WS_ROWTOK = 22 * MiB;
constexpr size_t WS_WT = 28 * MiB;
constexpr size_t WT_IN = 0, WT_BR = 19 * MiB, WT_WO = 25 * MiB, WT_GU = 27 * MiB, WT_DN = 91 * MiB, WT_BYTES = 123 * MiB;
constexpr size_t WS_X = 152 * MiB;
constexpr size_t WS_KV = 220 * MiB;
constexpr size_t WS_PROJ = 288 * MiB;
constexpr size_t WS_HROWS = WS_PROJ;
constexpr size_t WS_YROWS = WS_PROJ + 80 * MiB;
constexpr size_t WS_GT = 736 * MiB;
constexpr size_t WS_YB = 940 * MiB;
constexpr size_t WS_END = 1144 * MiB;
static_assert(WS_PROJ + (size_t)NTOK * LDP * 2 <= WS_GT && WS_GT + (size_t)3 * NTOK * 1024 * 2 <= WS_YB, "ws map");
constexpr int CW_BAR = 1024;
constexpr int CW_BAR_L = 20480, CW_BAR_C = 24576;
constexpr int CW_CNT = 8192;
constexpr size_t CTL_ZROW = 64 * 1024;

constexpr int LDS_BYTES = 163840;
constexpr int LDS_CTL = 155648;
constexpr int MISC_OFF = LDS_CTL + 320;

__device__ __forceinline__ unsigned f2bf(float f) { unsigned u = __builtin_bit_cast(unsigned, f); return (u + 0x7fffu + ((u >> 16) & 1u)) >> 16; }
typedef __bf16 bf16x2_t __attribute__((ext_vector_type(2)));
__device__ __forceinline__ unsigned pk2(float lo, float hi) { const f32x2 v = {lo, hi}; return __builtin_bit_cast(unsigned, __builtin_convertvector(v, bf16x2_t)); }
__device__ __forceinline__ float bf2f(unsigned b) { return __builtin_bit_cast(float, b << 16); }
__device__ __forceinline__ float bflo(unsigned w) { return __builtin_bit_cast(float, w << 16); }
__device__ __forceinline__ float bfhi(unsigned w) { return __builtin_bit_cast(float, w & 0xffff0000u); }
__device__ __forceinline__ float wave_sum(float v) {
#pragma unroll
    for (int o = 1; o < 64; o <<= 1) v += __shfl_xor(v, o);
    return v;
}
__device__ __forceinline__ float sigmoidf_(float x) { return 1.0f / (1.0f + __expf(-x)); }
__device__ __forceinline__ float siluf_(float x) { return x / (1.0f + __expf(-x)); }
__device__ __forceinline__ float gelu_tanh(float x) {
    const float u = 0.7978845608028654f * (x + 0.044715f * x * x * x);
    return x / (1.0f + __expf(-2.0f * u));
}
__device__ __forceinline__ float log1p_fast(float x) { const float u = 1.0f + x; const float d = u - 1.0f; return d == 0.f ? x : __logf(u) * (x / d); }
__device__ __forceinline__ float expm1_fast(float x) { const float u = __expf(x); const float um1 = u - 1.0f; if (um1 == 0.f) return x; const float lu = __logf(u); return um1 == -1.0f ? -1.0f : um1 * (x / lu); }
#define LDS_BARRIER() do { asm volatile("s_waitcnt lgkmcnt(0)" ::: "memory"); __builtin_amdgcn_s_barrier(); asm volatile("" ::: "memory"); } while (0)
#define LDS_WAIT() asm volatile("s_waitcnt lgkmcnt(0)" ::: "memory")
#define VM_WAIT() asm volatile("s_waitcnt vmcnt(0)" ::: "memory")

#define XB_TMO      128
#define XB_XCNT(j)  (256  + 64 * (j))
#define XB_XSUB(j)  (1280 + 64 * (j))
#define XB_XGEN(j)  (2304 + 64 * (j))
#define XB_TOP      3328
#define XB_TOPGEN   3392
#define XCD_BAR_WORDS 3456
#define XB_SPIN_CAP (1u << 22)
__device__ __forceinline__ unsigned xb_ld(unsigned* p)              { return __hip_atomic_load(p, __ATOMIC_RELAXED, __HIP_MEMORY_SCOPE_AGENT); }
__device__ __forceinline__ unsigned xb_add(unsigned* p, unsigned v) { return __hip_atomic_fetch_add(p, v, __ATOMIC_RELAXED, __HIP_MEMORY_SCOPE_AGENT); }
__device__ __forceinline__ unsigned xb_xcc_id() { return (unsigned)__builtin_amdgcn_s_getreg((3 << 11) | 20) & 0xFu; }
#define XB_SPIN(cond, bar) do { unsigned _sp = 0; while (cond) { __builtin_amdgcn_s_sleep(1); \
    if ((++_sp & 255u) == 0u) { if (xb_ld(&(bar)[XB_TMO])) break; if (_sp > XB_SPIN_CAP) { atomicAdd(&(bar)[XB_TMO], 1u); break; } } } } while (0)
struct XcdBarrier { unsigned* bar; unsigned x; volatile LAS unsigned* st; unsigned G; };
__device__ __forceinline__ XcdBarrier xcd_barrier_post(unsigned* bar, volatile LAS unsigned* st, unsigned G) {
    XcdBarrier b; b.bar = bar; b.x = xb_xcc_id(); b.st = st; b.G = G;
    if (threadIdx.x == 0) (void)xb_add(&bar[XB_XCNT(b.x)], 1u);
    return b;
}
__device__ __forceinline__ void xcd_barrier_complete(unsigned* bar, unsigned x, unsigned G, unsigned& nloc, unsigned& nx) {
    unsigned sum, cnt, mine, sp = 0u;
    for (;;) {
        sum = 0u; cnt = 0u; mine = 0u;
#pragma unroll
        for (unsigned j = 0; j < 16; ++j) { const unsigned c = xb_ld(&bar[XB_XCNT(j)]); sum += c; cnt += (c > 0u) ? 1u : 0u; mine = (j == x) ? c : mine; }
        if (sum == G) break;
        __builtin_amdgcn_s_sleep(1);
        if ((++sp & 255u) == 0u) { if (xb_ld(&bar[XB_TMO])) break; if (sp > XB_SPIN_CAP) { atomicAdd(&bar[XB_TMO], 1u); break; } }
    }
    nloc = mine > 0u ? mine : 1u; nx = cnt > 0u ? cnt : 1u;
}
__device__ __forceinline__ void xcd_barrier(const XcdBarrier& b) {
    asm volatile("s_waitcnt vmcnt(0)" ::: "memory");
    __syncthreads();
    if (threadIdx.x == 0) {
        unsigned* bar = b.bar;
        __builtin_amdgcn_s_waitcnt(0);
        unsigned nloc = b.st[0], nx = b.st[1];
        if (nloc == 0u) { xcd_barrier_complete(bar, b.x, b.G, nloc, nx); b.st[0] = nloc; b.st[1] = nx; }
        const unsigned old = xb_add(&bar[XB_XSUB(b.x)], 1u);
        const unsigned gen = old / nloc;
        if (old + 1u == (gen + 1u) * nloc) {
            __builtin_amdgcn_fence(__ATOMIC_RELEASE, "agent");
            asm volatile("s_waitcnt vmcnt(0)" ::: "memory");
            const unsigned og = xb_add(&bar[XB_TOP], 1u);
            const unsigned tg = og / nx;
            if (og + 1u == (tg + 1u) * nx) xb_add(&bar[XB_TOPGEN], 1u);
            else XB_SPIN(xb_ld(&bar[XB_TOPGEN]) == tg, bar);
            __builtin_amdgcn_fence(__ATOMIC_ACQUIRE, "agent");
            xb_add(&bar[XB_XGEN(b.x)], 1u);
            asm volatile("s_waitcnt vmcnt(0)" ::: "memory");
        } else {
            XB_SPIN(xb_ld(&bar[XB_XGEN(b.x)]) == gen, bar);
            __builtin_amdgcn_fence(__ATOMIC_ACQUIRE, "agent");
            asm volatile("s_waitcnt vmcnt(0)" ::: "memory");
        }
    }
    __syncthreads();
}

namespace pg8 {
constexpr int BM = 256, BK = 64, HALF = 128, HTB = HALF * BK * 2, STAGE_BYTES = 8 * HTB;
__device__ __forceinline__ int lds_byte(int r, int c) { const int st = (r >> 4) * 2 + (c >> 5), rr = r & 15, cc = c & 31, ob = rr * 64 + cc * 2; return st * 1024 + (ob ^ (((ob >> 9) & 1) << 5)); }
__device__ __forceinline__ void stage_rc(int b, int& R, int& C) { const int st = b / 1024, sb = b % 1024, swz = sb ^ (((sb >> 9) & 1) << 5); R = (st >> 1) * 16 + swz / 64; C = (st & 1) * 32 + (swz % 64) / 2; }
__device__ __forceinline__ int perm32(int rho) { const int n = rho >> 4, i = rho & 15; return 8 * (i >> 2) + 4 * n + (i & 3); }
__device__ __forceinline__ unsigned cvt_pk_bf16(float lo, float hi) { return pk2(lo, hi); }

template <class Epi, class Sched>
__device__ __forceinline__ void gemm_phase(LAS unsigned char* lds, const Sched& S, const Epi& E, const int tid) {
    typedef typename Sched::Unit Unit;
    const int wid = __builtin_amdgcn_readfirstlane(tid >> 6), lane = tid & 63, wr = wid >> 2, wc = wid & 3, fr = lane & 15, fq = lane >> 4;
    constexpr int nt = Sched::KT; constexpr int K = nt * BK;
    int R[2], C[2]; unsigned voffB[2];
#pragma unroll
    for (int i = 0; i < 2; ++i) { stage_rc(tid * 16 + i * 8192, R[i], C[i]); const int Rb = Epi::PERM ? ((R[i] & ~31) + perm32(R[i] & 31)) : R[i]; voffB[i] = (unsigned)(Rb * K + C[i]) * 2u; }
    constexpr size_t kstep = (size_t)(BK * 2);
    constexpr size_t hstepB = (size_t)HALF * K * 2;
    const unsigned ldsw = (unsigned)wid * 1024u;
    const int aoff = lds_byte(wr * 64 + fr, fq * 8), boff = lds_byte(wc * 32 + fr, fq * 8);
#define PG8_SA(b, h) (((b) * 2 + (h)) * HTB)
#define PG8_SB(b, h) ((4 + (b) * 2 + (h)) * HTB)
#define PG8_STAGEA(bufoff, gbase, vv, h) do { _Pragma("unroll") for (int _i = 0; _i < 2; ++_i) \
        __builtin_amdgcn_global_load_lds((const unsigned*)((const char*)(gbase) + (vv)[h][_i]), (LAS unsigned*)(lds + (bufoff) + ldsw + _i * 8192), 16, 0, 0); } while (0)
#define PG8_STAGEB(bufoff, gbase) do { _Pragma("unroll") for (int _i = 0; _i < 2; ++_i) \
        __builtin_amdgcn_global_load_lds((const unsigned*)((const char*)(gbase) + voffB[_i]), (LAS unsigned*)(lds + (bufoff) + ldsw + _i * 8192), 16, 0, 0); } while (0)
#define PG8_LDA(dst, b, h) do { _Pragma("unroll") for (int m = 0; m < 4; ++m) _Pragma("unroll") for (int k = 0; k < 2; ++k) dst[m][k] = *(const LAS bf16x8*)(lds + PG8_SA(b, h) + aoff + m * 2048 + k * 1024); } while (0)
#define PG8_LDB(dst, b, h) do { _Pragma("unroll") for (int n = 0; n < 2; ++n) _Pragma("unroll") for (int k = 0; k < 2; ++k) dst[n][k] = *(const LAS bf16x8*)(lds + PG8_SB(b, h) + boff + n * 2048 + k * 1024); } while (0)
#define PG8_MMA(ai, bj, At, Bt) do { __builtin_amdgcn_s_setprio(1); _Pragma("unroll") for (int m = 0; m < 4; ++m) _Pragma("unroll") for (int n = 0; n < 2; ++n) _Pragma("unroll") for (int k = 0; k < 2; ++k) \
        acc[ai][bj][m][n] = __builtin_amdgcn_mfma_f32_16x16x32_bf16(Bt[n][k], At[m][k], acc[ai][bj][m][n], 0, 0, 0); __builtin_amdgcn_s_setprio(0); } while (0)
#define PG8_WAIT_V(n) asm volatile("s_waitcnt vmcnt(" #n ")" ::: "memory")
#define PG8_WAIT_L(n) asm volatile("s_waitcnt lgkmcnt(" #n ")" ::: "memory")
#define PG8_BAR __builtin_amdgcn_s_barrier()
#define PG8_SCHED __builtin_amdgcn_sched_barrier(0)
    Unit cur, nxt; int ui = 0;
    if (!S.next(0, cur)) return;
    f32x4 acc[2][2][4][2];
#pragma unroll
    for (int a = 0; a < 2; ++a)
#pragma unroll
        for (int b = 0; b < 2; ++b)
#pragma unroll
            for (int m = 0; m < 4; ++m)
#pragma unroll
                for (int n = 0; n < 2; ++n) acc[a][b][m][n] = (f32x4){0.f, 0.f, 0.f, 0.f};
    bf16x8 At[4][2], B0[2][2], B1[2][2];
    unsigned vA[2][2], vAn[2][2];
    S.a_voff(cur, tid, vA);
#pragma unroll
    for (int h = 0; h < 2; ++h)
#pragma unroll
        for (int i = 0; i < 2; ++i) vAn[h][i] = vA[h][i];
    const char* cA = S.a_base(cur); const char* cB = S.b_base(cur);
    { const char* a0 = cA + S.a_koff(0); const char* a1p = cA + S.a_koff(1);
      PG8_STAGEB(PG8_SB(0, 0), cB); PG8_STAGEB(PG8_SB(0, 1), cB + hstepB); PG8_STAGEA(PG8_SA(0, 0), a0, vA, 0); PG8_STAGEA(PG8_SA(0, 1), a0, vA, 1);
      if (wr == 1) PG8_BAR;
      PG8_WAIT_V(2); PG8_BAR;
      PG8_STAGEB(PG8_SB(1, 0), cB + kstep); PG8_STAGEA(PG8_SA(1, 0), a1p, vA, 0); PG8_STAGEB(PG8_SB(1, 1), cB + hstepB + kstep);
      PG8_WAIT_V(6); PG8_BAR; }
    for (;;) {
        const bool has_next = S.next(ui + 1, nxt);
        const char* nA = cA; const char* nB = cB;
        if (has_next) { nA = S.a_base(nxt); nB = S.b_base(nxt); }
#pragma unroll 1
        for (int t = 0; t < nt; t += 2) {
            const bool last = (t == nt - 2);
            if constexpr (Epi::MIDK) { if (t == 16 || t == 32) E.mid(acc, cur, t, wr, wc, fr, fq); }
            if constexpr (Sched::GATHER) { if (t == nt - 4 && has_next) S.a_voff(nxt, tid, vAn); }
            const char* a1 = cA + S.a_koff(t + 1);
            const char* a2 = last ? nA + S.a_koff(0) : cA + S.a_koff(t + 2);
            const char* a3 = last ? nA + S.a_koff(1) : cA + S.a_koff(t + 3);
            const char* b2 = last ? nB : cB + (size_t)(t + 2) * kstep; const char* b3 = b2 + kstep;
            PG8_LDB(B0, 0, 0); PG8_LDB(B1, 0, 1); PG8_SCHED; PG8_LDA(At, 0, 0); PG8_STAGEA(PG8_SA(1, 1), a1, vA, 1);
            PG8_WAIT_V(8); PG8_WAIT_L(0); PG8_BAR; PG8_MMA(0, 0, At, B0); PG8_MMA(0, 1, At, B1); PG8_BAR; PG8_SCHED;
            PG8_LDA(At, 0, 1); PG8_STAGEB(PG8_SB(0, 0), b2); PG8_STAGEB(PG8_SB(0, 1), b2 + hstepB);
            if (last) { PG8_STAGEA(PG8_SA(0, 0), a2, vAn, 0); } else { PG8_STAGEA(PG8_SA(0, 0), a2, vA, 0); }
            PG8_WAIT_V(8); PG8_WAIT_L(0); PG8_BAR; PG8_MMA(1, 0, At, B0); PG8_MMA(1, 1, At, B1); PG8_BAR; PG8_SCHED;
            PG8_LDB(B0, 1, 0); PG8_LDB(B1, 1, 1); PG8_SCHED; PG8_LDA(At, 1, 0);
            if (last) { PG8_STAGEA(PG8_SA(0, 1), a2, vAn, 1); } else { PG8_STAGEA(PG8_SA(0, 1), a2, vA, 1); }
            PG8_WAIT_V(8); PG8_WAIT_L(0); PG8_BAR; PG8_MMA(0, 0, At, B0); PG8_MMA(0, 1, At, B1); PG8_BAR; PG8_SCHED;
            PG8_LDA(At, 1, 1); PG8_STAGEB(PG8_SB(1, 0), b3); PG8_STAGEB(PG8_SB(1, 1), b3 + hstepB);
            if (last) { PG8_STAGEA(PG8_SA(1, 0), a3, vAn, 0); } else { PG8_STAGEA(PG8_SA(1, 0), a3, vA, 0); }
            PG8_WAIT_V(8); PG8_WAIT_L(0); PG8_BAR; PG8_MMA(1, 0, At, B0); PG8_MMA(1, 1, At, B1); PG8_BAR; PG8_SCHED;
        }
        if (wr == 0) PG8_BAR;
        E(acc, cur, wr, wc, fr, fq);
        if (!has_next) break;
#pragma unroll
        for (int a = 0; a < 2; ++a)
#pragma unroll
            for (int b = 0; b < 2; ++b)
#pragma unroll
                for (int m = 0; m < 4; ++m)
#pragma unroll
                    for (int n = 0; n < 2; ++n) acc[a][b][m][n] = (f32x4){0.f, 0.f, 0.f, 0.f};
        cur = nxt; cA = nA; cB = nB; ++ui;
        if constexpr (Sched::GATHER) {
#pragma unroll
            for (int h = 0; h < 2; ++h)
#pragma unroll
                for (int i = 0; i < 2; ++i) vA[h][i] = vAn[h][i];
        }
        if (wr == 1) PG8_BAR;
    }
    PG8_WAIT_V(0);
    PG8_BAR;
#undef PG8_SA
#undef PG8_SB
#undef PG8_STAGEA
#undef PG8_STAGEB
#undef PG8_LDA
#undef PG8_LDB
#undef PG8_MMA
#undef PG8_WAIT_V
#undef PG8_WAIT_L
#undef PG8_BAR
#undef PG8_SCHED
}
}
namespace gm {
using pg8::cvt_pk_bf16;
__device__ __forceinline__ float fexp_(float x) { return __builtin_amdgcn_exp2f(1.4426950408889634f * x); }
__device__ __forceinline__ float fsig_(float x) { return __builtin_amdgcn_rcpf(1.0f + fexp_(-x)); }
__device__ __forceinline__ float fsilu_(float x) { return x * fsig_(x); }
struct Unit { int pm, pn; };
struct OrderBase {
    int nM, nN, nwg, G, c;
    __device__ __forceinline__ void init(int nM_, int nN_, int G_, int c_) { nM = nM_; nN = nN_; nwg = nM * nN; G = G_; c = c_; }
    __device__ __forceinline__ bool next(int i, Unit& u) const {
        const int L = i * G + c; if (L >= nwg) return false;
        int wgid = L; { const int q = nwg / 8, r = nwg % 8, xcd = wgid % 8, off = wgid / 8; wgid = (xcd < r ? xcd * (q + 1) : r * (q + 1) + (xcd - r) * q) + off; }
        const int nig = 8 * nN, gid = wgid / nig, fm = gid * 8, gsz = (nM - fm) < 8 ? (nM - fm) : 8;
        u.pm = fm + ((wgid % nig) % gsz); u.pn = (wgid % nig) / gsz; return true;
    }
};
struct OrderColAffine {
    int nM, nN, nwg, G, c;
    __device__ __forceinline__ void init(int nM_, int nN_, int G_, int c_) { nM = nM_; nN = nN_; nwg = nM * nN; G = G_; c = c_; }
    __device__ __forceinline__ bool next(int i, Unit& u) const {
        if (G != 256 || nN != 4) { const int L = i * G + c; if (L >= nwg) return false; u.pm = L / nN; u.pn = L % nN; return true; }
        const int x = c & 7, k = c >> 3, j = i * 32 + k; if (2 * j + (x >> 2) >= nM) return false;
        u.pm = 2 * j + (x >> 2); u.pn = x & 3; return true;
    }
};
struct OrderSub : OrderBase {
    int pm0; bool on;
    __device__ __forceinline__ void init(int nM_, int nN_, int Gs, int cs, int pm0_, bool on_) { OrderBase::init(nM_, nN_, Gs, cs); pm0 = pm0_; on = on_; }
    __device__ __forceinline__ bool next(int i, Unit& u) const { if (!on || !OrderBase::next(i, u)) return false; u.pm += pm0; return true; }
};
template <int KT_, int LDA, class Order = OrderBase> struct SchedPlain : Order {
    typedef gm::Unit Unit; static constexpr int KT = KT_; static constexpr bool GATHER = false;
    const char* A; const char* Bt;
    __device__ __forceinline__ const char* a_base(const Unit& u) const { return A + (size_t)u.pm * 256 * LDA * 2; }
    __device__ __forceinline__ void a_voff(const Unit&, int tid, unsigned (&v)[2][2]) const {
#pragma unroll
        for (int i = 0; i < 2; ++i) { int R, C; pg8::stage_rc(tid * 16 + i * 8192, R, C);
#pragma unroll
            for (int h = 0; h < 2; ++h) v[h][i] = (unsigned)((h * 128 + R) * LDA + C) * 2u; }
    }
    __device__ __forceinline__ size_t a_koff(int kt) const { return (size_t)kt * 128; }
    __device__ __forceinline__ const char* b_base(const Unit& u) const { return Bt + (size_t)u.pn * 256 * (KT * 64) * 2; }
};
struct SchedMerge : OrderBase {
    typedef gm::Unit Unit; static constexpr int KT = 48; static constexpr bool GATHER = false;
    const char* A; const char* Bt;
    __device__ __forceinline__ const char* a_base(const Unit& u) const { return A + (size_t)u.pm * 256 * LDP * 2; }
    __device__ __forceinline__ void a_voff(const Unit&, int tid, unsigned (&v)[2][2]) const {
#pragma unroll
        for (int i = 0; i < 2; ++i) { int R, C; pg8::stage_rc(tid * 16 + i * 8192, R, C);
#pragma unroll
            for (int h = 0; h < 2; ++h) v[h][i] = (unsigned)((h * 128 + R) * LDP + C) * 2u; }
    }
    __device__ __forceinline__ size_t a_koff(int kt) const { return (size_t)(kt < 16 ? (C_AY + 64 * kt) : (C_BG - 1024 + 64 * kt)) * 2; }
    __device__ __forceinline__ const char* b_base(const Unit& u) const { return Bt + (size_t)u.pn * 256 * 3072 * 2; }
};
struct MUnit { int e, tile, pn, slot0; };
template <int KT_, bool GATHER_> struct SchedMoe {
    typedef gm::MUnit Unit; static constexpr int KT = KT_; static constexpr bool GATHER = GATHER_;
    const volatile LAS int* tileoff; const volatile LAS int* cnt;
    int G, c, nunits;
    const char* wsbase; const int* rowtok; const char* A; const char* Bt;
    __device__ __forceinline__ bool next(int i, Unit& u) const {
        const int L = i * G + c; if (L >= nunits) return false;
        const int rt = L >> 2; u.pn = L & 3;
        int e = 0;
#pragma unroll 1
        for (int k = 1; k < 32; ++k) e = (rt >= tileoff[k]) ? k : e;
        u.e = e; u.tile = rt - tileoff[e]; u.slot0 = rt * 256; return true;
    }
    __device__ __forceinline__ const char* a_base(const Unit& u) const { if constexpr (GATHER) return wsbase; else return A + (size_t)u.slot0 * DEXP * 2; }
    __device__ __forceinline__ void a_voff(const Unit& u, int tid, unsigned (&v)[2][2]) const {
        if constexpr (GATHER) {
            asm volatile("" : "+v"(tid));
            const int n = cnt[u.e]; const int* rt = rowtok + (size_t)u.e * NTOK + u.tile * 256;
#pragma unroll
            for (int i = 0; i < 2; ++i) { int R, C; pg8::stage_rc(tid * 16 + i * 8192, R, C);
#pragma unroll
                for (int h = 0; h < 2; ++h) { const int r = h * 128 + R; const bool ok = (u.tile * 256 + r) < n; const int tok = ok ? rt[r] : 0;
                    v[h][i] = ok ? (unsigned)(WS_X + (size_t)tok * 2048 + C * 2) : (unsigned)(CTL_ZROW + C * 2); } }
        } else {
#pragma unroll
            for (int i = 0; i < 2; ++i) { int R, C; pg8::stage_rc(tid * 16 + i * 8192, R, C);
#pragma unroll
                for (int h = 0; h < 2; ++h) v[h][i] = (unsigned)((h * 128 + R) * DEXP + C) * 2u; }
        }
    }
    __device__ __forceinline__ size_t a_koff(int kt) const { return (size_t)kt * 128; }
    __device__ __forceinline__ const char* b_base(const Unit& u) const { return Bt + ((size_t)u.e * 1024 + u.pn * 256) * (KT * 64) * 2; }
};

struct EpiProj {
    static constexpr bool PERM = true, MIDK = false; bf16* O; unsigned char* GT;
    static __device__ __forceinline__ unsigned gq8_(float z) { return (unsigned)fmaxf(fsig_(z) * 255.0f + 0.5f, 1.0f); }
    __device__ __forceinline__ void operator()(const f32x4 (&acc)[2][2][4][2], const Unit& u, int wr, int wc, int fr, int fq) const {
        if (u.pn >= 26) {
            const int br = (u.pn - 26) >> 2, pq = (u.pn - 26) & 3; const int wave = wr * 4 + wc, lane = fq * 16 + fr;
            unsigned char* t = GT + (((size_t)(br * 136 + u.pm) * 4 + pq) << 16) + (size_t)(wave * 64 + lane) * 16;
#pragma unroll
            for (int ai = 0; ai < 2; ++ai)
#pragma unroll
                for (int m = 0; m < 4; ++m) { u32x4 w;
#pragma unroll
                    for (int bj = 0; bj < 2; ++bj) { const f32x4 v0 = acc[ai][bj][m][0], v1 = acc[ai][bj][m][1];
                        w[2 * bj] = gq8_(v0[0]) | (gq8_(v0[1]) << 8) | (gq8_(v0[2]) << 16) | (gq8_(v0[3]) << 24);
                        w[2 * bj + 1] = gq8_(v1[0]) | (gq8_(v1[1]) << 8) | (gq8_(v1[2]) << 16) | (gq8_(v1[3]) << 24); }
                    *(u32x4*)(t + (ai * 4 + m) * 8192) = w; }
            return;
        }
        bf16* base = O + (size_t)(u.pm * 256 + wr * 64 + fr) * LDP + u.pn * 256 + wc * 32 + 8 * fq;
#pragma unroll
        for (int ai = 0; ai < 2; ++ai)
#pragma unroll
            for (int m = 0; m < 4; ++m) { bf16* rowp = base + (size_t)(ai * 128 + m * 16) * LDP;
#pragma unroll
                for (int bj = 0; bj < 2; ++bj) { const f32x4 v0 = acc[ai][bj][m][0], v1 = acc[ai][bj][m][1];
                    u32x4 w; w.x = cvt_pk_bf16(v0[0], v0[1]); w.y = cvt_pk_bf16(v0[2], v0[3]); w.z = cvt_pk_bf16(v1[0], v1[1]); w.w = cvt_pk_bf16(v1[2], v1[3]);
                    *(u32x4*)(rowp + bj * 128) = w; } }
    }
};
struct EpiPlain {
    static constexpr bool PERM = true, MIDK = false; bf16* O;
    __device__ __forceinline__ void operator()(const f32x4 (&acc)[2][2][4][2], const Unit& u, int wr, int wc, int fr, int fq) const {
        bf16* base = O + (size_t)(u.pm * 256 + wr * 64 + fr) * 1024 + u.pn * 256 + wc * 32 + 8 * fq;
#pragma unroll
        for (int ai = 0; ai < 2; ++ai)
#pragma unroll
            for (int m = 0; m < 4; ++m) { bf16* rowp = base + (size_t)(ai * 128 + m * 16) * 1024;
#pragma unroll
                for (int bj = 0; bj < 2; ++bj) { const f32x4 v0 = acc[ai][bj][m][0], v1 = acc[ai][bj][m][1];
                    u32x4 w; w.x = cvt_pk_bf16(v0[0], v0[1]); w.y = cvt_pk_bf16(v0[2], v0[3]); w.z = cvt_pk_bf16(v1[0], v1[1]); w.w = cvt_pk_bf16(v1[2], v1[3]);
                    *(u32x4*)(rowp + bj * 128) = w; } }
    }
};
struct EpiMerge {
    static constexpr bool PERM = true, MIDK = true; const unsigned char* GT; bf16* O;
    __device__ __forceinline__ const unsigned char* tile(const Unit& u, int br, int wr, int wc, int fr, int fq) const {
        return GT + (((size_t)(br * 136 + u.pm) * 4 + u.pn) << 16) + (size_t)((wr * 4 + wc) * 64 + fq * 16 + fr) * 16; }
    static __device__ __forceinline__ float b8_(unsigned w, int k) { return (float)((w >> (8 * k)) & 0xffu); }
    __device__ __forceinline__ void mid(f32x4 (&acc)[2][2][4][2], const Unit& u, int t, int wr, int wc, int fr, int fq) const {
        const int br = (t == 16) ? 0 : 1; const unsigned char* ta = tile(u, br, wr, wc, fr, fq); const unsigned char* tb = tile(u, br + 1, wr, wc, fr, fq);
        u32x4 ga[8], gb[8];
#pragma unroll
        for (int j = 0; j < 8; ++j) { ga[j] = *(const u32x4*)(ta + 8192 * j); gb[j] = *(const u32x4*)(tb + 8192 * j); }
#pragma unroll
        for (int ai = 0; ai < 2; ++ai)
#pragma unroll
            for (int m = 0; m < 4; ++m)
#pragma unroll
                for (int bj = 0; bj < 2; ++bj)
#pragma unroll
                    for (int hw = 0; hw < 2; ++hw) { const unsigned wa = ga[ai * 4 + m][2 * bj + hw], wb = gb[ai * 4 + m][2 * bj + hw];
#pragma unroll
                        for (int k = 0; k < 4; ++k) acc[ai][bj][m][hw][k] *= b8_(wa, k) * __builtin_amdgcn_rcpf(b8_(wb, k)); }
    }
    __device__ __forceinline__ void operator()(const f32x4 (&acc)[2][2][4][2], const Unit& u, int wr, int wc, int fr, int fq) const {
        const unsigned char* tc = tile(u, 2, wr, wc, fr, fq);
        u32x4 gc[8];
#pragma unroll
        for (int j = 0; j < 8; ++j) gc[j] = *(const u32x4*)(tc + 8192 * j);
        const size_t row0 = (size_t)(u.pm * 256 + wr * 64 + fr); const int col0 = u.pn * 256 + wc * 32 + 8 * fq;
        constexpr float S = 1.0f / 255.0f;
#pragma unroll
        for (int ai = 0; ai < 2; ++ai)
#pragma unroll
            for (int m = 0; m < 4; ++m) { const size_t row = row0 + ai * 128 + m * 16;
#pragma unroll
                for (int bj = 0; bj < 2; ++bj) { const unsigned g0 = gc[ai * 4 + m][2 * bj], g1 = gc[ai * 4 + m][2 * bj + 1];
                    const f32x4 v0 = acc[ai][bj][m][0] * S, v1 = acc[ai][bj][m][1] * S; u32x4 w;
                    w.x = cvt_pk_bf16(v0[0] * b8_(g0, 0), v0[1] * b8_(g0, 1)); w.y = cvt_pk_bf16(v0[2] * b8_(g0, 2), v0[3] * b8_(g0, 3));
                    w.z = cvt_pk_bf16(v1[0] * b8_(g1, 0), v1[1] * b8_(g1, 1)); w.w = cvt_pk_bf16(v1[2] * b8_(g1, 2), v1[3] * b8_(g1, 3));
                    *(u32x4*)(O + row * 1024 + col0 + bj * 128) = w; } }
    }
};
struct EpiWo {
    static constexpr bool PERM = false, MIDK = false; float* h; float* hc; const float* mod; bool wen; const float* hsrc; const float* hcsrc;
    __device__ __forceinline__ void operator()(const f32x4 (&acc)[2][2][4][2], const Unit& u, int wr, int wc, int fr, int fq) const {
        const bool lat = u.pm < 128; const int mb = lat ? (u.pm >> 4) : 8;
        float* hb = lat ? h + (size_t)u.pm * 256 * 1024 : hc + (size_t)(u.pm - 128) * 256 * 1024;
        const float* sb = lat ? hsrc + (size_t)u.pm * 256 * 1024 : hcsrc + (size_t)(u.pm - 128) * 256 * 1024;
        const int col0 = u.pn * 256 + wc * 32 + 4 * fq; const float* mp = mod + (size_t)mb * 6144 + 2 * 1024 + col0;
        f32x4 mv[2][2];
#pragma unroll
        for (int bj = 0; bj < 2; ++bj)
#pragma unroll
            for (int n = 0; n < 2; ++n) mv[bj][n] = *(const f32x4*)(mp + bj * 128 + n * 16);
#pragma unroll
        for (int ai = 0; ai < 2; ++ai)
#pragma unroll
            for (int m = 0; m < 4; ++m) { const size_t ro = (size_t)(ai * 128 + wr * 64 + m * 16 + fr) * 1024 + col0; float* rowp = hb + ro; const float* srcp = sb + ro;
#pragma unroll
                for (int bj = 0; bj < 2; ++bj)
#pragma unroll
                    for (int n = 0; n < 2; ++n) { f32x4 hv = *(const f32x4*)(srcp + bj * 128 + n * 16); hv = hv + mv[bj][n] * acc[ai][bj][m][n]; if (wen) *(f32x4*)(rowp + bj * 128 + n * 16) = hv; } }
    }
};
struct EpiGU {
    static constexpr bool PERM = true, MIDK = false; bf16* H;
    __device__ __forceinline__ void operator()(const f32x4 (&acc)[2][2][4][2], const MUnit& u, int wr, int wc, int fr, int fq) const {
        bf16* base = H + (size_t)(u.slot0 + wr * 64 + fr) * DEXP + u.pn * 128 + wc * 32 + 8 * fq;
#pragma unroll
        for (int ai = 0; ai < 2; ++ai)
#pragma unroll
            for (int m = 0; m < 4; ++m) { const f32x4 g0 = acc[ai][0][m][0], g1 = acc[ai][0][m][1], u0 = acc[ai][1][m][0], u1 = acc[ai][1][m][1]; u32x4 w;
                w.x = cvt_pk_bf16(fsilu_(g0[0]) * u0[0], fsilu_(g0[1]) * u0[1]); w.y = cvt_pk_bf16(fsilu_(g0[2]) * u0[2], fsilu_(g0[3]) * u0[3]);
                w.z = cvt_pk_bf16(fsilu_(g1[0]) * u1[0], fsilu_(g1[1]) * u1[1]); w.w = cvt_pk_bf16(fsilu_(g1[2]) * u1[2], fsilu_(g1[3]) * u1[3]);
                *(u32x4*)(base + (size_t)(ai * 128 + m * 16) * DEXP) = w; }
    }
};
struct EpiDN {
    static constexpr bool PERM = true, MIDK = false; bf16* Y;
    __device__ __forceinline__ void operator()(const f32x4 (&acc)[2][2][4][2], const MUnit& u, int wr, int wc, int fr, int fq) const {
        bf16* base = Y + (size_t)(u.slot0 + wr * 64 + fr) * 1024 + u.pn * 256 + wc * 32 + 8 * fq;
#pragma unroll
        for (int ai = 0; ai < 2; ++ai)
#pragma unroll
            for (int m = 0; m < 4; ++m) { bf16* rowp = base + (size_t)(ai * 128 + m * 16) * 1024;
#pragma unroll
                for (int bj = 0; bj < 2; ++bj) { const f32x4 v0 = acc[ai][bj][m][0], v1 = acc[ai][bj][m][1];
                    u32x4 w; w.x = cvt_pk_bf16(v0[0], v0[1]); w.y = cvt_pk_bf16(v0[2], v0[3]); w.z = cvt_pk_bf16(v1[0], v1[1]); w.w = cvt_pk_bf16(v1[2], v1[3]);
                    *(u32x4*)(rowp + bj * 128) = w; } }
    }
};
}
struct Args { const float* in[30]; float* out; unsigned char* ws; int ph_lo, ph_hi; };
enum { I_X = 0, I_C, I_CTX, I_CCTX, I_WMOD, I_BMOD, I_N1G, I_N2G, I_WIN, I_CONVW, I_CONVB, I_WA, I_BA, I_WX, I_BX, I_LAM, I_RLAM, I_SINK,
       I_WBA, I_WBB, I_WBC, I_WOUT, I_RGW, I_RGB, I_REW, I_REB, I_EWG, I_EWU, I_EWD, I_FNG };
typedef const GAS float* cfp_t;
struct Frame {
    LAS unsigned char* lds; int tid, lane, wave, G, bid, gw, NGW; bool wr;
    const __attribute__((address_space(4))) cfp_t* in; float* out; unsigned char* ws;
};
#define FIN(i)     ((const float*)F.in[i])
#define F_MOD(F)   ((float*)((F).ws + WS_MOD))
#define F_HC(F)    ((float*)((F).ws + WS_HC))
#define F_X(F)     ((bf16*)((F).ws + WS_X))
#define F_PROJ(F)  ((bf16*)((F).ws + WS_PROJ))
#define F_YB(F)    ((bf16*)((F).ws + WS_YB))
#define F_CNT(F)   ((int*)((F).ws + WS_CTL) + CW_CNT)

__device__ __forceinline__ void ph_prologue(Frame& F) {
    LAS float* sc = (LAS float*)F.lds;
    LAS float* part = (LAS float*)(F.lds + 40960);
    for (int i = F.tid; i < 9 * 1024; i += 512) { const int mb = i >> 10, k = i & 1023; const float cv = mb < 8 ? FIN(I_C)[mb * 1024 + k] : FIN(I_CCTX)[k]; sc[i] = siluf_(cv); }
    __syncthreads();
    for (int item = F.bid; item < 4 * 96; item += F.G) {
        const int l = item / 96, n0 = (item % 96) * 64;
        const float* wp = FIN(I_WMOD) + ((size_t)l * 1024 + F.wave * 128) * 6144 + n0 + F.lane;
        float acc[9];
#pragma unroll
        for (int mb = 0; mb < 9; ++mb) acc[mb] = 0.f;
#pragma unroll 32
        for (int k = 0; k < 128; ++k) { const float wv = wp[(size_t)k * 6144];
#pragma unroll
            for (int mb = 0; mb < 9; ++mb) acc[mb] += sc[mb * 1024 + F.wave * 128 + k] * wv; }
#pragma unroll
        for (int mb = 0; mb < 9; ++mb) part[(F.wave * 9 + mb) * 64 + F.lane] = acc[mb];
        __syncthreads();
        for (int t = F.tid; t < 576; t += 512) { const int mb = t >> 6, ln = t & 63; float s = FIN(I_BMOD)[l * 6144 + n0 + ln];
#pragma unroll
            for (int w = 0; w < 8; ++w) s += part[(w * 9 + mb) * 64 + ln];
            F_MOD(F)[((size_t)l * 9 + mb) * 6144 + n0 + ln] = s; }
        __syncthreads();
    }
    f32x2* rt = (f32x2*)(F.ws + WS_ROPE);
    for (int i = F.bid * 512 + F.tid; i < 4096 * 32; i += F.G * 512) { const int pos = i >> 5, f = i & 31;
        const float inv = (float)pow(10000.0, -(double)(2 * f) / 64.0); const float ang = (float)pos * inv;
        rt[i] = (f32x2){(float)cos((double)ang), (float)sin((double)ang)}; }
    f32x2* at = (f32x2*)(F.ws + WS_ROPE + 1 * MiB);
    for (int i = F.bid * 512 + F.tid; i < 64 * 16; i += F.G * 512) { const int pos = i >> 4, f = i & 15;
        const float inv = (float)pow(10000.0, -(double)(2 * f) / 32.0); const float ang = (float)pos * inv;
        at[i] = (f32x2){(float)cos((double)ang), (float)sin((double)ang)}; }
}

__device__ __forceinline__ void tr_item(const float* W, int ldw, int k0, int n0, bf16* dst  , int ldk, LAS float* scr, int lane) {
    float wv[32];
#pragma unroll
    for (int i = 0; i < 32; ++i) { const int kk = 2 * i + (lane >> 5); wv[i] = W[(size_t)(k0 + kk) * ldw + n0 + (lane & 31)]; }
#pragma unroll
    for (int i = 0; i < 32; ++i) { const int kk = 2 * i + (lane >> 5); scr[kk * 33 + (lane & 31)] = wv[i]; }
    LDS_WAIT(); asm volatile("" ::: "memory");
    const int c = lane & 7;
#pragma unroll
    for (int j = 0; j < 4; ++j) { const int n = (lane >> 3) + 8 * j; const LAS float* s = scr + (8 * c) * 33 + n;
        u32x4 o; o.x = pk2(s[0 * 33], s[1 * 33]); o.y = pk2(s[2 * 33], s[3 * 33]); o.z = pk2(s[4 * 33], s[5 * 33]); o.w = pk2(s[6 * 33], s[7 * 33]);
        *(u32x4*)(dst + (size_t)n * ldk + 8 * c) = o; }
    LDS_WAIT(); asm volatile("" ::: "memory");
}
__device__ __forceinline__ void ph_convert(Frame& F, int l) {
    LAS float* scr = (LAS float*)(F.lds + F.wave * 16384);
    bf16* wt = (bf16*)(F.ws + WS_WT);
    constexpr int I_IN = 16 * 304, I_BRN = 16 * 32, I_GU1 = 16 * 16, I_DN1 = 8 * 32;
    constexpr int NITEMS = I_IN + 4 * I_BRN + 32 * 2 * I_GU1 + 32 * I_DN1;
    for (int it = F.gw; it < NITEMS; it += F.NGW) {
        int r = it;
        if (r < I_IN) { const int kb = r / 304, nb = r % 304; tr_item(FIN(I_WIN) + (size_t)l * 1024 * DIN, DIN, 64 * kb, 32 * nb, wt + WT_IN / 2 + (size_t)(32 * nb) * 1024 + 64 * kb, 1024, scr, F.lane); continue; }
        r -= I_IN;
        if (r < 3 * I_BRN) { const int br = r / I_BRN, q = r % I_BRN, kb = q / 32, nb = q % 32; const float* W = FIN(I_WBA + br) + (size_t)l * 1024 * 1024;
            tr_item(W, 1024, 64 * kb, 32 * nb, wt + WT_BR / 2 + (size_t)(32 * nb) * 3072 + br * 1024 + 64 * kb, 3072, scr, F.lane); continue; }
        r -= 3 * I_BRN;
        if (r < I_BRN) { const int kb = r / 32, nb = r % 32; tr_item(FIN(I_WOUT) + (size_t)l * 1024 * 1024, 1024, 64 * kb, 32 * nb, wt + WT_WO / 2 + (size_t)(32 * nb) * 1024 + 64 * kb, 1024, scr, F.lane); continue; }
        r -= I_BRN;
        if (r < 32 * 2 * I_GU1) { const int e = r / (2 * I_GU1), q = r % (2 * I_GU1), up = q / I_GU1, q2 = q % I_GU1, kb = q2 / 16, nb = q2 % 16;
            const float* W = FIN(up ? I_EWU : I_EWG) + ((size_t)l * 32 + e) * 1024 * 512; const int n0 = 32 * nb;
            const int drow = e * 1024 + (n0 >> 7) * 256 + up * 128 + (n0 & 127);
            tr_item(W, 512, 64 * kb, n0, wt + WT_GU / 2 + (size_t)drow * 1024 + 64 * kb, 1024, scr, F.lane); continue; }
        r -= 32 * 2 * I_GU1;
        { const int e = r / I_DN1, q = r % I_DN1, kb = q / 32, nb = q % 32; const float* W = FIN(I_EWD) + ((size_t)l * 32 + e) * 512 * 1024;
            tr_item(W, 1024, 64 * kb, 32 * nb, wt + WT_DN / 2 + (size_t)(e * 1024 + 32 * nb) * 512 + 64 * kb, 512, scr, F.lane); }
    }
}
constexpr size_t RW_ELEMS = (size_t)4 * 9 * 48 * 1024;
__device__ __forceinline__ void ph_router_fold(Frame& F) {
    float* Wp = (float*)(F.ws + WS_RW); float* rc = Wp + RW_ELEMS;
    for (int i = F.bid * 512 + F.tid; i < (int)RW_ELEMS; i += F.G * 512) {
        const int k = i & 1023, j = (i >> 10) % 48, mb = (i / (48 * 1024)) % 9, l = i / (48 * 1024 * 9);
        float v = 0.f;
        if (j < RCOLS) { const float w = j < 4 ? FIN(I_RGW)[((size_t)l * 1024 + k) * 4 + j] : FIN(I_REW)[((size_t)l * 1024 + k) * 32 + (j - 4)];
            v = FIN(I_N2G)[l * 1024 + k] * (1.0f + F_MOD(F)[((size_t)l * 9 + mb) * 6144 + 4 * 1024 + k]) * w; }
        Wp[i] = v;
    }
    for (int it = F.gw; it < 4 * 9 * RCOLS; it += F.NGW) { const int j = it % RCOLS, mb = (it / RCOLS) % 9, l = it / (RCOLS * 9);
        float s = 0.f;
        for (int k = F.lane; k < 1024; k += 64) { const float w = j < 4 ? FIN(I_RGW)[((size_t)l * 1024 + k) * 4 + j] : FIN(I_REW)[((size_t)l * 1024 + k) * 32 + (j - 4)];
            s += F_MOD(F)[((size_t)l * 9 + mb) * 6144 + 3 * 1024 + k] * w; }
        s = wave_sum(s);
        if (F.lane == 0) rc[(l * 9 + mb) * 64 + j] = s + (j < 4 ? FIN(I_RGB)[l * 4 + j] : FIN(I_REB)[l * 32 + (j - 4)]);
    }
}

struct RowJob { const float* src; float* copy_to; int mb; };
template <class RowFn> __device__ __forceinline__ void rows_norm_loop(Frame& F, int row0, int nrows, int w, int NW, const float* gain, const float* mod, int shift_i, int scale_i, bf16* dst, RowFn rowfn) {
    const int lane = F.lane;
    f32x4 nv[4]; RowJob nj = {nullptr, nullptr, 0};
    int r = row0 + w;
    if (r < nrows) { nj = rowfn(r);
#pragma unroll
        for (int j = 0; j < 4; ++j) nv[j] = *(const f32x4*)(nj.src + 4 * lane + 256 * j); }
    for (; r < nrows; r += NW) {
        f32x4 v[4]; const RowJob cj = nj;
#pragma unroll
        for (int j = 0; j < 4; ++j) v[j] = nv[j];
        const int rn = r + NW;
        if (rn < nrows) { nj = rowfn(rn);
#pragma unroll
            for (int j = 0; j < 4; ++j) nv[j] = *(const f32x4*)(nj.src + 4 * lane + 256 * j); }
        f32x4 g[4], sh[4], sc[4];
#pragma unroll
        for (int j = 0; j < 4; ++j) { g[j] = *(const f32x4*)(gain + 4 * lane + 256 * j); sh[j] = *(const f32x4*)(mod + cj.mb * 6144 + shift_i * 1024 + 4 * lane + 256 * j); sc[j] = *(const f32x4*)(mod + cj.mb * 6144 + scale_i * 1024 + 4 * lane + 256 * j); }
        float ss = 0.f;
#pragma unroll
        for (int j = 0; j < 4; ++j) ss += (v[j].x * v[j].x + v[j].y * v[j].y) + (v[j].z * v[j].z + v[j].w * v[j].w);
        if (cj.copy_to) {
#pragma unroll
            for (int j = 0; j < 4; ++j) *(f32x4*)(cj.copy_to + 4 * lane + 256 * j) = v[j]; }
        const float rstd = 1.0f / sqrtf(wave_sum(ss) * (1.0f / 1024.0f) + EPS);
#pragma unroll
        for (int j = 0; j < 4; ++j) { const f32x4 y = (v[j] * rstd) * g[j] * (sc[j] + 1.0f) + sh[j];
            u32x2 w; w.x = pk2(y.x, y.y); w.y = pk2(y.z, y.w); *(u32x2*)(dst + (size_t)r * 1024 + 4 * lane + 256 * j) = w; }
    }
}
__device__ __forceinline__ void ph_rows_u(Frame& F, int l, bool first) {
    const float* mod = F_MOD(F) + (size_t)l * 9 * 6144; const float* g = FIN(I_N1G) + l * 1024;
    float* out = F.out; float* hc = F_HC(F); const float* xin = FIN(I_X); const float* cin = FIN(I_CTX);
    rows_norm_loop(F, 0, NTOK, F.gw, F.NGW, g, mod, 0, 1, F_X(F), [=](int r) { const bool lat = r < NLAT; RowJob j; j.mb = lat ? (r >> 12) : 8;
        float* hrow = lat ? out + (size_t)r * 1024 : hc + (size_t)(r - NLAT) * 1024;
        j.src = first ? (lat ? xin + (size_t)r * 1024 : cin + (size_t)(r - NLAT) * 1024) : hrow; j.copy_to = nullptr; return j; });
}
__device__ __forceinline__ void ph_rows_v(Frame& F, int l, int row0, int ntok, int w, int NW) {
    const float* mod = F_MOD(F) + (size_t)l * 9 * 6144; const float* g = FIN(I_N2G) + l * 1024;
    float* out = F.out; float* hc = F_HC(F);
    rows_norm_loop(F, row0, ntok, w, NW, g, mod, 3, 4, F_X(F), [=](int r) { const bool lat = r < NLAT; RowJob j; j.mb = lat ? (r >> 12) : 8;
        j.src = lat ? out + (size_t)r * 1024 : hc + (size_t)(r - NLAT) * 1024; j.copy_to = nullptr; return j; });
}

__device__ __forceinline__ void ph_router(Frame& F, int l, int bt0, int bt1, int c, int G) {
    LAS float* Bs = (LAS float*)F.lds;
    LAS float* lgs = (LAS float*)(F.lds + 53248 + F.wave * 4096);
    const float* WpL = (const float*)(F.ws + WS_RW) + (size_t)l * 9 * 48 * 1024; const float* rcL = (const float*)(F.ws + WS_RW) + RW_ELEMS + l * 9 * 64;
    int* cnt = F_CNT(F) + l * 32; int* rowtok = (int*)(F.ws + WS_ROWTOK); unsigned* tinfo = (unsigned*)(F.ws + WS_TOKINFO);
    const int lane = F.lane, i16 = lane & 15, kq = lane >> 4, tid = F.tid;
    const int ntask = bt1 - bt0, nfull = (ntask / G) * G, rem = ntask - nfull;
    const int rtok0 = (bt0 + nfull) * 128, rtok1 = bt1 * 128 - 1;
    const bool minis = rem > 0 && ((rtok0 < NLAT ? (rtok0 >> 12) : 8) == (rtok1 < NLAT ? (rtok1 >> 12) : 8));
    const int npass = nfull / G + (rem > 0 ? (minis ? 1 : (c < rem ? 1 : 0)) : 0);
    for (int ps_ = 0; ps_ < npass; ++ps_) {
        const bool mini = minis && ps_ == nfull / G;
        const int mt = c + G * F.wave;
        const bool active = !mini || mt < rem * 8;
        const int tok0 = mini ? (active ? rtok0 + mt * 16 : rtok0) : (bt0 + c + ps_ * G) * 128 + F.wave * 16; const bool lat = tok0 < NLAT; const int mb = lat ? (tok0 >> 12) : 8;
        const float* hrow = (lat ? F.out + (size_t)(tok0 + i16) * 1024 : F_HC(F) + (size_t)(tok0 + i16 - NLAT) * 1024) + 4 * kq;
        const float* wsrc = WpL + (size_t)mb * 48 * 1024;
        f32x4 acc[3]; float ss = 0.f;
#pragma unroll
        for (int c = 0; c < 3; ++c) acc[c] = (f32x4){0.f, 0.f, 0.f, 0.f};
        f32x4 bnext[6];
#pragma unroll
        for (int j = 0; j < 6; ++j) { const int i = tid + 512 * j; bnext[j] = *(const f32x4*)(wsrc + (size_t)(i >> 6) * 1024 + 4 * (i & 63)); }
        f32x4 an[16];
        if (active) {
#pragma unroll
            for (int S = 0; S < 16; ++S) an[S] = *(const f32x4*)(hrow + 16 * S); }
#pragma unroll 1
        for (int kc = 0; kc < 4; ++kc) {
            LDS_BARRIER();
#pragma unroll
            for (int j = 0; j < 6; ++j) { const int i = tid + 512 * j; *(LAS f32x4*)(Bs + (i >> 6) * 260 + 4 * (i & 63)) = bnext[j]; }
            LDS_BARRIER();
            if (kc < 3) {
#pragma unroll
                for (int j = 0; j < 6; ++j) { const int i = tid + 512 * j; bnext[j] = *(const f32x4*)(wsrc + (size_t)(i >> 6) * 1024 + (kc + 1) * 256 + 4 * (i & 63)); } }
            const LAS float* bp = Bs + i16 * 260 + 4 * kq;
            f32x4 ac[16];
#pragma unroll
            for (int S = 0; S < 16; ++S) ac[S] = an[S];
            if (active && kc < 3) {
#pragma unroll
                for (int S = 0; S < 16; ++S) an[S] = *(const f32x4*)(hrow + (kc + 1) * 256 + 16 * S); }
            if (active)
#pragma unroll
            for (int S = 0; S < 16; ++S) {
                const f32x4 a = ac[S];
                const f32x4 b0 = *(const LAS f32x4*)(bp + 16 * S), b1 = *(const LAS f32x4*)(bp + 16 * 260 + 16 * S), b2 = *(const LAS f32x4*)(bp + 32 * 260 + 16 * S);
                ss += (a.x * a.x + a.y * a.y) + (a.z * a.z + a.w * a.w);
#pragma unroll
                for (int s = 0; s < 4; ++s) { acc[0] = __builtin_amdgcn_mfma_f32_16x16x4f32(a[s], b0[s], acc[0], 0, 0, 0); acc[1] = __builtin_amdgcn_mfma_f32_16x16x4f32(a[s], b1[s], acc[1], 0, 0, 0);
                    acc[2] = __builtin_amdgcn_mfma_f32_16x16x4f32(a[s], b2[s], acc[2], 0, 0, 0); }
            }
        }
        if (active) {
        ss += __shfl_xor(ss, 16); ss += __shfl_xor(ss, 32);
#pragma unroll
        for (int c = 0; c < 3; ++c)
#pragma unroll
            for (int r = 0; r < 4; ++r) lgs[(4 * kq + r) * 52 + 16 * c + i16] = acc[c][r];
        LDS_WAIT(); asm volatile("" ::: "memory");
        const float rstd = 1.0f / sqrtf(ss * (1.0f / 1024.0f) + EPS);
        float lg[RCOLS];
#pragma unroll
        for (int j4 = 0; j4 < RCOLS / 4; ++j4) { const f32x4 v = *(const LAS f32x4*)(lgs + i16 * 52 + 4 * j4); const f32x4 rcv = *(const f32x4*)(rcL + mb * 64 + 4 * j4);
            lg[4 * j4] = v.x * rstd + rcv.x; lg[4 * j4 + 1] = v.y * rstd + rcv.y; lg[4 * j4 + 2] = v.z * rstd + rcv.z; lg[4 * j4 + 3] = v.w * rstd + rcv.w; }
        LDS_WAIT(); asm volatile("" ::: "memory");
        const int tok = tok0 + i16;
        int g = 0; float gm = lg[0];
#pragma unroll
        for (int j = 1; j < 4; ++j) if (lg[j] > gm) { gm = lg[j]; g = j; }
        float gs = 0.f;
#pragma unroll
        for (int j = 0; j < 4; ++j) gs += __expf(lg[j] - gm);
        const float g_w = 1.0f / gs;
        float el[8];
#pragma unroll
        for (int i = 0; i < 8; ++i) { el[i] = lg[4 + i];
#pragma unroll
            for (int gg = 1; gg < 4; ++gg) el[i] = (g == gg) ? lg[4 + gg * 8 + i] : el[i]; }
        int i1 = 0; float m1 = el[0];
#pragma unroll
        for (int i = 1; i < 8; ++i) if (el[i] > m1) { m1 = el[i]; i1 = i; }
        int i2 = -1; float m2 = -3.0e38f;
#pragma unroll
        for (int i = 0; i < 8; ++i) if (i != i1 && el[i] > m2) { m2 = el[i]; i2 = i; }
        const float p2 = __expf(m2 - m1); const float w1 = g_w / (1.0f + p2), w2 = g_w * p2 / (1.0f + p2);
        const int e1 = g * 8 + i1, e2 = g * 8 + i2;
        int r1 = 0, r2 = 0;
        { unsigned long long todo = 0xFFFFull;
          while (todo) { const int ld = __builtin_ctzll(todo); const int x = __shfl(e1, ld); const unsigned long long m = __ballot(e1 == x) & todo;
              int base = 0; if (lane == ld && F.wr) base = atomicAdd(&cnt[x], (int)__builtin_popcountll(m)); base = __shfl(base, ld);
              if (e1 == x) r1 = base + (int)__builtin_popcountll(m & ((1ull << lane) - 1ull)); todo &= ~m; } }
        { unsigned long long todo = 0xFFFFull;
          while (todo) { const int ld = __builtin_ctzll(todo); const int x = __shfl(e2, ld); const unsigned long long m = __ballot(e2 == x) & todo;
              int base = 0; if (lane == ld && F.wr) base = atomicAdd(&cnt[x], (int)__builtin_popcountll(m)); base = __shfl(base, ld);
              if (e2 == x) r2 = base + (int)__builtin_popcountll(m & ((1ull << lane) - 1ull)); todo &= ~m; } }
        if (lane < 16 && F.wr) { rowtok[(size_t)e1 * NTOK + r1] = tok; rowtok[(size_t)e2 * NTOK + r2] = tok;
            u32x4 a; a.x = (unsigned)e1; a.y = (unsigned)r1; a.z = (unsigned)e2; a.w = (unsigned)r2;
            *(u32x4*)(tinfo + (size_t)tok * 8) = a; *(f32x2*)(tinfo + (size_t)tok * 8 + 4) = (f32x2){w1, w2}; }
        }
    }
}
__device__ __forceinline__ void moe_tables(Frame& F, int l, volatile LAS int*& tileoff, volatile LAS int*& cntl) {
    volatile LAS int* t = (volatile LAS int*)(F.lds + LDS_CTL + 512); cntl = t; tileoff = t + 32;
    if (F.tid < 32) t[F.tid] = __hip_atomic_load(F_CNT(F) + l * 32 + F.tid, __ATOMIC_RELAXED, __HIP_MEMORY_SCOPE_AGENT);
    __syncthreads();
    if (F.tid == 0) { int s = 0;
#pragma unroll 1
        for (int e = 0; e < 32; ++e) { t[32 + e] = s; s += (t[e] + 255) >> 8; } t[64] = s; }
    __syncthreads();
}
__device__ __forceinline__ void ph_combine(Frame& F, int l, int ntok) {
    volatile LAS int* tileoff; volatile LAS int* cntl; moe_tables(F, l, tileoff, cntl);
    const float* mod = F_MOD(F) + (size_t)l * 9 * 6144; const bool lastl = (l == DEPTH - 1);
    const float* modn = F_MOD(F) + (size_t)(lastl ? l : l + 1) * 9 * 6144; const float* gn = lastl ? FIN(I_FNG) : FIN(I_N1G) + (l + 1) * 1024;
    const bf16* Y = (const bf16*)(F.ws + WS_YROWS); const unsigned* tinfo = (const unsigned*)(F.ws + WS_TOKINFO);
    const int lane = F.lane;
    u32x4 ninf = (u32x4){0u, 0u, 0u, 0u}, n2inf = ninf; f32x2 nwv = (f32x2){0.f, 0.f}, n2wv = nwv; f32x4 nh[4]; u32x2 nya[4], nyb[4];
    const int per = (ntok + F.NGW - 1) / F.NGW; int r = F.gw * per; const int rend = (r + per < ntok) ? r + per : ntok;
#define CMB_HROW(rr) ((rr) < NLAT ? F.out + (size_t)(rr) * 1024 : F_HC(F) + (size_t)((rr) - NLAT) * 1024)
#define CMB_LOAD_ROW(rr) do { const float* hp_ = CMB_HROW(rr); \
        const bf16* y1_ = Y + ((size_t)tileoff[ninf.x] * 256 + ninf.y) * 1024; const bf16* y2_ = Y + ((size_t)tileoff[ninf.z] * 256 + ninf.w) * 1024; \
        _Pragma("unroll") for (int j = 0; j < 4; ++j) { nh[j] = *(const f32x4*)(hp_ + 4 * lane + 256 * j); nya[j] = *(const u32x2*)(y1_ + 4 * lane + 256 * j); nyb[j] = *(const u32x2*)(y2_ + 4 * lane + 256 * j); } } while (0)
    if (r < rend) { ninf = *(const u32x4*)(tinfo + (size_t)r * 8); nwv = *(const f32x2*)(tinfo + (size_t)r * 8 + 4);
        if (r + 1 < rend) { n2inf = *(const u32x4*)(tinfo + (size_t)(r + 1) * 8); n2wv = *(const f32x2*)(tinfo + (size_t)(r + 1) * 8 + 4); }
        CMB_LOAD_ROW(r); }
    int mbc = -1; f32x4 cm5[4], cgs[4], csh[4];
    for (; r < rend; ++r) {
        const f32x2 wv = nwv; f32x4 hv[4]; u32x2 ya[4], yb[4];
#pragma unroll
        for (int j = 0; j < 4; ++j) { hv[j] = nh[j]; ya[j] = nya[j]; yb[j] = nyb[j]; }
        const bool lat = r < NLAT; const int mb = lat ? (r >> 12) : 8; float* hrow = CMB_HROW(r);
        if (r + 1 < rend) { ninf = n2inf; nwv = n2wv; CMB_LOAD_ROW(r + 1); }
        if (r + 2 < rend) { n2inf = *(const u32x4*)(tinfo + (size_t)(r + 2) * 8); n2wv = *(const f32x2*)(tinfo + (size_t)(r + 2) * 8 + 4); }
        if (mb != mbc) { mbc = mb;
#pragma unroll
            for (int j = 0; j < 4; ++j) { const int c = 4 * lane + 256 * j; cm5[j] = *(const f32x4*)(mod + mb * 6144 + 5 * 1024 + c); const f32x4 g = *(const f32x4*)(gn + c);
                if (lastl) { cgs[j] = g; csh[j] = (f32x4){0.f, 0.f, 0.f, 0.f}; }
                else { cgs[j] = g * (*(const f32x4*)(modn + mb * 6144 + 1024 + c) + 1.0f); csh[j] = *(const f32x4*)(modn + mb * 6144 + c); } } }
        f32x4 v[4]; float ss = 0.f;
#pragma unroll
        for (int j = 0; j < 4; ++j) { const u32x2 a = ya[j], b = yb[j];
            f32x4 y; y.x = wv.x * bflo(a.x) + wv.y * bflo(b.x); y.y = wv.x * bfhi(a.x) + wv.y * bfhi(b.x); y.z = wv.x * bflo(a.y) + wv.y * bflo(b.y); y.w = wv.x * bfhi(a.y) + wv.y * bfhi(b.y);
            v[j] = hv[j] + cm5[j] * y; ss += (v[j].x * v[j].x + v[j].y * v[j].y) + (v[j].z * v[j].z + v[j].w * v[j].w); }
        const float rstd = 1.0f / sqrtf(wave_sum(ss) * (1.0f / 1024.0f) + EPS);
        if (lastl) {
#pragma unroll
            for (int j = 0; j < 4; ++j) { const int c = 4 * lane + 256 * j; if (F.wr) *(f32x4*)(hrow + c) = (v[j] * rstd) * cgs[j]; }
        } else {
#pragma unroll
            for (int j = 0; j < 4; ++j) { const int c = 4 * lane + 256 * j; if (F.wr) *(f32x4*)(hrow + c) = v[j];
                const f32x4 y = (v[j] * rstd) * cgs[j] + csh[j]; u32x2 w; w.x = pk2(y.x, y.y); w.y = pk2(y.z, y.w); if (F.wr) *(u32x2*)(F_X(F) + (size_t)r * 1024 + c) = w; }
        }
    }
#undef CMB_LOAD_ROW
#undef CMB_HROW
}
#define MFMA16(a, b, c) __builtin_amdgcn_mfma_f32_16x16x32_bf16((a), (b), (c), 0, 0, 0)
__device__ __forceinline__ bf16x8 ldfrag(const LAS bf16* base, int row0, int k0, int ld, int lane) {
    return *(const LAS bf16x8*)(base + (row0 + (lane & 15)) * ld + k0 + 8 * (lane >> 4));
}
__device__ __forceinline__ float fast_sigmoid(float x) { return __builtin_amdgcn_rcpf(1.0f + __builtin_amdgcn_exp2f(-1.4426950408889634f * x)); }
__device__ __forceinline__ float fast_gelu_tanh(float x) {
    const float u2 = 1.5957691216057308f * (x + 0.044715f * x * x * x);
    return x * __builtin_amdgcn_rcpf(1.0f + __builtin_amdgcn_exp2f(-1.4426950408889634f * u2));
}

__device__ __forceinline__ void att_rope8(const f32x2* tab, const float (&x1)[8], const float (&x2)[8], float (&o1)[8], float (&o2)[8]) {
#pragma unroll
    for (int e = 0; e < 8; ++e) { const f32x2 cs = tab[e]; o1[e] = x1[e] * cs.x - x2[e] * cs.y; o2[e] = x2[e] * cs.x + x1[e] * cs.y; }
}
__device__ __forceinline__ void unpack8(const u32x4 a, float (&x)[8]) { x[0] = bflo(a.x); x[1] = bfhi(a.x); x[2] = bflo(a.y); x[3] = bfhi(a.y); x[4] = bflo(a.z); x[5] = bfhi(a.z); x[6] = bflo(a.w); x[7] = bfhi(a.w); }
__device__ __forceinline__ u32x4 pack8(const float (&x)[8], float s) { u32x4 r; r.x = pk2(x[0] * s, x[1] * s); r.y = pk2(x[2] * s, x[3] * s); r.z = pk2(x[4] * s, x[5] * s); r.w = pk2(x[6] * s, x[7] * s); return r; }

template <int RS> __device__ __forceinline__ void tr_frags4(unsigned addr, bf16x8 (&f)[4]) {
    u32x2 a0, a1, b0, b1, c0, c1, d0, d1;
    asm volatile("ds_read_b64_tr_b16 %0, %8\n\tds_read_b64_tr_b16 %1, %8 offset:%9\n\tds_read_b64_tr_b16 %2, %8 offset:32\n\tds_read_b64_tr_b16 %3, %8 offset:%10\n\t"
                 "ds_read_b64_tr_b16 %4, %8 offset:64\n\tds_read_b64_tr_b16 %5, %8 offset:%11\n\tds_read_b64_tr_b16 %6, %8 offset:96\n\tds_read_b64_tr_b16 %7, %8 offset:%12\n\ts_waitcnt lgkmcnt(0)"
                 : "=&v"(a0), "=&v"(a1), "=&v"(b0), "=&v"(b1), "=&v"(c0), "=&v"(c1), "=&v"(d0), "=&v"(d1)
                 : "v"(addr), "i"(4 * RS), "i"(32 + 4 * RS), "i"(64 + 4 * RS), "i"(96 + 4 * RS) : "memory");
    u32x4 t; t.x = a0.x; t.y = a0.y; t.z = a1.x; t.w = a1.y; f[0] = __builtin_bit_cast(bf16x8, t);
    t.x = b0.x; t.y = b0.y; t.z = b1.x; t.w = b1.y; f[1] = __builtin_bit_cast(bf16x8, t);
    t.x = c0.x; t.y = c0.y; t.z = c1.x; t.w = c1.y; f[2] = __builtin_bit_cast(bf16x8, t);
    t.x = d0.x; t.y = d0.y; t.z = d1.x; t.w = d1.y; f[3] = __builtin_bit_cast(bf16x8, t);
}


__device__ __forceinline__ float xor16_max(float x) { const unsigned xi = __builtin_bit_cast(unsigned, x); const auto r = __builtin_amdgcn_permlane16_swap(xi, xi, false, false); return fmaxf(__builtin_bit_cast(float, (unsigned)r[0]), __builtin_bit_cast(float, (unsigned)r[1])); }
__device__ __forceinline__ float xor32_max(float x) { const unsigned xi = __builtin_bit_cast(unsigned, x); const auto r = __builtin_amdgcn_permlane32_swap(xi, xi, false, false); return fmaxf(__builtin_bit_cast(float, (unsigned)r[0]), __builtin_bit_cast(float, (unsigned)r[1])); }
__device__ __forceinline__ float xor16_sum(float x) { const unsigned xi = __builtin_bit_cast(unsigned, x); const auto r = __builtin_amdgcn_permlane16_swap(xi, xi, false, false); return __builtin_bit_cast(float, (unsigned)r[0]) + __builtin_bit_cast(float, (unsigned)r[1]); }
__device__ __forceinline__ float xor32_sum(float x) { const unsigned xi = __builtin_bit_cast(unsigned, x); const auto r = __builtin_amdgcn_permlane32_swap(xi, xi, false, false); return __builtin_bit_cast(float, (unsigned)r[0]) + __builtin_bit_cast(float, (unsigned)r[1]); }

#ifndef LRU_ABL
#define LRU_ABL 0
#endif
__device__ __forceinline__ void lru_unit(Frame& F, int l, int b, int hd, int half) {
    LAS bf16* ub = (LAS bf16*)F.lds;
    LAS bf16* waT = (LAS bf16*)(F.lds + 36864);
    LAS bf16* wxT = (LAS bf16*)(F.lds + 36864 + 4608);
    LAS f32x2* wcomp = (LAS f32x2*)(F.lds + 92800);
    LAS bf16* ho = (LAS bf16*)(F.lds + 46080 + 3 * 8192 + 256);
    const int tid = F.tid, lane = F.lane, w = F.wave, q = lane >> 4, fr = lane & 15;
    bf16* proj = F_PROJ(F); bf16* X = F_X(F);
    const int chh = hd * 64;
    const int c8 = tid & 7, rg = tid >> 3;
    LAS float* cwl = (LAS float*)(F.lds + 91392 + 128);
    __syncthreads();
    if (tid < 320) { const int j = tid >> 6, c = tid & 63; cwl[tid] = j < 4 ? FIN(I_CONVW)[((size_t)l * 4 + j) * 1024 + chh + c] : FIN(I_CONVB)[l * 1024 + chh + c]; }
    const int orow = tid >> 1, ohh = tid & 1;
#pragma unroll 1
    for (int dir = 0; dir < 2; ++dir) {
        __syncthreads();
        for (int i = tid; i < 2048; i += 512) { const int k = i >> 5, c = i & 31; const size_t gi = ((((size_t)l * 2 + dir) * 16 + hd) * 64 + k) * 64 + half * 32 + c;
            waT[c * 72 + k] = (bf16)f2bf(FIN(I_WA)[gi]); wxT[c * 72 + k] = (bf16)f2bf(FIN(I_WX)[gi]); }
        float ba_[2], bx_[2], sp8_[2], carry[2] = {0.f, 0.f};
#pragma unroll
        for (int cb = 0; cb < 2; ++cb) { const int ch = chh + half * 32 + cb * 16 + fr; const size_t gi = ((size_t)l * 2 + dir) * 1024 + ch;
            ba_[cb] = FIN(I_BA)[gi]; bx_[cb] = FIN(I_BX)[gi]; const float lam = FIN(I_LAM)[gi]; sp8_[cb] = -8.0f * 1.4426950408889634f * log1p_fast(__expf(-lam)); }
        __syncthreads();
        const int rgd = dir ? 63 - rg : rg;
        u32x4 axr[7]; u32x4 pf[4];
#define LRU_CHUNK(ci, isctx_, T0_, rowbase_) const bool isctx_ = (ci) == 0; const int T0_ = isctx_ ? 0 : 256 * (dir ? (16 - (ci)) : ((ci) - 1)); const size_t rowbase_ = isctx_ ? (size_t)NLAT + b * LCX : (size_t)b * SEQ
#define LRU_PREFETCH(ci) do { LRU_CHUNK(ci, ic_, t0_, rb_); const int Ls_ = ic_ ? LCX : SEQ; \
            _Pragma("unroll") for (int j = 0; j < 7; ++j) { const int tt = t0_ + 4 * rgd - 2 + j; const int tc_ = (tt >= 0 && tt < Ls_) ? tt : 0; \
                const GAS bf16* p_ = (const GAS bf16*)(proj + (rb_ + tc_) * LDP + C_AX + chh + 8 * c8); \
                asm volatile("global_load_dwordx4 %0, %1, off" : "=v"(axr[j]) : "v"(p_) : "memory"); } } while (0)
#define LRU_AX_WAIT(ci) do { if (dir == 0) asm volatile("s_waitcnt vmcnt(2)" : "+v"(axr[0]), "+v"(axr[1]), "+v"(axr[2]), "+v"(axr[3]), "+v"(axr[4]), "+v"(axr[5]), "+v"(axr[6]) :: "memory"); \
            else asm volatile("s_waitcnt vmcnt(6)" : "+v"(axr[0]), "+v"(axr[1]), "+v"(axr[2]), "+v"(axr[3]), "+v"(axr[4]), "+v"(axr[5]), "+v"(axr[6]) :: "memory"); \
            LRU_CHUNK(ci, ic_, t0_, rb_); (void)rb_; const int Ls_ = ic_ ? LCX : SEQ; \
            _Pragma("unroll") for (int j = 0; j < 7; ++j) { const int tt = t0_ + 4 * rgd - 2 + j; if (!(tt >= 0 && tt < Ls_)) axr[j] = (u32x4){0u, 0u, 0u, 0u}; } } while (0)
#define LRU_PREFETCH_OUT(ci) do { if (dir == 1) { LRU_CHUNK(ci, ic_, t0_, rb_); const size_t orow_g = rb_ + t0_ + (255 - orow); \
                pf[0] = *(const u32x4*)(X + orow_g * 1024 + chh + half * 32 + ohh * 16); pf[1] = *(const u32x4*)(X + orow_g * 1024 + chh + half * 32 + ohh * 16 + 8); \
                pf[2] = *(const u32x4*)(proj + orow_g * LDP + C_AY + chh + half * 32 + ohh * 16); pf[3] = *(const u32x4*)(proj + orow_g * LDP + C_AY + chh + half * 32 + ohh * 16 + 8); } } while (0)
        LRU_PREFETCH(0); LRU_PREFETCH_OUT(0);
        asm volatile("s_waitcnt vmcnt(0)" : "+v"(axr[0]), "+v"(axr[1]), "+v"(axr[2]), "+v"(axr[3]), "+v"(axr[4]), "+v"(axr[5]), "+v"(axr[6]) :: "memory");
#pragma unroll 1
        for (int ci = 0; ci < 17; ++ci) {
            LRU_CHUNK(ci, isctx, T0, rowbase);
            if (ci > 0) { LRU_AX_WAIT(ci); } else {
#pragma unroll
                for (int j = 0; j < 7; ++j) { const int tt = 4 * rgd - 2 + j; if (!(tt >= 0 && tt < LCX)) axr[j] = (u32x4){0u, 0u, 0u, 0u}; } }
            { float u[4][8];
#pragma unroll
              for (int r = 0; r < 4; ++r) { const f32x4 b0 = *(const LAS f32x4*)(cwl + 256 + 8 * c8), b1 = *(const LAS f32x4*)(cwl + 256 + 8 * c8 + 4);
                  u[r][0] = b0.x; u[r][1] = b0.y; u[r][2] = b0.z; u[r][3] = b0.w; u[r][4] = b1.x; u[r][5] = b1.y; u[r][6] = b1.z; u[r][7] = b1.w; }
#pragma unroll
              for (int j = 0; j < 7; ++j) { float x[8]; x[0] = bflo(axr[j].x); x[1] = bfhi(axr[j].x); x[2] = bflo(axr[j].y); x[3] = bfhi(axr[j].y); x[4] = bflo(axr[j].z); x[5] = bfhi(axr[j].z); x[6] = bflo(axr[j].w); x[7] = bfhi(axr[j].w);
#pragma unroll
                  for (int t = 0; t < 4; ++t) { const int r = j - t; if (r >= 0 && r < 4) {
                      const f32x4 w0 = *(const LAS f32x4*)(cwl + 64 * t + 8 * c8), w1 = *(const LAS f32x4*)(cwl + 64 * t + 8 * c8 + 4);
                      u[r][0] += w0.x * x[0]; u[r][1] += w0.y * x[1]; u[r][2] += w0.z * x[2]; u[r][3] += w0.w * x[3]; u[r][4] += w1.x * x[4]; u[r][5] += w1.y * x[5]; u[r][6] += w1.z * x[6]; u[r][7] += w1.w * x[7]; } } }
#pragma unroll
              for (int r = 0; r < 4; ++r) { const int tl = 4 * rgd + r, p = dir ? (255 - tl) : tl;
                  u32x4 o; o.x = pk2(u[r][0], u[r][1]); o.y = pk2(u[r][2], u[r][3]); o.z = pk2(u[r][4], u[r][5]); o.w = pk2(u[r][6], u[r][7]); *(LAS u32x4*)(ub + p * 72 + 8 * c8) = o; } }
            if (ci + 1 < 17) LRU_PREFETCH(ci + 1);
            LDS_WAIT(); asm volatile("" ::: "memory");
            float hl[2][2][4], Ac[2][2][4], sa[2][2], sb[2][2];
            bf16x8 Ba[2][2], Bx[2][2];
#pragma unroll
            for (int cb = 0; cb < 2; ++cb)
#pragma unroll
                for (int ks = 0; ks < 2; ++ks) { Ba[cb][ks] = ldfrag(waT, cb * 16, ks * 32, 72, lane); Bx[cb][ks] = ldfrag(wxT, cb * 16, ks * 32, 72, lane); }
#pragma unroll
            for (int rb = 0; rb < 2; ++rb) { const bf16x8 A0 = ldfrag(ub, 32 * w + 16 * rb, 0, 72, lane), A1 = ldfrag(ub, 32 * w + 16 * rb, 32, 72, lane);
#pragma unroll
                for (int cb = 0; cb < 2; ++cb) {
                    f32x4 ra = (f32x4){0.f, 0.f, 0.f, 0.f}, rx = ra;
                    ra = MFMA16(A0, Ba[cb][0], ra); ra = MFMA16(A1, Ba[cb][1], ra); rx = MFMA16(A0, Bx[cb][0], rx); rx = MFMA16(A1, Bx[cb][1], rx);
                    float hprev = 0.f, aprev = 1.f;
#pragma unroll
                    for (int r = 0; r < 4; ++r) { const int p = 32 * w + 16 * rb + 4 * q + r; const float u = bf2f(ub[p * 72 + half * 32 + cb * 16 + fr]);
                        const float rgt = fast_sigmoid(ra[r] + ba_[cb]), igt = fast_sigmoid(rx[r] + bx_[cb]);
                        const float a = __builtin_amdgcn_exp2f(sp8_[cb] * rgt), bb = __builtin_amdgcn_sqrtf(fmaxf((1.0f - a) * (1.0f + a), 0.f)) * (igt * u);
                        hprev = a * hprev + bb; aprev = a * aprev; hl[rb][cb][r] = hprev; Ac[rb][cb][r] = aprev; }
                    sa[rb][cb] = aprev; sb[rb][cb] = hprev; } }
            float ea[2][2], eb[2][2];
            const int par = ci & 1;
#pragma unroll
            for (int cb = 0; cb < 2; ++cb) { float ia[2], ib[2];
#pragma unroll
                for (int rb = 0; rb < 2; ++rb) { float a = sa[rb][cb], bq = sb[rb][cb];
                    float a1 = __shfl_up(a, 16), b1 = __shfl_up(bq, 16); if (q >= 1) { bq = a * b1 + bq; a = a * a1; }
                    a1 = __shfl_up(a, 32); b1 = __shfl_up(bq, 32); if (q >= 2) { bq = a * b1 + bq; a = a * a1; }
                    ia[rb] = a; ib[rb] = bq;
                    a1 = __shfl_up(a, 16); b1 = __shfl_up(bq, 16); ea[rb][cb] = q ? a1 : 1.0f; eb[rb][cb] = q ? b1 : 0.0f; }
                const float t0a = __shfl(ia[0], 48 + fr), t0b = __shfl(ib[0], 48 + fr);
                eb[1][cb] = ea[1][cb] * t0b + eb[1][cb]; ea[1][cb] = ea[1][cb] * t0a;
                if (q == 3) wcomp[(par * 8 + w) * 32 + cb * 16 + fr] = (f32x2){ia[1] * t0a, ia[1] * t0b + ib[1]}; }
            LDS_BARRIER();
#pragma unroll
            for (int cb = 0; cb < 2; ++cb) { float h = carry[cb], hin = h;
#pragma unroll
                for (int k = 0; k < 8; ++k) { const f32x2 c = wcomp[(par * 8 + k) * 32 + cb * 16 + fr]; h = c.x * h + c.y; hin = (k + 1 == w) ? h : hin; }
                carry[cb] = h;
#pragma unroll
                for (int rb = 0; rb < 2; ++rb) { const float hs = ea[rb][cb] * hin + eb[rb][cb];
#pragma unroll
                    for (int r = 0; r < 4; ++r) { const int p = 32 * w + 16 * rb + 4 * q + r; ho[p * 40 + cb * 16 + fr] = (bf16)f2bf(Ac[rb][cb][r] * hs + hl[rb][cb][r]); } } }
            LDS_WAIT(); asm volatile("" ::: "memory");
            { const int tl = dir ? (255 - orow) : orow; const size_t row = rowbase + T0 + tl;
              const u32x4 h0 = *(const LAS u32x4*)(ho + orow * 40 + ohh * 16), h1 = *(const LAS u32x4*)(ho + orow * 40 + ohh * 16 + 8);
              if (dir == 0) { *(u32x4*)(X + row * 1024 + chh + half * 32 + ohh * 16) = h0; *(u32x4*)(X + row * 1024 + chh + half * 32 + ohh * 16 + 8) = h1; }
              else { u32x4 o0, o1;
#define LRU_Y(hb, hf, ay) pk2((bflo(hf) + bflo(hb)) * fast_gelu_tanh(bflo(ay)), (bfhi(hf) + bfhi(hb)) * fast_gelu_tanh(bfhi(ay)))
                  o0.x = LRU_Y(h0.x, pf[0].x, pf[2].x); o0.y = LRU_Y(h0.y, pf[0].y, pf[2].y); o0.z = LRU_Y(h0.z, pf[0].z, pf[2].z); o0.w = LRU_Y(h0.w, pf[0].w, pf[2].w);
                  o1.x = LRU_Y(h1.x, pf[1].x, pf[3].x); o1.y = LRU_Y(h1.y, pf[1].y, pf[3].y); o1.z = LRU_Y(h1.z, pf[1].z, pf[3].z); o1.w = LRU_Y(h1.w, pf[1].w, pf[3].w);
#undef LRU_Y
                  { bf16* yb_ = F_YB(F) + row * 3072 + chh + half * 32 + ohh * 16; *(u32x4*)yb_ = o0; *(u32x4*)(yb_ + 8) = o1; } } }
            if (ci + 1 < 17) LRU_PREFETCH_OUT(ci + 1);
        }
#undef LRU_AX_WAIT
#undef LRU_PREFETCH_OUT
#undef LRU_PREFETCH
#undef LRU_CHUNK
    }
}
__device__ __forceinline__ size_t ret_rowbase(int b, int cidx) { return cidx < 2 ? (size_t)NLAT + b * LCX + cidx * 128 : (size_t)b * SEQ + (cidx - 2) * 128; }
__device__ __forceinline__ float ret_logg(Frame& F, int l, int dir, int h) { const float lam = FIN(I_RLAM)[(l * 2 + dir) * 8 + h]; return -log1p_fast(__expf(-lam)); }

__device__ __forceinline__ void ret_load_qk(Frame& F, const bf16* src  , bool rope, int pos0, float scale, float (&o1)[8], float (&o2)[8]) {
    const int row = F.tid >> 2, cp = F.tid & 3;
    const u32x4 a = *(const u32x4*)(src + (size_t)row * LDP + 8 * cp), b = *(const u32x4*)(src + (size_t)row * LDP + 32 + 8 * cp);
    float x1[8] = {bflo(a.x), bfhi(a.x), bflo(a.y), bfhi(a.y), bflo(a.z), bfhi(a.z), bflo(a.w), bfhi(a.w)};
    float x2[8] = {bflo(b.x), bfhi(b.x), bflo(b.y), bfhi(b.y), bflo(b.z), bfhi(b.z), bflo(b.w), bfhi(b.w)};
    if (rope) { const f32x2* rt = (const f32x2*)(F.ws + WS_ROPE) + (size_t)(pos0 + row) * 32 + 8 * cp;
#pragma unroll
        for (int e = 0; e < 8; ++e) { const f32x2 cs = rt[e]; o1[e] = (x1[e] * cs.x - x2[e] * cs.y) * scale; o2[e] = (x2[e] * cs.x + x1[e] * cs.y) * scale; }
    } else {
#pragma unroll
        for (int e = 0; e < 8; ++e) { o1[e] = x1[e] * scale; o2[e] = x2[e] * scale; }
    }
}
__device__ __forceinline__ void ph_ret_r1(Frame& F, int l) {
    LAS bf16* Kf = (LAS bf16*)F.lds;
    LAS bf16* Kb = Kf + 128 * 72;
    LAS bf16* Vs = Kb + 128 * 72;
    const int tid = F.tid, lane = F.lane, w = F.wave, q = lane >> 4, fr = lane & 15;
    const bf16* proj = F_PROJ(F);
    const int row = tid >> 2, cp = tid & 3;
    u32x4 ka, kb, vv[4];
#define R1_LOAD(u) do { const int bh__ = (u) / 34, ci__ = (u) % 34; const size_t rb__ = ret_rowbase(bh__ >> 3, ci__); const int h__ = bh__ & 7; \
        const bf16* ks_ = proj + (rb__ + row) * LDP + C_BK + h__ * 64 + 8 * cp; ka = *(const u32x4*)ks_; kb = *(const u32x4*)(ks_ + 32); \
        _Pragma("unroll") for (int i = 0; i < 4; ++i) { const int t_ = tid + 512 * i; vv[i] = *(const u32x4*)(proj + (rb__ + (t_ >> 4)) * LDP + C_BV + h__ * 128 + 8 * (t_ & 15)); } } while (0)
    int u = F.bid;
    if (u < 64 * 34) R1_LOAD(u);
    const int dir = w >> 2, e0 = 32 * (w & 3);
    const unsigned vlane = (unsigned)(size_t)Vs + (unsigned)((8 * q + (fr >> 2)) * 272 + (fr & 3) * 8 + e0 * 2);
    const unsigned klane = (unsigned)(size_t)(dir ? Kb : Kf) + (unsigned)((8 * q + (fr >> 2)) * 144 + (fr & 3) * 8);
#pragma unroll 1
    for (; u < 64 * 34; u += F.G) {
        const int bh = u / 34, cidx = u % 34, b = bh >> 3, h = bh & 7; const bool lat = cidx >= 2;
        const float lg0 = ret_logg(F, l, 0, h), lg1 = ret_logg(F, l, 1, h);
        LDS_BARRIER();
        { float x1[8], x2[8], o1[8], o2[8]; unpack8(ka, x1); unpack8(kb, x2);
          if (lat) { const f32x2* rt = (const f32x2*)(F.ws + WS_ROPE) + (size_t)((cidx - 2) * 128 + row) * 32 + 8 * cp;
#pragma unroll
              for (int e = 0; e < 8; ++e) { const f32x2 cs = rt[e]; o1[e] = (x1[e] * cs.x - x2[e] * cs.y) * 0.125f; o2[e] = (x2[e] * cs.x + x1[e] * cs.y) * 0.125f; } }
          else {
#pragma unroll
              for (int e = 0; e < 8; ++e) { o1[e] = x1[e] * 0.125f; o2[e] = x2[e] * 0.125f; } }
          const float df = __expf(lg0 * (float)(127 - row)), db = __expf(lg1 * (float)row);
          *(LAS u32x4*)(Kf + row * 72 + 8 * cp) = pack8(o1, df); *(LAS u32x4*)(Kf + row * 72 + 32 + 8 * cp) = pack8(o2, df);
          *(LAS u32x4*)(Kb + row * 72 + 8 * cp) = pack8(o1, db); *(LAS u32x4*)(Kb + row * 72 + 32 + 8 * cp) = pack8(o2, db); }
#pragma unroll
        for (int i = 0; i < 4; ++i) { const int t = tid + 512 * i; *(LAS u32x4*)(Vs + (t >> 4) * 136 + 8 * (t & 15)) = vv[i]; }
        LDS_BARRIER();
        if (u + F.G < 64 * 34) R1_LOAD(u + F.G);
        f32x4 acc[2][4];
#pragma unroll
        for (int eb = 0; eb < 2; ++eb)
#pragma unroll
            for (int db = 0; db < 4; ++db) acc[eb][db] = (f32x4){0.f, 0.f, 0.f, 0.f};
#pragma unroll
        for (int ks = 0; ks < 4; ++ks) { bf16x8 av[4], bk[4];
            tr_frags4<272>(vlane + ks * 32 * 272, av);
            tr_frags4<144>(klane + ks * 32 * 144, bk);
#pragma unroll
            for (int eb = 0; eb < 2; ++eb)
#pragma unroll
                for (int db = 0; db < 4; ++db) acc[eb][db] = MFMA16(bk[db], av[eb], acc[eb][db]); }
        bf16* kv = (bf16*)(F.ws + WS_KV) + ((((size_t)(b * 8 + h) * 34 + cidx) * 2) + dir) * 8192;
#pragma unroll
        for (int eb = 0; eb < 2; ++eb)
#pragma unroll
            for (int db = 0; db < 4; ++db) { u32x2 o; o.x = pk2(acc[eb][db][0], acc[eb][db][1]); o.y = pk2(acc[eb][db][2], acc[eb][db][3]);
                *(u32x2*)(kv + (e0 + 16 * eb + fr) * 64 + 16 * db + 4 * q) = o; }
    }
#undef R1_LOAD
}
__device__ __forceinline__ void ret_scan(Frame& F, int l) {
    unsigned* kvw = (unsigned*)(F.ws + WS_KV);
    for (int i = F.bid * 512 + F.tid; i < 64 * 2 * 4096; i += F.G * 512) { const int pr = i & 4095, dir = (i >> 12) & 1, bh = i >> 13, h = bh & 7;
        const float gC = __expf(ret_logg(F, l, dir, h) * 128.0f);
        unsigned* base = kvw + ((size_t)bh * 34 * 2 + dir) * 4096 + pr;
        unsigned v[34];
#pragma unroll
        for (int k = 0; k < 34; ++k) v[k] = base[(size_t)k * 8192];
        float s0 = 0.f, s1 = 0.f;
        if (dir == 0) {
#pragma unroll
            for (int k = 0; k < 34; ++k) { const unsigned x = v[k]; v[k] = pk2(s0, s1); s0 = gC * s0 + bflo(x); s1 = gC * s1 + bfhi(x); }
        } else {
#pragma unroll
            for (int k = 0; k < 34; ++k) { const int c = k < 2 ? 1 - k : 35 - k; const unsigned x = v[c]; v[c] = pk2(s0, s1); s0 = gC * s0 + bflo(x); s1 = gC * s1 + bfhi(x); }
        }
        if (F.wr) {
#pragma unroll
            for (int k = 0; k < 34; ++k) base[(size_t)k * 8192] = v[k]; }
    }
}
__device__ __forceinline__ void ph_ret_r2(Frame& F, int l, bool lastl) {
    LAS bf16* Qs = (LAS bf16*)F.lds;
    LAS bf16* Ks = Qs + 128 * 72;
    LAS bf16* Vs = Ks + 128 * 72;
    LAS bf16* Ps = Vs + 128 * 136 + F.wave * (16 * 136);
    LAS bf16* Ss = Vs + 128 * 136 + 8 * (16 * 136);
    const int tid = F.tid, lane = F.lane, w = F.wave, q = lane >> 4, fr = lane & 15;
    const bf16* proj = F_PROJ(F);
    const int nch = lastl ? 32 : 34, nunits = 64 * nch;
    const int row = tid >> 2, cp = tid & 3;
    u32x4 qa, qb_, ka, kb, vv[4], sv[4];
#define R2_DECODE(u, bh_, cidx_) const int bh_ = (u) / nch, cidx_ = (u) % nch + (lastl ? 2 : 0)
#define R2_LOAD(u) do { R2_DECODE(u, bh__, ci__); const size_t rb__ = ret_rowbase(bh__ >> 3, ci__); const int h__ = bh__ & 7; \
        const bf16* qs_ = proj + (rb__ + row) * LDP + C_BQ + h__ * 64 + 8 * cp; qa = *(const u32x4*)qs_; qb_ = *(const u32x4*)(qs_ + 32); \
        const bf16* ks_ = proj + (rb__ + row) * LDP + C_BK + h__ * 64 + 8 * cp; ka = *(const u32x4*)ks_; kb = *(const u32x4*)(ks_ + 32); \
        _Pragma("unroll") for (int i = 0; i < 4; ++i) { const int t_ = tid + 512 * i; vv[i] = *(const u32x4*)(proj + (rb__ + (t_ >> 4)) * LDP + C_BV + h__ * 128 + 8 * (t_ & 15)); \
            sv[i] = *(const u32x4*)((const bf16*)(F.ws + WS_KV) + (((size_t)bh__ * 34 + ci__) * 2) * 8192 + (size_t)t_ * 8); } } while (0)
    int u = F.bid;
    if (u < nunits) R2_LOAD(u);
    const unsigned vlane = (unsigned)(size_t)Vs + (unsigned)((8 * q + (fr >> 2)) * 272 + (fr & 3) * 8);
#pragma unroll 1
    for (; u < nunits; u += F.G) {
        R2_DECODE(u, bh, cidx); const int b = bh >> 3, h = bh & 7; const size_t rb = ret_rowbase(b, cidx); const bool lat = cidx >= 2;
        const float lg0 = ret_logg(F, l, 0, h), lg1 = ret_logg(F, l, 1, h);
        LDS_BARRIER();
        { float x1[8], x2[8], o1[8], o2[8];
          unpack8(qa, x1); unpack8(qb_, x2);
          if (lat) { const f32x2* rt = (const f32x2*)(F.ws + WS_ROPE) + (size_t)((cidx - 2) * 128 + row) * 32 + 8 * cp;
#pragma unroll
              for (int e = 0; e < 8; ++e) { const f32x2 cs = rt[e]; o1[e] = x1[e] * cs.x - x2[e] * cs.y; o2[e] = x2[e] * cs.x + x1[e] * cs.y; } }
          else {
#pragma unroll
              for (int e = 0; e < 8; ++e) { o1[e] = x1[e]; o2[e] = x2[e]; } }
          *(LAS u32x4*)(Qs + row * 72 + 8 * cp) = pack8(o1, 1.0f); *(LAS u32x4*)(Qs + row * 72 + 32 + 8 * cp) = pack8(o2, 1.0f);
          unpack8(ka, x1); unpack8(kb, x2);
          if (lat) { const f32x2* rt = (const f32x2*)(F.ws + WS_ROPE) + (size_t)((cidx - 2) * 128 + row) * 32 + 8 * cp;
#pragma unroll
              for (int e = 0; e < 8; ++e) { const f32x2 cs = rt[e]; o1[e] = x1[e] * cs.x - x2[e] * cs.y; o2[e] = x2[e] * cs.x + x1[e] * cs.y; } }
          else {
#pragma unroll
              for (int e = 0; e < 8; ++e) { o1[e] = x1[e]; o2[e] = x2[e]; } }
          *(LAS u32x4*)(Ks + row * 72 + 8 * cp) = pack8(o1, 0.125f); *(LAS u32x4*)(Ks + row * 72 + 32 + 8 * cp) = pack8(o2, 0.125f); }
#pragma unroll
        for (int i = 0; i < 4; ++i) { const int t = tid + 512 * i; *(LAS u32x4*)(Vs + (t >> 4) * 136 + 8 * (t & 15)) = vv[i]; *(LAS u32x4*)(Ss + (t >> 3) * 72 + 8 * (t & 7)) = sv[i]; }
        LDS_BARRIER();
        if (u + F.G < nunits) R2_LOAD(u + F.G);
        const int il = 16 * w + fr;
        const bf16x8 Bq0 = ldfrag(Qs, 16 * w, 0, 72, lane), Bq1 = ldfrag(Qs, 16 * w, 32, 72, lane);
        const float l2g0 = lg0 * 1.4426950408889634f, l2g1 = lg1 * 1.4426950408889634f;
#pragma unroll
        for (int jb = 0; jb < 8; ++jb) { f32x4 acc = (f32x4){0.f, 0.f, 0.f, 0.f};
            acc = MFMA16(ldfrag(Ks, 16 * jb, 0, 72, lane), Bq0, acc); acc = MFMA16(ldfrag(Ks, 16 * jb, 32, 72, lane), Bq1, acc);
            float pv[4];
#pragma unroll
            for (int r = 0; r < 4; ++r) { const int j = 16 * jb + 4 * q + r; const int dd = il - j;
                const float df = dd >= 0 ? __builtin_amdgcn_exp2f(l2g0 * (float)dd) : 0.f, dbk = dd <= 0 ? __builtin_amdgcn_exp2f(l2g1 * (float)(-dd)) : 0.f;
                pv[r] = acc[r] * (df + dbk); }
            u32x2 pw; pw.x = pg8::cvt_pk_bf16(pv[0], pv[1]); pw.y = pg8::cvt_pk_bf16(pv[2], pv[3]); *(LAS u32x2*)(Ps + fr * 136 + 16 * jb + 4 * q) = pw; }
        LDS_WAIT(); asm volatile("" ::: "memory");
        const bf16* gp = proj + (rb + il) * LDP + C_BG + h * 128 + 4 * q;
        u32x2 gwv[4];
#pragma unroll
        for (int eb = 0; eb < 4; ++eb) gwv[eb] = *(const u32x2*)(gp + 16 * eb);
        f32x4 Y[8];
#pragma unroll
        for (int eb = 0; eb < 8; ++eb) Y[eb] = (f32x4){0.f, 0.f, 0.f, 0.f};
#pragma unroll
        for (int ks = 0; ks < 4; ++ks) { const bf16x8 bp = ldfrag(Ps, 0, 32 * ks, 136, lane); bf16x8 av[4];
            tr_frags4<272>(vlane + ks * 32 * 272, av);
#pragma unroll
            for (int eb = 0; eb < 4; ++eb) Y[eb] = MFMA16(av[eb], bp, Y[eb]);
            tr_frags4<272>(vlane + ks * 32 * 272 + 128, av);
#pragma unroll
            for (int eb = 0; eb < 4; ++eb) Y[4 + eb] = MFMA16(av[eb], bp, Y[4 + eb]); }
        const float qf = __builtin_amdgcn_exp2f(l2g0 * (float)(il + 1)), qbw = __builtin_amdgcn_exp2f(l2g1 * (float)(128 - il));
#pragma unroll
        for (int eb = 0; eb < 8; ++eb) { f32x4 zf = (f32x4){0.f, 0.f, 0.f, 0.f}, zb = zf;
            zf = MFMA16(ldfrag(Ss, 16 * eb, 0, 72, lane), Bq0, zf); zf = MFMA16(ldfrag(Ss, 16 * eb, 32, 72, lane), Bq1, zf);
            zb = MFMA16(ldfrag(Ss, 128 + 16 * eb, 0, 72, lane), Bq0, zb); zb = MFMA16(ldfrag(Ss, 128 + 16 * eb, 32, 72, lane), Bq1, zb);
            Y[eb] = Y[eb] + zf * qf + zb * qbw; }
        float s = 0.f;
#pragma unroll
        for (int eb = 0; eb < 8; ++eb) s += (Y[eb][0] + Y[eb][1]) + (Y[eb][2] + Y[eb][3]);
        s += __shfl_xor(s, 16); s += __shfl_xor(s, 32);
        const float mu = s * (1.0f / 128.0f); float vq = 0.f;
#pragma unroll
        for (int eb = 0; eb < 8; ++eb) { const f32x4 d = Y[eb] - mu; vq += (d[0] * d[0] + d[1] * d[1]) + (d[2] * d[2] + d[3] * d[3]); }
        vq += __shfl_xor(vq, 16); vq += __shfl_xor(vq, 32);
        const float rstd = __builtin_amdgcn_rsqf(vq * (1.0f / 128.0f) + EPS);
        bf16* yo = F_YB(F) + (rb + il) * 3072 + 1024 + h * 128 + 4 * q;
        u32x2 gw2[4];
#pragma unroll
        for (int eb = 0; eb < 4; ++eb) gw2[eb] = *(const u32x2*)(gp + 16 * (4 + eb));
#pragma unroll
        for (int eb = 0; eb < 8; ++eb) { const u32x2 gw = eb < 4 ? gwv[eb & 3] : gw2[eb & 3]; const f32x4 yn = (Y[eb] - mu) * rstd;
            u32x2 o; o.x = pg8::cvt_pk_bf16(gm::fsilu_(bflo(gw.x)) * yn[0], gm::fsilu_(bfhi(gw.x)) * yn[1]); o.y = pg8::cvt_pk_bf16(gm::fsilu_(bflo(gw.y)) * yn[2], gm::fsilu_(bfhi(gw.y)) * yn[3]);
            if (F.wr) *(u32x2*)(yo + 16 * eb) = o; }
    }
#undef R2_LOAD
#undef R2_DECODE
}
__device__ __forceinline__ void att_rope_keys(Frame& F) {
    bf16* proj = F_PROJ(F); const f32x2* atab = (const f32x2*)(F.ws + WS_ROPE + 1 * MiB);
    for (int i = F.bid * 512 + F.tid; i < NLAT * 16; i += F.G * 512) { const int pr = i & 3, g = (i >> 2) & 3, row = i >> 4; const int c = (pr & 1) + 4 * (pr >> 1);
        bf16* src = proj + (size_t)row * LDP + C_CK + g * 64 + 8 * c;
        float x1[8], x2[8], o1[8], o2[8]; unpack8(*(const u32x4*)src, x1); unpack8(*(const u32x4*)(src + 16), x2);
        const int pos = row & (SEQ - 1); const int ap = (pr >> 1) ? (pos & 63) : (pos >> 6); att_rope8(atab + ap * 16 + 8 * (pr & 1), x1, x2, o1, o2);
        if (F.wr) { *(u32x4*)src = pack8(o1, 1.0f); *(u32x4*)(src + 16) = pack8(o2, 1.0f); } }
}
__device__ __forceinline__ void att_unit(Frame& F, int l, int b, int g, int qb, bool isctxq) {
    LAS bf16* Kt = (LAS bf16*)F.lds;
    LAS bf16* Vt = Kt + 64 * 72;
    LAS bf16* Pw = Vt + 64 * 72 + F.wave * (64 * 72);
    const int tid = F.tid, lane = F.lane, w = F.wave, q = lane >> 4, fr = lane & 15;
    const bf16* proj = F_PROJ(F); const f32x2* atab = (const f32x2*)(F.ws + WS_ROPE + 1 * MiB);
    const int hq = 4 * g + (w >> 1);
    const size_t qrow0 = (isctxq ? (size_t)NLAT + b * LCX : (size_t)b * SEQ) + qb * 128 + (w & 1) * 64;
    const int qpos0 = qb * 128 + (w & 1) * 64;
    constexpr float QS = 0.125f * 1.4426950408889634f;
    unsigned vmask = 0xFu;
    if (!isctxq) {
#pragma unroll
        for (int t = 4; t < 10; ++t) { const int kp = qb * 128 - 128 + 64 * (t - 4); if (kp >= 0 && kp < SEQ) vmask |= 1u << t; } }
    const int vrow = tid >> 3, vc8 = tid & 7;
    u32x4 kx = (u32x4){0u, 0u, 0u, 0u}, vx = kx;
#define ATT_KROW0(t) ((t) >= 4 ? (size_t)b * SEQ + (qb * 128 - 128 + 64 * ((t) - 4)) : (size_t)NLAT + b * LCX + 64 * (t))
#define ATT_LOAD(t) do { const size_t kr0_ = ATT_KROW0(t); kx = *(const u32x4*)(proj + (kr0_ + vrow) * LDP + C_CK + g * 64 + 8 * vc8); \
        vx = *(const u32x4*)(proj + (kr0_ + vrow) * LDP + C_CV + g * 64 + 8 * vc8); } while (0)
    int t = __builtin_ctz(vmask); vmask &= vmask - 1;
    ATT_LOAD(t);
    LDS_BARRIER();
#pragma unroll
    for (int i = 0; i < 4; ++i) { const int tt = lane + 64 * i, row = tt >> 2, pr = tt & 3;
        const int c = (pr & 1) + 4 * (pr >> 1); const bf16* src = proj + (qrow0 + row) * LDP + C_CQ + hq * 64;
        float x1[8], x2[8], o1[8], o2[8]; unpack8(*(const u32x4*)(src + 8 * c), x1); unpack8(*(const u32x4*)(src + 8 * c + 16), x2);
        if (!isctxq) { const int pos = qpos0 + row; const int ap = (pr >> 1) ? (pos & 63) : (pos >> 6); att_rope8(atab + ap * 16 + 8 * (pr & 1), x1, x2, o1, o2); }
        else {
#pragma unroll
            for (int e = 0; e < 8; ++e) { o1[e] = x1[e]; o2[e] = x2[e]; } }
        *(LAS u32x4*)(Pw + row * 72 + 8 * c) = pack8(o1, QS); *(LAS u32x4*)(Pw + row * 72 + 8 * c + 16) = pack8(o2, QS); }
    LDS_WAIT(); asm volatile("" ::: "memory");
    bf16x8 Bq[4][2];
#pragma unroll
    for (int ib = 0; ib < 4; ++ib)
#pragma unroll
        for (int ks = 0; ks < 2; ++ks) Bq[ib][ks] = ldfrag(Pw, 16 * ib, 32 * ks, 72, lane);
    LDS_WAIT(); asm volatile("" ::: "memory");
    const float sink = FIN(I_SINK)[l * 16 + hq] * 1.4426950408889634f;
    float mrow[4], lrow[4], aprev[4]; f32x4 O[4][4];
#pragma unroll
    for (int ib = 0; ib < 4; ++ib) { mrow[ib] = sink; aprev[ib] = 1.0f; lrow[ib] = (q == 0) ? 1.0f : 0.0f;
#pragma unroll
        for (int db = 0; db < 4; ++db) O[db][ib] = (f32x4){0.f, 0.f, 0.f, 0.f}; }
    const unsigned vt_lane = (unsigned)(size_t)Vt + (unsigned)((8 * q + (fr >> 2)) * 144 + (fr & 3) * 8);
#pragma unroll 1
    for (;;) {
        const int kpos0 = t >= 4 ? (qb * 128 - 128 + 64 * (t - 4)) : 0;
        LDS_BARRIER();
        *(LAS u32x4*)(Kt + vrow * 72 + 8 * vc8) = kx;
        *(LAS u32x4*)(Vt + vrow * 72 + 8 * vc8) = vx;
        LDS_BARRIER();
        const int tcur = t; const bool more = vmask != 0u;
        if (more) { t = __builtin_ctz(vmask); vmask &= vmask - 1; ATT_LOAD(t); }
        const bool skipt = !isctxq && tcur == ((w & 1) ? 4 : 9);
        const bool maskt = !isctxq && (tcur == ((w & 1) ? 5 : 4) || tcur == ((w & 1) ? 9 : 8));
        if (!skipt) {
#pragma unroll
        for (int hf = 0; hf < 2; ++hf) {
            f32x4 S[4][2];
#pragma unroll
            for (int jb = 0; jb < 4; ++jb) { const bf16x8 a0 = ldfrag(Kt, 16 * jb, 0, 72, lane), a1 = ldfrag(Kt, 16 * jb, 32, 72, lane);
#pragma unroll
                for (int i2 = 0; i2 < 2; ++i2) { const float nm = -mrow[2 * hf + i2]; f32x4 acc = (f32x4){nm, nm, nm, nm};
                    acc = MFMA16(a0, Bq[2 * hf + i2][0], acc); acc = MFMA16(a1, Bq[2 * hf + i2][1], acc); S[jb][i2] = acc; } }
            if (maskt) {
#pragma unroll
                for (int jb = 0; jb < 4; ++jb)
#pragma unroll
                    for (int i2 = 0; i2 < 2; ++i2)
#pragma unroll
                        for (int r = 0; r < 4; ++r) { const int dd = (qpos0 + 16 * (2 * hf + i2) + fr) - (kpos0 + 16 * jb + 4 * q + r); if (dd > 128 || dd < -128) S[jb][i2][r] = -1.0e30f; }
            }
#pragma unroll
            for (int i2 = 0; i2 < 2; ++i2) { const int ib = 2 * hf + i2;
                float mx = -1.0e30f;
#pragma unroll
                for (int jb = 0; jb < 4; ++jb) mx = fmaxf(mx, fmaxf(fmaxf(S[jb][i2][0], S[jb][i2][1]), fmaxf(S[jb][i2][2], S[jb][i2][3])));
                mx = fmaxf(mx, __shfl_xor(mx, 16)); mx = fmaxf(mx, __shfl_xor(mx, 32));
                const float alpha = aprev[ib]; const float dm = fmaxf(mx, 0.f); aprev[ib] = __builtin_amdgcn_exp2f(-dm); mrow[ib] += dm;
                float ps = 0.f;
#pragma unroll
                for (int jb = 0; jb < 4; ++jb) { float p[4];
#pragma unroll
                    for (int r = 0; r < 4; ++r) { p[r] = __builtin_amdgcn_exp2f(S[jb][i2][r]); ps += p[r]; }
                    u32x2 pw; pw.x = pk2(p[0], p[1]); pw.y = pk2(p[2], p[3]); *(LAS u32x2*)(Pw + (16 * ib + fr) * 72 + 16 * jb + 4 * q) = pw; }
                lrow[ib] = lrow[ib] * alpha + ps;
#pragma unroll
                for (int db = 0; db < 4; ++db) O[db][ib] = O[db][ib] * alpha;
            }
        }
        LDS_WAIT(); asm volatile("" ::: "memory");
#pragma unroll
        for (int ks = 0; ks < 2; ++ks) { bf16x8 av[4], bp[4];
            tr_frags4<144>(vt_lane + ks * 32 * 144, av); __builtin_amdgcn_sched_barrier(0);
#pragma unroll
            for (int ib = 0; ib < 4; ++ib) bp[ib] = ldfrag(Pw, 16 * ib, 32 * ks, 72, lane);
#pragma unroll
            for (int db = 0; db < 4; ++db)
#pragma unroll
                for (int ib = 0; ib < 4; ++ib) O[db][ib] = MFMA16(av[db], bp[ib], O[db][ib]); }
        LDS_WAIT(); asm volatile("" ::: "memory");
        }
        if (!more) break;
    }
#undef ATT_LOAD
#undef ATT_KROW0
#pragma unroll
    for (int ib = 0; ib < 4; ++ib) { float lt = lrow[ib]; lt += __shfl_xor(lt, 16); lt += __shfl_xor(lt, 32); const float inv = __builtin_amdgcn_rcpf(lt);
        bf16* dst = F_YB(F) + (qrow0 + 16 * ib + fr) * 3072 + 2048 + hq * 64 + 4 * q;
#pragma unroll
        for (int db = 0; db < 4; ++db) { const f32x4 o = O[db][ib] * inv; u32x2 ow; ow.x = pg8::cvt_pk_bf16(o[0], o[1]); ow.y = pg8::cvt_pk_bf16(o[2], o[3]); if (F.wr) *(u32x2*)(dst + 16 * db) = ow; } }
}
#ifndef PROBE_MASK
#define PROBE_MASK 0
#endif
#ifndef PROBE_SUB
#define PROBE_SUB 0
#endif
#ifdef PROBE_REAL
#define WR_DRY wr_true
#else
#define WR_DRY wr_false
#endif
#define NREP(n) (((PROBE_MASK >> (n)) & 1) ? 2 : 1)
#ifndef DIAG_PH
#define PHON(n) true
#else
#define PHON(n) ((n) == DIAG_PH)
#endif
constexpr int N_PHASES = 2 + 10 * DEPTH;
__global__ void __launch_bounds__(512, 2) fwd_kernel(Args args) {
    extern __shared__ __attribute__((aligned(16))) unsigned char lds_raw[];
    Frame F; F.lds = (LAS unsigned char*)lds_raw; F.tid = threadIdx.x; F.lane = F.tid & 63; F.wave = __builtin_amdgcn_readfirstlane(F.tid >> 6);
    F.G = gridDim.x; F.bid = blockIdx.x; F.gw = F.bid * 8 + F.wave; F.NGW = F.G * 8; F.in = (const __attribute__((address_space(4))) cfp_t*)__builtin_amdgcn_kernarg_segment_ptr(); F.out = args.out; F.ws = args.ws;
    volatile LAS unsigned* MISC = (volatile LAS unsigned*)(F.lds + MISC_OFF);
    for (int u = F.tid; u < (LDS_BYTES - LDS_CTL) / 4; u += 512) ((LAS unsigned*)(F.lds + LDS_CTL))[u] = 0u;
    __syncthreads();
    unsigned* ctl = (unsigned*)(F.ws + WS_CTL);
#if MK_N_LAUNCHES == 1
    XcdBarrier bar = xcd_barrier_post(ctl + CW_BAR, MISC + 8, gridDim.x);
    XcdBarrier sbar = xcd_barrier_post(ctl + (blockIdx.x < 32 ? CW_BAR_C : CW_BAR_L), MISC + 12, blockIdx.x < 32 ? 32u : gridDim.x - 32u);
#define SUB_BAR() do { GAS unsigned* _bp = (GAS unsigned*)sbar.bar; asm volatile("" : "+s"(_bp)); XcdBarrier _b2 = sbar; _b2.bar = (unsigned*)_bp; xcd_barrier(_b2); } while (0)
#define GRID_BAR() do { GAS unsigned* _bp = (GAS unsigned*)bar.bar; asm volatile("" : "+s"(_bp)); XcdBarrier _b2 = bar; _b2.bar = (unsigned*)_bp; xcd_barrier(_b2); } while (0)
#else
#define GRID_BAR() do {} while (0)
#define SUB_BAR() do {} while (0)
#endif
    const int wave0 = F.wave; const bool wr_true = args.ph_hi > 0, wr_false = args.ph_hi < 0; F.wr = wr_true;
    const int lo = args.ph_lo, hi = args.ph_hi;
#define FRESH() do { LAS unsigned char* _l = (LAS unsigned char*)lds_raw; asm volatile("" : "+s"(_l)); F.lds = _l; int _ln; asm volatile("v_mbcnt_lo_u32_b32 %0, -1, 0\n\tv_mbcnt_hi_u32_b32 %0, -1, %0" : "=v"(_ln)); F.tid = wave0 * 64 + _ln; F.lane = _ln; F.wave = wave0; F.gw = F.bid * 8 + F.wave; \
        GAS unsigned char* _ws = (GAS unsigned char*)args.ws; asm volatile("" : "+s"(_ws)); F.ws = (unsigned char*)_ws; GAS float* _out = (GAS float*)args.out; asm volatile("" : "+s"(_out)); F.out = (float*)_out; \
        const __attribute__((address_space(4))) cfp_t* _in = (const __attribute__((address_space(4))) cfp_t*)__builtin_amdgcn_kernarg_segment_ptr(); asm volatile("" : "+s"(_in)); F.in = _in; } while (0)
#define IN(k) (lo <= (k) && (k) < hi)
#define SEAM(k) do { if (IN(k) && IN((k) + 1)) GRID_BAR(); } while (0)
    if (PHON(0) && IN(0)) for (int rep_ = NREP(0); rep_ > 0; --rep_) { FRESH(); F.wr = (rep_ == 1) ? wr_true : WR_DRY; if (NREP(0) > 1) GRID_BAR(); ph_prologue(F); } SEAM(0);
    if (PHON(1) && IN(1)) for (int rep_ = NREP(1); rep_ > 0; --rep_) { FRESH(); F.wr = (rep_ == 1) ? wr_true : WR_DRY; if (NREP(1) > 1) GRID_BAR(); ph_convert(F, 0); ph_rows_u(F, 0, true); ph_router_fold(F); } SEAM(1);
#pragma unroll 1
    for (int l = 0; l < DEPTH; ++l) {
        const int pb = 2 + 10 * l; const bool lastl = (l == DEPTH - 1); const int nM2 = lastl ? 128 : 136; const int ntok = lastl ? NLAT : NTOK;
        unsigned char* wt = F.ws + WS_WT;
        if (PHON(2) && IN(pb + 0)) for (int rep_ = NREP(2); rep_ > 0; --rep_) { FRESH(); F.wr = (rep_ == 1) ? wr_true : WR_DRY; if (NREP(2) > 1) GRID_BAR();
            gm::SchedPlain<16, 1024> S; S.init(136, 38, F.G, F.bid); S.A = (const char*)(F.ws + WS_X); S.Bt = (const char*)(wt + WT_IN);
            gm::EpiProj E{F_PROJ(F), F.ws + WS_GT}; pg8::gemm_phase(F.lds, S, E, F.tid);
        } SEAM(pb + 0);
        if (PHON(3) && IN(pb + 1)) for (int rep_ = NREP(3); rep_ > 0; --rep_) { FRESH(); F.wr = (rep_ == 1) ? wr_true : WR_DRY; if (NREP(3) > 1) GRID_BAR();
            if (!(rep_ > 1 && PROBE_SUB == 2)) for (int u = F.bid; u < 256; u += F.G) { const int hu = ((u >> 4) << 3) + (u & 7); lru_unit(F, l, hu >> 4, hu & 15, (u >> 3) & 1); }
            if (!(rep_ > 1 && PROBE_SUB == 1)) { __syncthreads(); ph_ret_r1(F, l); __syncthreads(); }
            att_rope_keys(F);
        } SEAM(pb + 1);
        if (PHON(4) && IN(pb + 2)) for (int rep_ = NREP(4); rep_ > 0; --rep_) { FRESH(); F.wr = (rep_ == 1) ? wr_true : WR_DRY; if (NREP(4) > 1) GRID_BAR();
            if (!(rep_ > 1 && PROBE_SUB == 2)) ret_scan(F, l);
            if (!(rep_ > 1 && PROBE_SUB == 1))
            for (int u = F.bid; u < (lastl ? 1024 : 1088); u += F.G) { const bool cq = u >= 1024; const int v = u - 1024;
                int ab = cq ? (v >> 3) : (u >> 7), ag = cq ? ((v >> 1) & 3) : ((u >> 5) & 3), aq = cq ? (v & 1) : (u & 31);
                if (F.G == 256) { const int x = F.bid & 7, y = F.bid >> 3;
                    ab = x; ag = cq ? (y >> 1) : (u >> 8); aq = cq ? (y & 1) : y; }
                att_unit(F, l, ab, ag, aq, cq); }
        } SEAM(pb + 2);
        if (PHON(5) && IN(pb + 3)) for (int rep_ = NREP(5); rep_ > 0; --rep_) { FRESH(); F.wr = (rep_ == 1) ? wr_true : WR_DRY; if (NREP(5) > 1) GRID_BAR();
            ph_ret_r2(F, l, lastl);
        } SEAM(pb + 3);
#ifdef PROBE_MERGE_K
        if (IN(pb + 4)) { FRESH(); GRID_BAR();
            gm::SchedPlain<PROBE_MERGE_K, 3072> S; S.init(nM2, 4, F.G, F.bid); S.A = (const char*)(F.ws + WS_YB); S.Bt = (const char*)(wt + WT_BR);
            gm::EpiPlain E{(bf16*)(F.ws + WS_KV)}; pg8::gemm_phase(F.lds, S, E, F.tid); GRID_BAR(); }
#endif
        const bool split = !lastl && gridDim.x == 256 && MK_N_LAUNCHES == 1;
        if (PHON(6) && IN(pb + 4)) for (int rep_ = NREP(6); rep_ > 0; --rep_) { FRESH(); F.wr = (rep_ == 1) ? wr_true : WR_DRY; if (NREP(6) > 1) GRID_BAR();
            gm::SchedPlain<48, 3072> S; S.init(split ? 128 : nM2, 4, F.G, F.bid); S.A = (const char*)(F.ws + WS_YB); S.Bt = (const char*)(wt + WT_BR);
            gm::EpiMerge E{F.ws + WS_GT, F_X(F)}; pg8::gemm_phase(F.lds, S, E, F.tid);
        } SEAM(pb + 4);
        if (IN(pb + 5)) { FRESH(); F.wr = wr_true;
            const bool cgrp = split && F.bid < 32;
            if (cgrp) {
                gm::SchedPlain<48, 3072, gm::OrderSub> S; S.init(8, 4, 32, F.bid, 128, true); S.A = (const char*)(F.ws + WS_YB); S.Bt = (const char*)(wt + WT_BR);
                gm::EpiMerge E{F.ws + WS_GT, F_X(F)}; pg8::gemm_phase(F.lds, S, E, F.tid);
                SUB_BAR(); FRESH();
            }
            {
                gm::SchedPlain<16, 1024, gm::OrderSub> S; S.init(split ? (cgrp ? 8 : 128) : nM2, 4, split ? (cgrp ? 32 : 224) : F.G, split && !cgrp ? F.bid - 32 : F.bid, cgrp ? 128 : 0, true);
                S.A = (const char*)(F.ws + WS_X); S.Bt = (const char*)(wt + WT_WO);
                gm::EpiWo E{F.out, F_HC(F), F_MOD(F) + (size_t)l * 9 * 6144, F.wr, l == 0 ? (const float*)FIN(I_X) : (const float*)F.out, l == 0 ? (const float*)FIN(I_CTX) : (const float*)F_HC(F)}; pg8::gemm_phase(F.lds, S, E, F.tid);
            }
        }
        if (split) { if (IN(pb + 5) && IN(pb + 6)) SUB_BAR(); } else SEAM(pb + 5);
        if (PHON(8) && IN(pb + 6)) for (int rep_ = NREP(8); rep_ > 0; --rep_) { FRESH(); F.wr = (rep_ == 1) ? wr_true : WR_DRY; if (NREP(8) > 1) GRID_BAR();
            const bool cgrp = split && F.bid < 32;
            const int row0 = cgrp ? NLAT : 0, row1 = split && !cgrp ? NLAT : ntok, gc = split && !cgrp ? F.bid - 32 : F.bid, gn = split ? (cgrp ? 32 : 224) : F.G;
            if (!(rep_ > 1 && PROBE_SUB == 2)) ph_rows_v(F, l, row0, row1, gc * 8 + F.wave, gn * 8);
            if (!(rep_ > 1 && PROBE_SUB == 1)) ph_router(F, l, row0 / 128, row1 / 128, gc, gn);
        } SEAM(pb + 6);
        if (PHON(9) && IN(pb + 7)) for (int rep_ = NREP(9); rep_ > 0; --rep_) { FRESH(); F.wr = (rep_ == 1) ? wr_true : WR_DRY; if (NREP(9) > 1) GRID_BAR();
            volatile LAS int* tileoff; volatile LAS int* cntl; moe_tables(F, l, tileoff, cntl);
            gm::SchedMoe<16, true> S; S.tileoff = tileoff; S.cnt = cntl; S.G = F.G; S.c = F.bid; S.nunits = tileoff[32] * 4; S.wsbase = (const char*)F.ws; S.rowtok = (const int*)(F.ws + WS_ROWTOK);
            S.A = nullptr; S.Bt = (const char*)(wt + WT_GU);
            gm::EpiGU E{(bf16*)(F.ws + WS_HROWS)}; pg8::gemm_phase(F.lds, S, E, F.tid);
        } SEAM(pb + 7);
        if (PHON(10) && IN(pb + 8)) for (int rep_ = NREP(10); rep_ > 0; --rep_) { FRESH(); F.wr = (rep_ == 1) ? wr_true : WR_DRY; if (NREP(10) > 1) GRID_BAR();
            volatile LAS int* tileoff; volatile LAS int* cntl; moe_tables(F, l, tileoff, cntl);
            gm::SchedMoe<8, false> S; S.tileoff = tileoff; S.cnt = cntl; S.G = F.G; S.c = F.bid; S.nunits = tileoff[32] * 4; S.wsbase = (const char*)F.ws; S.rowtok = nullptr;
            S.A = (const char*)(F.ws + WS_HROWS); S.Bt = (const char*)(wt + WT_DN);
            gm::EpiDN E{(bf16*)(F.ws + WS_YROWS)}; pg8::gemm_phase(F.lds, S, E, F.tid);
        } SEAM(pb + 8);
        if (PHON(11) && IN(pb + 9)) for (int rep_ = NREP(11); rep_ > 0; --rep_) { FRESH(); F.wr = (rep_ == 1) ? wr_true : WR_DRY; if (NREP(11) > 1) GRID_BAR();
            if (!(rep_ > 1 && PROBE_SUB == 2)) ph_combine(F, l, ntok);
            if (!lastl && !(rep_ > 1 && PROBE_SUB == 1)) ph_convert(F, l + 1);
        } if (!lastl) SEAM(pb + 9);
    }
#undef IN
#undef SEAM
}

extern "C" void kernel_launch(void* const* d_in, const int* in_sizes, int n_in, void* d_out, int out_size, void* d_ws, size_t ws_size, hipStream_t stream) {
    static int grid = 0;
    if (grid == 0) {
        if (n_in != 30 || out_size != NLAT * D || ws_size < WS_END) { fprintf(stderr, "kernel_launch: unexpected shapes (n_in %d out %d ws %zu, need %zu)\n", n_in, out_size, ws_size, (size_t)WS_END); grid = -1; return; }
        int dev = 0, cus = 0;
        if (hipGetDevice(&dev) != hipSuccess || hipDeviceGetAttribute(&cus, hipDeviceAttributeMultiprocessorCount, dev) != hipSuccess) { grid = -1; return; }
        if (hipFuncSetAttribute((const void*)fwd_kernel, hipFuncAttributeMaxDynamicSharedMemorySize, LDS_BYTES) != hipSuccess) { fprintf(stderr, "kernel_launch: hipFuncSetAttribute failed\n"); grid = -1; return; }
        int per_cu = 0;
        if (hipOccupancyMaxActiveBlocksPerMultiprocessor(&per_cu, (const void*)fwd_kernel, 512, LDS_BYTES) != hipSuccess || per_cu < 1) { fprintf(stderr, "kernel_launch: occupancy query says %d\n", per_cu); }
        (void)hipGetLastError();
        grid = cus;
    }
    if (grid < 0) return;
    (void)hipMemsetAsync((char*)d_ws + WS_CTL, 0, CTL_BYTES, stream);
#ifdef DIAG_ZERO_GT
    (void)hipMemsetAsync((char*)d_ws + WS_GT, 0x3f, (size_t)204 * MiB, stream);
#endif
    Args a{};
    for (int i = 0; i < 30; ++i) a.in[i] = (const float*)d_in[i];
    a.out = (float*)d_out; a.ws = (unsigned char*)d_ws;
#if MK_N_LAUNCHES == 1
    a.ph_lo = 0; a.ph_hi = N_PHASES;
    hipLaunchKernelGGL(fwd_kernel, dim3(grid), dim3(512), LDS_BYTES, stream, a);
#else
    for (int p = 0; p < N_PHASES; ++p) { a.ph_lo = p; a.ph_hi = p + 1; hipLaunchKernelGGL(fwd_kernel, dim3(grid), dim3(512), LDS_BYTES, stream, a); }
#endif
}
```

```cpp
#include <hip/hip_runtime.h>
#include <cstdio>
#include <cstdint>

#define LAS __attribute__((address_space(3)))
#define GAS __attribute__((address_space(1)))
typedef unsigned short bf16;
typedef short bf16x8 __attribute__((ext_vector_type(8)));
typedef float f32x4 __attribute__((ext_vector_type(4)));
typedef float f32x2 __attribute__((ext_vector_type(2)));
typedef unsigned u32x4 __attribute__((ext_vector_type(4)));
typedef unsigned u32x2 __attribute__((ext_vector_type(2)));

#ifndef MK_N_LAUNCHES
#define MK_N_LAUNCHES 1
#endif

constexpr int D = 1024, NB = 8, SEQ = 4096, LCX = 256, DEPTH = 4;
constexpr int NLAT = NB * SEQ, NCTX = NB * LCX, NTOK = NLAT + NCTX;
constexpr int DIN = 9728;
constexpr int LDP = 6720;
constexpr int C_AX = 0, C_AY = 1024, C_BQ = 2048, C_BK = 2560, C_BV = 3072, C_BG = 4096, C_CQ = 5120, C_CK = 6144, C_CV = 6400, C_GA = 6656;
constexpr int NMOD = 6, NMB = 9;
constexpr int NEXP = 32, DEXP = 512, RCOLS = 36;
constexpr int PMAX = 77824;
constexpr float EPS = 1e-6f;

constexpr size_t MiB = 1u << 20;
constexpr size_t WS_CTL = 0, CTL_BYTES = 1 * MiB;
constexpr size_t WS_MOD = 1 * MiB;
constexpr size_t WS_ROPE = 2 * MiB;
constexpr size_t WS_RW = 4 * MiB;
constexpr size_t WS_HC = 12 * MiB;
constexpr size_t WS_TOKINFO = 20 * MiB;
constexpr size_t WS_ROWTOK = 22 * MiB;
constexpr size_t WS_WT = 28 * MiB;
constexpr size_t WT_IN = 0, WT_BR = 19 * MiB, WT_WO = 25 * MiB, WT_GU = 27 * MiB, WT_DN = 91 * MiB, WT_BYTES = 123 * MiB;
constexpr size_t WS_X = 152 * MiB;
constexpr size_t WS_KV = 220 * MiB;
constexpr size_t WS_PROJ = 288 * MiB;
constexpr size_t WS_HROWS = WS_PROJ;
constexpr size_t WS_YROWS = WS_PROJ + 80 * MiB;
constexpr size_t WS_GT = 736 * MiB;
constexpr size_t WS_YB = 940 * MiB;
constexpr size_t WS_END = 1144 * MiB;
static_assert(WS_PROJ + (size_t)NTOK * LDP * 2 <= WS_GT && WS_GT + (size_t)3 * NTOK * 1024 * 2 <= WS_YB, "ws map");
constexpr int CW_BAR = 1024;
constexpr int CW_BAR_L = 20480, CW_BAR_C = 24576;
constexpr int CW_CNT = 8192;
constexpr size_t CTL_ZROW = 64 * 1024;

constexpr int LDS_BYTES = 163840;
constexpr int LDS_CTL = 155648;
constexpr int MISC_OFF = LDS_CTL + 320;

__device__ __forceinline__ unsigned f2bf(float f) { unsigned u = __builtin_bit_cast(unsigned, f); return (u + 0x7fffu + ((u >> 16) & 1u)) >> 16; }
typedef __bf16 bf16x2_t __attribute__((ext_vector_type(2)));
__device__ __forceinline__ unsigned pk2(float lo, float hi) { const f32x2 v = {lo, hi}; return __builtin_bit_cast(unsigned, __builtin_convertvector(v, bf16x2_t)); }
__device__ __forceinline__ float bf2f(unsigned b) { return __builtin_bit_cast(float, b << 16); }
__device__ __forceinline__ float bflo(unsigned w) { return __builtin_bit_cast(float, w << 16); }
__device__ __forceinline__ float bfhi(unsigned w) { return __builtin_bit_cast(float, w & 0xffff0000u); }
__device__ __forceinline__ float wave_sum(float v) {
#pragma unroll
    for (int o = 1; o < 64; o <<= 1) v += __shfl_xor(v, o);
    return v;
}
__device__ __forceinline__ float sigmoidf_(float x) { return 1.0f / (1.0f + __expf(-x)); }
__device__ __forceinline__ float siluf_(float x) { return x / (1.0f + __expf(-x)); }
__device__ __forceinline__ float gelu_tanh(float x) {
    const float u = 0.7978845608028654f * (x + 0.044715f * x * x * x);
    return x / (1.0f + __expf(-2.0f * u));
}
__device__ __forceinline__ float log1p_fast(float x) { const float u = 1.0f + x; const float d = u - 1.0f; return d == 0.f ? x : __logf(u) * (x / d); }
__device__ __forceinline__ float expm1_fast(float x) { const float u = __expf(x); const float um1 = u - 1.0f; if (um1 == 0.f) return x; const float lu = __logf(u); return um1 == -1.0f ? -1.0f : um1 * (x / lu); }
#define LDS_BARRIER() do { asm volatile("s_waitcnt lgkmcnt(0)" ::: "memory"); __builtin_amdgcn_s_barrier(); asm volatile("" ::: "memory"); } while (0)
#define LDS_WAIT() asm volatile("s_waitcnt lgkmcnt(0)" ::: "memory")
#define VM_WAIT() asm volatile("s_waitcnt vmcnt(0)" ::: "memory")

#define XB_TMO      128
#define XB_XCNT(j)  (256  + 64 * (j))
#define XB_XSUB(j)  (1280 + 64 * (j))
#define XB_XGEN(j)  (2304 + 64 * (j))
#define XB_TOP      3328
#define XB_TOPGEN   3392
#define XCD_BAR_WORDS 3456
#define XB_SPIN_CAP (1u << 22)
__device__ __forceinline__ unsigned xb_ld(unsigned* p)              { return __hip_atomic_load(p, __ATOMIC_RELAXED, __HIP_MEMORY_SCOPE_AGENT); }
__device__ __forceinline__ unsigned xb_add(unsigned* p, unsigned v) { return __hip_atomic_fetch_add(p, v, __ATOMIC_RELAXED, __HIP_MEMORY_SCOPE_AGENT); }
__device__ __forceinline__ unsigned xb_xcc_id() { return (unsigned)__builtin_amdgcn_s_getreg((3 << 11) | 20) & 0xFu; }
#define XB_SPIN(cond, bar) do { unsigned _sp = 0; while (cond) { __builtin_amdgcn_s_sleep(1); \
    if ((++_sp & 255u) == 0u) { if (xb_ld(&(bar)[XB_TMO])) break; if (_sp > XB_SPIN_CAP) { atomicAdd(&(bar)[XB_TMO], 1u); break; } } } } while (0)
struct XcdBarrier { unsigned* bar; unsigned x; volatile LAS unsigned* st; unsigned G; };
__device__ __forceinline__ XcdBarrier xcd_barrier_post(unsigned* bar, volatile LAS unsigned* st, unsigned G) {
    XcdBarrier b; b.bar = bar; b.x = xb_xcc_id(); b.st = st; b.G = G;
    if (threadIdx.x == 0) (void)xb_add(&bar[XB_XCNT(b.x)], 1u);
    return b;
}
__device__ __forceinline__ void xcd_barrier_complete(unsigned* bar, unsigned x, unsigned G, unsigned& nloc, unsigned& nx) {
    unsigned sum, cnt, mine, sp = 0u;
    for (;;) {
        sum = 0u; cnt = 0u; mine = 0u;
#pragma unroll
        for (unsigned j = 0; j < 16; ++j) { const unsigned c = xb_ld(&bar[XB_XCNT(j)]); sum += c; cnt += (c > 0u) ? 1u : 0u; mine = (j == x) ? c : mine; }
        if (sum == G) break;
        __builtin_amdgcn_s_sleep(1);
        if ((++sp & 255u) == 0u) { if (xb_ld(&bar[XB_TMO])) break; if (sp > XB_SPIN_CAP) { atomicAdd(&bar[XB_TMO], 1u); break; } }
    }
    nloc = mine > 0u ? mine : 1u; nx = cnt > 0u ? cnt : 1u;
}
__device__ __forceinline__ void xcd_barrier(const XcdBarrier& b) {
    asm volatile("s_waitcnt vmcnt(0)" ::: "memory");
    __syncthreads();
    if (threadIdx.x == 0) {
        unsigned* bar = b.bar;
        __builtin_amdgcn_s_waitcnt(0);
        unsigned nloc = b.st[0], nx = b.st[1];
        if (nloc == 0u) { xcd_barrier_complete(bar, b.x, b.G, nloc, nx); b.st[0] = nloc; b.st[1] = nx; }
        const unsigned old = xb_add(&bar[XB_XSUB(b.x)], 1u);
        const unsigned gen = old / nloc;
        if (old + 1u == (gen + 1u) * nloc) {
            __builtin_amdgcn_fence(__ATOMIC_RELEASE, "agent");
            asm volatile("s_waitcnt vmcnt(0)" ::: "memory");
            const unsigned og = xb_add(&bar[XB_TOP], 1u);
            const unsigned tg = og / nx;
            if (og + 1u == (tg + 1u) * nx) xb_add(&bar[XB_TOPGEN], 1u);
            else XB_SPIN(xb_ld(&bar[XB_TOPGEN]) == tg, bar);
            __builtin_amdgcn_fence(__ATOMIC_ACQUIRE, "agent");
            xb_add(&bar[XB_XGEN(b.x)], 1u);
            asm volatile("s_waitcnt vmcnt(0)" ::: "memory");
        } else {
            XB_SPIN(xb_ld(&bar[XB_XGEN(b.x)]) == gen, bar);
            __builtin_amdgcn_fence(__ATOMIC_ACQUIRE, "agent");
            asm volatile("s_waitcnt vmcnt(0)" ::: "memory");
        }
    }
    __syncthreads();
}

namespace pg8 {
constexpr int BM = 256, BK = 64, HALF = 128, HTB = HALF * BK * 2, STAGE_BYTES = 8 * HTB;
__device__ __forceinline__ int lds_byte(int r, int c) { const int st = (r >> 4) * 2 + (c >> 5), rr = r & 15, cc = c & 31, ob = rr * 64 + cc * 2; return st * 1024 + (ob ^ (((ob >> 9) & 1) << 5)); }
__device__ __forceinline__ void stage_rc(int b, int& R, int& C) { const int st = b / 1024, sb = b % 1024, swz = sb ^ (((sb >> 9) & 1) << 5); R = (st >> 1) * 16 + swz / 64; C = (st & 1) * 32 + (swz % 64) / 2; }
__device__ __forceinline__ int perm32(int rho) { const int n = rho >> 4, i = rho & 15; return 8 * (i >> 2) + 4 * n + (i & 3); }
__device__ __forceinline__ unsigned cvt_pk_bf16(float lo, float hi) { return pk2(lo, hi); }

template <class Epi, class Sched>
__device__ __forceinline__ void gemm_phase(LAS unsigned char* lds, const Sched& S, const Epi& E, const int tid) {
    typedef typename Sched::Unit Unit;
    const int wid = __builtin_amdgcn_readfirstlane(tid >> 6), lane = tid & 63, wr = wid >> 2, wc = wid & 3, fr = lane & 15, fq = lane >> 4;
    constexpr int nt = Sched::KT; constexpr int K = nt * BK;
    int R[2], C[2]; unsigned voffB[2];
#pragma unroll
    for (int i = 0; i < 2; ++i) { stage_rc(tid * 16 + i * 8192, R[i], C[i]); const int Rb = Epi::PERM ? ((R[i] & ~31) + perm32(R[i] & 31)) : R[i]; voffB[i] = (unsigned)(Rb * K + C[i]) * 2u; }
    constexpr size_t kstep = (size_t)(BK * 2);
    constexpr size_t hstepB = (size_t)HALF * K * 2;
    const unsigned ldsw = (unsigned)wid * 1024u;
    const int aoff = lds_byte(wr * 64 + fr, fq * 8), boff = lds_byte(wc * 32 + fr, fq * 8);
#define PG8_SA(b, h) (((b) * 2 + (h)) * HTB)
#define PG8_SB(b, h) ((4 + (b) * 2 + (h)) * HTB)
#define PG8_STAGEA(bufoff, gbase, vv, h) do { _Pragma("unroll") for (int _i = 0; _i < 2; ++_i) \
        __builtin_amdgcn_global_load_lds((const unsigned*)((const char*)(gbase) + (vv)[h][_i]), (LAS unsigned*)(lds + (bufoff) + ldsw + _i * 8192), 16, 0, 0); } while (0)
#define PG8_STAGEB(bufoff, gbase) do { _Pragma("unroll") for (int _i = 0; _i < 2; ++_i) \
        __builtin_amdgcn_global_load_lds((const unsigned*)((const char*)(gbase) + voffB[_i]), (LAS unsigned*)(lds + (bufoff) + ldsw + _i * 8192), 16, 0, 0); } while (0)
#define PG8_LDA(dst, b, h) do { _Pragma("unroll") for (int m = 0; m < 4; ++m) _Pragma("unroll") for (int k = 0; k < 2; ++k) dst[m][k] = *(const LAS bf16x8*)(lds + PG8_SA(b, h) + aoff + m * 2048 + k * 1024); } while (0)
#define PG8_LDB(dst, b, h) do { _Pragma("unroll") for (int n = 0; n < 2; ++n) _Pragma("unroll") for (int k = 0; k < 2; ++k) dst[n][k] = *(const LAS bf16x8*)(lds + PG8_SB(b, h) + boff + n * 2048 + k * 1024); } while (0)
#define PG8_MMA(ai, bj, At, Bt) do { __builtin_amdgcn_s_setprio(1); _Pragma("unroll") for (int m = 0; m < 4; ++m) _Pragma("unroll") for (int n = 0; n < 2; ++n) _Pragma("unroll") for (int k = 0; k < 2; ++k) \
        acc[ai][bj][m][n] = __builtin_amdgcn_mfma_f32_16x16x32_bf16(Bt[n][k], At[m][k], acc[ai][bj][m][n], 0, 0, 0); __builtin_amdgcn_s_setprio(0); } while (0)
#define PG8_WAIT_V(n) asm volatile("s_waitcnt vmcnt(" #n ")" ::: "memory")
#define PG8_WAIT_L(n) asm volatile("s_waitcnt lgkmcnt(" #n ")" ::: "memory")
#define PG8_BAR __builtin_amdgcn_s_barrier()
#define PG8_SCHED __builtin_amdgcn_sched_barrier(0)
    Unit cur, nxt; int ui = 0;
    if (!S.next(0, cur)) return;
    f32x4 acc[2][2][4][2];
#pragma unroll
    for (int a = 0; a < 2; ++a)
#pragma unroll
        for (int b = 0; b < 2; ++b)
#pragma unroll
            for (int m = 0; m < 4; ++m)
#pragma unroll
                for (int n = 0; n < 2; ++n) acc[a][b][m][n] = (f32x4){0.f, 0.f, 0.f, 0.f};
    bf16x8 At[4][2], B0[2][2], B1[2][2];
    unsigned vA[2][2], vAn[2][2];
    S.a_voff(cur, tid, vA);
#pragma unroll
    for (int h = 0; h < 2; ++h)
#pragma unroll
        for (int i = 0; i < 2; ++i) vAn[h][i] = vA[h][i];
    const char* cA = S.a_base(cur); const char* cB = S.b_base(cur);
    { const char* a0 = cA + S.a_koff(0); const char* a1p = cA + S.a_koff(1);
      PG8_STAGEB(PG8_SB(0, 0), cB); PG8_STAGEB(PG8_SB(0, 1), cB + hstepB); PG8_STAGEA(PG8_SA(0, 0), a0, vA, 0); PG8_STAGEA(PG8_SA(0, 1), a0, vA, 1);
      if (wr == 1) PG8_BAR;
      PG8_WAIT_V(2); PG8_BAR;
      PG8_STAGEB(PG8_SB(1, 0), cB + kstep); PG8_STAGEA(PG8_SA(1, 0), a1p, vA, 0); PG8_STAGEB(PG8_SB(1, 1), cB + hstepB + kstep);
      PG8_WAIT_V(6); PG8_BAR; }
    for (;;) {
        const bool has_next = S.next(ui + 1, nxt);
        const char* nA = cA; const char* nB = cB;
        if (has_next) { nA = S.a_base(nxt); nB = S.b_base(nxt); }
#pragma unroll 1
        for (int t = 0; t < nt; t += 2) {
            const bool last = (t == nt - 2);
            if constexpr (Epi::MIDK) { if (t == 16 || t == 32) E.mid(acc, cur, t, wr, wc, fr, fq); }
            if constexpr (Sched::GATHER) { if (t == nt - 4 && has_next) S.a_voff(nxt, tid, vAn); }
            const char* a1 = cA + S.a_koff(t + 1);
            const char* a2 = last ? nA + S.a_koff(0) : cA + S.a_koff(t + 2);
            const char* a3 = last ? nA + S.a_koff(1) : cA + S.a_koff(t + 3);
            const char* b2 = last ? nB : cB + (size_t)(t + 2) * kstep; const char* b3 = b2 + kstep;
            PG8_LDB(B0, 0, 0); PG8_LDB(B1, 0, 1); PG8_SCHED; PG8_LDA(At, 0, 0); PG8_STAGEA(PG8_SA(1, 1), a1, vA, 1);
            PG8_WAIT_V(8); PG8_WAIT_L(0); PG8_BAR; PG8_MMA(0, 0, At, B0); PG8_MMA(0, 1, At, B1); PG8_BAR; PG8_SCHED;
            PG8_LDA(At, 0, 1); PG8_STAGEB(PG8_SB(0, 0), b2); PG8_STAGEB(PG8_SB(0, 1), b2 + hstepB);
            if (last) { PG8_STAGEA(PG8_SA(0, 0), a2, vAn, 0); } else { PG8_STAGEA(PG8_SA(0, 0), a2, vA, 0); }
            PG8_WAIT_V(8); PG8_WAIT_L(0); PG8_BAR; PG8_MMA(1, 0, At, B0); PG8_MMA(1, 1, At, B1); PG8_BAR; PG8_SCHED;
            PG8_LDB(B0, 1, 0); PG8_LDB(B1, 1, 1); PG8_SCHED; PG8_LDA(At, 1, 0);
            if (last) { PG8_STAGEA(PG8_SA(0, 1), a2, vAn, 1); } else { PG8_STAGEA(PG8_SA(0, 1), a2, vA, 1); }
            PG8_WAIT_V(8); PG8_WAIT_L(0); PG8_BAR; PG8_MMA(0, 0, At, B0); PG8_MMA(0, 1, At, B1); PG8_BAR; PG8_SCHED;
            PG8_LDA(At, 1, 1); PG8_STAGEB(PG8_SB(1, 0), b3); PG8_STAGEB(PG8_SB(1, 1), b3 + hstepB);
            if (last) { PG8_STAGEA(PG8_SA(1, 0), a3, vAn, 0); } else { PG8_STAGEA(PG8_SA(1, 0), a3, vA, 0); }
            PG8_WAIT_V(8); PG8_WAIT_L(0); PG8_BAR; PG8_MMA(1, 0, At, B0); PG8_MMA(1, 1, At, B1); PG8_BAR; PG8_SCHED;
        }
        if (wr == 0) PG8_BAR;
        E(acc, cur, wr, wc, fr, fq);
        if (!has_next) break;
#pragma unroll
        for (int a = 0; a < 2; ++a)
#pragma unroll
            for (int b = 0; b < 2; ++b)
#pragma unroll
                for (int m = 0; m < 4; ++m)
#pragma unroll
                    for (int n = 0; n < 2; ++n) acc[a][b][m][n] = (f32x4){0.f, 0.f, 0.f, 0.f};
        cur = nxt; cA = nA; cB = nB; ++ui;
        if constexpr (Sched::GATHER) {
#pragma unroll
            for (int h = 0; h < 2; ++h)
#pragma unroll
                for (int i = 0; i < 2; ++i) vA[h][i] = vAn[h][i];
        }
        if (wr == 1) PG8_BAR;
    }
    PG8_WAIT_V(0);
    PG8_BAR;
#undef PG8_SA
#undef PG8_SB
#undef PG8_STAGEA
#undef PG8_STAGEB
#undef PG8_LDA
#undef PG8_LDB
#undef PG8_MMA
#undef PG8_WAIT_V
#undef PG8_WAIT_L
#undef PG8_BAR
#undef PG8_SCHED
}
}
namespace gm {
using pg8::cvt_pk_bf16;
__device__ __forceinline__ float fexp_(float x) { return __builtin_amdgcn_exp2f(1.4426950408889634f * x); }
__device__ __forceinline__ float fsig_(float x) { return __builtin_amdgcn_rcpf(1.0f + fexp_(-x)); }
__device__ __forceinline__ float fsilu_(float x) { return x * fsig_(x); }
struct Unit { int pm, pn; };
struct OrderBase {
    int nM, nN, nwg, G, c;
    __device__ __forceinline__ void init(int nM_, int nN_, int G_, int c_) { nM = nM_; nN = nN_; nwg = nM * nN; G = G_; c = c_; }
    __device__ __forceinline__ bool next(int i, Unit& u) const {
        const int L = i * G + c; if (L >= nwg) return false;
        int wgid = L; { const int q = nwg / 8, r = nwg % 8, xcd = wgid % 8, off = wgid / 8; wgid = (xcd < r ? xcd * (q + 1) : r * (q + 1) + (xcd - r) * q) + off; }
        const int nig = 8 * nN, gid = wgid / nig, fm = gid * 8, gsz = (nM - fm) < 8 ? (nM - fm) : 8;
        u.pm = fm + ((wgid % nig) % gsz); u.pn = (wgid % nig) / gsz; return true;
    }
};
struct OrderColAffine {
    int nM, nN, nwg, G, c;
    __device__ __forceinline__ void init(int nM_, int nN_, int G_, int c_) { nM = nM_; nN = nN_; nwg = nM * nN; G = G_; c = c_; }
    __device__ __forceinline__ bool next(int i, Unit& u) const {
        if (G != 256 || nN != 4) { const int L = i * G + c; if (L >= nwg) return false; u.pm = L / nN; u.pn = L % nN; return true; }
        const int x = c & 7, k = c >> 3, j = i * 32 + k; if (2 * j + (x >> 2) >= nM) return false;
        u.pm = 2 * j + (x >> 2); u.pn = x & 3; return true;
    }
};
struct OrderSub : OrderBase {
    int pm0; bool on;
    __device__ __forceinline__ void init(int nM_, int nN_, int Gs, int cs, int pm0_, bool on_) { OrderBase::init(nM_, nN_, Gs, cs); pm0 = pm0_; on = on_; }
    __device__ __forceinline__ bool next(int i, Unit& u) const { if (!on || !OrderBase::next(i, u)) return false; u.pm += pm0; return true; }
};
template <int KT_, int LDA, class Order = OrderBase> struct SchedPlain : Order {
    typedef gm::Unit Unit; static constexpr int KT = KT_; static constexpr bool GATHER = false;
    const char* A; const char* Bt;
    __device__ __forceinline__ const char* a_base(const Unit& u) const { return A + (size_t)u.pm * 256 * LDA * 2; }
    __device__ __forceinline__ void a_voff(const Unit&, int tid, unsigned (&v)[2][2]) const {
#pragma unroll
        for (int i = 0; i < 2; ++i) { int R, C; pg8::stage_rc(tid * 16 + i * 8192, R, C);
#pragma unroll
            for (int h = 0; h < 2; ++h) v[h][i] = (unsigned)((h * 128 + R) * LDA + C) * 2u; }
    }
    __device__ __forceinline__ size_t a_koff(int kt) const { return (size_t)kt * 128; }
    __device__ __forceinline__ const char* b_base(const Unit& u) const { return Bt + (size_t)u.pn * 256 * (KT * 64) * 2; }
};
struct SchedMerge : OrderBase {
    typedef gm::Unit Unit; static constexpr int KT = 48; static constexpr bool GATHER = false;
    const char* A; const char* Bt;
    __device__ __forceinline__ const char* a_base(const Unit& u) const { return A + (size_t)u.pm * 256 * LDP * 2; }
    __device__ __forceinline__ void a_voff(const Unit&, int tid, unsigned (&v)[2][2]) const {
#pragma unroll
        for (int i = 0; i < 2; ++i) { int R, C; pg8::stage_rc(tid * 16 + i * 8192, R, C);
#pragma unroll
            for (int h = 0; h < 2; ++h) v[h][i] = (unsigned)((h * 128 + R) * LDP + C) * 2u; }
    }
    __device__ __forceinline__ size_t a_koff(int kt) const { return (size_t)(kt < 16 ? (C_AY + 64 * kt) : (C_BG - 1024 + 64 * kt)) * 2; }
    __device__ __forceinline__ const char* b_base(const Unit& u) const { return Bt + (size_t)u.pn * 256 * 3072 * 2; }
};
struct MUnit { int e, tile, pn, slot0; };
template <int KT_, bool GATHER_> struct SchedMoe {
    typedef gm::MUnit Unit; static constexpr int KT = KT_; static constexpr bool GATHER = GATHER_;
    const volatile LAS int* tileoff; const volatile LAS int* cnt;
    int G, c, nunits;
    const char* wsbase; const int* rowtok; const char* A; const char* Bt;
    __device__ __forceinline__ bool next(int i, Unit& u) const {
        const int L = i * G + c; if (L >= nunits) return false;
        const int rt = L >> 2; u.pn = L & 3;
        int e = 0;
#pragma unroll 1
        for (int k = 1; k < 32; ++k) e = (rt >= tileoff[k]) ? k : e;
        u.e = e; u.tile = rt - tileoff[e]; u.slot0 = rt * 256; return true;
    }
    __device__ __forceinline__ const char* a_base(const Unit& u) const { if constexpr (GATHER) return wsbase; else return A + (size_t)u.slot0 * DEXP * 2; }
    __device__ __forceinline__ void a_voff(const Unit& u, int tid, unsigned (&v)[2][2]) const {
        if constexpr (GATHER) {
            asm volatile("" : "+v"(tid));
            const int n = cnt[u.e]; const int* rt = rowtok + (size_t)u.e * NTOK + u.tile * 256;
#pragma unroll
            for (int i = 0; i < 2; ++i) { int R, C; pg8::stage_rc(tid * 16 + i * 8192, R, C);
#pragma unroll
                for (int h = 0; h < 2; ++h) { const int r = h * 128 + R; const bool ok = (u.tile * 256 + r) < n; const int tok = ok ? rt[r] : 0;
                    v[h][i] = ok ? (unsigned)(WS_X + (size_t)tok * 2048 + C * 2) : (unsigned)(CTL_ZROW + C * 2); } }
        } else {
#pragma unroll
            for (int i = 0; i < 2; ++i) { int R, C; pg8::stage_rc(tid * 16 + i * 8192, R, C);
#pragma unroll
                for (int h = 0; h < 2; ++h) v[h][i] = (unsigned)((h * 128 + R) * DEXP + C) * 2u; }
        }
    }
    __device__ __forceinline__ size_t a_koff(int kt) const { return (size_t)kt * 128; }
    __device__ __forceinline__ const char* b_base(const Unit& u) const { return Bt + ((size_t)u.e * 1024 + u.pn * 256) * (KT * 64) * 2; }
};

struct EpiProj {
    static constexpr bool PERM = true, MIDK = false; bf16* O; unsigned char* GT;
    static __device__ __forceinline__ unsigned gq8_(float z) { return (unsigned)fmaxf(fsig_(z) * 255.0f + 0.5f, 1.0f); }
    __device__ __forceinline__ void operator()(const f32x4 (&acc)[2][2][4][2], const Unit& u, int wr, int wc, int fr, int fq) const {
        if (u.pn >= 26) {
            const int br = (u.pn - 26) >> 2, pq = (u.pn - 26) & 3; const int wave = wr * 4 + wc, lane = fq * 16 + fr;
            unsigned char* t = GT + (((size_t)(br * 136 + u.pm) * 4 + pq) << 16) + (size_t)(wave * 64 + lane) * 16;
#pragma unroll
            for (int ai = 0; ai < 2; ++ai)
#pragma unroll
                for (int m = 0; m < 4; ++m) { u32x4 w;
#pragma unroll
                    for (int bj = 0; bj < 2; ++bj) { const f32x4 v0 = acc[ai][bj][m][0], v1 = acc[ai][bj][m][1];
                        w[2 * bj] = gq8_(v0[0]) | (gq8_(v0[1]) << 8) | (gq8_(v0[2]) << 16) | (gq8_(v0[3]) << 24);
                        w[2 * bj + 1] = gq8_(v1[0]) | (gq8_(v1[1]) << 8) | (gq8_(v1[2]) << 16) | (gq8_(v1[3]) << 24); }
                    *(u32x4*)(t + (ai * 4 + m) * 8192) = w; }
            return;
        }
        bf16* base = O + (size_t)(u.pm * 256 + wr * 64 + fr) * LDP + u.pn * 256 + wc * 32 + 8 * fq;
#pragma unroll
        for (int ai = 0; ai < 2; ++ai)
#pragma unroll
            for (int m = 0; m < 4; ++m) { bf16* rowp = base + (size_t)(ai * 128 + m * 16) * LDP;
#pragma unroll
                for (int bj = 0; bj < 2; ++bj) { const f32x4 v0 = acc[ai][bj][m][0], v1 = acc[ai][bj][m][1];
                    u32x4 w; w.x = cvt_pk_bf16(v0[0], v0[1]); w.y = cvt_pk_bf16(v0[2], v0[3]); w.z = cvt_pk_bf16(v1[0], v1[1]); w.w = cvt_pk_bf16(v1[2], v1[3]);
                    *(u32x4*)(rowp + bj * 128) = w; } }
    }
};
struct EpiPlain {
    static constexpr bool PERM = true, MIDK = false; bf16* O;
    __device__ __forceinline__ void operator()(const f32x4 (&acc)[2][2][4][2], const Unit& u, int wr, int wc, int fr, int fq) const {
        bf16* base = O + (size_t)(u.pm * 256 + wr * 64 + fr) * 1024 + u.pn * 256 + wc * 32 + 8 * fq;
#pragma unroll
        for (int ai = 0; ai < 2; ++ai)
#pragma unroll
            for (int m = 0; m < 4; ++m) { bf16* rowp = base + (size_t)(ai * 128 + m * 16) * 1024;
#pragma unroll
                for (int bj = 0; bj < 2; ++bj) { const f32x4 v0 = acc[ai][bj][m][0], v1 = acc[ai][bj][m][1];
                    u32x4 w; w.x = cvt_pk_bf16(v0[0], v0[1]); w.y = cvt_pk_bf16(v0[2], v0[3]); w.z = cvt_pk_bf16(v1[0], v1[1]); w.w = cvt_pk_bf16(v1[2], v1[3]);
                    *(u32x4*)(rowp + bj * 128) = w; } }
    }
};
struct EpiMerge {
    static constexpr bool PERM = true, MIDK = true; const unsigned char* GT; bf16* O;
    __device__ __forceinline__ const unsigned char* tile(const Unit& u, int br, int wr, int wc, int fr, int fq) const {
        return GT + (((size_t)(br * 136 + u.pm) * 4 + u.pn) << 16) + (size_t)((wr * 4 + wc) * 64 + fq * 16 + fr) * 16; }
    static __device__ __forceinline__ float b8_(unsigned w, int k) { return (float)((w >> (8 * k)) & 0xffu); }
    __device__ __forceinline__ void mid(f32x4 (&acc)[2][2][4][2], const Unit& u, int t, int wr, int wc, int fr, int fq) const {
        const int br = (t == 16) ? 0 : 1; const unsigned char* ta = tile(u, br, wr, wc, fr, fq); const unsigned char* tb = tile(u, br + 1, wr, wc, fr, fq);
        u32x4 ga[8], gb[8];
#pragma unroll
        for (int j = 0; j < 8; ++j) { ga[j] = *(const u32x4*)(ta + 8192 * j); gb[j] = *(const u32x4*)(tb + 8192 * j); }
#pragma unroll
        for (int ai = 0; ai < 2; ++ai)
#pragma unroll
            for (int m = 0; m < 4; ++m)
#pragma unroll
                for (int bj = 0; bj < 2; ++bj)
#pragma unroll
                    for (int hw = 0; hw < 2; ++hw) { const unsigned wa = ga[ai * 4 + m][2 * bj + hw], wb = gb[ai * 4 + m][2 * bj + hw];
#pragma unroll
                        for (int k = 0; k < 4; ++k) acc[ai][bj][m][hw][k] *= b8_(wa, k) * __builtin_amdgcn_rcpf(b8_(wb, k)); }
    }
    __device__ __forceinline__ void operator()(const f32x4 (&acc)[2][2][4][2], const Unit& u, int wr, int wc, int fr, int fq) const {
        const unsigned char* tc = tile(u, 2, wr, wc, fr, fq);
        u32x4 gc[8];
#pragma unroll
        for (int j = 0; j < 8; ++j) gc[j] = *(const u32x4*)(tc + 8192 * j);
        const size_t row0 = (size_t)(u.pm * 256 + wr * 64 + fr); const int col0 = u.pn * 256 + wc * 32 + 8 * fq;
        constexpr float S = 1.0f / 255.0f;
#pragma unroll
        for (int ai = 0; ai < 2; ++ai)
#pragma unroll
            for (int m = 0; m < 4; ++m) { const size_t row = row0 + ai * 128 + m * 16;
#pragma unroll
                for (int bj = 0; bj < 2; ++bj) { const unsigned g0 = gc[ai * 4 + m][2 * bj], g1 = gc[ai * 4 + m][2 * bj + 1];
                    const f32x4 v0 = acc[ai][bj][m][0] * S, v1 = acc[ai][bj][m][1] * S; u32x4 w;
                    w.x = cvt_pk_bf16(v0[0] * b8_(g0, 0), v0[1] * b8_(g0, 1)); w.y = cvt_pk_bf16(v0[2] * b8_(g0, 2), v0[3] * b8_(g0, 3));
                    w.z = cvt_pk_bf16(v1[0] * b8_(g1, 0), v1[1] * b8_(g1, 1)); w.w = cvt_pk_bf16(v1[2] * b8_(g1, 2), v1[3] * b8_(g1, 3));
                    *(u32x4*)(O + row * 1024 + col0 + bj * 128) = w; } }
    }
};
struct EpiWo {
    static constexpr bool PERM = false, MIDK = false; float* h; float* hc; const float* mod; bool wen; const float* hsrc; const float* hcsrc;
    __device__ __forceinline__ void operator()(const f32x4 (&acc)[2][2][4][2], const Unit& u, int wr, int wc, int fr, int fq) const {
        const bool lat = u.pm < 128; const int mb = lat ? (u.pm >> 4) : 8;
        float* hb = lat ? h + (size_t)u.pm * 256 * 1024 : hc + (size_t)(u.pm - 128) * 256 * 1024;
        const float* sb = lat ? hsrc + (size_t)u.pm * 256 * 1024 : hcsrc + (size_t)(u.pm - 128) * 256 * 1024;
        const int col0 = u.pn * 256 + wc * 32 + 4 * fq; const float* mp = mod + (size_t)mb * 6144 + 2 * 1024 + col0;
        f32x4 mv[2][2];
#pragma unroll
        for (int bj = 0; bj < 2; ++bj)
#pragma unroll
            for (int n = 0; n < 2; ++n) mv[bj][n] = *(const f32x4*)(mp + bj * 128 + n * 16);
#pragma unroll
        for (int ai = 0; ai < 2; ++ai)
#pragma unroll
            for (int m = 0; m < 4; ++m) { const size_t ro = (size_t)(ai * 128 + wr * 64 + m * 16 + fr) * 1024 + col0; float* rowp = hb + ro; const float* srcp = sb + ro;
#pragma unroll
                for (int bj = 0; bj < 2; ++bj)
#pragma unroll
                    for (int n = 0; n < 2; ++n) { f32x4 hv = *(const f32x4*)(srcp + bj * 128 + n * 16); hv = hv + mv[bj][n] * acc[ai][bj][m][n]; if (wen) *(f32x4*)(rowp + bj * 128 + n * 16) = hv; } }
    }
};
struct EpiGU {
    static constexpr bool PERM = true, MIDK = false; bf16* H;
    __device__ __forceinline__ void operator()(const f32x4 (&acc)[2][2][4][2], const MUnit& u, int wr, int wc, int fr, int fq) const {
        bf16* base = H + (size_t)(u.slot0 + wr * 64 + fr) * DEXP + u.pn * 128 + wc * 32 + 8 * fq;
#pragma unroll
        for (int ai = 0; ai < 2; ++ai)
#pragma unroll
            for (int m = 0; m < 4; ++m) { const f32x4 g0 = acc[ai][0][m][0], g1 = acc[ai][0][m][1], u0 = acc[ai][1][m][0], u1 = acc[ai][1][m][1]; u32x4 w;
                w.x = cvt_pk_bf16(fsilu_(g0[0]) * u0[0], fsilu_(g0[1]) * u0[1]); w.y = cvt_pk_bf16(fsilu_(g0[2]) * u0[2], fsilu_(g0[3]) * u0[3]);
                w.z = cvt_pk_bf16(fsilu_(g1[0]) * u1[0], fsilu_(g1[1]) * u1[1]); w.w = cvt_pk_bf16(fsilu_(g1[2]) * u1[2], fsilu_(g1[3]) * u1[3]);
                *(u32x4*)(base + (size_t)(ai * 128 + m * 16) * DEXP) = w; }
    }
};
struct EpiDN {
    static constexpr bool PERM = true, MIDK = false; bf16* Y;
    __device__ __forceinline__ void operator()(const f32x4 (&acc)[2][2][4][2], const MUnit& u, int wr, int wc, int fr, int fq) const {
        bf16* base = Y + (size_t)(u.slot0 + wr * 64 + fr) * 1024 + u.pn * 256 + wc * 32 + 8 * fq;
#pragma unroll
        for (int ai = 0; ai < 2; ++ai)
#pragma unroll
            for (int m = 0; m < 4; ++m) { bf16* rowp = base + (size_t)(ai * 128 + m * 16) * 1024;
#pragma unroll
                for (int bj = 0; bj < 2; ++bj) { const f32x4 v0 = acc[ai][bj][m][0], v1 = acc[ai][bj][m][1];
                    u32x4 w; w.x = cvt_pk_bf16(v0[0], v0[1]); w.y = cvt_pk_bf16(v0[2], v0[3]); w.z = cvt_pk_bf16(v1[0], v1[1]); w.w = cvt_pk_bf16(v1[2], v1[3]);
                    *(u32x4*)(rowp + bj * 128) = w; } }
    }
};
}
struct Args { const float* in[30]; float* out; unsigned char* ws; int ph_lo, ph_hi; };
enum { I_X = 0, I_C, I_CTX, I_CCTX, I_WMOD, I_BMOD, I_N1G, I_N2G, I_WIN, I_CONVW, I_CONVB, I_WA, I_BA, I_WX, I_BX, I_LAM, I_RLAM, I_SINK,
       I_WBA, I_WBB, I_WBC, I_WOUT, I_RGW, I_RGB, I_REW, I_REB, I_EWG, I_EWU, I_EWD, I_FNG };
typedef const GAS float* cfp_t;
struct Frame {
    LAS unsigned char* lds; int tid, lane, wave, G, bid, gw, NGW; bool wr;
    const __attribute__((address_space(4))) cfp_t* in; float* out; unsigned char* ws;
};
#define FIN(i)     ((const float*)F.in[i])
#define F_MOD(F)   ((float*)((F).ws + WS_MOD))
#define F_HC(F)    ((float*)((F).ws + WS_HC))
#define F_X(F)     ((bf16*)((F).ws + WS_X))
#define F_PROJ(F)  ((bf16*)((F).ws + WS_PROJ))
#define F_YB(F)    ((bf16*)((F).ws + WS_YB))
#define F_CNT(F)   ((int*)((F).ws + WS_CTL) + CW_CNT)

__device__ __forceinline__ void ph_prologue(Frame& F) {
    LAS float* sc = (LAS float*)F.lds;
    LAS float* part = (LAS float*)(F.lds + 40960);
    for (int i = F.tid; i < 9 * 1024; i += 512) { const int mb = i >> 10, k = i & 1023; const float cv = mb < 8 ? FIN(I_C)[mb * 1024 + k] : FIN(I_CCTX)[k]; sc[i] = siluf_(cv); }
    __syncthreads();
    for (int item = F.bid; item < 4 * 96; item += F.G) {
        const int l = item / 96, n0 = (item % 96) * 64;
        const float* wp = FIN(I_WMOD) + ((size_t)l * 1024 + F.wave * 128) * 6144 + n0 + F.lane;
        float acc[9];
#pragma unroll
        for (int mb = 0; mb < 9; ++mb) acc[mb] = 0.f;
#pragma unroll 32
        for (int k = 0; k < 128; ++k) { const float wv = wp[(size_t)k * 6144];
#pragma unroll
            for (int mb = 0; mb < 9; ++mb) acc[mb] += sc[mb * 1024 + F.wave * 128 + k] * wv; }
#pragma unroll
        for (int mb = 0; mb < 9; ++mb) part[(F.wave * 9 + mb) * 64 + F.lane] = acc[mb];
        __syncthreads();
        for (int t = F.tid; t < 576; t += 512) { const int mb = t >> 6, ln = t & 63; float s = FIN(I_BMOD)[l * 6144 + n0 + ln];
#pragma unroll
            for (int w = 0; w < 8; ++w) s += part[(w * 9 + mb) * 64 + ln];
            F_MOD(F)[((size_t)l * 9 + mb) * 6144 + n0 + ln] = s; }
        __syncthreads();
    }
    f32x2* rt = (f32x2*)(F.ws + WS_ROPE);
    for (int i = F.bid * 512 + F.tid; i < 4096 * 32; i += F.G * 512) { const int pos = i >> 5, f = i & 31;
        const float inv = (float)pow(10000.0, -(double)(2 * f) / 64.0); const float ang = (float)pos * inv;
        rt[i] = (f32x2){(float)cos((double)ang), (float)sin((double)ang)}; }
    f32x2* at = (f32x2*)(F.ws + WS_ROPE + 1 * MiB);
    for (int i = F.bid * 512 + F.tid; i < 64 * 16; i += F.G * 512) { const int pos = i >> 4, f = i & 15;
        const float inv = (float)pow(10000.0, -(double)(2 * f) / 32.0); const float ang = (float)pos * inv;
        at[i] = (f32x2){(float)cos((double)ang), (float)sin((double)ang)}; }
}

__device__ __forceinline__ void tr_item(const float* W, int ldw, int k0, int n0, bf16* dst  , int ldk, LAS float* scr, int lane) {
    float wv[32];
#pragma unroll
    for (int i = 0; i < 32; ++i) { const int kk = 2 * i + (lane >> 5); wv[i] = W[(size_t)(k0 + kk) * ldw + n0 + (lane & 31)]; }
#pragma unroll
    for (int i = 0; i < 32; ++i) { const int kk = 2 * i + (lane >> 5); scr[kk * 33 + (lane & 31)] = wv[i]; }
    LDS_WAIT(); asm volatile("" ::: "memory");
    const int c = lane & 7;
#pragma unroll
    for (int j = 0; j < 4; ++j) { const int n = (lane >> 3) + 8 * j; const LAS float* s = scr + (8 * c) * 33 + n;
        u32x4 o; o.x = pk2(s[0 * 33], s[1 * 33]); o.y = pk2(s[2 * 33], s[3 * 33]); o.z = pk2(s[4 * 33], s[5 * 33]); o.w = pk2(s[6 * 33], s[7 * 33]);
        *(u32x4*)(dst + (size_t)n * ldk + 8 * c) = o; }
    LDS_WAIT(); asm volatile("" ::: "memory");
}
__device__ __forceinline__ void ph_convert(Frame& F, int l) {
    LAS float* scr = (LAS float*)(F.lds + F.wave * 16384);
    bf16* wt = (bf16*)(F.ws + WS_WT);
    constexpr int I_IN = 16 * 304, I_BRN = 16 * 32, I_GU1 = 16 * 16, I_DN1 = 8 * 32;
    constexpr int NITEMS = I_IN + 4 * I_BRN + 32 * 2 * I_GU1 + 32 * I_DN1;
    for (int it = F.gw; it < NITEMS; it += F.NGW) {
        int r = it;
        if (r < I_IN) { const int kb = r / 304, nb = r % 304; tr_item(FIN(I_WIN) + (size_t)l * 1024 * DIN, DIN, 64 * kb, 32 * nb, wt + WT_IN / 2 + (size_t)(32 * nb) * 1024 + 64 * kb, 1024, scr, F.lane); continue; }
        r -= I_IN;
        if (r < 3 * I_BRN) { const int br = r / I_BRN, q = r % I_BRN, kb = q / 32, nb = q % 32; const float* W = FIN(I_WBA + br) + (size_t)l * 1024 * 1024;
            tr_item(W, 1024, 64 * kb, 32 * nb, wt + WT_BR / 2 + (size_t)(32 * nb) * 3072 + br * 1024 + 64 * kb, 3072, scr, F.lane); continue; }
        r -= 3 * I_BRN;
        if (r < I_BRN) { const int kb = r / 32, nb = r % 32; tr_item(FIN(I_WOUT) + (size_t)l * 1024 * 1024, 1024, 64 * kb, 32 * nb, wt + WT_WO / 2 + (size_t)(32 * nb) * 1024 + 64 * kb, 1024, scr, F.lane); continue; }
        r -= I_BRN;
        if (r < 32 * 2 * I_GU1) { const int e = r / (2 * I_GU1), q = r % (2 * I_GU1), up = q / I_GU1, q2 = q % I_GU1, kb = q2 / 16, nb = q2 % 16;
            const float* W = FIN(up ? I_EWU : I_EWG) + ((size_t)l * 32 + e) * 1024 * 512; const int n0 = 32 * nb;
            const int drow = e * 1024 + (n0 >> 7) * 256 + up * 128 + (n0 & 127);
            tr_item(W, 512, 64 * kb, n0, wt + WT_GU / 2 + (size_t)drow * 1024 + 64 * kb, 1024, scr, F.lane); continue; }
        r -= 32 * 2 * I_GU1;
        { const int e = r / I_DN1, q = r % I_DN1, kb = q / 32, nb = q % 32; const float* W = FIN(I_EWD) + ((size_t)l * 32 + e) * 512 * 1024;
            tr_item(W, 1024, 64 * kb, 32 * nb, wt + WT_DN / 2 + (size_t)(e * 1024 + 32 * nb) * 512 + 64 * kb, 512, scr, F.lane); }
    }
}
constexpr size_t RW_ELEMS = (size_t)4 * 9 * 48 * 1024;
__device__ __forceinline__ void ph_router_fold(Frame& F) {
    float* Wp = (float*)(F.ws + WS_RW); float* rc = Wp + RW_ELEMS;
    for (int i = F.bid * 512 + F.tid; i < (int)RW_ELEMS; i += F.G * 512) {
        const int k = i & 1023, j = (i >> 10) % 48, mb = (i / (48 * 1024)) % 9, l = i / (48 * 1024 * 9);
        float v = 0.f;
        if (j < RCOLS) { const float w = j < 4 ? FIN(I_RGW)[((size_t)l * 1024 + k) * 4 + j] : FIN(I_REW)[((size_t)l * 1024 + k) * 32 + (j - 4)];
            v = FIN(I_N2G)[l * 1024 + k] * (1.0f + F_MOD(F)[((size_t)l * 9 + mb) * 6144 + 4 * 1024 + k]) * w; }
        Wp[i] = v;
    }
    for (int it = F.gw; it < 4 * 9 * RCOLS; it += F.NGW) { const int j = it % RCOLS, mb = (it / RCOLS) % 9, l = it / (RCOLS * 9);
        float s = 0.f;
        for (int k = F.lane; k < 1024; k += 64) { const float w = j < 4 ? FIN(I_RGW)[((size_t)l * 1024 + k) * 4 + j] : FIN(I_REW)[((size_t)l * 1024 + k) * 32 + (j - 4)];
            s += F_MOD(F)[((size_t)l * 9 + mb) * 6144 + 3 * 1024 + k] * w; }
        s = wave_sum(s);
        if (F.lane == 0) rc[(l * 9 + mb) * 64 + j] = s + (j < 4 ? FIN(I_RGB)[l * 4 + j] : FIN(I_REB)[l * 32 + (j - 4)]);
    }
}

struct RowJob { const float* src; float* copy_to; int mb; };
template <class RowFn> __device__ __forceinline__ void rows_norm_loop(Frame& F, int row0, int nrows, int w, int NW, const float* gain, const float* mod, int shift_i, int scale_i, bf16* dst, RowFn rowfn) {
    const int lane = F.lane;
    f32x4 nv[4]; RowJob nj = {nullptr, nullptr, 0};
    const int per = (nrows - row0 + NW - 1) / NW; int r = row0 + w * per; const int rend = (r + per < nrows) ? r + per : nrows;
    if (r < rend) { nj = rowfn(r);
#pragma unroll
        for (int j = 0; j < 4; ++j) nv[j] = *(const f32x4*)(nj.src + 4 * lane + 256 * j); }
    int mbc = -1; f32x4 cgs[4], csh[4];
    for (; r < rend; ++r) {
        f32x4 v[4]; const RowJob cj = nj;
#pragma unroll
        for (int j = 0; j < 4; ++j) v[j] = nv[j];
        if (r + 1 < rend) { nj = rowfn(r + 1);
#pragma unroll
            for (int j = 0; j < 4; ++j) nv[j] = *(const f32x4*)(nj.src + 4 * lane + 256 * j); }
        if (cj.mb != mbc) { mbc = cj.mb;
#pragma unroll
            for (int j = 0; j < 4; ++j) { cgs[j] = *(const f32x4*)(gain + 4 * lane + 256 * j) * (*(const f32x4*)(mod + cj.mb * 6144 + scale_i * 1024 + 4 * lane + 256 * j) + 1.0f);
                csh[j] = *(const f32x4*)(mod + cj.mb * 6144 + shift_i * 1024 + 4 * lane + 256 * j); } }
        float ss = 0.f;
#pragma unroll
        for (int j = 0; j < 4; ++j) ss += (v[j].x * v[j].x + v[j].y * v[j].y) + (v[j].z * v[j].z + v[j].w * v[j].w);
        if (cj.copy_to) {
#pragma unroll
            for (int j = 0; j < 4; ++j) *(f32x4*)(cj.copy_to + 4 * lane + 256 * j) = v[j]; }
        const float rstd = 1.0f / sqrtf(wave_sum(ss) * (1.0f / 1024.0f) + EPS);
#pragma unroll
        for (int j = 0; j < 4; ++j) { const f32x4 y = (v[j] * rstd) * cgs[j] + csh[j];
            u32x2 w; w.x = pk2(y.x, y.y); w.y = pk2(y.z, y.w); *(u32x2*)(dst + (size_t)r * 1024 + 4 * lane + 256 * j) = w; }
    }
}
__device__ __forceinline__ void ph_rows_u(Frame& F, int l, bool first) {
    const float* mod = F_MOD(F) + (size_t)l * 9 * 6144; const float* g = FIN(I_N1G) + l * 1024;
    float* out = F.out; float* hc = F_HC(F); const float* xin = FIN(I_X); const float* cin = FIN(I_CTX);
    rows_norm_loop(F, 0, NTOK, F.gw, F.NGW, g, mod, 0, 1, F_X(F), [=](int r) { const bool lat = r < NLAT; RowJob j; j.mb = lat ? (r >> 12) : 8;
        float* hrow = lat ? out + (size_t)r * 1024 : hc + (size_t)(r - NLAT) * 1024;
        j.src = first ? (lat ? xin + (size_t)r * 1024 : cin + (size_t)(r - NLAT) * 1024) : hrow; j.copy_to = nullptr; return j; });
}
__device__ __forceinline__ void ph_rows_v(Frame& F, int l, int row0, int ntok, int w, int NW) {
    const float* mod = F_MOD(F) + (size_t)l * 9 * 6144; const float* g = FIN(I_N2G) + l * 1024;
    float* out = F.out; float* hc = F_HC(F);
    rows_norm_loop(F, row0, ntok, w, NW, g, mod, 3, 4, F_X(F), [=](int r) { const bool lat = r < NLAT; RowJob j; j.mb = lat ? (r >> 12) : 8;
        j.src = lat ? out + (size_t)r * 1024 : hc + (size_t)(r - NLAT) * 1024; j.copy_to = nullptr; return j; });
}

__device__ __forceinline__ void ph_router(Frame& F, int l, int bt0, int bt1, int c, int G) {
    LAS float* Bs = (LAS float*)F.lds;
    LAS float* lgs = (LAS float*)(F.lds + 53248 + F.wave * 4096);
    const float* WpL = (const float*)(F.ws + WS_RW) + (size_t)l * 9 * 48 * 1024; const float* rcL = (const float*)(F.ws + WS_RW) + RW_ELEMS + l * 9 * 64;
    int* cnt = F_CNT(F) + l * 32; int* rowtok = (int*)(F.ws + WS_ROWTOK); unsigned* tinfo = (unsigned*)(F.ws + WS_TOKINFO);
    const int lane = F.lane, i16 = lane & 15, kq = lane >> 4, tid = F.tid;
    const int ntask = bt1 - bt0, nfull = (ntask / G) * G, rem = ntask - nfull;
    const int rtok0 = (bt0 + nfull) * 128, rtok1 = bt1 * 128 - 1;
    const bool minis = rem > 0 && ((rtok0 < NLAT ? (rtok0 >> 12) : 8) == (rtok1 < NLAT ? (rtok1 >> 12) : 8));
    const int npass = nfull / G + (rem > 0 ? (minis ? 1 : (c < rem ? 1 : 0)) : 0);
    for (int ps_ = 0; ps_ < npass; ++ps_) {
        const bool mini = minis && ps_ == nfull / G;
        const int mt = c + G * F.wave;
        const bool active = !mini || mt < rem * 8;
        const int tok0 = mini ? (active ? rtok0 + mt * 16 : rtok0) : (bt0 + c + ps_ * G) * 128 + F.wave * 16; const bool lat = tok0 < NLAT; const int mb = lat ? (tok0 >> 12) : 8;
        const float* hrow = (lat ? F.out + (size_t)(tok0 + i16) * 1024 : F_HC(F) + (size_t)(tok0 + i16 - NLAT) * 1024) + 4 * kq;
        const float* wsrc = WpL + (size_t)mb * 48 * 1024;
        f32x4 acc[3]; float ss = 0.f;
#pragma unroll
        for (int c = 0; c < 3; ++c) acc[c] = (f32x4){0.f, 0.f, 0.f, 0.f};
        f32x4 bnext[6];
#pragma unroll
        for (int j = 0; j < 6; ++j) { const int i = tid + 512 * j; bnext[j] = *(const f32x4*)(wsrc + (size_t)(i >> 6) * 1024 + 4 * (i & 63)); }
        f32x4 an[16];
        if (active) {
#pragma unroll
            for (int S = 0; S < 16; ++S) an[S] = *(const f32x4*)(hrow + 16 * S); }
#pragma unroll 1
        for (int kc = 0; kc < 4; ++kc) {
            LDS_BARRIER();
#pragma unroll
            for (int j = 0; j < 6; ++j) { const int i = tid + 512 * j; *(LAS f32x4*)(Bs + (i >> 6) * 260 + 4 * (i & 63)) = bnext[j]; }
            LDS_BARRIER();
            if (kc < 3) {
#pragma unroll
                for (int j = 0; j < 6; ++j) { const int i = tid + 512 * j; bnext[j] = *(const f32x4*)(wsrc + (size_t)(i >> 6) * 1024 + (kc + 1) * 256 + 4 * (i & 63)); } }
            const LAS float* bp = Bs + i16 * 260 + 4 * kq;
            f32x4 ac[16];
#pragma unroll
            for (int S = 0; S < 16; ++S) ac[S] = an[S];
            if (active && kc < 3) {
#pragma unroll
                for (int S = 0; S < 16; ++S) an[S] = *(const f32x4*)(hrow + (kc + 1) * 256 + 16 * S); }
            if (active)
#pragma unroll
            for (int S = 0; S < 16; ++S) {
                const f32x4 a = ac[S];
                const f32x4 b0 = *(const LAS f32x4*)(bp + 16 * S), b1 = *(const LAS f32x4*)(bp + 16 * 260 + 16 * S), b2 = *(const LAS f32x4*)(bp + 32 * 260 + 16 * S);
                ss += (a.x * a.x + a.y * a.y) + (a.z * a.z + a.w * a.w);
#pragma unroll
                for (int s = 0; s < 4; ++s) { acc[0] = __builtin_amdgcn_mfma_f32_16x16x4f32(a[s], b0[s], acc[0], 0, 0, 0); acc[1] = __builtin_amdgcn_mfma_f32_16x16x4f32(a[s], b1[s], acc[1], 0, 0, 0);
                    acc[2] = __builtin_amdgcn_mfma_f32_16x16x4f32(a[s], b2[s], acc[2], 0, 0, 0); }
            }
        }
        if (active) {
        ss += __shfl_xor(ss, 16); ss += __shfl_xor(ss, 32);
#pragma unroll
        for (int c = 0; c < 3; ++c)
#pragma unroll
            for (int r = 0; r < 4; ++r) lgs[(4 * kq + r) * 52 + 16 * c + i16] = acc[c][r];
        LDS_WAIT(); asm volatile("" ::: "memory");
        const float rstd = 1.0f / sqrtf(ss * (1.0f / 1024.0f) + EPS);
        float lg[RCOLS];
#pragma unroll
        for (int j4 = 0; j4 < RCOLS / 4; ++j4) { const f32x4 v = *(const LAS f32x4*)(lgs + i16 * 52 + 4 * j4); const f32x4 rcv = *(const f32x4*)(rcL + mb * 64 + 4 * j4);
            lg[4 * j4] = v.x * rstd + rcv.x; lg[4 * j4 + 1] = v.y * rstd + rcv.y; lg[4 * j4 + 2] = v.z * rstd + rcv.z; lg[4 * j4 + 3] = v.w * rstd + rcv.w; }
        LDS_WAIT(); asm volatile("" ::: "memory");
        const int tok = tok0 + i16;
        int g = 0; float gm = lg[0];
#pragma unroll
        for (int j = 1; j < 4; ++j) if (lg[j] > gm) { gm = lg[j]; g = j; }
        float gs = 0.f;
#pragma unroll
        for (int j = 0; j < 4; ++j) gs += __expf(lg[j] - gm);
        const float g_w = 1.0f / gs;
        float el[8];
#pragma unroll
        for (int i = 0; i < 8; ++i) { el[i] = lg[4 + i];
#pragma unroll
            for (int gg = 1; gg < 4; ++gg) el[i] = (g == gg) ? lg[4 + gg * 8 + i] : el[i]; }
        int i1 = 0; float m1 = el[0];
#pragma unroll
        for (int i = 1; i < 8; ++i) if (el[i] > m1) { m1 = el[i]; i1 = i; }
        int i2 = -1; float m2 = -3.0e38f;
#pragma unroll
        for (int i = 0; i < 8; ++i) if (i != i1 && el[i] > m2) { m2 = el[i]; i2 = i; }
        const float p2 = __expf(m2 - m1); const float w1 = g_w / (1.0f + p2), w2 = g_w * p2 / (1.0f + p2);
        const int e1 = g * 8 + i1, e2 = g * 8 + i2;
        int r1 = 0, r2 = 0;
        { unsigned long long todo = 0xFFFFull;
          while (todo) { const int ld = __builtin_ctzll(todo); const int x = __shfl(e1, ld); const unsigned long long m = __ballot(e1 == x) & todo;
              int base = 0; if (lane == ld && F.wr) base = atomicAdd(&cnt[x], (int)__builtin_popcountll(m)); base = __shfl(base, ld);
              if (e1 == x) r1 = base + (int)__builtin_popcountll(m & ((1ull << lane) - 1ull)); todo &= ~m; } }
        { unsigned long long todo = 0xFFFFull;
          while (todo) { const int ld = __builtin_ctzll(todo); const int x = __shfl(e2, ld); const unsigned long long m = __ballot(e2 == x) & todo;
              int base = 0; if (lane == ld && F.wr) base = atomicAdd(&cnt[x], (int)__builtin_popcountll(m)); base = __shfl(base, ld);
              if (e2 == x) r2 = base + (int)__builtin_popcountll(m & ((1ull << lane) - 1ull)); todo &= ~m; } }
        if (lane < 16 && F.wr) { rowtok[(size_t)e1 * NTOK + r1] = tok; rowtok[(size_t)e2 * NTOK + r2] = tok;
            u32x4 a; a.x = (unsigned)e1; a.y = (unsigned)r1; a.z = (unsigned)e2; a.w = (unsigned)r2;
            *(u32x4*)(tinfo + (size_t)tok * 8) = a; *(f32x2*)(tinfo + (size_t)tok * 8 + 4) = (f32x2){w1, w2}; }
        }
    }
}
__device__ __forceinline__ void moe_tables(Frame& F, int l, volatile LAS int*& tileoff, volatile LAS int*& cntl) {
    volatile LAS int* t = (volatile LAS int*)(F.lds + LDS_CTL + 512); cntl = t; tileoff = t + 32;
    if (F.tid < 32) t[F.tid] = __hip_atomic_load(F_CNT(F) + l * 32 + F.tid, __ATOMIC_RELAXED, __HIP_MEMORY_SCOPE_AGENT);
    __syncthreads();
    if (F.tid == 0) { int s = 0;
#pragma unroll 1
        for (int e = 0; e < 32; ++e) { t[32 + e] = s; s += (t[e] + 255) >> 8; } t[64] = s; }
    __syncthreads();
}
__device__ __forceinline__ void ph_combine(Frame& F, int l, int ntok) {
    volatile LAS int* tileoff; volatile LAS int* cntl; moe_tables(F, l, tileoff, cntl);
    const float* mod = F_MOD(F) + (size_t)l * 9 * 6144; const bool lastl = (l == DEPTH - 1);
    const float* modn = F_MOD(F) + (size_t)(lastl ? l : l + 1) * 9 * 6144; const float* gn = lastl ? FIN(I_FNG) : FIN(I_N1G) + (l + 1) * 1024;
    const bf16* Y = (const bf16*)(F.ws + WS_YROWS); const unsigned* tinfo = (const unsigned*)(F.ws + WS_TOKINFO);
    const int lane = F.lane;
    u32x4 ninf = (u32x4){0u, 0u, 0u, 0u}, n2inf = ninf; f32x2 nwv = (f32x2){0.f, 0.f}, n2wv = nwv; f32x4 nh[4]; u32x2 nya[4], nyb[4];
    const int per = (ntok + F.NGW - 1) / F.NGW; int r = F.gw * per; const int rend = (r + per < ntok) ? r + per : ntok;
#define CMB_HROW(rr) ((rr) < NLAT ? F.out + (size_t)(rr) * 1024 : F_HC(F) + (size_t)((rr) - NLAT) * 1024)
#define CMB_LOAD_ROW(rr) do { const float* hp_ = CMB_HROW(rr); \
        const bf16* y1_ = Y + ((size_t)tileoff[ninf.x] * 256 + ninf.y) * 1024; const bf16* y2_ = Y + ((size_t)tileoff[ninf.z] * 256 + ninf.w) * 1024; \
        _Pragma("unroll") for (int j = 0; j < 4; ++j) { nh[j] = *(const f32x4*)(hp_ + 4 * lane + 256 * j); nya[j] = *(const u32x2*)(y1_ + 4 * lane + 256 * j); nyb[j] = *(const u32x2*)(y2_ + 4 * lane + 256 * j); } } while (0)
    if (r < rend) { ninf = *(const u32x4*)(tinfo + (size_t)r * 8); nwv = *(const f32x2*)(tinfo + (size_t)r * 8 + 4);
        if (r + 1 < rend) { n2inf = *(const u32x4*)(tinfo + (size_t)(r + 1) * 8); n2wv = *(const f32x2*)(tinfo + (size_t)(r + 1) * 8 + 4); }
        CMB_LOAD_ROW(r); }
    int mbc = -1; f32x4 cm5[4], cgs[4], csh[4];
    for (; r < rend; ++r) {
        const f32x2 wv = nwv; f32x4 hv[4]; u32x2 ya[4], yb[4];
#pragma unroll
        for (int j = 0; j < 4; ++j) { hv[j] = nh[j]; ya[j] = nya[j]; yb[j] = nyb[j]; }
        const bool lat = r < NLAT; const int mb = lat ? (r >> 12) : 8; float* hrow = CMB_HROW(r);
        if (r + 1 < rend) { ninf = n2inf; nwv = n2wv; CMB_LOAD_ROW(r + 1); }
        if (r + 2 < rend) { n2inf = *(const u32x4*)(tinfo + (size_t)(r + 2) * 8); n2wv = *(const f32x2*)(tinfo + (size_t)(r + 2) * 8 + 4); }
        if (mb != mbc) { mbc = mb;
#pragma unroll
            for (int j = 0; j < 4; ++j) { const int c = 4 * lane + 256 * j; cm5[j] = *(const f32x4*)(mod + mb * 6144 + 5 * 1024 + c); const f32x4 g = *(const f32x4*)(gn + c);
                if (lastl) { cgs[j] = g; csh[j] = (f32x4){0.f, 0.f, 0.f, 0.f}; }
                else { cgs[j] = g * (*(const f32x4*)(modn + mb * 6144 + 1024 + c) + 1.0f); csh[j] = *(const f32x4*)(modn + mb * 6144 + c); } } }
        f32x4 v[4]; float ss = 0.f;
#pragma unroll
        for (int j = 0; j < 4; ++j) { const u32x2 a = ya[j], b = yb[j];
            f32x4 y; y.x = wv.x * bflo(a.x) + wv.y * bflo(b.x); y.y = wv.x * bfhi(a.x) + wv.y * bfhi(b.x); y.z = wv.x * bflo(a.y) + wv.y * bflo(b.y); y.w = wv.x * bfhi(a.y) + wv.y * bfhi(b.y);
            v[j] = hv[j] + cm5[j] * y; ss += (v[j].x * v[j].x + v[j].y * v[j].y) + (v[j].z * v[j].z + v[j].w * v[j].w); }
        const float rstd = 1.0f / sqrtf(wave_sum(ss) * (1.0f / 1024.0f) + EPS);
        if (lastl) {
#pragma unroll
            for (int j = 0; j < 4; ++j) { const int c = 4 * lane + 256 * j; if (F.wr) *(f32x4*)(hrow + c) = (v[j] * rstd) * cgs[j]; }
        } else {
#pragma unroll
            for (int j = 0; j < 4; ++j) { const int c = 4 * lane + 256 * j; if (F.wr) *(f32x4*)(hrow + c) = v[j];
                const f32x4 y = (v[j] * rstd) * cgs[j] + csh[j]; u32x2 w; w.x = pk2(y.x, y.y); w.y = pk2(y.z, y.w); if (F.wr) *(u32x2*)(F_X(F) + (size_t)r * 1024 + c) = w; }
        }
    }
#undef CMB_LOAD_ROW
#undef CMB_HROW
}
#define MFMA16(a, b, c) __builtin_amdgcn_mfma_f32_16x16x32_bf16((a), (b), (c), 0, 0, 0)
__device__ __forceinline__ bf16x8 ldfrag(const LAS bf16* base, int row0, int k0, int ld, int lane) {
    return *(const LAS bf16x8*)(base + (row0 + (lane & 15)) * ld + k0 + 8 * (lane >> 4));
}
__device__ __forceinline__ float fast_sigmoid(float x) { return __builtin_amdgcn_rcpf(1.0f + __builtin_amdgcn_exp2f(-1.4426950408889634f * x)); }
__device__ __forceinline__ float fast_gelu_tanh(float x) {
    const float u2 = 1.5957691216057308f * (x + 0.044715f * x * x * x);
    return x * __builtin_amdgcn_rcpf(1.0f + __builtin_amdgcn_exp2f(-1.4426950408889634f * u2));
}

__device__ __forceinline__ void att_rope8(const f32x2* tab, const float (&x1)[8], const float (&x2)[8], float (&o1)[8], float (&o2)[8]) {
#pragma unroll
    for (int e = 0; e < 8; ++e) { const f32x2 cs = tab[e]; o1[e] = x1[e] * cs.x - x2[e] * cs.y; o2[e] = x2[e] * cs.x + x1[e] * cs.y; }
}
__device__ __forceinline__ void unpack8(const u32x4 a, float (&x)[8]) { x[0] = bflo(a.x); x[1] = bfhi(a.x); x[2] = bflo(a.y); x[3] = bfhi(a.y); x[4] = bflo(a.z); x[5] = bfhi(a.z); x[6] = bflo(a.w); x[7] = bfhi(a.w); }
__device__ __forceinline__ u32x4 pack8(const float (&x)[8], float s) { u32x4 r; r.x = pk2(x[0] * s, x[1] * s); r.y = pk2(x[2] * s, x[3] * s); r.z = pk2(x[4] * s, x[5] * s); r.w = pk2(x[6] * s, x[7] * s); return r; }

template <int RS> __device__ __forceinline__ void tr_frags4(unsigned addr, bf16x8 (&f)[4]) {
    u32x2 a0, a1, b0, b1, c0, c1, d0, d1;
    asm volatile("ds_read_b64_tr_b16 %0, %8\n\tds_read_b64_tr_b16 %1, %8 offset:%9\n\tds_read_b64_tr_b16 %2, %8 offset:32\n\tds_read_b64_tr_b16 %3, %8 offset:%10\n\t"
                 "ds_read_b64_tr_b16 %4, %8 offset:64\n\tds_read_b64_tr_b16 %5, %8 offset:%11\n\tds_read_b64_tr_b16 %6, %8 offset:96\n\tds_read_b64_tr_b16 %7, %8 offset:%12\n\ts_waitcnt lgkmcnt(0)"
                 : "=&v"(a0), "=&v"(a1), "=&v"(b0), "=&v"(b1), "=&v"(c0), "=&v"(c1), "=&v"(d0), "=&v"(d1)
                 : "v"(addr), "i"(4 * RS), "i"(32 + 4 * RS), "i"(64 + 4 * RS), "i"(96 + 4 * RS) : "memory");
    u32x4 t; t.x = a0.x; t.y = a0.y; t.z = a1.x; t.w = a1.y; f[0] = __builtin_bit_cast(bf16x8, t);
    t.x = b0.x; t.y = b0.y; t.z = b1.x; t.w = b1.y; f[1] = __builtin_bit_cast(bf16x8, t);
    t.x = c0.x; t.y = c0.y; t.z = c1.x; t.w = c1.y; f[2] = __builtin_bit_cast(bf16x8, t);
    t.x = d0.x; t.y = d0.y; t.z = d1.x; t.w = d1.y; f[3] = __builtin_bit_cast(bf16x8, t);
}


__device__ __forceinline__ float xor16_max(float x) { const unsigned xi = __builtin_bit_cast(unsigned, x); const auto r = __builtin_amdgcn_permlane16_swap(xi, xi, false, false); return fmaxf(__builtin_bit_cast(float, (unsigned)r[0]), __builtin_bit_cast(float, (unsigned)r[1])); }
__device__ __forceinline__ float xor32_max(float x) { const unsigned xi = __builtin_bit_cast(unsigned, x); const auto r = __builtin_amdgcn_permlane32_swap(xi, xi, false, false); return fmaxf(__builtin_bit_cast(float, (unsigned)r[0]), __builtin_bit_cast(float, (unsigned)r[1])); }
__device__ __forceinline__ float xor16_sum(float x) { const unsigned xi = __builtin_bit_cast(unsigned, x); const auto r = __builtin_amdgcn_permlane16_swap(xi, xi, false, false); return __builtin_bit_cast(float, (unsigned)r[0]) + __builtin_bit_cast(float, (unsigned)r[1]); }
__device__ __forceinline__ float xor32_sum(float x) { const unsigned xi = __builtin_bit_cast(unsigned, x); const auto r = __builtin_amdgcn_permlane32_swap(xi, xi, false, false); return __builtin_bit_cast(float, (unsigned)r[0]) + __builtin_bit_cast(float, (unsigned)r[1]); }

#ifndef LRU_ABL
#define LRU_ABL 0
#endif
__device__ __forceinline__ void lru_unit(Frame& F, int l, int b, int hd, int half) {
    LAS bf16* ub = (LAS bf16*)F.lds;
    LAS bf16* waT = (LAS bf16*)(F.lds + 36864);
    LAS bf16* wxT = (LAS bf16*)(F.lds + 36864 + 4608);
    LAS f32x2* wcomp = (LAS f32x2*)(F.lds + 92800);
    LAS bf16* ho = (LAS bf16*)(F.lds + 46080 + 3 * 8192 + 256);
    const int tid = F.tid, lane = F.lane, w = F.wave, q = lane >> 4, fr = lane & 15;
    bf16* proj = F_PROJ(F); bf16* X = F_X(F);
    const int chh = hd * 64;
    const int c8 = tid & 7, rg = tid >> 3;
    LAS float* cwl = (LAS float*)(F.lds + 91392 + 128);
    __syncthreads();
    if (tid < 320) { const int j = tid >> 6, c = tid & 63; cwl[tid] = j < 4 ? FIN(I_CONVW)[((size_t)l * 4 + j) * 1024 + chh + c] : FIN(I_CONVB)[l * 1024 + chh + c]; }
    const int orow = tid >> 1, ohh = tid & 1;
#pragma unroll 1
    for (int dir = 0; dir < 2; ++dir) {
        __syncthreads();
        for (int i = tid; i < 2048; i += 512) { const int k = i >> 5, c = i & 31; const size_t gi = ((((size_t)l * 2 + dir) * 16 + hd) * 64 + k) * 64 + half * 32 + c;
            waT[c * 72 + k] = (bf16)f2bf(FIN(I_WA)[gi]); wxT[c * 72 + k] = (bf16)f2bf(FIN(I_WX)[gi]); }
        float ba_[2], bx_[2], sp8_[2], carry[2] = {0.f, 0.f};
#pragma unroll
        for (int cb = 0; cb < 2; ++cb) { const int ch = chh + half * 32 + cb * 16 + fr; const size_t gi = ((size_t)l * 2 + dir) * 1024 + ch;
            ba_[cb] = FIN(I_BA)[gi]; bx_[cb] = FIN(I_BX)[gi]; const float lam = FIN(I_LAM)[gi]; sp8_[cb] = -8.0f * 1.4426950408889634f * log1p_fast(__expf(-lam)); }
        __syncthreads();
        const int rgd = dir ? 63 - rg : rg;
        u32x4 axr[7]; u32x4 pf[4];
#define LRU_CHUNK(ci, isctx_, T0_, rowbase_) const bool isctx_ = (ci) == 0; const int T0_ = isctx_ ? 0 : 256 * (dir ? (16 - (ci)) : ((ci) - 1)); const size_t rowbase_ = isctx_ ? (size_t)NLAT + b * LCX : (size_t)b * SEQ
#define LRU_PREFETCH(ci) do { LRU_CHUNK(ci, ic_, t0_, rb_); const int Ls_ = ic_ ? LCX : SEQ; \
            _Pragma("unroll") for (int j = 0; j < 7; ++j) { const int tt = t0_ + 4 * rgd - 2 + j; const int tc_ = (tt >= 0 && tt < Ls_) ? tt : 0; \
                const GAS bf16* p_ = (const GAS bf16*)(proj + (rb_ + tc_) * LDP + C_AX + chh + 8 * c8); \
                asm volatile("global_load_dwordx4 %0, %1, off" : "=v"(axr[j]) : "v"(p_) : "memory"); } } while (0)
#define LRU_AX_WAIT(ci) do { if (dir == 0) asm volatile("s_waitcnt vmcnt(2)" : "+v"(axr[0]), "+v"(axr[1]), "+v"(axr[2]), "+v"(axr[3]), "+v"(axr[4]), "+v"(axr[5]), "+v"(axr[6]) :: "memory"); \
            else asm volatile("s_waitcnt vmcnt(6)" : "+v"(axr[0]), "+v"(axr[1]), "+v"(axr[2]), "+v"(axr[3]), "+v"(axr[4]), "+v"(axr[5]), "+v"(axr[6]) :: "memory"); \
            LRU_CHUNK(ci, ic_, t0_, rb_); (void)rb_; const int Ls_ = ic_ ? LCX : SEQ; \
            _Pragma("unroll") for (int j = 0; j < 7; ++j) { const int tt = t0_ + 4 * rgd - 2 + j; if (!(tt >= 0 && tt < Ls_)) axr[j] = (u32x4){0u, 0u, 0u, 0u}; } } while (0)
#define LRU_PREFETCH_OUT(ci) do { if (dir == 1) { LRU_CHUNK(ci, ic_, t0_, rb_); const size_t orow_g = rb_ + t0_ + (255 - orow); \
                pf[0] = *(const u32x4*)(X + orow_g * 1024 + chh + half * 32 + ohh * 16); pf[1] = *(const u32x4*)(X + orow_g * 1024 + chh + half * 32 + ohh * 16 + 8); \
                pf[2] = *(const u32x4*)(proj + orow_g * LDP + C_AY + chh + half * 32 + ohh * 16); pf[3] = *(const u32x4*)(proj + orow_g * LDP + C_AY + chh + half * 32 + ohh * 16 + 8); } } while (0)
        LRU_PREFETCH(0); LRU_PREFETCH_OUT(0);
        asm volatile("s_waitcnt vmcnt(0)" : "+v"(axr[0]), "+v"(axr[1]), "+v"(axr[2]), "+v"(axr[3]), "+v"(axr[4]), "+v"(axr[5]), "+v"(axr[6]) :: "memory");
#pragma unroll 1
        for (int ci = 0; ci < 17; ++ci) {
            LRU_CHUNK(ci, isctx, T0, rowbase);
            if (ci > 0) { LRU_AX_WAIT(ci); } else {
#pragma unroll
                for (int j = 0; j < 7; ++j) { const int tt = 4 * rgd - 2 + j; if (!(tt >= 0 && tt < LCX)) axr[j] = (u32x4){0u, 0u, 0u, 0u}; } }
            { float u[4][8];
#pragma unroll
              for (int r = 0; r < 4; ++r) { const f32x4 b0 = *(const LAS f32x4*)(cwl + 256 + 8 * c8), b1 = *(const LAS f32x4*)(cwl + 256 + 8 * c8 + 4);
                  u[r][0] = b0.x; u[r][1] = b0.y; u[r][2] = b0.z; u[r][3] = b0.w; u[r][4] = b1.x; u[r][5] = b1.y; u[r][6] = b1.z; u[r][7] = b1.w; }
#pragma unroll
              for (int j = 0; j < 7; ++j) { float x[8]; x[0] = bflo(axr[j].x); x[1] = bfhi(axr[j].x); x[2] = bflo(axr[j].y); x[3] = bfhi(axr[j].y); x[4] = bflo(axr[j].z); x[5] = bfhi(axr[j].z); x[6] = bflo(axr[j].w); x[7] = bfhi(axr[j].w);
#pragma unroll
                  for (int t = 0; t < 4; ++t) { const int r = j - t; if (r >= 0 && r < 4) {
                      const f32x4 w0 = *(const LAS f32x4*)(cwl + 64 * t + 8 * c8), w1 = *(const LAS f32x4*)(cwl + 64 * t + 8 * c8 + 4);
                      u[r][0] += w0.x * x[0]; u[r][1] += w0.y * x[1]; u[r][2] += w0.z * x[2]; u[r][3] += w0.w * x[3]; u[r][4] += w1.x * x[4]; u[r][5] += w1.y * x[5]; u[r][6] += w1.z * x[6]; u[r][7] += w1.w * x[7]; } } }
#pragma unroll
              for (int r = 0; r < 4; ++r) { const int tl = 4 * rgd + r, p = dir ? (255 - tl) : tl;
                  u32x4 o; o.x = pk2(u[r][0], u[r][1]); o.y = pk2(u[r][2], u[r][3]); o.z = pk2(u[r][4], u[r][5]); o.w = pk2(u[r][6], u[r][7]); *(LAS u32x4*)(ub + p * 72 + 8 * c8) = o; } }
            if (ci + 1 < 17) LRU_PREFETCH(ci + 1);
            LDS_WAIT(); asm volatile("" ::: "memory");
            float hl[2][2][4], Ac[2][2][4], sa[2][2], sb[2][2];
            bf16x8 Ba[2][2], Bx[2][2];
#pragma unroll
            for (int cb = 0; cb < 2; ++cb)
#pragma unroll
                for (int ks = 0; ks < 2; ++ks) { Ba[cb][ks] = ldfrag(waT, cb * 16, ks * 32, 72, lane); Bx[cb][ks] = ldfrag(wxT, cb * 16, ks * 32, 72, lane); }
#pragma unroll
            for (int rb = 0; rb < 2; ++rb) { const bf16x8 A0 = ldfrag(ub, 32 * w + 16 * rb, 0, 72, lane), A1 = ldfrag(ub, 32 * w + 16 * rb, 32, 72, lane);
#pragma unroll
                for (int cb = 0; cb < 2; ++cb) {
                    f32x4 ra = (f32x4){0.f, 0.f, 0.f, 0.f}, rx = ra;
                    ra = MFMA16(A0, Ba[cb][0], ra); ra = MFMA16(A1, Ba[cb][1], ra); rx = MFMA16(A0, Bx[cb][0], rx); rx = MFMA16(A1, Bx[cb][1], rx);
                    float hprev = 0.f, aprev = 1.f;
#pragma unroll
                    for (int r = 0; r < 4; ++r) { const int p = 32 * w + 16 * rb + 4 * q + r; const float u = bf2f(ub[p * 72 + half * 32 + cb * 16 + fr]);
                        const float rgt = fast_sigmoid(ra[r] + ba_[cb]), igt = fast_sigmoid(rx[r] + bx_[cb]);
                        const float a = __builtin_amdgcn_exp2f(sp8_[cb] * rgt), bb = __builtin_amdgcn_sqrtf(fmaxf((1.0f - a) * (1.0f + a), 0.f)) * (igt * u);
                        hprev = a * hprev + bb; aprev = a * aprev; hl[rb][cb][r] = hprev; Ac[rb][cb][r] = aprev; }
                    sa[rb][cb] = aprev; sb[rb][cb] = hprev; } }
            float ea[2][2], eb[2][2];
            const int par = ci & 1;
#pragma unroll
            for (int cb = 0; cb < 2; ++cb) { float ia[2], ib[2];
#pragma unroll
                for (int rb = 0; rb < 2; ++rb) { float a = sa[rb][cb], bq = sb[rb][cb];
                    float a1 = __shfl_up(a, 16), b1 = __shfl_up(bq, 16); if (q >= 1) { bq = a * b1 + bq; a = a * a1; }
                    a1 = __shfl_up(a, 32); b1 = __shfl_up(bq, 32); if (q >= 2) { bq = a * b1 + bq; a = a * a1; }
                    ia[rb] = a; ib[rb] = bq;
                    a1 = __shfl_up(a, 16); b1 = __shfl_up(bq, 16); ea[rb][cb] = q ? a1 : 1.0f; eb[rb][cb] = q ? b1 : 0.0f; }
                const float t0a = __shfl(ia[0], 48 + fr), t0b = __shfl(ib[0], 48 + fr);
                eb[1][cb] = ea[1][cb] * t0b + eb[1][cb]; ea[1][cb] = ea[1][cb] * t0a;
                if (q == 3) wcomp[(par * 8 + w) * 32 + cb * 16 + fr] = (f32x2){ia[1] * t0a, ia[1] * t0b + ib[1]}; }
            LDS_BARRIER();
#pragma unroll
            for (int cb = 0; cb < 2; ++cb) { float h = carry[cb], hin = h;
#pragma unroll
                for (int k = 0; k < 8; ++k) { const f32x2 c = wcomp[(par * 8 + k) * 32 + cb * 16 + fr]; h = c.x * h + c.y; hin = (k + 1 == w) ? h : hin; }
                carry[cb] = h;
#pragma unroll
                for (int rb = 0; rb < 2; ++rb) { const float hs = ea[rb][cb] * hin + eb[rb][cb];
#pragma unroll
                    for (int r = 0; r < 4; ++r) { const int p = 32 * w + 16 * rb + 4 * q + r; ho[p * 40 + cb * 16 + fr] = (bf16)f2bf(Ac[rb][cb][r] * hs + hl[rb][cb][r]); } } }
            LDS_WAIT(); asm volatile("" ::: "memory");
            { const int tl = dir ? (255 - orow) : orow; const size_t row = rowbase + T0 + tl;
              const u32x4 h0 = *(const LAS u32x4*)(ho + orow * 40 + ohh * 16), h1 = *(const LAS u32x4*)(ho + orow * 40 + ohh * 16 + 8);
              if (dir == 0) { *(u32x4*)(X + row * 1024 + chh + half * 32 + ohh * 16) = h0; *(u32x4*)(X + row * 1024 + chh + half * 32 + ohh * 16 + 8) = h1; }
              else { u32x4 o0, o1;
#define LRU_Y(hb, hf, ay) pk2((bflo(hf) + bflo(hb)) * fast_gelu_tanh(bflo(ay)), (bfhi(hf) + bfhi(hb)) * fast_gelu_tanh(bfhi(ay)))
                  o0.x = LRU_Y(h0.x, pf[0].x, pf[2].x); o0.y = LRU_Y(h0.y, pf[0].y, pf[2].y); o0.z = LRU_Y(h0.z, pf[0].z, pf[2].z); o0.w = LRU_Y(h0.w, pf[0].w, pf[2].w);
                  o1.x = LRU_Y(h1.x, pf[1].x, pf[3].x); o1.y = LRU_Y(h1.y, pf[1].y, pf[3].y); o1.z = LRU_Y(h1.z, pf[1].z, pf[3].z); o1.w = LRU_Y(h1.w, pf[1].w, pf[3].w);
#undef LRU_Y
                  { bf16* yb_ = F_YB(F) + row * 3072 + chh + half * 32 + ohh * 16; *(u32x4*)yb_ = o0; *(u32x4*)(yb_ + 8) = o1; } } }
            if (ci + 1 < 17) LRU_PREFETCH_OUT(ci + 1);
        }
#undef LRU_AX_WAIT
#undef LRU_PREFETCH_OUT
#undef LRU_PREFETCH
#undef LRU_CHUNK
    }
}
__device__ __forceinline__ size_t ret_rowbase(int b, int cidx) { return cidx < 2 ? (size_t)NLAT + b * LCX + cidx * 128 : (size_t)b * SEQ + (cidx - 2) * 128; }
__device__ __forceinline__ float ret_logg(Frame& F, int l, int dir, int h) { const float lam = FIN(I_RLAM)[(l * 2 + dir) * 8 + h]; return -log1p_fast(__expf(-lam)); }

__device__ __forceinline__ void ret_load_qk(Frame& F, const bf16* src  , bool rope, int pos0, float scale, float (&o1)[8], float (&o2)[8]) {
    const int row = F.tid >> 2, cp = F.tid & 3;
    const u32x4 a = *(const u32x4*)(src + (size_t)row * LDP + 8 * cp), b = *(const u32x4*)(src + (size_t)row * LDP + 32 + 8 * cp);
    float x1[8] = {bflo(a.x), bfhi(a.x), bflo(a.y), bfhi(a.y), bflo(a.z), bfhi(a.z), bflo(a.w), bfhi(a.w)};
    float x2[8] = {bflo(b.x), bfhi(b.x), bflo(b.y), bfhi(b.y), bflo(b.z), bfhi(b.z), bflo(b.w), bfhi(b.w)};
    if (rope) { const f32x2* rt = (const f32x2*)(F.ws + WS_ROPE) + (size_t)(pos0 + row) * 32 + 8 * cp;
#pragma unroll
        for (int e = 0; e < 8; ++e) { const f32x2 cs = rt[e]; o1[e] = (x1[e] * cs.x - x2[e] * cs.y) * scale; o2[e] = (x2[e] * cs.x + x1[e] * cs.y) * scale; }
    } else {
#pragma unroll
        for (int e = 0; e < 8; ++e) { o1[e] = x1[e] * scale; o2[e] = x2[e] * scale; }
    }
}
__device__ __forceinline__ void ph_ret_r1(Frame& F, int l) {
    LAS bf16* Kf = (LAS bf16*)F.lds;
    LAS bf16* Kb = Kf + 128 * 72;
    LAS bf16* Vs = Kb + 128 * 72;
    const int tid = F.tid, lane = F.lane, w = F.wave, q = lane >> 4, fr = lane & 15;
    const bf16* proj = F_PROJ(F);
    const int row = tid >> 2, cp = tid & 3;
    u32x4 ka, kb, vv[4];
#define R1_LOAD(u) do { const int bh__ = (u) / 34, ci__ = (u) % 34; const size_t rb__ = ret_rowbase(bh__ >> 3, ci__); const int h__ = bh__ & 7; \
        const bf16* ks_ = proj + (rb__ + row) * LDP + C_BK + h__ * 64 + 8 * cp; ka = *(const u32x4*)ks_; kb = *(const u32x4*)(ks_ + 32); \
        _Pragma("unroll") for (int i = 0; i < 4; ++i) { const int t_ = tid + 512 * i; vv[i] = *(const u32x4*)(proj + (rb__ + (t_ >> 4)) * LDP + C_BV + h__ * 128 + 8 * (t_ & 15)); } } while (0)
    int u = F.bid;
    if (u < 64 * 34) R1_LOAD(u);
    const int dir = w >> 2, e0 = 32 * (w & 3);
    const unsigned vlane = (unsigned)(size_t)Vs + (unsigned)((8 * q + (fr >> 2)) * 272 + (fr & 3) * 8 + e0 * 2);
    const unsigned klane = (unsigned)(size_t)(dir ? Kb : Kf) + (unsigned)((8 * q + (fr >> 2)) * 144 + (fr & 3) * 8);
#pragma unroll 1
    for (; u < 64 * 34; u += F.G) {
        const int bh = u / 34, cidx = u % 34, b = bh >> 3, h = bh & 7; const bool lat = cidx >= 2;
        const float lg0 = ret_logg(F, l, 0, h), lg1 = ret_logg(F, l, 1, h);
        LDS_BARRIER();
        { float x1[8], x2[8], o1[8], o2[8]; unpack8(ka, x1); unpack8(kb, x2);
          if (lat) { const f32x2* rt = (const f32x2*)(F.ws + WS_ROPE) + (size_t)((cidx - 2) * 128 + row) * 32 + 8 * cp;
#pragma unroll
              for (int e = 0; e < 8; ++e) { const f32x2 cs = rt[e]; o1[e] = (x1[e] * cs.x - x2[e] * cs.y) * 0.125f; o2[e] = (x2[e] * cs.x + x1[e] * cs.y) * 0.125f; } }
          else {
#pragma unroll
              for (int e = 0; e < 8; ++e) { o1[e] = x1[e] * 0.125f; o2[e] = x2[e] * 0.125f; } }
          const float df = __expf(lg0 * (float)(127 - row)), db = __expf(lg1 * (float)row);
          *(LAS u32x4*)(Kf + row * 72 + 8 * cp) = pack8(o1, df); *(LAS u32x4*)(Kf + row * 72 + 32 + 8 * cp) = pack8(o2, df);
          *(LAS u32x4*)(Kb + row * 72 + 8 * cp) = pack8(o1, db); *(LAS u32x4*)(Kb + row * 72 + 32 + 8 * cp) = pack8(o2, db); }
#pragma unroll
        for (int i = 0; i < 4; ++i) { const int t = tid + 512 * i; *(LAS u32x4*)(Vs + (t >> 4) * 136 + 8 * (t & 15)) = vv[i]; }
        LDS_BARRIER();
        if (u + F.G < 64 * 34) R1_LOAD(u + F.G);
        f32x4 acc[2][4];
#pragma unroll
        for (int eb = 0; eb < 2; ++eb)
#pragma unroll
            for (int db = 0; db < 4; ++db) acc[eb][db] = (f32x4){0.f, 0.f, 0.f, 0.f};
#pragma unroll
        for (int ks = 0; ks < 4; ++ks) { bf16x8 av[4], bk[4];
            tr_frags4<272>(vlane + ks * 32 * 272, av);
            tr_frags4<144>(klane + ks * 32 * 144, bk);
#pragma unroll
            for (int eb = 0; eb < 2; ++eb)
#pragma unroll
                for (int db = 0; db < 4; ++db) acc[eb][db] = MFMA16(bk[db], av[eb], acc[eb][db]); }
        bf16* kv = (bf16*)(F.ws + WS_KV) + ((((size_t)(b * 8 + h) * 34 + cidx) * 2) + dir) * 8192;
#pragma unroll
        for (int eb = 0; eb < 2; ++eb)
#pragma unroll
            for (int db = 0; db < 4; ++db) { u32x2 o; o.x = pk2(acc[eb][db][0], acc[eb][db][1]); o.y = pk2(acc[eb][db][2], acc[eb][db][3]);
                *(u32x2*)(kv + (e0 + 16 * eb + fr) * 64 + 16 * db + 4 * q) = o; }
    }
#undef R1_LOAD
}
__device__ __forceinline__ void ret_scan(Frame& F, int l) {
    unsigned* kvw = (unsigned*)(F.ws + WS_KV);
    for (int i = F.bid * 512 + F.tid; i < 64 * 2 * 4096; i += F.G * 512) { const int pr = i & 4095, dir = (i >> 12) & 1, bh = i >> 13, h = bh & 7;
        const float gC = __expf(ret_logg(F, l, dir, h) * 128.0f);
        unsigned* base = kvw + ((size_t)bh * 34 * 2 + dir) * 4096 + pr;
        unsigned v[34];
#pragma unroll
        for (int k = 0; k < 34; ++k) v[k] = base[(size_t)k * 8192];
        float s0 = 0.f, s1 = 0.f;
        if (dir == 0) {
#pragma unroll
            for (int k = 0; k < 34; ++k) { const unsigned x = v[k]; v[k] = pk2(s0, s1); s0 = gC * s0 + bflo(x); s1 = gC * s1 + bfhi(x); }
        } else {
#pragma unroll
            for (int k = 0; k < 34; ++k) { const int c = k < 2 ? 1 - k : 35 - k; const unsigned x = v[c]; v[c] = pk2(s0, s1); s0 = gC * s0 + bflo(x); s1 = gC * s1 + bfhi(x); }
        }
        if (F.wr) {
#pragma unroll
            for (int k = 0; k < 34; ++k) base[(size_t)k * 8192] = v[k]; }
    }
}
__device__ __forceinline__ void ph_ret_r2(Frame& F, int l, bool lastl) {
    LAS bf16* Qs = (LAS bf16*)F.lds;
    LAS bf16* Ks = Qs + 128 * 72;
    LAS bf16* Vs = Ks + 128 * 72;
    LAS bf16* Ps = Vs + 128 * 136 + F.wave * (16 * 136);
    LAS bf16* Ss = Vs + 128 * 136 + 8 * (16 * 136);
    const int tid = F.tid, lane = F.lane, w = F.wave, q = lane >> 4, fr = lane & 15;
    const bf16* proj = F_PROJ(F);
    const int nch = lastl ? 32 : 34, nunits = 64 * nch;
    const int row = tid >> 2, cp = tid & 3;
    u32x4 qa, qb_, ka, kb, vv[4], sv[4];
#define R2_DECODE(u, bh_, cidx_) const int bh_ = (u) / nch, cidx_ = (u) % nch + (lastl ? 2 : 0)
#define R2_LOAD(u) do { R2_DECODE(u, bh__, ci__); const size_t rb__ = ret_rowbase(bh__ >> 3, ci__); const int h__ = bh__ & 7; \
        const bf16* qs_ = proj + (rb__ + row) * LDP + C_BQ + h__ * 64 + 8 * cp; qa = *(const u32x4*)qs_; qb_ = *(const u32x4*)(qs_ + 32); \
        const bf16* ks_ = proj + (rb__ + row) * LDP + C_BK + h__ * 64 + 8 * cp; ka = *(const u32x4*)ks_; kb = *(const u32x4*)(ks_ + 32); \
        _Pragma("unroll") for (int i = 0; i < 4; ++i) { const int t_ = tid + 512 * i; vv[i] = *(const u32x4*)(proj + (rb__ + (t_ >> 4)) * LDP + C_BV + h__ * 128 + 8 * (t_ & 15)); \
            sv[i] = *(const u32x4*)((const bf16*)(F.ws + WS_KV) + (((size_t)bh__ * 34 + ci__) * 2) * 8192 + (size_t)t_ * 8); } } while (0)
    int u = F.bid;
    if (u < nunits) R2_LOAD(u);
    const unsigned vlane = (unsigned)(size_t)Vs + (unsigned)((8 * q + (fr >> 2)) * 272 + (fr & 3) * 8);
#pragma unroll 1
    for (; u < nunits; u += F.G) {
        R2_DECODE(u, bh, cidx); const int b = bh >> 3, h = bh & 7; const size_t rb = ret_rowbase(b, cidx); const bool lat = cidx >= 2;
        const float lg0 = ret_logg(F, l, 0, h), lg1 = ret_logg(F, l, 1, h);
        LDS_BARRIER();
        { float x1[8], x2[8], o1[8], o2[8];
          unpack8(qa, x1); unpack8(qb_, x2);
          if (lat) { const f32x2* rt = (const f32x2*)(F.ws + WS_ROPE) + (size_t)((cidx - 2) * 128 + row) * 32 + 8 * cp;
#pragma unroll
              for (int e = 0; e < 8; ++e) { const f32x2 cs = rt[e]; o1[e] = x1[e] * cs.x - x2[e] * cs.y; o2[e] = x2[e] * cs.x + x1[e] * cs.y; } }
          else {
#pragma unroll
              for (int e = 0; e < 8; ++e) { o1[e] = x1[e]; o2[e] = x2[e]; } }
          *(LAS u32x4*)(Qs + row * 72 + 8 * cp) = pack8(o1, 1.0f); *(LAS u32x4*)(Qs + row * 72 + 32 + 8 * cp) = pack8(o2, 1.0f);
          unpack8(ka, x1); unpack8(kb, x2);
          if (lat) { const f32x2* rt = (const f32x2*)(F.ws + WS_ROPE) + (size_t)((cidx - 2) * 128 + row) * 32 + 8 * cp;
#pragma unroll
              for (int e = 0; e < 8; ++e) { const f32x2 cs = rt[e]; o1[e] = x1[e] * cs.x - x2[e] * cs.y; o2[e] = x2[e] * cs.x + x1[e] * cs.y; } }
          else {
#pragma unroll
              for (int e = 0; e < 8; ++e) { o1[e] = x1[e]; o2[e] = x2[e]; } }
          *(LAS u32x4*)(Ks + row * 72 + 8 * cp) = pack8(o1, 0.125f); *(LAS u32x4*)(Ks + row * 72 + 32 + 8 * cp) = pack8(o2, 0.125f); }
#pragma unroll
        for (int i = 0; i < 4; ++i) { const int t = tid + 512 * i; *(LAS u32x4*)(Vs + (t >> 4) * 136 + 8 * (t & 15)) = vv[i]; *(LAS u32x4*)(Ss + (t >> 3) * 72 + 8 * (t & 7)) = sv[i]; }
        LDS_BARRIER();
        if (u + F.G < nunits) R2_LOAD(u + F.G);
        const int il = 16 * w + fr;
        const bf16x8 Bq0 = ldfrag(Qs, 16 * w, 0, 72, lane), Bq1 = ldfrag(Qs, 16 * w, 32, 72, lane);
        const float l2g0 = lg0 * 1.4426950408889634f, l2g1 = lg1 * 1.4426950408889634f;
#pragma unroll
        for (int jb = 0; jb < 8; ++jb) { f32x4 acc = (f32x4){0.f, 0.f, 0.f, 0.f};
            acc = MFMA16(ldfrag(Ks, 16 * jb, 0, 72, lane), Bq0, acc); acc = MFMA16(ldfrag(Ks, 16 * jb, 32, 72, lane), Bq1, acc);
            float pv[4];
#pragma unroll
            for (int r = 0; r < 4; ++r) { const int j = 16 * jb + 4 * q + r; const int dd = il - j;
                const float df = dd >= 0 ? __builtin_amdgcn_exp2f(l2g0 * (float)dd) : 0.f, dbk = dd <= 0 ? __builtin_amdgcn_exp2f(l2g1 * (float)(-dd)) : 0.f;
                pv[r] = acc[r] * (df + dbk); }
            u32x2 pw; pw.x = pg8::cvt_pk_bf16(pv[0], pv[1]); pw.y = pg8::cvt_pk_bf16(pv[2], pv[3]); *(LAS u32x2*)(Ps + fr * 136 + 16 * jb + 4 * q) = pw; }
        LDS_WAIT(); asm volatile("" ::: "memory");
        const bf16* gp = proj + (rb + il) * LDP + C_BG + h * 128 + 4 * q;
        u32x2 gwv[4];
#pragma unroll
        for (int eb = 0; eb < 4; ++eb) gwv[eb] = *(const u32x2*)(gp + 16 * eb);
        f32x4 Y[8];
#pragma unroll
        for (int eb = 0; eb < 8; ++eb) Y[eb] = (f32x4){0.f, 0.f, 0.f, 0.f};
#pragma unroll
        for (int ks = 0; ks < 4; ++ks) { const bf16x8 bp = ldfrag(Ps, 0, 32 * ks, 136, lane); bf16x8 av[4];
            tr_frags4<272>(vlane + ks * 32 * 272, av);
#pragma unroll
            for (int eb = 0; eb < 4; ++eb) Y[eb] = MFMA16(av[eb], bp, Y[eb]);
            tr_frags4<272>(vlane + ks * 32 * 272 + 128, av);
#pragma unroll
            for (int eb = 0; eb < 4; ++eb) Y[4 + eb] = MFMA16(av[eb], bp, Y[4 + eb]); }
        const float qf = __builtin_amdgcn_exp2f(l2g0 * (float)(il + 1)), qbw = __builtin_amdgcn_exp2f(l2g1 * (float)(128 - il));
#pragma unroll
        for (int eb = 0; eb < 8; ++eb) { f32x4 zf = (f32x4){0.f, 0.f, 0.f, 0.f}, zb = zf;
            zf = MFMA16(ldfrag(Ss, 16 * eb, 0, 72, lane), Bq0, zf); zf = MFMA16(ldfrag(Ss, 16 * eb, 32, 72, lane), Bq1, zf);
            zb = MFMA16(ldfrag(Ss, 128 + 16 * eb, 0, 72, lane), Bq0, zb); zb = MFMA16(ldfrag(Ss, 128 + 16 * eb, 32, 72, lane), Bq1, zb);
            Y[eb] = Y[eb] + zf * qf + zb * qbw; }
        float s = 0.f;
#pragma unroll
        for (int eb = 0; eb < 8; ++eb) s += (Y[eb][0] + Y[eb][1]) + (Y[eb][2] + Y[eb][3]);
        s += __shfl_xor(s, 16); s += __shfl_xor(s, 32);
        const float mu = s * (1.0f / 128.0f); float vq = 0.f;
#pragma unroll
        for (int eb = 0; eb < 8; ++eb) { const f32x4 d = Y[eb] - mu; vq += (d[0] * d[0] + d[1] * d[1]) + (d[2] * d[2] + d[3] * d[3]); }
        vq += __shfl_xor(vq, 16); vq += __shfl_xor(vq, 32);
        const float rstd = __builtin_amdgcn_rsqf(vq * (1.0f / 128.0f) + EPS);
        bf16* yo = F_YB(F) + (rb + il) * 3072 + 1024 + h * 128 + 4 * q;
        u32x2 gw2[4];
#pragma unroll
        for (int eb = 0; eb < 4; ++eb) gw2[eb] = *(const u32x2*)(gp + 16 * (4 + eb));
#pragma unroll
        for (int eb = 0; eb < 8; ++eb) { const u32x2 gw = eb < 4 ? gwv[eb & 3] : gw2[eb & 3]; const f32x4 yn = (Y[eb] - mu) * rstd;
            u32x2 o; o.x = pg8::cvt_pk_bf16(gm::fsilu_(bflo(gw.x)) * yn[0], gm::fsilu_(bfhi(gw.x)) * yn[1]); o.y = pg8::cvt_pk_bf16(gm::fsilu_(bflo(gw.y)) * yn[2], gm::fsilu_(bfhi(gw.y)) * yn[3]);
            if (F.wr) *(u32x2*)(yo + 16 * eb) = o; }
    }
#undef R2_LOAD
#undef R2_DECODE
}
__device__ __forceinline__ void att_rope_keys(Frame& F) {
    bf16* proj = F_PROJ(F); const f32x2* atab = (const f32x2*)(F.ws + WS_ROPE + 1 * MiB);
    for (int i = F.bid * 512 + F.tid; i < NLAT * 16; i += F.G * 512) { const int pr = i & 3, g = (i >> 2) & 3, row = i >> 4; const int c = (pr & 1) + 4 * (pr >> 1);
        bf16* src = proj + (size_t)row * LDP + C_CK + g * 64 + 8 * c;
        float x1[8], x2[8], o1[8], o2[8]; unpack8(*(const u32x4*)src, x1); unpack8(*(const u32x4*)(src + 16), x2);
        const int pos = row & (SEQ - 1); const int ap = (pr >> 1) ? (pos & 63) : (pos >> 6); att_rope8(atab + ap * 16 + 8 * (pr & 1), x1, x2, o1, o2);
        if (F.wr) { *(u32x4*)src = pack8(o1, 1.0f); *(u32x4*)(src + 16) = pack8(o2, 1.0f); } }
}
__device__ __forceinline__ void att_unit(Frame& F, int l, int b, int g, int qb, bool isctxq) {
    LAS bf16* Kt = (LAS bf16*)F.lds;
    LAS bf16* Vt = Kt + 64 * 72;
    LAS bf16* Pw = Vt + 64 * 72 + F.wave * (64 * 72);
    const int tid = F.tid, lane = F.lane, w = F.wave, q = lane >> 4, fr = lane & 15;
    const bf16* proj = F_PROJ(F); const f32x2* atab = (const f32x2*)(F.ws + WS_ROPE + 1 * MiB);
    const int hq = 4 * g + (w >> 1);
    const size_t qrow0 = (isctxq ? (size_t)NLAT + b * LCX : (size_t)b * SEQ) + qb * 128 + (w & 1) * 64;
    const int qpos0 = qb * 128 + (w & 1) * 64;
    constexpr float QS = 0.125f * 1.4426950408889634f;
    unsigned vmask = 0xFu;
    if (!isctxq) {
#pragma unroll
        for (int t = 4; t < 10; ++t) { const int kp = qb * 128 - 128 + 64 * (t - 4); if (kp >= 0 && kp < SEQ) vmask |= 1u << t; } }
    const int vrow = tid >> 3, vc8 = tid & 7;
    u32x4 kx = (u32x4){0u, 0u, 0u, 0u}, vx = kx;
#define ATT_KROW0(t) ((t) >= 4 ? (size_t)b * SEQ + (qb * 128 - 128 + 64 * ((t) - 4)) : (size_t)NLAT + b * LCX + 64 * (t))
#define ATT_LOAD(t) do { const size_t kr0_ = ATT_KROW0(t); kx = *(const u32x4*)(proj + (kr0_ + vrow) * LDP + C_CK + g * 64 + 8 * vc8); \
        vx = *(const u32x4*)(proj + (kr0_ + vrow) * LDP + C_CV + g * 64 + 8 * vc8); } while (0)
    int t = __builtin_ctz(vmask); vmask &= vmask - 1;
    ATT_LOAD(t);
    LDS_BARRIER();
#pragma unroll
    for (int i = 0; i < 4; ++i) { const int tt = lane + 64 * i, row = tt >> 2, pr = tt & 3;
        const int c = (pr & 1) + 4 * (pr >> 1); const bf16* src = proj + (qrow0 + row) * LDP + C_CQ + hq * 64;
        float x1[8], x2[8], o1[8], o2[8]; unpack8(*(const u32x4*)(src + 8 * c), x1); unpack8(*(const u32x4*)(src + 8 * c + 16), x2);
        if (!isctxq) { const int pos = qpos0 + row; const int ap = (pr >> 1) ? (pos & 63) : (pos >> 6); att_rope8(atab + ap * 16 + 8 * (pr & 1), x1, x2, o1, o2); }
        else {
#pragma unroll
            for (int e = 0; e < 8; ++e) { o1[e] = x1[e]; o2[e] = x2[e]; } }
        *(LAS u32x4*)(Pw + row * 72 + 8 * c) = pack8(o1, QS); *(LAS u32x4*)(Pw + row * 72 + 8 * c + 16) = pack8(o2, QS); }
    LDS_WAIT(); asm volatile("" ::: "memory");
    bf16x8 Bq[4][2];
#pragma unroll
    for (int ib = 0; ib < 4; ++ib)
#pragma unroll
        for (int ks = 0; ks < 2; ++ks) Bq[ib][ks] = ldfrag(Pw, 16 * ib, 32 * ks, 72, lane);
    LDS_WAIT(); asm volatile("" ::: "memory");
    const float sink = FIN(I_SINK)[l * 16 + hq] * 1.4426950408889634f;
    float mrow[4], lrow[4], aprev[4]; f32x4 O[4][4];
#pragma unroll
    for (int ib = 0; ib < 4; ++ib) { mrow[ib] = sink; aprev[ib] = 1.0f; lrow[ib] = (q == 0) ? 1.0f : 0.0f;
#pragma unroll
        for (int db = 0; db < 4; ++db) O[db][ib] = (f32x4){0.f, 0.f, 0.f, 0.f}; }
    const unsigned vt_lane = (unsigned)(size_t)Vt + (unsigned)((8 * q + (fr >> 2)) * 144 + (fr & 3) * 8);
#pragma unroll 1
    for (;;) {
        const int kpos0 = t >= 4 ? (qb * 128 - 128 + 64 * (t - 4)) : 0;
        LDS_BARRIER();
        *(LAS u32x4*)(Kt + vrow * 72 + 8 * vc8) = kx;
        *(LAS u32x4*)(Vt + vrow * 72 + 8 * vc8) = vx;
        LDS_BARRIER();
        const int tcur = t; const bool more = vmask != 0u;
        if (more) { t = __builtin_ctz(vmask); vmask &= vmask - 1; ATT_LOAD(t); }
        const bool skipt = !isctxq && tcur == ((w & 1) ? 4 : 9);
        const bool maskt = !isctxq && (tcur == ((w & 1) ? 5 : 4) || tcur == ((w & 1) ? 9 : 8));
        if (!skipt) {
#pragma unroll
        for (int hf = 0; hf < 2; ++hf) {
            f32x4 S[4][2];
#pragma unroll
            for (int jb = 0; jb < 4; ++jb) { const bf16x8 a0 = ldfrag(Kt, 16 * jb, 0, 72, lane), a1 = ldfrag(Kt, 16 * jb, 32, 72, lane);
#pragma unroll
                for (int i2 = 0; i2 < 2; ++i2) { const float nm = -mrow[2 * hf + i2]; f32x4 acc = (f32x4){nm, nm, nm, nm};
                    acc = MFMA16(a0, Bq[2 * hf + i2][0], acc); acc = MFMA16(a1, Bq[2 * hf + i2][1], acc); S[jb][i2] = acc; } }
            if (maskt) {
#pragma unroll
                for (int jb = 0; jb < 4; ++jb)
#pragma unroll
                    for (int i2 = 0; i2 < 2; ++i2)
#pragma unroll
                        for (int r = 0; r < 4; ++r) { const int dd = (qpos0 + 16 * (2 * hf + i2) + fr) - (kpos0 + 16 * jb + 4 * q + r); if (dd > 128 || dd < -128) S[jb][i2][r] = -1.0e30f; }
            }
#pragma unroll
            for (int i2 = 0; i2 < 2; ++i2) { const int ib = 2 * hf + i2;
                float mx = -1.0e30f;
#pragma unroll
                for (int jb = 0; jb < 4; ++jb) mx = fmaxf(mx, fmaxf(fmaxf(S[jb][i2][0], S[jb][i2][1]), fmaxf(S[jb][i2][2], S[jb][i2][3])));
                mx = fmaxf(mx, __shfl_xor(mx, 16)); mx = fmaxf(mx, __shfl_xor(mx, 32));
                const float alpha = aprev[ib]; const float dm = fmaxf(mx, 0.f); aprev[ib] = __builtin_amdgcn_exp2f(-dm); mrow[ib] += dm;
                float ps = 0.f;
#pragma unroll
                for (int jb = 0; jb < 4; ++jb) { float p[4];
#pragma unroll
                    for (int r = 0; r < 4; ++r) { p[r] = __builtin_amdgcn_exp2f(S[jb][i2][r]); ps += p[r]; }
                    u32x2 pw; pw.x = pk2(p[0], p[1]); pw.y = pk2(p[2], p[3]); *(LAS u32x2*)(Pw + (16 * ib + fr) * 72 + 16 * jb + 4 * q) = pw; }
                lrow[ib] = lrow[ib] * alpha + ps;
#pragma unroll
                for (int db = 0; db < 4; ++db) O[db][ib] = O[db][ib] * alpha;
            }
        }
        LDS_WAIT(); asm volatile("" ::: "memory");
#pragma unroll
        for (int ks = 0; ks < 2; ++ks) { bf16x8 av[4], bp[4];
            tr_frags4<144>(vt_lane + ks * 32 * 144, av); __builtin_amdgcn_sched_barrier(0);
#pragma unroll
            for (int ib = 0; ib < 4; ++ib) bp[ib] = ldfrag(Pw, 16 * ib, 32 * ks, 72, lane);
#pragma unroll
            for (int db = 0; db < 4; ++db)
#pragma unroll
                for (int ib = 0; ib < 4; ++ib) O[db][ib] = MFMA16(av[db], bp[ib], O[db][ib]); }
        LDS_WAIT(); asm volatile("" ::: "memory");
        }
        if (!more) break;
    }
#undef ATT_LOAD
#undef ATT_KROW0
#pragma unroll
    for (int ib = 0; ib < 4; ++ib) { float lt = lrow[ib]; lt += __shfl_xor(lt, 16); lt += __shfl_xor(lt, 32); const float inv = __builtin_amdgcn_rcpf(lt);
        bf16* dst = F_YB(F) + (qrow0 + 16 * ib + fr) * 3072 + 2048 + hq * 64 + 4 * q;
#pragma unroll
        for (int db = 0; db < 4; ++db) { const f32x4 o = O[db][ib] * inv; u32x2 ow; ow.x = pg8::cvt_pk_bf16(o[0], o[1]); ow.y = pg8::cvt_pk_bf16(o[2], o[3]); if (F.wr) *(u32x2*)(dst + 16 * db) = ow; } }
}
#ifndef PROBE_MASK
#define PROBE_MASK 0
#endif
#ifndef PROBE_SUB
#define PROBE_SUB 0
#endif
#ifdef PROBE_REAL
#define WR_DRY wr_true
#else
#define WR_DRY wr_false
#endif
#define NREP(n) (((PROBE_MASK >> (n)) & 1) ? 2 : 1)
#ifndef DIAG_PH
#define PHON(n) true
#else
#define PHON(n) ((n) == DIAG_PH)
#endif
constexpr int N_PHASES = 2 + 10 * DEPTH;
__global__ void __launch_bounds__(512, 2) fwd_kernel(Args args) {
    extern __shared__ __attribute__((aligned(16))) unsigned char lds_raw[];
    Frame F; F.lds = (LAS unsigned char*)lds_raw; F.tid = threadIdx.x; F.lane = F.tid & 63; F.wave = __builtin_amdgcn_readfirstlane(F.tid >> 6);
    F.G = gridDim.x; F.bid = blockIdx.x; F.gw = F.bid * 8 + F.wave; F.NGW = F.G * 8; F.in = (const __attribute__((address_space(4))) cfp_t*)__builtin_amdgcn_kernarg_segment_ptr(); F.out = args.out; F.ws = args.ws;
    volatile LAS unsigned* MISC = (volatile LAS unsigned*)(F.lds + MISC_OFF);
    for (int u = F.tid; u < (LDS_BYTES - LDS_CTL) / 4; u += 512) ((LAS unsigned*)(F.lds + LDS_CTL))[u] = 0u;
    __syncthreads();
    unsigned* ctl = (unsigned*)(F.ws + WS_CTL);
#if MK_N_LAUNCHES == 1
    XcdBarrier bar = xcd_barrier_post(ctl + CW_BAR, MISC + 8, gridDim.x);
    XcdBarrier sbar = xcd_barrier_post(ctl + (blockIdx.x < 32 ? CW_BAR_C : CW_BAR_L), MISC + 12, blockIdx.x < 32 ? 32u : gridDim.x - 32u);
#define SUB_BAR() do { GAS unsigned* _bp = (GAS unsigned*)sbar.bar; asm volatile("" : "+s"(_bp)); XcdBarrier _b2 = sbar; _b2.bar = (unsigned*)_bp; xcd_barrier(_b2); } while (0)
#define GRID_BAR() do { GAS unsigned* _bp = (GAS unsigned*)bar.bar; asm volatile("" : "+s"(_bp)); XcdBarrier _b2 = bar; _b2.bar = (unsigned*)_bp; xcd_barrier(_b2); } while (0)
#else
#define GRID_BAR() do {} while (0)
#define SUB_BAR() do {} while (0)
#endif
    const int wave0 = F.wave; const bool wr_true = args.ph_hi > 0, wr_false = args.ph_hi < 0; F.wr = wr_true;
    const int lo = args.ph_lo, hi = args.ph_hi;
#define FRESH() do { LAS unsigned char* _l = (LAS unsigned char*)lds_raw; asm volatile("" : "+s"(_l)); F.lds = _l; int _ln; asm volatile("v_mbcnt_lo_u32_b32 %0, -1, 0\n\tv_mbcnt_hi_u32_b32 %0, -1, %0" : "=v"(_ln)); F.tid = wave0 * 64 + _ln; F.lane = _ln; F.wave = wave0; F.gw = F.bid * 8 + F.wave; \
        GAS unsigned char* _ws = (GAS unsigned char*)args.ws; asm volatile("" : "+s"(_ws)); F.ws = (unsigned char*)_ws; GAS float* _out = (GAS float*)args.out; asm volatile("" : "+s"(_out)); F.out = (float*)_out; \
        const __attribute__((address_space(4))) cfp_t* _in = (const __attribute__((address_space(4))) cfp_t*)__builtin_amdgcn_kernarg_segment_ptr(); asm volatile("" : "+s"(_in)); F.in = _in; } while (0)
#define IN(k) (lo <= (k) && (k) < hi)
#define SEAM(k) do { if (IN(k) && IN((k) + 1)) GRID_BAR(); } while (0)
    if (PHON(0) && IN(0)) for (int rep_ = NREP(0); rep_ > 0; --rep_) { FRESH(); F.wr = (rep_ == 1) ? wr_true : WR_DRY; if (NREP(0) > 1) GRID_BAR(); ph_prologue(F); } SEAM(0);
    if (PHON(1) && IN(1)) for (int rep_ = NREP(1); rep_ > 0; --rep_) { FRESH(); F.wr = (rep_ == 1) ? wr_true : WR_DRY; if (NREP(1) > 1) GRID_BAR(); ph_convert(F, 0); ph_rows_u(F, 0, true); ph_router_fold(F); } SEAM(1);
#pragma unroll 1
    for (int l = 0; l < DEPTH; ++l) {
        const int pb = 2 + 10 * l; const bool lastl = (l == DEPTH - 1); const int nM2 = lastl ? 128 : 136; const int ntok = lastl ? NLAT : NTOK;
        unsigned char* wt = F.ws + WS_WT;
        if (PHON(2) && IN(pb + 0)) for (int rep_ = NREP(2); rep_ > 0; --rep_) { FRESH(); F.wr = (rep_ == 1) ? wr_true : WR_DRY; if (NREP(2) > 1) GRID_BAR();
            gm::SchedPlain<16, 1024> S; S.init(136, 38, F.G, F.bid); S.A = (const char*)(F.ws + WS_X); S.Bt = (const char*)(wt + WT_IN);
            gm::EpiProj E{F_PROJ(F), F.ws + WS_GT}; pg8::gemm_phase(F.lds, S, E, F.tid);
        } SEAM(pb + 0);
        if (PHON(3) && IN(pb + 1)) for (int rep_ = NREP(3); rep_ > 0; --rep_) { FRESH(); F.wr = (rep_ == 1) ? wr_true : WR_DRY; if (NREP(3) > 1) GRID_BAR();
            if (!(rep_ > 1 && PROBE_SUB == 2)) for (int u = F.bid; u < 256; u += F.G) { const int hu = ((u >> 4) << 3) + (u & 7); lru_unit(F, l, hu >> 4, hu & 15, (u >> 3) & 1); }
            if (!(rep_ > 1 && PROBE_SUB == 1)) { __syncthreads(); ph_ret_r1(F, l); __syncthreads(); }
            att_rope_keys(F);
        } SEAM(pb + 1);
        if (PHON(4) && IN(pb + 2)) for (int rep_ = NREP(4); rep_ > 0; --rep_) { FRESH(); F.wr = (rep_ == 1) ? wr_true : WR_DRY; if (NREP(4) > 1) GRID_BAR();
            if (!(rep_ > 1 && PROBE_SUB == 2)) ret_scan(F, l);
            if (!(rep_ > 1 && PROBE_SUB == 1))
            for (int u = F.bid; u < (lastl ? 1024 : 1088); u += F.G) { const bool cq = u >= 1024; const int v = u - 1024;
                int ab = cq ? (v >> 3) : (u >> 7), ag = cq ? ((v >> 1) & 3) : ((u >> 5) & 3), aq = cq ? (v & 1) : (u & 31);
                if (F.G == 256) { const int x = F.bid & 7, y = F.bid >> 3;
                    ab = x; ag = cq ? (y >> 1) : (u >> 8); aq = cq ? (y & 1) : y; }
                att_unit(F, l, ab, ag, aq, cq); }
        } SEAM(pb + 2);
        if (PHON(5) && IN(pb + 3)) for (int rep_ = NREP(5); rep_ > 0; --rep_) { FRESH(); F.wr = (rep_ == 1) ? wr_true : WR_DRY; if (NREP(5) > 1) GRID_BAR();
            ph_ret_r2(F, l, lastl);
        } SEAM(pb + 3);
#ifdef PROBE_MERGE_K
        if (IN(pb + 4)) { FRESH(); GRID_BAR();
            gm::SchedPlain<PROBE_MERGE_K, 3072> S; S.init(nM2, 4, F.G, F.bid); S.A = (const char*)(F.ws + WS_YB); S.Bt = (const char*)(wt + WT_BR);
            gm::EpiPlain E{(bf16*)(F.ws + WS_KV)}; pg8::gemm_phase(F.lds, S, E, F.tid); GRID_BAR(); }
#endif
        const bool split = !lastl && gridDim.x == 256 && MK_N_LAUNCHES == 1;
        if (PHON(6) && IN(pb + 4)) for (int rep_ = NREP(6); rep_ > 0; --rep_) { FRESH(); F.wr = (rep_ == 1) ? wr_true : WR_DRY; if (NREP(6) > 1) GRID_BAR();
            gm::SchedPlain<48, 3072> S; S.init(split ? 128 : nM2, 4, F.G, F.bid); S.A = (const char*)(F.ws + WS_YB); S.Bt = (const char*)(wt + WT_BR);
            gm::EpiMerge E{F.ws + WS_GT, F_X(F)}; pg8::gemm_phase(F.lds, S, E, F.tid);
        } SEAM(pb + 4);
        if (IN(pb + 5)) { FRESH(); F.wr = wr_true;
            const bool cgrp = split && F.bid < 32;
            if (cgrp) {
                gm::SchedPlain<48, 3072, gm::OrderSub> S; S.init(8, 4, 32, F.bid, 128, true); S.A = (const char*)(F.ws + WS_YB); S.Bt = (const char*)(wt + WT_BR);
                gm::EpiMerge E{F.ws + WS_GT, F_X(F)}; pg8::gemm_phase(F.lds, S, E, F.tid);
                SUB_BAR(); FRESH();
            }
            {
                gm::SchedPlain<16, 1024, gm::OrderSub> S; S.init(split ? (cgrp ? 8 : 128) : nM2, 4, split ? (cgrp ? 32 : 224) : F.G, split && !cgrp ? F.bid - 32 : F.bid, cgrp ? 128 : 0, true);
                S.A = (const char*)(F.ws + WS_X); S.Bt = (const char*)(wt + WT_WO);
                gm::EpiWo E{F.out, F_HC(F), F_MOD(F) + (size_t)l * 9 * 6144, F.wr, l == 0 ? (const float*)FIN(I_X) : (const float*)F.out, l == 0 ? (const float*)FIN(I_CTX) : (const float*)F_HC(F)}; pg8::gemm_phase(F.lds, S, E, F.tid);
            }
        }
        if (split) { if (IN(pb + 5) && IN(pb + 6)) SUB_BAR(); } else SEAM(pb + 5);
        if (PHON(8) && IN(pb + 6)) for (int rep_ = NREP(8); rep_ > 0; --rep_) { FRESH(); F.wr = (rep_ == 1) ? wr_true : WR_DRY; if (NREP(8) > 1) GRID_BAR();
            const bool cgrp = split && F.bid < 32;
            const int row0 = cgrp ? NLAT : 0, row1 = split && !cgrp ? NLAT : ntok, gc = split && !cgrp ? F.bid - 32 : F.bid, gn = split ? (cgrp ? 32 : 224) : F.G;
            if (!(rep_ > 1 && PROBE_SUB == 2)) ph_rows_v(F, l, row0, row1, gc * 8 + F.wave, gn * 8);
            if (!(rep_ > 1 && PROBE_SUB == 1)) ph_router(F, l, row0 / 128, row1 / 128, gc, gn);
        } SEAM(pb + 6);
        if (PHON(9) && IN(pb + 7)) for (int rep_ = NREP(9); rep_ > 0; --rep_) { FRESH(); F.wr = (rep_ == 1) ? wr_true : WR_DRY; if (NREP(9) > 1) GRID_BAR();
            volatile LAS int* tileoff; volatile LAS int* cntl; moe_tables(F, l, tileoff, cntl);
            gm::SchedMoe<16, true> S; S.tileoff = tileoff; S.cnt = cntl; S.G = F.G; S.c = F.bid; S.nunits = tileoff[32] * 4; S.wsbase = (const char*)F.ws; S.rowtok = (const int*)(F.ws + WS_ROWTOK);
            S.A = nullptr; S.Bt = (const char*)(wt + WT_GU);
            gm::EpiGU E{(bf16*)(F.ws + WS_HROWS)}; pg8::gemm_phase(F.lds, S, E, F.tid);
        } SEAM(pb + 7);
        if (PHON(10) && IN(pb + 8)) for (int rep_ = NREP(10); rep_ > 0; --rep_) { FRESH(); F.wr = (rep_ == 1) ? wr_true : WR_DRY; if (NREP(10) > 1) GRID_BAR();
            volatile LAS int* tileoff; volatile LAS int* cntl; moe_tables(F, l, tileoff, cntl);
            gm::SchedMoe<8, false> S; S.tileoff = tileoff; S.cnt = cntl; S.G = F.G; S.c = F.bid; S.nunits = tileoff[32] * 4; S.wsbase = (const char*)F.ws; S.rowtok = nullptr;
            S.A = (const char*)(F.ws + WS_HROWS); S.Bt = (const char*)(wt + WT_DN);
            gm::EpiDN E{(bf16*)(F.ws + WS_YROWS)}; pg8::gemm_phase(F.lds, S, E, F.tid);
        } SEAM(pb + 8);
        if (PHON(11) && IN(pb + 9)) for (int rep_ = NREP(11); rep_ > 0; --rep_) { FRESH(); F.wr = (rep_ == 1) ? wr_true : WR_DRY; if (NREP(11) > 1) GRID_BAR();
            if (!(rep_ > 1 && PROBE_SUB == 2)) ph_combine(F, l, ntok);
            if (!lastl && !(rep_ > 1 && PROBE_SUB == 1)) ph_convert(F, l + 1);
        } if (!lastl) SEAM(pb + 9);
    }
#undef IN
#undef SEAM
}

extern "C" void kernel_launch(void* const* d_in, const int* in_sizes, int n_in, void* d_out, int out_size, void* d_ws, size_t ws_size, hipStream_t stream) {
    static int grid = 0;
    if (grid == 0) {
        if (n_in != 30 || out_size != NLAT * D || ws_size < WS_END) { fprintf(stderr, "kernel_launch: unexpected shapes (n_in %d out %d ws %zu, need %zu)\n", n_in, out_size, ws_size, (size_t)WS_END); grid = -1; return; }
        int dev = 0, cus = 0;
        if (hipGetDevice(&dev) != hipSuccess || hipDeviceGetAttribute(&cus, hipDeviceAttributeMultiprocessorCount, dev) != hipSuccess) { grid = -1; return; }
        if (hipFuncSetAttribute((const void*)fwd_kernel, hipFuncAttributeMaxDynamicSharedMemorySize, LDS_BYTES) != hipSuccess) { fprintf(stderr, "kernel_launch: hipFuncSetAttribute failed\n"); grid = -1; return; }
        int per_cu = 0;
        if (hipOccupancyMaxActiveBlocksPerMultiprocessor(&per_cu, (const void*)fwd_kernel, 512, LDS_BYTES) != hipSuccess || per_cu < 1) { fprintf(stderr, "kernel_launch: occupancy query says %d\n", per_cu); }
        (void)hipGetLastError();
        grid = cus;
    }
    if (grid < 0) return;
    (void)hipMemsetAsync((char*)d_ws + WS_CTL, 0, CTL_BYTES, stream);
#ifdef DIAG_ZERO_GT
    (void)hipMemsetAsync((char*)d_ws + WS_GT, 0x3f, (size_t)204 * MiB, stream);
#endif
    Args a{};
    for (int i = 0; i < 30; ++i) a.in[i] = (const float*)d_in[i];
    a.out = (float*)d_out; a.ws = (unsigned char*)d_ws;
#if MK_N_LAUNCHES == 1
    a.ph_lo = 0; a.ph_hi = N_PHASES;
    hipLaunchKernelGGL(fwd_kernel, dim3(grid), dim3(512), LDS_BYTES, stream, a);
#else
    for (int p = 0; p < N_PHASES; ++p) { a.ph_lo = p; a.ph_hi = p + 1; hipLaunchKernelGGL(fwd_kernel, dim3(grid), dim3(512), LDS_BYTES, stream, a); }
#endif
}
```

```cpp
#include <hip/hip_runtime.h>
#include <cstdio>
#include <cstdint>

#define LAS __attribute__((address_space(3)))
#define GAS __attribute__((address_space(1)))
typedef unsigned short bf16;
typedef short bf16x8 __attribute__((ext_vector_type(8)));
typedef float f32x4 __attribute__((ext_vector_type(4)));
typedef float f32x2 __attribute__((ext_vector_type(2)));
typedef unsigned u32x4 __attribute__((ext_vector_type(4)));
typedef unsigned u32x2 __attribute__((ext_vector_type(2)));

#ifndef MK_N_LAUNCHES
#define MK_N_LAUNCHES 1
#endif

constexpr int D = 1024, NB = 8, SEQ = 4096, LCX = 256, DEPTH = 4;
constexpr int NLAT = NB * SEQ, NCTX = NB * LCX, NTOK = NLAT + NCTX;
constexpr int DIN = 9728;
constexpr int LDP = 6720;
constexpr int C_AX = 0, C_AY = 1024, C_BQ = 2048, C_BK = 2560, C_BV = 3072, C_BG = 4096, C_CQ = 5120, C_CK = 6144, C_CV = 6400, C_GA = 6656;
constexpr int NMOD = 6, NMB = 9;
constexpr int NEXP = 32, DEXP = 512, RCOLS = 36;
constexpr int PMAX = 77824;
constexpr float EPS = 1e-6f;

constexpr size_t MiB = 1u << 20;
constexpr size_t WS_CTL = 0, CTL_BYTES = 1 * MiB;
constexpr size_t WS_MOD = 1 * MiB;
constexpr size_t WS_ROPE = 2 * MiB;
constexpr size_t WS_RW = 4 * MiB;
constexpr size_t WS_HC = 12 * MiB;
constexpr size_t WS_TOKINFO = 20 * MiB;
constexpr size_t WS_ROWTOK = 22 * MiB;
constexpr size_t WS_WT = 28 * MiB;
constexpr size_t WT_IN = 0, WT_BR = 19 * MiB, WT_WO = 25 * MiB, WT_GU = 27 * MiB, WT_DN = 91 * MiB, WT_BYTES = 123 * MiB;
constexpr size_t WS_X = 152 * MiB;
constexpr size_t WS_KV = 220 * MiB;
constexpr size_t WS_PROJ = 288 * MiB;
constexpr size_t WS_HROWS = WS_PROJ;
constexpr size_t WS_YROWS = WS_PROJ + 80 * MiB;
constexpr size_t WS_GT = 736 * MiB;
constexpr size_t WS_YB = 940 * MiB;
constexpr size_t WS_END = 1144 * MiB;
static_assert(WS_PROJ + (size_t)NTOK * LDP * 2 <= WS_GT && WS_GT + (size_t)3 * NTOK * 1024 * 2 <= WS_YB, "ws map");
constexpr int CW_BAR = 1024;
constexpr int CW_BAR_L = 20480, CW_BAR_C = 24576;
constexpr int CW_CNT = 8192;
constexpr size_t CTL_ZROW = 64 * 1024;

constexpr int LDS_BYTES = 163840;
constexpr int LDS_CTL = 155648;
constexpr int MISC_OFF = LDS_CTL + 320;

__device__ __forceinline__ unsigned f2bf(float f) { unsigned u = __builtin_bit_cast(unsigned, f); return (u + 0x7fffu + ((u >> 16) & 1u)) >> 16; }
typedef __bf16 bf16x2_t __attribute__((ext_vector_type(2)));
__device__ __forceinline__ unsigned pk2(float lo, float hi) { const f32x2 v = {lo, hi}; return __builtin_bit_cast(unsigned, __builtin_convertvector(v, bf16x2_t)); }
__device__ __forceinline__ float bf2f(unsigned b) { return __builtin_bit_cast(float, b << 16); }
__device__ __forceinline__ float bflo(unsigned w) { return __builtin_bit_cast(float, w << 16); }
__device__ __forceinline__ float bfhi(unsigned w) { return __builtin_bit_cast(float, w & 0xffff0000u); }
__device__ __forceinline__ float wave_sum(float v) {
#pragma unroll
    for (int o = 1; o < 64; o <<= 1) v += __shfl_xor(v, o);
    return v;
}
__device__ __forceinline__ float sigmoidf_(float x) { return 1.0f / (1.0f + __expf(-x)); }
__device__ __forceinline__ float siluf_(float x) { return x / (1.0f + __expf(-x)); }
__device__ __forceinline__ float gelu_tanh(float x) {
    const float u = 0.7978845608028654f * (x + 0.044715f * x * x * x);
    return x / (1.0f + __expf(-2.0f * u));
}
__device__ __forceinline__ float log1p_fast(float x) { const float u = 1.0f + x; const float d = u - 1.0f; return d == 0.f ? x : __logf(u) * (x / d); }
__device__ __forceinline__ float expm1_fast(float x) { const float u = __expf(x); const float um1 = u - 1.0f; if (um1 == 0.f) return x; const float lu = __logf(u); return um1 == -1.0f ? -1.0f : um1 * (x / lu); }
#define LDS_BARRIER() do { asm volatile("s_waitcnt lgkmcnt(0)" ::: "memory"); __builtin_amdgcn_s_barrier(); asm volatile("" ::: "memory"); } while (0)
#define LDS_WAIT() asm volatile("s_waitcnt lgkmcnt(0)" ::: "memory")
#define VM_WAIT() asm volatile("s_waitcnt vmcnt(0)" ::: "memory")

#define XB_TMO      128
#define XB_XCNT(j)  (256  + 64 * (j))
#define XB_XSUB(j)  (1280 + 64 * (j))
#define XB_XGEN(j)  (2304 + 64 * (j))
#define XB_TOP      3328
#define XB_TOPGEN   3392
#define XCD_BAR_WORDS 3456
#define XB_SPIN_CAP (1u << 22)
__device__ __forceinline__ unsigned xb_ld(unsigned* p)              { return __hip_atomic_load(p, __ATOMIC_RELAXED, __HIP_MEMORY_SCOPE_AGENT); }
__device__ __forceinline__ unsigned xb_add(unsigned* p, unsigned v) { return __hip_atomic_fetch_add(p, v, __ATOMIC_RELAXED, __HIP_MEMORY_SCOPE_AGENT); }
__device__ __forceinline__ unsigned xb_xcc_id() { return (unsigned)__builtin_amdgcn_s_getreg((3 << 11) | 20) & 0xFu; }
#define XB_SPIN(cond, bar) do { unsigned _sp = 0; while (cond) { __builtin_amdgcn_s_sleep(1); \
    if ((++_sp & 255u) == 0u) { if (xb_ld(&(bar)[XB_TMO])) break; if (_sp > XB_SPIN_CAP) { atomicAdd(&(bar)[XB_TMO], 1u); break; } } } } while (0)
struct XcdBarrier { unsigned* bar; unsigned x; volatile LAS unsigned* st; unsigned G; };
__device__ __forceinline__ XcdBarrier xcd_barrier_post(unsigned* bar, volatile LAS unsigned* st, unsigned G) {
    XcdBarrier b; b.bar = bar; b.x = xb_xcc_id(); b.st = st; b.G = G;
    if (threadIdx.x == 0) (void)xb_add(&bar[XB_XCNT(b.x)], 1u);
    return b;
}
__device__ __forceinline__ void xcd_barrier_complete(unsigned* bar, unsigned x, unsigned G, unsigned& nloc, unsigned& nx) {
    unsigned sum, cnt, mine, sp = 0u;
    for (;;) {
        sum = 0u; cnt = 0u; mine = 0u;
#pragma unroll
        for (unsigned j = 0; j < 16; ++j) { const unsigned c = xb_ld(&bar[XB_XCNT(j)]); sum += c; cnt += (c > 0u) ? 1u : 0u; mine = (j == x) ? c : mine; }
        if (sum == G) break;
        __builtin_amdgcn_s_sleep(1);
        if ((++sp & 255u) == 0u) { if (xb_ld(&bar[XB_TMO])) break; if (sp > XB_SPIN_CAP) { atomicAdd(&bar[XB_TMO], 1u); break; } }
    }
    nloc = mine > 0u ? mine : 1u; nx = cnt > 0u ? cnt : 1u;
}
__device__ __forceinline__ void xcd_barrier(const XcdBarrier& b) {
    asm volatile("s_waitcnt vmcnt(0)" ::: "memory");
    __syncthreads();
    if (threadIdx.x == 0) {
        unsigned* bar = b.bar;
        __builtin_amdgcn_s_waitcnt(0);
        unsigned nloc = b.st[0], nx = b.st[1];
        if (nloc == 0u) { xcd_barrier_complete(bar, b.x, b.G, nloc, nx); b.st[0] = nloc; b.st[1] = nx; }
        const unsigned old = xb_add(&bar[XB_XSUB(b.x)], 1u);
        const unsigned gen = old / nloc;
        if (old + 1u == (gen + 1u) * nloc) {
            __builtin_amdgcn_fence(__ATOMIC_RELEASE, "agent");
            asm volatile("s_waitcnt vmcnt(0)" ::: "memory");
            const unsigned og = xb_add(&bar[XB_TOP], 1u);
            const unsigned tg = og / nx;
            if (og + 1u == (tg + 1u) * nx) xb_add(&bar[XB_TOPGEN], 1u);
            else XB_SPIN(xb_ld(&bar[XB_TOPGEN]) == tg, bar);
            xb_add(&bar[XB_XGEN(b.x)], 1u);
            __builtin_amdgcn_fence(__ATOMIC_ACQUIRE, "agent");
            asm volatile("s_waitcnt vmcnt(0)" ::: "memory");
        } else {
            XB_SPIN(xb_ld(&bar[XB_XGEN(b.x)]) == gen, bar);
            __builtin_amdgcn_fence(__ATOMIC_ACQUIRE, "agent");
            asm volatile("s_waitcnt vmcnt(0)" ::: "memory");
        }
    }
    __syncthreads();
}

namespace pg8 {
constexpr int BM = 256, BK = 64, HALF = 128, HTB = HALF * BK * 2, STAGE_BYTES = 8 * HTB;
__device__ __forceinline__ int lds_byte(int r, int c) { const int st = (r >> 4) * 2 + (c >> 5), rr = r & 15, cc = c & 31, ob = rr * 64 + cc * 2; return st * 1024 + (ob ^ (((ob >> 9) & 1) << 5)); }
__device__ __forceinline__ void stage_rc(int b, int& R, int& C) { const int st = b / 1024, sb = b % 1024, swz = sb ^ (((sb >> 9) & 1) << 5); R = (st >> 1) * 16 + swz / 64; C = (st & 1) * 32 + (swz % 64) / 2; }
__device__ __forceinline__ int perm32(int rho) { const int n = rho >> 4, i = rho & 15; return 8 * (i >> 2) + 4 * n + (i & 3); }
__device__ __forceinline__ unsigned cvt_pk_bf16(float lo, float hi) { return pk2(lo, hi); }

template <class Epi, class Sched>
__device__ __forceinline__ void gemm_phase(LAS unsigned char* lds, const Sched& S, const Epi& E, const int tid) {
    typedef typename Sched::Unit Unit;
    const int wid = __builtin_amdgcn_readfirstlane(tid >> 6), lane = tid & 63, wr = wid >> 2, wc = wid & 3, fr = lane & 15, fq = lane >> 4;
    constexpr int nt = Sched::KT; constexpr int K = nt * BK;
    int R[2], C[2]; unsigned voffB[2];
#pragma unroll
    for (int i = 0; i < 2; ++i) { stage_rc(tid * 16 + i * 8192, R[i], C[i]); const int Rb = Epi::PERM ? ((R[i] & ~31) + perm32(R[i] & 31)) : R[i]; voffB[i] = (unsigned)(Rb * K + C[i]) * 2u; }
    constexpr size_t kstep = (size_t)(BK * 2);
    constexpr size_t hstepB = (size_t)HALF * K * 2;
    const unsigned ldsw = (unsigned)wid * 1024u;
    const int aoff = lds_byte(wr * 64 + fr, fq * 8), boff = lds_byte(wc * 32 + fr, fq * 8);
#define PG8_SA(b, h) (((b) * 2 + (h)) * HTB)
#define PG8_SB(b, h) ((4 + (b) * 2 + (h)) * HTB)
#define PG8_STAGEA(bufoff, gbase, vv, h) do { _Pragma("unroll") for (int _i = 0; _i < 2; ++_i) \
        __builtin_amdgcn_global_load_lds((const unsigned*)((const char*)(gbase) + (vv)[h][_i]), (LAS unsigned*)(lds + (bufoff) + ldsw + _i * 8192), 16, 0, 0); } while (0)
#define PG8_STAGEB(bufoff, gbase) do { _Pragma("unroll") for (int _i = 0; _i < 2; ++_i) \
        __builtin_amdgcn_global_load_lds((const unsigned*)((const char*)(gbase) + voffB[_i]), (LAS unsigned*)(lds + (bufoff) + ldsw + _i * 8192), 16, 0, 0); } while (0)
#define PG8_LDA(dst, b, h) do { _Pragma("unroll") for (int m = 0; m < 4; ++m) _Pragma("unroll") for (int k = 0; k < 2; ++k) dst[m][k] = *(const LAS bf16x8*)(lds + PG8_SA(b, h) + aoff + m * 2048 + k * 1024); } while (0)
#define PG8_LDB(dst, b, h) do { _Pragma("unroll") for (int n = 0; n < 2; ++n) _Pragma("unroll") for (int k = 0; k < 2; ++k) dst[n][k] = *(const LAS bf16x8*)(lds + PG8_SB(b, h) + boff + n * 2048 + k * 1024); } while (0)
#define PG8_MMA(ai, bj, At, Bt) do { __builtin_amdgcn_s_setprio(1); _Pragma("unroll") for (int m = 0; m < 4; ++m) _Pragma("unroll") for (int n = 0; n < 2; ++n) _Pragma("unroll") for (int k = 0; k < 2; ++k) \
        acc[ai][bj][m][n] = __builtin_amdgcn_mfma_f32_16x16x32_bf16(Bt[n][k], At[m][k], acc[ai][bj][m][n], 0, 0, 0); __builtin_amdgcn_s_setprio(0); } while (0)
#define PG8_WAIT_V(n) asm volatile("s_waitcnt vmcnt(" #n ")" ::: "memory")
#define PG8_WAIT_L(n) asm volatile("s_waitcnt lgkmcnt(" #n ")" ::: "memory")
#define PG8_BAR __builtin_amdgcn_s_barrier()
#define PG8_SCHED __builtin_amdgcn_sched_barrier(0)
    Unit cur, nxt; int ui = 0;
    if (!S.next(0, cur)) return;
    f32x4 acc[2][2][4][2];
#pragma unroll
    for (int a = 0; a < 2; ++a)
#pragma unroll
        for (int b = 0; b < 2; ++b)
#pragma unroll
            for (int m = 0; m < 4; ++m)
#pragma unroll
                for (int n = 0; n < 2; ++n) acc[a][b][m][n] = (f32x4){0.f, 0.f, 0.f, 0.f};
    bf16x8 At[4][2], B0[2][2], B1[2][2];
    unsigned vA[2][2], vAn[2][2];
    S.a_voff(cur, tid, vA);
#pragma unroll
    for (int h = 0; h < 2; ++h)
#pragma unroll
        for (int i = 0; i < 2; ++i) vAn[h][i] = vA[h][i];
    const char* cA = S.a_base(cur); const char* cB = S.b_base(cur);
    { const char* a0 = cA + S.a_koff(0); const char* a1p = cA + S.a_koff(1);
      PG8_STAGEB(PG8_SB(0, 0), cB); PG8_STAGEB(PG8_SB(0, 1), cB + hstepB); PG8_STAGEA(PG8_SA(0, 0), a0, vA, 0); PG8_STAGEA(PG8_SA(0, 1), a0, vA, 1);
      if (wr == 1) PG8_BAR;
      PG8_WAIT_V(2); PG8_BAR;
      PG8_STAGEB(PG8_SB(1, 0), cB + kstep); PG8_STAGEA(PG8_SA(1, 0), a1p, vA, 0); PG8_STAGEB(PG8_SB(1, 1), cB + hstepB + kstep);
      PG8_WAIT_V(6); PG8_BAR; }
    for (;;) {
        const bool has_next = S.next(ui + 1, nxt);
        const char* nA = cA; const char* nB = cB;
        if (has_next) { nA = S.a_base(nxt); nB = S.b_base(nxt); }
#pragma unroll 1
        for (int t = 0; t < nt; t += 2) {
            const bool last = (t == nt - 2);
            if constexpr (Epi::MIDK) { if (t == 16 || t == 32) E.mid(acc, cur, t, wr, wc, fr, fq); }
            if constexpr (Sched::GATHER) { if (t == nt - 4 && has_next) S.a_voff(nxt, tid, vAn); }
            const char* a1 = cA + S.a_koff(t + 1);
            const char* a2 = last ? nA + S.a_koff(0) : cA + S.a_koff(t + 2);
            const char* a3 = last ? nA + S.a_koff(1) : cA + S.a_koff(t + 3);
            const char* b2 = last ? nB : cB + (size_t)(t + 2) * kstep; const char* b3 = b2 + kstep;
            PG8_LDB(B0, 0, 0); PG8_LDB(B1, 0, 1); PG8_SCHED; PG8_LDA(At, 0, 0); PG8_STAGEA(PG8_SA(1, 1), a1, vA, 1);
            PG8_WAIT_V(8); PG8_WAIT_L(0); PG8_BAR; PG8_MMA(0, 0, At, B0); PG8_MMA(0, 1, At, B1); PG8_BAR; PG8_SCHED;
            PG8_LDA(At, 0, 1); PG8_STAGEB(PG8_SB(0, 0), b2); PG8_STAGEB(PG8_SB(0, 1), b2 + hstepB);
            if (last) { PG8_STAGEA(PG8_SA(0, 0), a2, vAn, 0); } else { PG8_STAGEA(PG8_SA(0, 0), a2, vA, 0); }
            PG8_WAIT_V(8); PG8_WAIT_L(0); PG8_BAR; PG8_MMA(1, 0, At, B0); PG8_MMA(1, 1, At, B1); PG8_BAR; PG8_SCHED;
            PG8_LDB(B0, 1, 0); PG8_LDB(B1, 1, 1); PG8_SCHED; PG8_LDA(At, 1, 0);
            if (last) { PG8_STAGEA(PG8_SA(0, 1), a2, vAn, 1); } else { PG8_STAGEA(PG8_SA(0, 1), a2, vA, 1); }
            PG8_WAIT_V(8); PG8_WAIT_L(0); PG8_BAR; PG8_MMA(0, 0, At, B0); PG8_MMA(0, 1, At, B1); PG8_BAR; PG8_SCHED;
            PG8_LDA(At, 1, 1); PG8_STAGEB(PG8_SB(1, 0), b3); PG8_STAGEB(PG8_SB(1, 1), b3 + hstepB);
            if (last) { PG8_STAGEA(PG8_SA(1, 0), a3, vAn, 0); } else { PG8_STAGEA(PG8_SA(1, 0), a3, vA, 0); }
            PG8_WAIT_V(8); PG8_WAIT_L(0); PG8_BAR; PG8_MMA(1, 0, At, B0); PG8_MMA(1, 1, At, B1); PG8_BAR; PG8_SCHED;
        }
        if (wr == 0) PG8_BAR;
        E(acc, cur, wr, wc, fr, fq);
        if (!has_next) break;
#pragma unroll
        for (int a = 0; a < 2; ++a)
#pragma unroll
            for (int b = 0; b < 2; ++b)
#pragma unroll
                for (int m = 0; m < 4; ++m)
#pragma unroll
                    for (int n = 0; n < 2; ++n) acc[a][b][m][n] = (f32x4){0.f, 0.f, 0.f, 0.f};
        cur = nxt; cA = nA; cB = nB; ++ui;
        if constexpr (Sched::GATHER) {
#pragma unroll
            for (int h = 0; h < 2; ++h)
#pragma unroll
                for (int i = 0; i < 2; ++i) vA[h][i] = vAn[h][i];
        }
        if (wr == 1) PG8_BAR;
    }
    PG8_WAIT_V(0);
    PG8_BAR;
#undef PG8_SA
#undef PG8_SB
#undef PG8_STAGEA
#undef PG8_STAGEB
#undef PG8_LDA
#undef PG8_LDB
#undef PG8_MMA
#undef PG8_WAIT_V
#undef PG8_WAIT_L
#undef PG8_BAR
#undef PG8_SCHED
}
}
namespace gm {
using pg8::cvt_pk_bf16;
__device__ __forceinline__ float fexp_(float x) { return __builtin_amdgcn_exp2f(1.4426950408889634f * x); }
__device__ __forceinline__ float fsig_(float x) { return __builtin_amdgcn_rcpf(1.0f + fexp_(-x)); }
__device__ __forceinline__ float fsilu_(float x) { return x * fsig_(x); }
struct Unit { int pm, pn; };
struct OrderBase {
    int nM, nN, nwg, G, c;
    __device__ __forceinline__ void init(int nM_, int nN_, int G_, int c_) { nM = nM_; nN = nN_; nwg = nM * nN; G = G_; c = c_; }
    __device__ __forceinline__ bool next(int i, Unit& u) const {
        const int L = i * G + c; if (L >= nwg) return false;
        int wgid = L; { const int q = nwg / 8, r = nwg % 8, xcd = wgid % 8, off = wgid / 8; wgid = (xcd < r ? xcd * (q + 1) : r * (q + 1) + (xcd - r) * q) + off; }
        const int nig = 8 * nN, gid = wgid / nig, fm = gid * 8, gsz = (nM - fm) < 8 ? (nM - fm) : 8;
        u.pm = fm + ((wgid % nig) % gsz); u.pn = (wgid % nig) / gsz; return true;
    }
};
struct OrderColAffine {
    int nM, nN, nwg, G, c;
    __device__ __forceinline__ void init(int nM_, int nN_, int G_, int c_) { nM = nM_; nN = nN_; nwg = nM * nN; G = G_; c = c_; }
    __device__ __forceinline__ bool next(int i, Unit& u) const {
        if (G != 256 || nN != 4) { const int L = i * G + c; if (L >= nwg) return false; u.pm = L / nN; u.pn = L % nN; return true; }
        const int x = c & 7, k = c >> 3, j = i * 32 + k; if (2 * j + (x >> 2) >= nM) return false;
        u.pm = 2 * j + (x >> 2); u.pn = x & 3; return true;
    }
};
struct OrderSub : OrderBase {
    int pm0; bool on;
    __device__ __forceinline__ void init(int nM_, int nN_, int Gs, int cs, int pm0_, bool on_) { OrderBase::init(nM_, nN_, Gs, cs); pm0 = pm0_; on = on_; }
    __device__ __forceinline__ bool next(int i, Unit& u) const { if (!on || !OrderBase::next(i, u)) return false; u.pm += pm0; return true; }
};
template <int KT_, int LDA, class Order = OrderBase> struct SchedPlain : Order {
    typedef gm::Unit Unit; static constexpr int KT = KT_; static constexpr bool GATHER = false;
    const char* A; const char* Bt;
    __device__ __forceinline__ const char* a_base(const Unit& u) const { return A + (size_t)u.pm * 256 * LDA * 2; }
    __device__ __forceinline__ void a_voff(const Unit&, int tid, unsigned (&v)[2][2]) const {
#pragma unroll
        for (int i = 0; i < 2; ++i) { int R, C; pg8::stage_rc(tid * 16 + i * 8192, R, C);
#pragma unroll
            for (int h = 0; h < 2; ++h) v[h][i] = (unsigned)((h * 128 + R) * LDA + C) * 2u; }
    }
    __device__ __forceinline__ size_t a_koff(int kt) const { return (size_t)kt * 128; }
    __device__ __forceinline__ const char* b_base(const Unit& u) const { return Bt + (size_t)u.pn * 256 * (KT * 64) * 2; }
};
struct SchedMerge : OrderBase {
    typedef gm::Unit Unit; static constexpr int KT = 48; static constexpr bool GATHER = false;
    const char* A; const char* Bt;
    __device__ __forceinline__ const char* a_base(const Unit& u) const { return A + (size_t)u.pm * 256 * LDP * 2; }
    __device__ __forceinline__ void a_voff(const Unit&, int tid, unsigned (&v)[2][2]) const {
#pragma unroll
        for (int i = 0; i < 2; ++i) { int R, C; pg8::stage_rc(tid * 16 + i * 8192, R, C);
#pragma unroll
            for (int h = 0; h < 2; ++h) v[h][i] = (unsigned)((h * 128 + R) * LDP + C) * 2u; }
    }
    __device__ __forceinline__ size_t a_koff(int kt) const { return (size_t)(kt < 16 ? (C_AY + 64 * kt) : (C_BG - 1024 + 64 * kt)) * 2; }
    __device__ __forceinline__ const char* b_base(const Unit& u) const { return Bt + (size_t)u.pn * 256 * 3072 * 2; }
};
struct MUnit { int e, tile, pn, slot0; };
template <int KT_, bool GATHER_> struct SchedMoe {
    typedef gm::MUnit Unit; static constexpr int KT = KT_; static constexpr bool GATHER = GATHER_;
    const volatile LAS int* tileoff; const volatile LAS int* cnt;
    int G, c, nunits;
    const char* wsbase; const int* rowtok; const char* A; const char* Bt;
    __device__ __forceinline__ bool next(int i, Unit& u) const {
        const int L = i * G + c; if (L >= nunits) return false;
        const int rt = L >> 2; u.pn = L & 3;
        const int ln_ = (int)__builtin_amdgcn_mbcnt_hi(~0u, __builtin_amdgcn_mbcnt_lo(~0u, 0u));
        const int e = (int)__builtin_popcountll(__ballot(rt >= tileoff[ln_ & 31]) & 0xFFFFFFFFull) - 1;
        u.e = e; u.tile = rt - tileoff[e]; u.slot0 = rt * 256; return true;
    }
    __device__ __forceinline__ const char* a_base(const Unit& u) const { if constexpr (GATHER) return wsbase; else return A + (size_t)u.slot0 * DEXP * 2; }
    __device__ __forceinline__ void a_voff(const Unit& u, int tid, unsigned (&v)[2][2]) const {
        if constexpr (GATHER) {
            asm volatile("" : "+v"(tid));
            const int n = cnt[u.e]; const int* rt = rowtok + (size_t)u.e * NTOK + u.tile * 256;
#pragma unroll
            for (int i = 0; i < 2; ++i) { int R, C; pg8::stage_rc(tid * 16 + i * 8192, R, C);
#pragma unroll
                for (int h = 0; h < 2; ++h) { const int r = h * 128 + R; const bool ok = (u.tile * 256 + r) < n; const int tok = ok ? rt[r] : 0;
                    v[h][i] = ok ? (unsigned)(WS_X + (size_t)tok * 2048 + C * 2) : (unsigned)(CTL_ZROW + C * 2); } }
        } else {
#pragma unroll
            for (int i = 0; i < 2; ++i) { int R, C; pg8::stage_rc(tid * 16 + i * 8192, R, C);
#pragma unroll
                for (int h = 0; h < 2; ++h) v[h][i] = (unsigned)((h * 128 + R) * DEXP + C) * 2u; }
        }
    }
    __device__ __forceinline__ size_t a_koff(int kt) const { return (size_t)kt * 128; }
    __device__ __forceinline__ const char* b_base(const Unit& u) const { return Bt + ((size_t)u.e * 1024 + u.pn * 256) * (KT * 64) * 2; }
};

struct EpiProj {
    static constexpr bool PERM = true, MIDK = false; bf16* O; unsigned char* GT;
    static __device__ __forceinline__ unsigned gq8_(float z) { return (unsigned)fmaxf(fsig_(z) * 255.0f + 0.5f, 1.0f); }
    __device__ __forceinline__ void operator()(const f32x4 (&acc)[2][2][4][2], const Unit& u, int wr, int wc, int fr, int fq) const {
        if (u.pn >= 26) {
            const int br = (u.pn - 26) >> 2, pq = (u.pn - 26) & 3; const int wave = wr * 4 + wc, lane = fq * 16 + fr;
            unsigned char* t = GT + (((size_t)(br * 136 + u.pm) * 4 + pq) << 16) + (size_t)(wave * 64 + lane) * 16;
#pragma unroll
            for (int ai = 0; ai < 2; ++ai)
#pragma unroll
                for (int m = 0; m < 4; ++m) { u32x4 w;
#pragma unroll
                    for (int bj = 0; bj < 2; ++bj) { const f32x4 v0 = acc[ai][bj][m][0], v1 = acc[ai][bj][m][1];
                        w[2 * bj] = gq8_(v0[0]) | (gq8_(v0[1]) << 8) | (gq8_(v0[2]) << 16) | (gq8_(v0[3]) << 24);
                        w[2 * bj + 1] = gq8_(v1[0]) | (gq8_(v1[1]) << 8) | (gq8_(v1[2]) << 16) | (gq8_(v1[3]) << 24); }
                    *(u32x4*)(t + (ai * 4 + m) * 8192) = w; }
            return;
        }
        bf16* base = O + (size_t)(u.pm * 256 + wr * 64 + fr) * LDP + u.pn * 256 + wc * 32 + 8 * fq;
#pragma unroll
        for (int ai = 0; ai < 2; ++ai)
#pragma unroll
            for (int m = 0; m < 4; ++m) { bf16* rowp = base + (size_t)(ai * 128 + m * 16) * LDP;
#pragma unroll
                for (int bj = 0; bj < 2; ++bj) { const f32x4 v0 = acc[ai][bj][m][0], v1 = acc[ai][bj][m][1];
                    u32x4 w; w.x = cvt_pk_bf16(v0[0], v0[1]); w.y = cvt_pk_bf16(v0[2], v0[3]); w.z = cvt_pk_bf16(v1[0], v1[1]); w.w = cvt_pk_bf16(v1[2], v1[3]);
                    *(u32x4*)(rowp + bj * 128) = w; } }
    }
};
struct EpiPlain {
    static constexpr bool PERM = true, MIDK = false; bf16* O;
    __device__ __forceinline__ void operator()(const f32x4 (&acc)[2][2][4][2], const Unit& u, int wr, int wc, int fr, int fq) const {
        bf16* base = O + (size_t)(u.pm * 256 + wr * 64 + fr) * 1024 + u.pn * 256 + wc * 32 + 8 * fq;
#pragma unroll
        for (int ai = 0; ai < 2; ++ai)
#pragma unroll
            for (int m = 0; m < 4; ++m) { bf16* rowp = base + (size_t)(ai * 128 + m * 16) * 1024;
#pragma unroll
                for (int bj = 0; bj < 2; ++bj) { const f32x4 v0 = acc[ai][bj][m][0], v1 = acc[ai][bj][m][1];
                    u32x4 w; w.x = cvt_pk_bf16(v0[0], v0[1]); w.y = cvt_pk_bf16(v0[2], v0[3]); w.z = cvt_pk_bf16(v1[0], v1[1]); w.w = cvt_pk_bf16(v1[2], v1[3]);
                    *(u32x4*)(rowp + bj * 128) = w; } }
    }
};
struct EpiMerge {
    static constexpr bool PERM = true, MIDK = true; const unsigned char* GT; bf16* O;
    __device__ __forceinline__ const unsigned char* tile(const Unit& u, int br, int wr, int wc, int fr, int fq) const {
        return GT + (((size_t)(br * 136 + u.pm) * 4 + u.pn) << 16) + (size_t)((wr * 4 + wc) * 64 + fq * 16 + fr) * 16; }
    static __device__ __forceinline__ float b8_(unsigned w, int k) { return (float)((w >> (8 * k)) & 0xffu); }
    __device__ __forceinline__ void mid(f32x4 (&acc)[2][2][4][2], const Unit& u, int t, int wr, int wc, int fr, int fq) const {
        const int br = (t == 16) ? 0 : 1; const unsigned char* ta = tile(u, br, wr, wc, fr, fq); const unsigned char* tb = tile(u, br + 1, wr, wc, fr, fq);
        u32x4 ga[8], gb[8];
#pragma unroll
        for (int j = 0; j < 8; ++j) { ga[j] = *(const u32x4*)(ta + 8192 * j); gb[j] = *(const u32x4*)(tb + 8192 * j); }
#pragma unroll
        for (int ai = 0; ai < 2; ++ai)
#pragma unroll
            for (int m = 0; m < 4; ++m)
#pragma unroll
                for (int bj = 0; bj < 2; ++bj)
#pragma unroll
                    for (int hw = 0; hw < 2; ++hw) { const unsigned wa = ga[ai * 4 + m][2 * bj + hw], wb = gb[ai * 4 + m][2 * bj + hw];
#pragma unroll
                        for (int k = 0; k < 4; ++k) acc[ai][bj][m][hw][k] *= b8_(wa, k) * __builtin_amdgcn_rcpf(b8_(wb, k)); }
    }
    __device__ __forceinline__ void operator()(const f32x4 (&acc)[2][2][4][2], const Unit& u, int wr, int wc, int fr, int fq) const {
        const unsigned char* tc = tile(u, 2, wr, wc, fr, fq);
        u32x4 gc[8];
#pragma unroll
        for (int j = 0; j < 8; ++j) gc[j] = *(const u32x4*)(tc + 8192 * j);
        const size_t row0 = (size_t)(u.pm * 256 + wr * 64 + fr); const int col0 = u.pn * 256 + wc * 32 + 8 * fq;
        constexpr float S = 1.0f / 255.0f;
#pragma unroll
        for (int ai = 0; ai < 2; ++ai)
#pragma unroll
            for (int m = 0; m < 4; ++m) { const size_t row = row0 + ai * 128 + m * 16;
#pragma unroll
                for (int bj = 0; bj < 2; ++bj) { const unsigned g0 = gc[ai * 4 + m][2 * bj], g1 = gc[ai * 4 + m][2 * bj + 1];
                    const f32x4 v0 = acc[ai][bj][m][0] * S, v1 = acc[ai][bj][m][1] * S; u32x4 w;
                    w.x = cvt_pk_bf16(v0[0] * b8_(g0, 0), v0[1] * b8_(g0, 1)); w.y = cvt_pk_bf16(v0[2] * b8_(g0, 2), v0[3] * b8_(g0, 3));
                    w.z = cvt_pk_bf16(v1[0] * b8_(g1, 0), v1[1] * b8_(g1, 1)); w.w = cvt_pk_bf16(v1[2] * b8_(g1, 2), v1[3] * b8_(g1, 3));
                    *(u32x4*)(O + row * 1024 + col0 + bj * 128) = w; } }
    }
};
struct EpiWo {
    static constexpr bool PERM = false, MIDK = false; float* h; float* hc; const float* mod; bool wen; const float* hsrc; const float* hcsrc;
    __device__ __forceinline__ void operator()(const f32x4 (&acc)[2][2][4][2], const Unit& u, int wr, int wc, int fr, int fq) const {
        const bool lat = u.pm < 128; const int mb = lat ? (u.pm >> 4) : 8;
        float* hb = lat ? h + (size_t)u.pm * 256 * 1024 : hc + (size_t)(u.pm - 128) * 256 * 1024;
        const float* sb = lat ? hsrc + (size_t)u.pm * 256 * 1024 : hcsrc + (size_t)(u.pm - 128) * 256 * 1024;
        const int col0 = u.pn * 256 + wc * 32 + 4 * fq; const float* mp = mod + (size_t)mb * 6144 + 2 * 1024 + col0;
        f32x4 mv[2][2];
#pragma unroll
        for (int bj = 0; bj < 2; ++bj)
#pragma unroll
            for (int n = 0; n < 2; ++n) mv[bj][n] = *(const f32x4*)(mp + bj * 128 + n * 16);
#pragma unroll
        for (int ai = 0; ai < 2; ++ai)
#pragma unroll
            for (int m = 0; m < 4; ++m) { const size_t ro = (size_t)(ai * 128 + wr * 64 + m * 16 + fr) * 1024 + col0; float* rowp = hb + ro; const float* srcp = sb + ro;
#pragma unroll
                for (int bj = 0; bj < 2; ++bj)
#pragma unroll
                    for (int n = 0; n < 2; ++n) { f32x4 hv = *(const f32x4*)(srcp + bj * 128 + n * 16); hv = hv + mv[bj][n] * acc[ai][bj][m][n]; if (wen) *(f32x4*)(rowp + bj * 128 + n * 16) = hv; } }
    }
};
struct EpiGU {
    static constexpr bool PERM = true, MIDK = false; bf16* H;
    __device__ __forceinline__ void operator()(const f32x4 (&acc)[2][2][4][2], const MUnit& u, int wr, int wc, int fr, int fq) const {
        bf16* base = H + (size_t)(u.slot0 + wr * 64 + fr) * DEXP + u.pn * 128 + wc * 32 + 8 * fq;
#pragma unroll
        for (int ai = 0; ai < 2; ++ai)
#pragma unroll
            for (int m = 0; m < 4; ++m) { const f32x4 g0 = acc[ai][0][m][0], g1 = acc[ai][0][m][1], u0 = acc[ai][1][m][0], u1 = acc[ai][1][m][1]; u32x4 w;
                w.x = cvt_pk_bf16(fsilu_(g0[0]) * u0[0], fsilu_(g0[1]) * u0[1]); w.y = cvt_pk_bf16(fsilu_(g0[2]) * u0[2], fsilu_(g0[3]) * u0[3]);
                w.z = cvt_pk_bf16(fsilu_(g1[0]) * u1[0], fsilu_(g1[1]) * u1[1]); w.w = cvt_pk_bf16(fsilu_(g1[2]) * u1[2], fsilu_(g1[3]) * u1[3]);
                *(u32x4*)(base + (size_t)(ai * 128 + m * 16) * DEXP) = w; }
    }
};
struct EpiDN {
    static constexpr bool PERM = true, MIDK = false; bf16* Y;
    __device__ __forceinline__ void operator()(const f32x4 (&acc)[2][2][4][2], const MUnit& u, int wr, int wc, int fr, int fq) const {
        bf16* base = Y + (size_t)(u.slot0 + wr * 64 + fr) * 1024 + u.pn * 256 + wc * 32 + 8 * fq;
#pragma unroll
        for (int ai = 0; ai < 2; ++ai)
#pragma unroll
            for (int m = 0; m < 4; ++m) { bf16* rowp = base + (size_t)(ai * 128 + m * 16) * 1024;
#pragma unroll
                for (int bj = 0; bj < 2; ++bj) { const f32x4 v0 = acc[ai][bj][m][0], v1 = acc[ai][bj][m][1];
                    u32x4 w; w.x = cvt_pk_bf16(v0[0], v0[1]); w.y = cvt_pk_bf16(v0[2], v0[3]); w.z = cvt_pk_bf16(v1[0], v1[1]); w.w = cvt_pk_bf16(v1[2], v1[3]);
                    *(u32x4*)(rowp + bj * 128) = w; } }
    }
};
}
struct Args { const float* in[30]; float* out; unsigned char* ws; int ph_lo, ph_hi; };
enum { I_X = 0, I_C, I_CTX, I_CCTX, I_WMOD, I_BMOD, I_N1G, I_N2G, I_WIN, I_CONVW, I_CONVB, I_WA, I_BA, I_WX, I_BX, I_LAM, I_RLAM, I_SINK,
       I_WBA, I_WBB, I_WBC, I_WOUT, I_RGW, I_RGB, I_REW, I_REB, I_EWG, I_EWU, I_EWD, I_FNG };
typedef const GAS float* cfp_t;
struct Frame {
    LAS unsigned char* lds; int tid, lane, wave, G, bid, gw, NGW; bool wr;
    const __attribute__((address_space(4))) cfp_t* in; float* out; unsigned char* ws;
};
#define FIN(i)     ((const float*)F.in[i])
#define F_MOD(F)   ((float*)((F).ws + WS_MOD))
#define F_HC(F)    ((float*)((F).ws + WS_HC))
#define F_X(F)     ((bf16*)((F).ws + WS_X))
#define F_PROJ(F)  ((bf16*)((F).ws + WS_PROJ))
#define F_YB(F)    ((bf16*)((F).ws + WS_YB))
#define F_CNT(F)   ((int*)((F).ws + WS_CTL) + CW_CNT)

__device__ __forceinline__ void ph_prologue(Frame& F) {
    LAS float* sc = (LAS float*)F.lds;
    LAS float* part = (LAS float*)(F.lds + 40960);
    for (int i = F.tid; i < 9 * 1024; i += 512) { const int mb = i >> 10, k = i & 1023; const float cv = mb < 8 ? FIN(I_C)[mb * 1024 + k] : FIN(I_CCTX)[k]; sc[i] = siluf_(cv); }
    __syncthreads();
    for (int item = F.bid; item < 4 * 96; item += F.G) {
        const int l = item / 96, n0 = (item % 96) * 64;
        const float* wp = FIN(I_WMOD) + ((size_t)l * 1024 + F.wave * 128) * 6144 + n0 + F.lane;
        float acc[9];
#pragma unroll
        for (int mb = 0; mb < 9; ++mb) acc[mb] = 0.f;
#pragma unroll 32
        for (int k = 0; k < 128; ++k) { const float wv = wp[(size_t)k * 6144];
#pragma unroll
            for (int mb = 0; mb < 9; ++mb) acc[mb] += sc[mb * 1024 + F.wave * 128 + k] * wv; }
#pragma unroll
        for (int mb = 0; mb < 9; ++mb) part[(F.wave * 9 + mb) * 64 + F.lane] = acc[mb];
        __syncthreads();
        for (int t = F.tid; t < 576; t += 512) { const int mb = t >> 6, ln = t & 63; float s = FIN(I_BMOD)[l * 6144 + n0 + ln];
#pragma unroll
            for (int w = 0; w < 8; ++w) s += part[(w * 9 + mb) * 64 + ln];
            F_MOD(F)[((size_t)l * 9 + mb) * 6144 + n0 + ln] = s; }
        __syncthreads();
    }
    f32x2* rt = (f32x2*)(F.ws + WS_ROPE);
    for (int i = F.bid * 512 + F.tid; i < 4096 * 32; i += F.G * 512) { const int pos = i >> 5, f = i & 31;
        const float inv = (float)pow(10000.0, -(double)(2 * f) / 64.0); const float ang = (float)pos * inv;
        rt[i] = (f32x2){(float)cos((double)ang), (float)sin((double)ang)}; }
    f32x2* at = (f32x2*)(F.ws + WS_ROPE + 1 * MiB);
    for (int i = F.bid * 512 + F.tid; i < 64 * 16; i += F.G * 512) { const int pos = i >> 4, f = i & 15;
        const float inv = (float)pow(10000.0, -(double)(2 * f) / 32.0); const float ang = (float)pos * inv;
        at[i] = (f32x2){(float)cos((double)ang), (float)sin((double)ang)}; }
}

__device__ __forceinline__ void tr_item(const float* W, int ldw, int k0, int n0, bf16* dst  , int ldk, LAS float* scr, int lane) {
    float wv[32];
#pragma unroll
    for (int i = 0; i < 32; ++i) { const int kk = 2 * i + (lane >> 5); wv[i] = __builtin_nontemporal_load(W + (size_t)(k0 + kk) * ldw + n0 + (lane & 31)); }
#pragma unroll
    for (int i = 0; i < 32; ++i) { const int kk = 2 * i + (lane >> 5); scr[kk * 33 + (lane & 31)] = wv[i]; }
    LDS_WAIT(); asm volatile("" ::: "memory");
    const int c = lane & 7;
#pragma unroll
    for (int j = 0; j < 4; ++j) { const int n = (lane >> 3) + 8 * j; const LAS float* s = scr + (8 * c) * 33 + n;
        u32x4 o; o.x = pk2(s[0 * 33], s[1 * 33]); o.y = pk2(s[2 * 33], s[3 * 33]); o.z = pk2(s[4 * 33], s[5 * 33]); o.w = pk2(s[6 * 33], s[7 * 33]);
        *(u32x4*)(dst + (size_t)n * ldk + 8 * c) = o; }
    LDS_WAIT(); asm volatile("" ::: "memory");
}
__device__ __forceinline__ void ph_convert(Frame& F, int l) {
    LAS float* scr = (LAS float*)(F.lds + F.wave * 16384);
    bf16* wt = (bf16*)(F.ws + WS_WT);
    constexpr int I_IN = 16 * 304, I_BRN = 16 * 32, I_GU1 = 16 * 16, I_DN1 = 8 * 32;
    constexpr int NITEMS = I_IN + 4 * I_BRN + 32 * 2 * I_GU1 + 32 * I_DN1;
    for (int it = F.gw; it < NITEMS; it += F.NGW) {
        int r = it;
        if (r < I_IN) { const int kb = r / 304, nb = r % 304; tr_item(FIN(I_WIN) + (size_t)l * 1024 * DIN, DIN, 64 * kb, 32 * nb, wt + WT_IN / 2 + (size_t)(32 * nb) * 1024 + 64 * kb, 1024, scr, F.lane); continue; }
        r -= I_IN;
        if (r < 3 * I_BRN) { const int br = r / I_BRN, q = r % I_BRN, kb = q / 32, nb = q % 32; const float* W = FIN(I_WBA + br) + (size_t)l * 1024 * 1024;
            tr_item(W, 1024, 64 * kb, 32 * nb, wt + WT_BR / 2 + (size_t)(32 * nb) * 3072 + br * 1024 + 64 * kb, 3072, scr, F.lane); continue; }
        r -= 3 * I_BRN;
        if (r < I_BRN) { const int kb = r / 32, nb = r % 32; tr_item(FIN(I_WOUT) + (size_t)l * 1024 * 1024, 1024, 64 * kb, 32 * nb, wt + WT_WO / 2 + (size_t)(32 * nb) * 1024 + 64 * kb, 1024, scr, F.lane); continue; }
        r -= I_BRN;
        if (r < 32 * 2 * I_GU1) { const int e = r / (2 * I_GU1), q = r % (2 * I_GU1), up = q / I_GU1, q2 = q % I_GU1, kb = q2 / 16, nb = q2 % 16;
            const float* W = FIN(up ? I_EWU : I_EWG) + ((size_t)l * 32 + e) * 1024 * 512; const int n0 = 32 * nb;
            const int drow = e * 1024 + (n0 >> 7) * 256 + up * 128 + (n0 & 127);
            tr_item(W, 512, 64 * kb, n0, wt + WT_GU / 2 + (size_t)drow * 1024 + 64 * kb, 1024, scr, F.lane); continue; }
        r -= 32 * 2 * I_GU1;
        { const int e = r / I_DN1, q = r % I_DN1, kb = q / 32, nb = q % 32; const float* W = FIN(I_EWD) + ((size_t)l * 32 + e) * 512 * 1024;
            tr_item(W, 1024, 64 * kb, 32 * nb, wt + WT_DN / 2 + (size_t)(e * 1024 + 32 * nb) * 512 + 64 * kb, 512, scr, F.lane); }
    }
}
constexpr size_t RW_ELEMS = (size_t)4 * 9 * 48 * 1024;
__device__ __forceinline__ void ph_router_fold(Frame& F) {
    float* Wp = (float*)(F.ws + WS_RW); float* rc = Wp + RW_ELEMS;
    const int fstride = F.G * 512;
    for (int i0 = F.bid * 512 + F.tid; i0 < (int)RW_ELEMS; i0 += 4 * fstride) {
        float w4[4], g4[4], m4[4];
#pragma unroll
        for (int q = 0; q < 4; ++q) { const int i = i0 + q * fstride; w4[q] = 0.f; g4[q] = 0.f; m4[q] = 0.f;
            if (i < (int)RW_ELEMS) { const int k = i & 1023, j = (i >> 10) % 48, mb = (i / (48 * 1024)) % 9, l = i / (48 * 1024 * 9);
                if (j < RCOLS) { w4[q] = j < 4 ? FIN(I_RGW)[((size_t)l * 1024 + k) * 4 + j] : FIN(I_REW)[((size_t)l * 1024 + k) * 32 + (j - 4)];
                    g4[q] = FIN(I_N2G)[l * 1024 + k]; m4[q] = F_MOD(F)[((size_t)l * 9 + mb) * 6144 + 4 * 1024 + k]; } } }
#pragma unroll
        for (int q = 0; q < 4; ++q) { const int i = i0 + q * fstride; if (i < (int)RW_ELEMS) Wp[i] = g4[q] * (1.0f + m4[q]) * w4[q]; }
    }
    for (int it = F.gw; it < 4 * 9 * RCOLS; it += F.NGW) { const int j = it % RCOLS, mb = (it / RCOLS) % 9, l = it / (RCOLS * 9);
        float s = 0.f;
        for (int k = F.lane; k < 1024; k += 64) { const float w = j < 4 ? FIN(I_RGW)[((size_t)l * 1024 + k) * 4 + j] : FIN(I_REW)[((size_t)l * 1024 + k) * 32 + (j - 4)];
            s += F_MOD(F)[((size_t)l * 9 + mb) * 6144 + 3 * 1024 + k] * w; }
        s = wave_sum(s);
        if (F.lane == 0) rc[(l * 9 + mb) * 64 + j] = s + (j < 4 ? FIN(I_RGB)[l * 4 + j] : FIN(I_REB)[l * 32 + (j - 4)]);
    }
}

struct RowJob { const float* src; float* copy_to; int mb; };
template <class RowFn> __device__ __forceinline__ void rows_norm_loop(Frame& F, int row0, int nrows, int w, int NW, const float* gain, const float* mod, int shift_i, int scale_i, bf16* dst, RowFn rowfn) {
    const int lane = F.lane;
    f32x4 nv[4]; RowJob nj = {nullptr, nullptr, 0};
    const int per = (nrows - row0 + NW - 1) / NW; int r = row0 + w * per; const int rend = (r + per < nrows) ? r + per : nrows;
    if (r < rend) { nj = rowfn(r);
#pragma unroll
        for (int j = 0; j < 4; ++j) nv[j] = *(const f32x4*)(nj.src + 4 * lane + 256 * j); }
    int mbc = -1; f32x4 cgs[4], csh[4];
    for (; r < rend; ++r) {
        f32x4 v[4]; const RowJob cj = nj;
#pragma unroll
        for (int j = 0; j < 4; ++j) v[j] = nv[j];
        if (r + 1 < rend) { nj = rowfn(r + 1);
#pragma unroll
            for (int j = 0; j < 4; ++j) nv[j] = *(const f32x4*)(nj.src + 4 * lane + 256 * j); }
        if (cj.mb != mbc) { mbc = cj.mb;
#pragma unroll
            for (int j = 0; j < 4; ++j) { cgs[j] = *(const f32x4*)(gain + 4 * lane + 256 * j) * (*(const f32x4*)(mod + cj.mb * 6144 + scale_i * 1024 + 4 * lane + 256 * j) + 1.0f);
                csh[j] = *(const f32x4*)(mod + cj.mb * 6144 + shift_i * 1024 + 4 * lane + 256 * j); } }
        float ss = 0.f;
#pragma unroll
        for (int j = 0; j < 4; ++j) ss += (v[j].x * v[j].x + v[j].y * v[j].y) + (v[j].z * v[j].z + v[j].w * v[j].w);
        if (cj.copy_to) {
#pragma unroll
            for (int j = 0; j < 4; ++j) *(f32x4*)(cj.copy_to + 4 * lane + 256 * j) = v[j]; }
        const float rstd = 1.0f / sqrtf(wave_sum(ss) * (1.0f / 1024.0f) + EPS);
#pragma unroll
        for (int j = 0; j < 4; ++j) { const f32x4 y = (v[j] * rstd) * cgs[j] + csh[j];
            u32x2 w; w.x = pk2(y.x, y.y); w.y = pk2(y.z, y.w); *(u32x2*)(dst + (size_t)r * 1024 + 4 * lane + 256 * j) = w; }
    }
}
__device__ __forceinline__ void ph_rows_u(Frame& F, int l, bool first) {
    const float* mod = F_MOD(F) + (size_t)l * 9 * 6144; const float* g = FIN(I_N1G) + l * 1024;
    float* out = F.out; float* hc = F_HC(F); const float* xin = FIN(I_X); const float* cin = FIN(I_CTX);
    rows_norm_loop(F, 0, NTOK, F.gw, F.NGW, g, mod, 0, 1, F_X(F), [=](int r) { const bool lat = r < NLAT; RowJob j; j.mb = lat ? (r >> 12) : 8;
        float* hrow = lat ? out + (size_t)r * 1024 : hc + (size_t)(r - NLAT) * 1024;
        j.src = first ? (lat ? xin + (size_t)r * 1024 : cin + (size_t)(r - NLAT) * 1024) : hrow; j.copy_to = nullptr; return j; });
}
__device__ __forceinline__ void ph_rows_v(Frame& F, int l, int row0, int ntok, int w, int NW) {
    const float* mod = F_MOD(F) + (size_t)l * 9 * 6144; const float* g = FIN(I_N2G) + l * 1024;
    float* out = F.out; float* hc = F_HC(F);
    rows_norm_loop(F, row0, ntok, w, NW, g, mod, 3, 4, F_X(F), [=](int r) { const bool lat = r < NLAT; RowJob j; j.mb = lat ? (r >> 12) : 8;
        j.src = lat ? out + (size_t)r * 1024 : hc + (size_t)(r - NLAT) * 1024; j.copy_to = nullptr; return j; });
}

__device__ __forceinline__ void ph_router(Frame& F, int l, int bt0, int bt1, int c, int G) {
    LAS float* Bs = (LAS float*)F.lds;
    LAS float* lgs = (LAS float*)(F.lds + 53248 + F.wave * 4096);
    const float* WpL = (const float*)(F.ws + WS_RW) + (size_t)l * 9 * 48 * 1024; const float* rcL = (const float*)(F.ws + WS_RW) + RW_ELEMS + l * 9 * 64;
    int* cnt = F_CNT(F) + l * 32; int* rowtok = (int*)(F.ws + WS_ROWTOK); unsigned* tinfo = (unsigned*)(F.ws + WS_TOKINFO);
    const int lane = F.lane, i16 = lane & 15, kq = lane >> 4, tid = F.tid;
    const int ntask = bt1 - bt0, nfull = (ntask / G) * G, rem = ntask - nfull;
    const int rtok0 = (bt0 + nfull) * 128, rtok1 = bt1 * 128 - 1;
    const bool minis = rem > 0 && ((rtok0 < NLAT ? (rtok0 >> 12) : 8) == (rtok1 < NLAT ? (rtok1 >> 12) : 8));
    const int npass = nfull / G + (rem > 0 ? (minis ? 1 : (c < rem ? 1 : 0)) : 0);
    for (int ps_ = 0; ps_ < npass; ++ps_) {
        const bool mini = minis && ps_ == nfull / G;
        const int mt = c + G * F.wave;
        const bool active = !mini || mt < rem * 8;
        const int tok0 = mini ? (active ? rtok0 + mt * 16 : rtok0) : (bt0 + c + ps_ * G) * 128 + F.wave * 16; const bool lat = tok0 < NLAT; const int mb = lat ? (tok0 >> 12) : 8;
        const float* hrow = (lat ? F.out + (size_t)(tok0 + i16) * 1024 : F_HC(F) + (size_t)(tok0 + i16 - NLAT) * 1024) + 4 * kq;
        const float* wsrc = WpL + (size_t)mb * 48 * 1024;
        f32x4 acc[3]; float ss = 0.f;
#pragma unroll
        for (int c = 0; c < 3; ++c) acc[c] = (f32x4){0.f, 0.f, 0.f, 0.f};
        f32x4 bnext[6];
#pragma unroll
        for (int j = 0; j < 6; ++j) { const int i = tid + 512 * j; bnext[j] = *(const f32x4*)(wsrc + (size_t)(i >> 6) * 1024 + 4 * (i & 63)); }
        f32x4 an[16];
        if (active) {
#pragma unroll
            for (int S = 0; S < 16; ++S) an[S] = *(const f32x4*)(hrow + 16 * S); }
#pragma unroll 1
        for (int kc = 0; kc < 4; ++kc) {
            LDS_BARRIER();
#pragma unroll
            for (int j = 0; j < 6; ++j) { const int i = tid + 512 * j; *(LAS f32x4*)(Bs + (i >> 6) * 260 + 4 * (i & 63)) = bnext[j]; }
            LDS_BARRIER();
            if (kc < 3) {
#pragma unroll
                for (int j = 0; j < 6; ++j) { const int i = tid + 512 * j; bnext[j] = *(const f32x4*)(wsrc + (size_t)(i >> 6) * 1024 + (kc + 1) * 256 + 4 * (i & 63)); } }
            const LAS float* bp = Bs + i16 * 260 + 4 * kq;
            f32x4 ac[16];
#pragma unroll
            for (int S = 0; S < 16; ++S) ac[S] = an[S];
            if (active && kc < 3) {
#pragma unroll
                for (int S = 0; S < 16; ++S) an[S] = *(const f32x4*)(hrow + (kc + 1) * 256 + 16 * S); }
            if (active)
#pragma unroll
            for (int S = 0; S < 16; ++S) {
                const f32x4 a = ac[S];
                const f32x4 b0 = *(const LAS f32x4*)(bp + 16 * S), b1 = *(const LAS f32x4*)(bp + 16 * 260 + 16 * S), b2 = *(const LAS f32x4*)(bp + 32 * 260 + 16 * S);
                ss += (a.x * a.x + a.y * a.y) + (a.z * a.z + a.w * a.w);
#pragma unroll
                for (int s = 0; s < 4; ++s) { acc[0] = __builtin_amdgcn_mfma_f32_16x16x4f32(a[s], b0[s], acc[0], 0, 0, 0); acc[1] = __builtin_amdgcn_mfma_f32_16x16x4f32(a[s], b1[s], acc[1], 0, 0, 0);
                    acc[2] = __builtin_amdgcn_mfma_f32_16x16x4f32(a[s], b2[s], acc[2], 0, 0, 0); }
            }
        }
        if (active) {
        ss += __shfl_xor(ss, 16); ss += __shfl_xor(ss, 32);
#pragma unroll
        for (int c = 0; c < 3; ++c)
#pragma unroll
            for (int r = 0; r < 4; ++r) lgs[(4 * kq + r) * 52 + 16 * c + i16] = acc[c][r];
        LDS_WAIT(); asm volatile("" ::: "memory");
        const float rstd = 1.0f / sqrtf(ss * (1.0f / 1024.0f) + EPS);
        float lg[RCOLS];
#pragma unroll
        for (int j4 = 0; j4 < RCOLS / 4; ++j4) { const f32x4 v = *(const LAS f32x4*)(lgs + i16 * 52 + 4 * j4); const f32x4 rcv = *(const f32x4*)(rcL + mb * 64 + 4 * j4);
            lg[4 * j4] = v.x * rstd + rcv.x; lg[4 * j4 + 1] = v.y * rstd + rcv.y; lg[4 * j4 + 2] = v.z * rstd + rcv.z; lg[4 * j4 + 3] = v.w * rstd + rcv.w; }
        LDS_WAIT(); asm volatile("" ::: "memory");
        const int tok = tok0 + i16;
        int g = 0; float gm = lg[0];
#pragma unroll
        for (int j = 1; j < 4; ++j) if (lg[j] > gm) { gm = lg[j]; g = j; }
        float gs = 0.f;
#pragma unroll
        for (int j = 0; j < 4; ++j) gs += __expf(lg[j] - gm);
        const float g_w = 1.0f / gs;
        float el[8];
#pragma unroll
        for (int i = 0; i < 8; ++i) { el[i] = lg[4 + i];
#pragma unroll
            for (int gg = 1; gg < 4; ++gg) el[i] = (g == gg) ? lg[4 + gg * 8 + i] : el[i]; }
        int i1 = 0; float m1 = el[0];
#pragma unroll
        for (int i = 1; i < 8; ++i) if (el[i] > m1) { m1 = el[i]; i1 = i; }
        int i2 = -1; float m2 = -3.0e38f;
#pragma unroll
        for (int i = 0; i < 8; ++i) if (i != i1 && el[i] > m2) { m2 = el[i]; i2 = i; }
        const float p2 = __expf(m2 - m1); const float w1 = g_w / (1.0f + p2), w2 = g_w * p2 / (1.0f + p2);
        const int e1 = g * 8 + i1, e2 = g * 8 + i2;
        int ld1 = 16, rk1 = 0, n1 = 0, ld2 = 16, rk2 = 0, n2 = 0; const int tl = lane & 15;
#pragma unroll
        for (int j = 0; j < 16; ++j) { const bool m1 = __shfl(e1, j) == e1, m2 = __shfl(e2, j) == e2;
            n1 += m1 ? 1 : 0; rk1 += (m1 && j < tl) ? 1 : 0; ld1 = (m1 && j < ld1) ? j : ld1; n2 += m2 ? 1 : 0; rk2 += (m2 && j < tl) ? 1 : 0; ld2 = (m2 && j < ld2) ? j : ld2; }
        int b1 = 0, b2 = 0;
        if (lane == ld1 && F.wr) b1 = atomicAdd(&cnt[e1], n1);
        if (lane == ld2 && F.wr) b2 = atomicAdd(&cnt[e2], n2);
        const int r1 = __shfl(b1, ld1) + rk1, r2 = __shfl(b2, ld2) + rk2;
        if (lane < 16 && F.wr) { rowtok[(size_t)e1 * NTOK + r1] = tok; rowtok[(size_t)e2 * NTOK + r2] = tok;
            u32x4 a; a.x = (unsigned)e1; a.y = (unsigned)r1; a.z = (unsigned)e2; a.w = (unsigned)r2;
            *(u32x4*)(tinfo + (size_t)tok * 8) = a; *(f32x2*)(tinfo + (size_t)tok * 8 + 4) = (f32x2){w1, w2}; }
        }
    }
}
__device__ __forceinline__ void moe_tables(Frame& F, int l, volatile LAS int*& tileoff, volatile LAS int*& cntl) {
    volatile LAS int* t = (volatile LAS int*)(F.lds + LDS_CTL + 512); cntl = t; tileoff = t + 32;
    __syncthreads();
    if (F.tid < 64) { const int k = F.tid & 31;
        const int cn = __hip_atomic_load(F_CNT(F) + l * 32 + k, __ATOMIC_RELAXED, __HIP_MEMORY_SCOPE_AGENT);
        const int nt_ = (cn + 255) >> 8; int inc = nt_;
#pragma unroll
        for (int d = 1; d < 32; d <<= 1) { const int o = __shfl_up(inc, d); if (k >= d) inc += o; }
        if (F.tid < 32) { t[k] = cn; t[32 + k] = inc - nt_; if (k == 31) t[64] = inc; } }
    __syncthreads();
}
__device__ __forceinline__ void ph_combine(Frame& F, int l, int ntok) {
    volatile LAS int* tileoff; volatile LAS int* cntl; moe_tables(F, l, tileoff, cntl);
    const float* mod = F_MOD(F) + (size_t)l * 9 * 6144; const bool lastl = (l == DEPTH - 1);
    const float* modn = F_MOD(F) + (size_t)(lastl ? l : l + 1) * 9 * 6144; const float* gn = lastl ? FIN(I_FNG) : FIN(I_N1G) + (l + 1) * 1024;
    const bf16* Y = (const bf16*)(F.ws + WS_YROWS); const unsigned* tinfo = (const unsigned*)(F.ws + WS_TOKINFO);
    const int lane = F.lane;
    u32x4 ninf = (u32x4){0u, 0u, 0u, 0u}, n2inf = ninf; f32x2 nwv = (f32x2){0.f, 0.f}, n2wv = nwv; f32x4 nh[4]; u32x2 nya[4], nyb[4];
    const int per = (ntok + F.NGW - 1) / F.NGW; int r = F.gw * per; const int rend = (r + per < ntok) ? r + per : ntok;
#define CMB_HROW(rr) ((rr) < NLAT ? F.out + (size_t)(rr) * 1024 : F_HC(F) + (size_t)((rr) - NLAT) * 1024)
#define CMB_LOAD_ROW(rr) do { const float* hp_ = CMB_HROW(rr); \
        const bf16* y1_ = Y + ((size_t)tileoff[ninf.x] * 256 + ninf.y) * 1024; const bf16* y2_ = Y + ((size_t)tileoff[ninf.z] * 256 + ninf.w) * 1024; \
        _Pragma("unroll") for (int j = 0; j < 4; ++j) { nh[j] = *(const f32x4*)(hp_ + 4 * lane + 256 * j); nya[j] = *(const u32x2*)(y1_ + 4 * lane + 256 * j); nyb[j] = *(const u32x2*)(y2_ + 4 * lane + 256 * j); } } while (0)
    if (r < rend) { ninf = *(const u32x4*)(tinfo + (size_t)r * 8); nwv = *(const f32x2*)(tinfo + (size_t)r * 8 + 4);
        if (r + 1 < rend) { n2inf = *(const u32x4*)(tinfo + (size_t)(r + 1) * 8); n2wv = *(const f32x2*)(tinfo + (size_t)(r + 1) * 8 + 4); }
        CMB_LOAD_ROW(r); }
    int mbc = -1; f32x4 cm5[4], cgs[4], csh[4];
    for (; r < rend; ++r) {
        const f32x2 wv = nwv; f32x4 hv[4]; u32x2 ya[4], yb[4];
#pragma unroll
        for (int j = 0; j < 4; ++j) { hv[j] = nh[j]; ya[j] = nya[j]; yb[j] = nyb[j]; }
        const bool lat = r < NLAT; const int mb = lat ? (r >> 12) : 8; float* hrow = CMB_HROW(r);
        if (r + 1 < rend) { ninf = n2inf; nwv = n2wv; CMB_LOAD_ROW(r + 1); }
        if (r + 2 < rend) { n2inf = *(const u32x4*)(tinfo + (size_t)(r + 2) * 8); n2wv = *(const f32x2*)(tinfo + (size_t)(r + 2) * 8 + 4); }
        if (mb != mbc) { mbc = mb;
#pragma unroll
            for (int j = 0; j < 4; ++j) { const int c = 4 * lane + 256 * j; cm5[j] = *(const f32x4*)(mod + mb * 6144 + 5 * 1024 + c); const f32x4 g = *(const f32x4*)(gn + c);
                if (lastl) { cgs[j] = g; csh[j] = (f32x4){0.f, 0.f, 0.f, 0.f}; }
                else { cgs[j] = g * (*(const f32x4*)(modn + mb * 6144 + 1024 + c) + 1.0f); csh[j] = *(const f32x4*)(modn + mb * 6144 + c); } } }
        f32x4 v[4]; float ss = 0.f;
#pragma unroll
        for (int j = 0; j < 4; ++j) { const u32x2 a = ya[j], b = yb[j];
            f32x4 y; y.x = wv.x * bflo(a.x) + wv.y * bflo(b.x); y.y = wv.x * bfhi(a.x) + wv.y * bfhi(b.x); y.z = wv.x * bflo(a.y) + wv.y * bflo(b.y); y.w = wv.x * bfhi(a.y) + wv.y * bfhi(b.y);
            v[j] = hv[j] + cm5[j] * y; ss += (v[j].x * v[j].x + v[j].y * v[j].y) + (v[j].z * v[j].z + v[j].w * v[j].w); }
        const float rstd = 1.0f / sqrtf(wave_sum(ss) * (1.0f / 1024.0f) + EPS);
        if (lastl) {
#pragma unroll
            for (int j = 0; j < 4; ++j) { const int c = 4 * lane + 256 * j; if (F.wr) *(f32x4*)(hrow + c) = (v[j] * rstd) * cgs[j]; }
        } else {
#pragma unroll
            for (int j = 0; j < 4; ++j) { const int c = 4 * lane + 256 * j; if (F.wr) *(f32x4*)(hrow + c) = v[j];
                const f32x4 y = (v[j] * rstd) * cgs[j] + csh[j]; u32x2 w; w.x = pk2(y.x, y.y); w.y = pk2(y.z, y.w); if (F.wr) *(u32x2*)(F_X(F) + (size_t)r * 1024 + c) = w; }
        }
    }
#undef CMB_LOAD_ROW
#undef CMB_HROW
}
#define MFMA16(a, b, c) __builtin_amdgcn_mfma_f32_16x16x32_bf16((a), (b), (c), 0, 0, 0)
__device__ __forceinline__ bf16x8 ldfrag(const LAS bf16* base, int row0, int k0, int ld, int lane) {
    return *(const LAS bf16x8*)(base + (row0 + (lane & 15)) * ld + k0 + 8 * (lane >> 4));
}
__device__ __forceinline__ float fast_sigmoid(float x) { return __builtin_amdgcn_rcpf(1.0f + __builtin_amdgcn_exp2f(-1.4426950408889634f * x)); }
__device__ __forceinline__ float fast_gelu_tanh(float x) {
    const float u2 = 1.5957691216057308f * (x + 0.044715f * x * x * x);
    return x * __builtin_amdgcn_rcpf(1.0f + __builtin_amdgcn_exp2f(-1.4426950408889634f * u2));
}

__device__ __forceinline__ void att_rope8(const f32x2* tab, const float (&x1)[8], const float (&x2)[8], float (&o1)[8], float (&o2)[8]) {
#pragma unroll
    for (int e = 0; e < 8; ++e) { const f32x2 cs = tab[e]; o1[e] = x1[e] * cs.x - x2[e] * cs.y; o2[e] = x2[e] * cs.x + x1[e] * cs.y; }
}
__device__ __forceinline__ void unpack8(const u32x4 a, float (&x)[8]) { x[0] = bflo(a.x); x[1] = bfhi(a.x); x[2] = bflo(a.y); x[3] = bfhi(a.y); x[4] = bflo(a.z); x[5] = bfhi(a.z); x[6] = bflo(a.w); x[7] = bfhi(a.w); }
__device__ __forceinline__ u32x4 pack8(const float (&x)[8], float s) { u32x4 r; r.x = pk2(x[0] * s, x[1] * s); r.y = pk2(x[2] * s, x[3] * s); r.z = pk2(x[4] * s, x[5] * s); r.w = pk2(x[6] * s, x[7] * s); return r; }

template <int RS> __device__ __forceinline__ void tr_frags4(unsigned addr, bf16x8 (&f)[4]) {
    u32x2 a0, a1, b0, b1, c0, c1, d0, d1;
    asm volatile("ds_read_b64_tr_b16 %0, %8\n\tds_read_b64_tr_b16 %1, %8 offset:%9\n\tds_read_b64_tr_b16 %2, %8 offset:32\n\tds_read_b64_tr_b16 %3, %8 offset:%10\n\t"
                 "ds_read_b64_tr_b16 %4, %8 offset:64\n\tds_read_b64_tr_b16 %5, %8 offset:%11\n\tds_read_b64_tr_b16 %6, %8 offset:96\n\tds_read_b64_tr_b16 %7, %8 offset:%12\n\ts_waitcnt lgkmcnt(0)"
                 : "=&v"(a0), "=&v"(a1), "=&v"(b0), "=&v"(b1), "=&v"(c0), "=&v"(c1), "=&v"(d0), "=&v"(d1)
                 : "v"(addr), "i"(4 * RS), "i"(32 + 4 * RS), "i"(64 + 4 * RS), "i"(96 + 4 * RS) : "memory");
    u32x4 t; t.x = a0.x; t.y = a0.y; t.z = a1.x; t.w = a1.y; f[0] = __builtin_bit_cast(bf16x8, t);
    t.x = b0.x; t.y = b0.y; t.z = b1.x; t.w = b1.y; f[1] = __builtin_bit_cast(bf16x8, t);
    t.x = c0.x; t.y = c0.y; t.z = c1.x; t.w = c1.y; f[2] = __builtin_bit_cast(bf16x8, t);
    t.x = d0.x; t.y = d0.y; t.z = d1.x; t.w = d1.y; f[3] = __builtin_bit_cast(bf16x8, t);
}


__device__ __forceinline__ float xor16_max(float x) { const unsigned xi = __builtin_bit_cast(unsigned, x); const auto r = __builtin_amdgcn_permlane16_swap(xi, xi, false, false); return fmaxf(__builtin_bit_cast(float, (unsigned)r[0]), __builtin_bit_cast(float, (unsigned)r[1])); }
__device__ __forceinline__ float xor32_max(float x) { const unsigned xi = __builtin_bit_cast(unsigned, x); const auto r = __builtin_amdgcn_permlane32_swap(xi, xi, false, false); return fmaxf(__builtin_bit_cast(float, (unsigned)r[0]), __builtin_bit_cast(float, (unsigned)r[1])); }
__device__ __forceinline__ float xor16_sum(float x) { const unsigned xi = __builtin_bit_cast(unsigned, x); const auto r = __builtin_amdgcn_permlane16_swap(xi, xi, false, false); return __builtin_bit_cast(float, (unsigned)r[0]) + __builtin_bit_cast(float, (unsigned)r[1]); }
__device__ __forceinline__ float xor32_sum(float x) { const unsigned xi = __builtin_bit_cast(unsigned, x); const auto r = __builtin_amdgcn_permlane32_swap(xi, xi, false, false); return __builtin_bit_cast(float, (unsigned)r[0]) + __builtin_bit_cast(float, (unsigned)r[1]); }

#ifndef LRU_ABL
#define LRU_ABL 0
#endif
__device__ __forceinline__ void lru_unit(Frame& F, int l, int b, int hd, int half) {
    LAS bf16* ub = (LAS bf16*)F.lds;
    LAS bf16* waT = (LAS bf16*)(F.lds + 36864);
    LAS bf16* wxT = (LAS bf16*)(F.lds + 36864 + 4608);
    LAS f32x2* wcomp = (LAS f32x2*)(F.lds + 92800);
    LAS bf16* ho = (LAS bf16*)(F.lds + 46080 + 3 * 8192 + 256);
    const int tid = F.tid, lane = F.lane, w = F.wave, q = lane >> 4, fr = lane & 15;
    bf16* proj = F_PROJ(F); bf16* X = F_X(F);
    const int chh = hd * 64;
    const int c8 = tid & 7, rg = tid >> 3;
    LAS float* cwl = (LAS float*)(F.lds + 91392 + 128);
    __syncthreads();
    if (tid < 320) { const int j = tid >> 6, c = tid & 63; cwl[tid] = j < 4 ? FIN(I_CONVW)[((size_t)l * 4 + j) * 1024 + chh + c] : FIN(I_CONVB)[l * 1024 + chh + c]; }
    const int orow = tid >> 1, ohh = tid & 1;
#pragma unroll 1
    for (int dir = 0; dir < 2; ++dir) {
        __syncthreads();
        { float wa4[4], wx4[4];
#pragma unroll
          for (int j = 0; j < 4; ++j) { const int i = tid + 512 * j, k = i >> 5, c = i & 31; const size_t gi = ((((size_t)l * 2 + dir) * 16 + hd) * 64 + k) * 64 + half * 32 + c;
              wa4[j] = FIN(I_WA)[gi]; wx4[j] = FIN(I_WX)[gi]; }
#pragma unroll
          for (int j = 0; j < 4; ++j) { const int i = tid + 512 * j, k = i >> 5, c = i & 31; waT[c * 72 + k] = (bf16)f2bf(wa4[j]); wxT[c * 72 + k] = (bf16)f2bf(wx4[j]); } }
        float ba_[2], bx_[2], sp8_[2], carry[2] = {0.f, 0.f};
#pragma unroll
        for (int cb = 0; cb < 2; ++cb) { const int ch = chh + half * 32 + cb * 16 + fr; const size_t gi = ((size_t)l * 2 + dir) * 1024 + ch;
            ba_[cb] = FIN(I_BA)[gi]; bx_[cb] = FIN(I_BX)[gi]; const float lam = FIN(I_LAM)[gi]; sp8_[cb] = -8.0f * 1.4426950408889634f * log1p_fast(__expf(-lam)); }
        __syncthreads();
        const int rgd = dir ? 63 - rg : rg;
        u32x4 axr[7]; u32x4 pf[4];
#define LRU_CHUNK(ci, isctx_, T0_, rowbase_) const bool isctx_ = (ci) == 0; const int T0_ = isctx_ ? 0 : 256 * (dir ? (16 - (ci)) : ((ci) - 1)); const size_t rowbase_ = isctx_ ? (size_t)NLAT + b * LCX : (size_t)b * SEQ
#define LRU_PREFETCH(ci) do { LRU_CHUNK(ci, ic_, t0_, rb_); const int Ls_ = ic_ ? LCX : SEQ; \
            _Pragma("unroll") for (int j = 0; j < 7; ++j) { const int tt = t0_ + 4 * rgd - 2 + j; const int tc_ = (tt >= 0 && tt < Ls_) ? tt : 0; \
                const GAS bf16* p_ = (const GAS bf16*)(proj + (rb_ + tc_) * LDP + C_AX + chh + 8 * c8); \
                asm volatile("global_load_dwordx4 %0, %1, off" : "=v"(axr[j]) : "v"(p_) : "memory"); } } while (0)
#define LRU_AX_WAIT(ci) do { if (dir == 0) asm volatile("s_waitcnt vmcnt(2)" : "+v"(axr[0]), "+v"(axr[1]), "+v"(axr[2]), "+v"(axr[3]), "+v"(axr[4]), "+v"(axr[5]), "+v"(axr[6]) :: "memory"); \
            else asm volatile("s_waitcnt vmcnt(6)" : "+v"(axr[0]), "+v"(axr[1]), "+v"(axr[2]), "+v"(axr[3]), "+v"(axr[4]), "+v"(axr[5]), "+v"(axr[6]) :: "memory"); \
            LRU_CHUNK(ci, ic_, t0_, rb_); (void)rb_; const int Ls_ = ic_ ? LCX : SEQ; \
            _Pragma("unroll") for (int j = 0; j < 7; ++j) { const int tt = t0_ + 4 * rgd - 2 + j; if (!(tt >= 0 && tt < Ls_)) axr[j] = (u32x4){0u, 0u, 0u, 0u}; } } while (0)
#define LRU_PREFETCH_OUT(ci) do { if (dir == 1) { LRU_CHUNK(ci, ic_, t0_, rb_); const size_t orow_g = rb_ + t0_ + (255 - orow); \
                pf[0] = *(const u32x4*)(X + orow_g * 1024 + chh + half * 32 + ohh * 16); pf[1] = *(const u32x4*)(X + orow_g * 1024 + chh + half * 32 + ohh * 16 + 8); \
                pf[2] = *(const u32x4*)(proj + orow_g * LDP + C_AY + chh + half * 32 + ohh * 16); pf[3] = *(const u32x4*)(proj + orow_g * LDP + C_AY + chh + half * 32 + ohh * 16 + 8); } } while (0)
        LRU_PREFETCH(0); LRU_PREFETCH_OUT(0);
        asm volatile("s_waitcnt vmcnt(0)" : "+v"(axr[0]), "+v"(axr[1]), "+v"(axr[2]), "+v"(axr[3]), "+v"(axr[4]), "+v"(axr[5]), "+v"(axr[6]) :: "memory");
#pragma unroll 1
        for (int ci = 0; ci < 17; ++ci) {
            LRU_CHUNK(ci, isctx, T0, rowbase);
            if (ci > 0) { LRU_AX_WAIT(ci); } else {
#pragma unroll
                for (int j = 0; j < 7; ++j) { const int tt = 4 * rgd - 2 + j; if (!(tt >= 0 && tt < LCX)) axr[j] = (u32x4){0u, 0u, 0u, 0u}; } }
            { float u[4][8];
#pragma unroll
              for (int r = 0; r < 4; ++r) { const f32x4 b0 = *(const LAS f32x4*)(cwl + 256 + 8 * c8), b1 = *(const LAS f32x4*)(cwl + 256 + 8 * c8 + 4);
                  u[r][0] = b0.x; u[r][1] = b0.y; u[r][2] = b0.z; u[r][3] = b0.w; u[r][4] = b1.x; u[r][5] = b1.y; u[r][6] = b1.z; u[r][7] = b1.w; }
#pragma unroll
              for (int j = 0; j < 7; ++j) { float x[8]; x[0] = bflo(axr[j].x); x[1] = bfhi(axr[j].x); x[2] = bflo(axr[j].y); x[3] = bfhi(axr[j].y); x[4] = bflo(axr[j].z); x[5] = bfhi(axr[j].z); x[6] = bflo(axr[j].w); x[7] = bfhi(axr[j].w);
#pragma unroll
                  for (int t = 0; t < 4; ++t) { const int r = j - t; if (r >= 0 && r < 4) {
                      const f32x4 w0 = *(const LAS f32x4*)(cwl + 64 * t + 8 * c8), w1 = *(const LAS f32x4*)(cwl + 64 * t + 8 * c8 + 4);
                      u[r][0] += w0.x * x[0]; u[r][1] += w0.y * x[1]; u[r][2] += w0.z * x[2]; u[r][3] += w0.w * x[3]; u[r][4] += w1.x * x[4]; u[r][5] += w1.y * x[5]; u[r][6] += w1.z * x[6]; u[r][7] += w1.w * x[7]; } } }
#pragma unroll
              for (int r = 0; r < 4; ++r) { const int tl = 4 * rgd + r, p = dir ? (255 - tl) : tl;
                  u32x4 o; o.x = pk2(u[r][0], u[r][1]); o.y = pk2(u[r][2], u[r][3]); o.z = pk2(u[r][4], u[r][5]); o.w = pk2(u[r][6], u[r][7]); *(LAS u32x4*)(ub + p * 72 + 8 * c8) = o; } }
            if (ci + 1 < 17) LRU_PREFETCH(ci + 1);
            LDS_WAIT(); asm volatile("" ::: "memory");
            float hl[2][2][4], Ac[2][2][4], sa[2][2], sb[2][2];
            bf16x8 Ba[2][2], Bx[2][2];
#pragma unroll
            for (int cb = 0; cb < 2; ++cb)
#pragma unroll
                for (int ks = 0; ks < 2; ++ks) { Ba[cb][ks] = ldfrag(waT, cb * 16, ks * 32, 72, lane); Bx[cb][ks] = ldfrag(wxT, cb * 16, ks * 32, 72, lane); }
#pragma unroll
            for (int rb = 0; rb < 2; ++rb) { const bf16x8 A0 = ldfrag(ub, 32 * w + 16 * rb, 0, 72, lane), A1 = ldfrag(ub, 32 * w + 16 * rb, 32, 72, lane);
#pragma unroll
                for (int cb = 0; cb < 2; ++cb) {
                    f32x4 ra = (f32x4){0.f, 0.f, 0.f, 0.f}, rx = ra;
                    ra = MFMA16(A0, Ba[cb][0], ra); ra = MFMA16(A1, Ba[cb][1], ra); rx = MFMA16(A0, Bx[cb][0], rx); rx = MFMA16(A1, Bx[cb][1], rx);
                    float hprev = 0.f, aprev = 1.f;
#pragma unroll
                    for (int r = 0; r < 4; ++r) { const int p = 32 * w + 16 * rb + 4 * q + r; const float u = bf2f(ub[p * 72 + half * 32 + cb * 16 + fr]);
                        const float rgt = fast_sigmoid(ra[r] + ba_[cb]), igt = fast_sigmoid(rx[r] + bx_[cb]);
                        const float a = __builtin_amdgcn_exp2f(sp8_[cb] * rgt), bb = __builtin_amdgcn_sqrtf(fmaxf((1.0f - a) * (1.0f + a), 0.f)) * (igt * u);
                        hprev = a * hprev + bb; aprev = a * aprev; hl[rb][cb][r] = hprev; Ac[rb][cb][r] = aprev; }
                    sa[rb][cb] = aprev; sb[rb][cb] = hprev; } }
            float ea[2][2], eb[2][2];
            const int par = ci & 1;
#pragma unroll
            for (int cb = 0; cb < 2; ++cb) { float ia[2], ib[2];
#pragma unroll
                for (int rb = 0; rb < 2; ++rb) { float a = sa[rb][cb], bq = sb[rb][cb];
                    float a1 = __shfl_up(a, 16), b1 = __shfl_up(bq, 16); if (q >= 1) { bq = a * b1 + bq; a = a * a1; }
                    a1 = __shfl_up(a, 32); b1 = __shfl_up(bq, 32); if (q >= 2) { bq = a * b1 + bq; a = a * a1; }
                    ia[rb] = a; ib[rb] = bq;
                    a1 = __shfl_up(a, 16); b1 = __shfl_up(bq, 16); ea[rb][cb] = q ? a1 : 1.0f; eb[rb][cb] = q ? b1 : 0.0f; }
                const float t0a = __shfl(ia[0], 48 + fr), t0b = __shfl(ib[0], 48 + fr);
                eb[1][cb] = ea[1][cb] * t0b + eb[1][cb]; ea[1][cb] = ea[1][cb] * t0a;
                if (q == 3) wcomp[(par * 8 + w) * 32 + cb * 16 + fr] = (f32x2){ia[1] * t0a, ia[1] * t0b + ib[1]}; }
            LDS_BARRIER();
#pragma unroll
            for (int cb = 0; cb < 2; ++cb) { float h = carry[cb], hin = h;
#pragma unroll
                for (int k = 0; k < 8; ++k) { const f32x2 c = wcomp[(par * 8 + k) * 32 + cb * 16 + fr]; h = c.x * h + c.y; hin = (k + 1 == w) ? h : hin; }
                carry[cb] = h;
#pragma unroll
                for (int rb = 0; rb < 2; ++rb) { const float hs = ea[rb][cb] * hin + eb[rb][cb];
#pragma unroll
                    for (int r = 0; r < 4; ++r) { const int p = 32 * w + 16 * rb + 4 * q + r; ho[p * 40 + cb * 16 + fr] = (bf16)f2bf(Ac[rb][cb][r] * hs + hl[rb][cb][r]); } } }
            LDS_WAIT(); asm volatile("" ::: "memory");
            { const int tl = dir ? (255 - orow) : orow; const size_t row = rowbase + T0 + tl;
              const u32x4 h0 = *(const LAS u32x4*)(ho + orow * 40 + ohh * 16), h1 = *(const LAS u32x4*)(ho + orow * 40 + ohh * 16 + 8);
              if (dir == 0) { *(u32x4*)(X + row * 1024 + chh + half * 32 + ohh * 16) = h0; *(u32x4*)(X + row * 1024 + chh + half * 32 + ohh * 16 + 8) = h1; }
              else { u32x4 o0, o1;
#define LRU_Y(hb, hf, ay) pk2((bflo(hf) + bflo(hb)) * fast_gelu_tanh(bflo(ay)), (bfhi(hf) + bfhi(hb)) * fast_gelu_tanh(bfhi(ay)))
                  o0.x = LRU_Y(h0.x, pf[0].x, pf[2].x); o0.y = LRU_Y(h0.y, pf[0].y, pf[2].y); o0.z = LRU_Y(h0.z, pf[0].z, pf[2].z); o0.w = LRU_Y(h0.w, pf[0].w, pf[2].w);
                  o1.x = LRU_Y(h1.x, pf[1].x, pf[3].x); o1.y = LRU_Y(h1.y, pf[1].y, pf[3].y); o1.z = LRU_Y(h1.z, pf[1].z, pf[3].z); o1.w = LRU_Y(h1.w, pf[1].w, pf[3].w);
#undef LRU_Y
                  { bf16* yb_ = F_YB(F) + row * 3072 + chh + half * 32 + ohh * 16; *(u32x4*)yb_ = o0; *(u32x4*)(yb_ + 8) = o1; } } }
            if (ci + 1 < 17) LRU_PREFETCH_OUT(ci + 1);
        }
#undef LRU_AX_WAIT
#undef LRU_PREFETCH_OUT
#undef LRU_PREFETCH
#undef LRU_CHUNK
    }
}
__device__ __forceinline__ size_t ret_rowbase(int b, int cidx) { return cidx < 2 ? (size_t)NLAT + b * LCX + cidx * 128 : (size_t)b * SEQ + (cidx - 2) * 128; }
__device__ __forceinline__ float ret_logg(Frame& F, int l, int dir, int h) { const float lam = FIN(I_RLAM)[(l * 2 + dir) * 8 + h]; return -log1p_fast(__expf(-lam)); }

__device__ __forceinline__ void ret_load_qk(Frame& F, const bf16* src  , bool rope, int pos0, float scale, float (&o1)[8], float (&o2)[8]) {
    const int row = F.tid >> 2, cp = F.tid & 3;
    const u32x4 a = *(const u32x4*)(src + (size_t)row * LDP + 8 * cp), b = *(const u32x4*)(src + (size_t)row * LDP + 32 + 8 * cp);
    float x1[8] = {bflo(a.x), bfhi(a.x), bflo(a.y), bfhi(a.y), bflo(a.z), bfhi(a.z), bflo(a.w), bfhi(a.w)};
    float x2[8] = {bflo(b.x), bfhi(b.x), bflo(b.y), bfhi(b.y), bflo(b.z), bfhi(b.z), bflo(b.w), bfhi(b.w)};
    if (rope) { const f32x2* rt = (const f32x2*)(F.ws + WS_ROPE) + (size_t)(pos0 + row) * 32 + 8 * cp;
#pragma unroll
        for (int e = 0; e < 8; ++e) { const f32x2 cs = rt[e]; o1[e] = (x1[e] * cs.x - x2[e] * cs.y) * scale; o2[e] = (x2[e] * cs.x + x1[e] * cs.y) * scale; }
    } else {
#pragma unroll
        for (int e = 0; e < 8; ++e) { o1[e] = x1[e] * scale; o2[e] = x2[e] * scale; }
    }
}
__device__ __forceinline__ void ph_ret_r1(Frame& F, int l) {
    LAS bf16* Kf = (LAS bf16*)F.lds;
    LAS bf16* Kb = Kf + 128 * 72;
    LAS bf16* Vs = Kb + 128 * 72;
    const int tid = F.tid, lane = F.lane, w = F.wave, q = lane >> 4, fr = lane & 15;
    const bf16* proj = F_PROJ(F);
    const int row = tid >> 2, cp = tid & 3;
    u32x4 ka, kb, vv[4];
#define R1_LOAD(u) do { const int bh__ = (u) / 34, ci__ = (u) % 34; const size_t rb__ = ret_rowbase(bh__ >> 3, ci__); const int h__ = bh__ & 7; \
        const bf16* ks_ = proj + (rb__ + row) * LDP + C_BK + h__ * 64 + 8 * cp; ka = *(const u32x4*)ks_; kb = *(const u32x4*)(ks_ + 32); \
        _Pragma("unroll") for (int i = 0; i < 4; ++i) { const int t_ = tid + 512 * i; vv[i] = *(const u32x4*)(proj + (rb__ + (t_ >> 4)) * LDP + C_BV + h__ * 128 + 8 * (t_ & 15)); } } while (0)
    int u = F.bid;
    if (u < 64 * 34) R1_LOAD(u);
    const int dir = w >> 2, e0 = 32 * (w & 3);
    const unsigned vlane = (unsigned)(size_t)Vs + (unsigned)((8 * q + (fr >> 2)) * 272 + (fr & 3) * 8 + e0 * 2);
    const unsigned klane = (unsigned)(size_t)(dir ? Kb : Kf) + (unsigned)((8 * q + (fr >> 2)) * 144 + (fr & 3) * 8);
#pragma unroll 1
    for (; u < 64 * 34; u += F.G) {
        const int bh = u / 34, cidx = u % 34, b = bh >> 3, h = bh & 7; const bool lat = cidx >= 2;
        const float lg0 = ret_logg(F, l, 0, h), lg1 = ret_logg(F, l, 1, h);
        LDS_BARRIER();
        { float x1[8], x2[8], o1[8], o2[8]; unpack8(ka, x1); unpack8(kb, x2);
          if (lat) { const f32x2* rt = (const f32x2*)(F.ws + WS_ROPE) + (size_t)((cidx - 2) * 128 + row) * 32 + 8 * cp;
#pragma unroll
              for (int e = 0; e < 8; ++e) { const f32x2 cs = rt[e]; o1[e] = (x1[e] * cs.x - x2[e] * cs.y) * 0.125f; o2[e] = (x2[e] * cs.x + x1[e] * cs.y) * 0.125f; } }
          else {
#pragma unroll
              for (int e = 0; e < 8; ++e) { o1[e] = x1[e] * 0.125f; o2[e] = x2[e] * 0.125f; } }
          const float df = __expf(lg0 * (float)(127 - row)), db = __expf(lg1 * (float)row);
          *(LAS u32x4*)(Kf + row * 72 + 8 * cp) = pack8(o1, df); *(LAS u32x4*)(Kf + row * 72 + 32 + 8 * cp) = pack8(o2, df);
          *(LAS u32x4*)(Kb + row * 72 + 8 * cp) = pack8(o1, db); *(LAS u32x4*)(Kb + row * 72 + 32 + 8 * cp) = pack8(o2, db); }
#pragma unroll
        for (int i = 0; i < 4; ++i) { const int t = tid + 512 * i; *(LAS u32x4*)(Vs + (t >> 4) * 136 + 8 * (t & 15)) = vv[i]; }
        LDS_BARRIER();
        if (u + F.G < 64 * 34) R1_LOAD(u + F.G);
        f32x4 acc[2][4];
#pragma unroll
        for (int eb = 0; eb < 2; ++eb)
#pragma unroll
            for (int db = 0; db < 4; ++db) acc[eb][db] = (f32x4){0.f, 0.f, 0.f, 0.f};
#pragma unroll
        for (int ks = 0; ks < 4; ++ks) { bf16x8 av[4], bk[4];
            tr_frags4<272>(vlane + ks * 32 * 272, av);
            tr_frags4<144>(klane + ks * 32 * 144, bk);
#pragma unroll
            for (int eb = 0; eb < 2; ++eb)
#pragma unroll
                for (int db = 0; db < 4; ++db) acc[eb][db] = MFMA16(bk[db], av[eb], acc[eb][db]); }
        bf16* kv = (bf16*)(F.ws + WS_KV) + ((((size_t)(b * 8 + h) * 34 + cidx) * 2) + dir) * 8192;
#pragma unroll
        for (int eb = 0; eb < 2; ++eb)
#pragma unroll
            for (int db = 0; db < 4; ++db) { u32x2 o; o.x = pk2(acc[eb][db][0], acc[eb][db][1]); o.y = pk2(acc[eb][db][2], acc[eb][db][3]);
                *(u32x2*)(kv + (e0 + 16 * eb + fr) * 64 + 16 * db + 4 * q) = o; }
    }
#undef R1_LOAD
}
__device__ __forceinline__ void ret_scan(Frame& F, int l) {
    unsigned* kvw = (unsigned*)(F.ws + WS_KV);
    const int N = 64 * 2 * 4096, stride = F.G * 512;
#define RS_BASE(i_) (kvw + ((size_t)((i_) >> 13) * 34 * 2 + (((i_) >> 12) & 1)) * 4096 + ((i_) & 4095))
    int i = F.bid * 512 + F.tid;
    unsigned vn[34];
    if (i < N) { const unsigned* bn = RS_BASE(i);
#pragma unroll
        for (int k = 0; k < 34; ++k) vn[k] = bn[(size_t)k * 8192]; }
    for (; i < N; i += stride) { const int dir = (i >> 12) & 1, h = (i >> 13) & 7;
        const float gC = __expf(ret_logg(F, l, dir, h) * 128.0f);
        unsigned* base = RS_BASE(i);
        unsigned v[34];
#pragma unroll
        for (int k = 0; k < 34; ++k) v[k] = vn[k];
        if (i + stride < N) { const unsigned* bn = RS_BASE(i + stride);
#pragma unroll
            for (int k = 0; k < 34; ++k) vn[k] = bn[(size_t)k * 8192]; }
        float s0 = 0.f, s1 = 0.f;
        if (dir == 0) {
#pragma unroll
            for (int k = 0; k < 34; ++k) { const unsigned x = v[k]; v[k] = pk2(s0, s1); s0 = gC * s0 + bflo(x); s1 = gC * s1 + bfhi(x); }
        } else {
#pragma unroll
            for (int k = 0; k < 34; ++k) { const int c = k < 2 ? 1 - k : 35 - k; const unsigned x = v[c]; v[c] = pk2(s0, s1); s0 = gC * s0 + bflo(x); s1 = gC * s1 + bfhi(x); }
        }
        if (F.wr) {
#pragma unroll
            for (int k = 0; k < 34; ++k) base[(size_t)k * 8192] = v[k]; }
    }
#undef RS_BASE
}
__device__ __forceinline__ void ph_ret_r2(Frame& F, int l, bool lastl) {
    LAS bf16* Qs = (LAS bf16*)F.lds;
    LAS bf16* Ks = Qs + 128 * 72;
    LAS bf16* Vs = Ks + 128 * 72;
    LAS bf16* Ps = Vs + 128 * 136 + F.wave * (16 * 136);
    LAS bf16* Ss = Vs + 128 * 136 + 8 * (16 * 136);
    const int tid = F.tid, lane = F.lane, w = F.wave, q = lane >> 4, fr = lane & 15;
    const bf16* proj = F_PROJ(F);
    const int nch = lastl ? 32 : 34, nunits = 64 * nch;
    const int row = tid >> 2, cp = tid & 3;
    u32x4 qa, qb_, ka, kb, vv[4], sv[4];
#define R2_DECODE(u, bh_, cidx_) const int bh_ = (u) / nch, cidx_ = (u) % nch + (lastl ? 2 : 0)
#define R2_LOAD(u) do { R2_DECODE(u, bh__, ci__); const size_t rb__ = ret_rowbase(bh__ >> 3, ci__); const int h__ = bh__ & 7; \
        const bf16* qs_ = proj + (rb__ + row) * LDP + C_BQ + h__ * 64 + 8 * cp; qa = *(const u32x4*)qs_; qb_ = *(const u32x4*)(qs_ + 32); \
        const bf16* ks_ = proj + (rb__ + row) * LDP + C_BK + h__ * 64 + 8 * cp; ka = *(const u32x4*)ks_; kb = *(const u32x4*)(ks_ + 32); \
        _Pragma("unroll") for (int i = 0; i < 4; ++i) { const int t_ = tid + 512 * i; vv[i] = *(const u32x4*)(proj + (rb__ + (t_ >> 4)) * LDP + C_BV + h__ * 128 + 8 * (t_ & 15)); \
            sv[i] = *(const u32x4*)((const bf16*)(F.ws + WS_KV) + (((size_t)bh__ * 34 + ci__) * 2) * 8192 + (size_t)t_ * 8); } } while (0)
    int u = F.bid;
    if (u < nunits) R2_LOAD(u);
    const unsigned vlane = (unsigned)(size_t)Vs + (unsigned)((8 * q + (fr >> 2)) * 272 + (fr & 3) * 8);
#pragma unroll 1
    for (; u < nunits; u += F.G) {
        R2_DECODE(u, bh, cidx); const int b = bh >> 3, h = bh & 7; const size_t rb = ret_rowbase(b, cidx); const bool lat = cidx >= 2;
        const float lg0 = ret_logg(F, l, 0, h), lg1 = ret_logg(F, l, 1, h);
        LDS_BARRIER();
        { float x1[8], x2[8], o1[8], o2[8];
          unpack8(qa, x1); unpack8(qb_, x2);
          if (lat) { const f32x2* rt = (const f32x2*)(F.ws + WS_ROPE) + (size_t)((cidx - 2) * 128 + row) * 32 + 8 * cp;
#pragma unroll
              for (int e = 0; e < 8; ++e) { const f32x2 cs = rt[e]; o1[e] = x1[e] * cs.x - x2[e] * cs.y; o2[e] = x2[e] * cs.x + x1[e] * cs.y; } }
          else {
#pragma unroll
              for (int e = 0; e < 8; ++e) { o1[e] = x1[e]; o2[e] = x2[e]; } }
          *(LAS u32x4*)(Qs + row * 72 + 8 * cp) = pack8(o1, 1.0f); *(LAS u32x4*)(Qs + row * 72 + 32 + 8 * cp) = pack8(o2, 1.0f);
          unpack8(ka, x1); unpack8(kb, x2);
          if (lat) { const f32x2* rt = (const f32x2*)(F.ws + WS_ROPE) + (size_t)((cidx - 2) * 128 + row) * 32 + 8 * cp;
#pragma unroll
              for (int e = 0; e < 8; ++e) { const f32x2 cs = rt[e]; o1[e] = x1[e] * cs.x - x2[e] * cs.y; o2[e] = x2[e] * cs.x + x1[e] * cs.y; } }
          else {
#pragma unroll
              for (int e = 0; e < 8; ++e) { o1[e] = x1[e]; o2[e] = x2[e]; } }
          *(LAS u32x4*)(Ks + row * 72 + 8 * cp) = pack8(o1, 0.125f); *(LAS u32x4*)(Ks + row * 72 + 32 + 8 * cp) = pack8(o2, 0.125f); }
#pragma unroll
        for (int i = 0; i < 4; ++i) { const int t = tid + 512 * i; *(LAS u32x4*)(Vs + (t >> 4) * 136 + 8 * (t & 15)) = vv[i]; *(LAS u32x4*)(Ss + (t >> 3) * 72 + 8 * (t & 7)) = sv[i]; }
        LDS_BARRIER();
        if (u + F.G < nunits) R2_LOAD(u + F.G);
        const int il = 16 * w + fr;
        const bf16x8 Bq0 = ldfrag(Qs, 16 * w, 0, 72, lane), Bq1 = ldfrag(Qs, 16 * w, 32, 72, lane);
        const float l2g0 = lg0 * 1.4426950408889634f, l2g1 = lg1 * 1.4426950408889634f;
#pragma unroll
        for (int jb = 0; jb < 8; ++jb) { f32x4 acc = (f32x4){0.f, 0.f, 0.f, 0.f};
            acc = MFMA16(ldfrag(Ks, 16 * jb, 0, 72, lane), Bq0, acc); acc = MFMA16(ldfrag(Ks, 16 * jb, 32, 72, lane), Bq1, acc);
            float pv[4];
#pragma unroll
            for (int r = 0; r < 4; ++r) { const int j = 16 * jb + 4 * q + r; const int dd = il - j;
                const float df = dd >= 0 ? __builtin_amdgcn_exp2f(l2g0 * (float)dd) : 0.f, dbk = dd <= 0 ? __builtin_amdgcn_exp2f(l2g1 * (float)(-dd)) : 0.f;
                pv[r] = acc[r] * (df + dbk); }
            u32x2 pw; pw.x = pg8::cvt_pk_bf16(pv[0], pv[1]); pw.y = pg8::cvt_pk_bf16(pv[2], pv[3]); *(LAS u32x2*)(Ps + fr * 136 + 16 * jb + 4 * q) = pw; }
        LDS_WAIT(); asm volatile("" ::: "memory");
        const bf16* gp = proj + (rb + il) * LDP + C_BG + h * 128 + 4 * q;
        u32x2 gwv[4];
#pragma unroll
        for (int eb = 0; eb < 4; ++eb) gwv[eb] = *(const u32x2*)(gp + 16 * eb);
        f32x4 Y[8];
#pragma unroll
        for (int eb = 0; eb < 8; ++eb) Y[eb] = (f32x4){0.f, 0.f, 0.f, 0.f};
#pragma unroll
        for (int ks = 0; ks < 4; ++ks) { const bf16x8 bp = ldfrag(Ps, 0, 32 * ks, 136, lane); bf16x8 av[4];
            tr_frags4<272>(vlane + ks * 32 * 272, av);
#pragma unroll
            for (int eb = 0; eb < 4; ++eb) Y[eb] = MFMA16(av[eb], bp, Y[eb]);
            tr_frags4<272>(vlane + ks * 32 * 272 + 128, av);
#pragma unroll
            for (int eb = 0; eb < 4; ++eb) Y[4 + eb] = MFMA16(av[eb], bp, Y[4 + eb]); }
        const float qf = __builtin_amdgcn_exp2f(l2g0 * (float)(il + 1)), qbw = __builtin_amdgcn_exp2f(l2g1 * (float)(128 - il));
#pragma unroll
        for (int eb = 0; eb < 8; ++eb) { f32x4 zf = (f32x4){0.f, 0.f, 0.f, 0.f}, zb = zf;
            zf = MFMA16(ldfrag(Ss, 16 * eb, 0, 72, lane), Bq0, zf); zf = MFMA16(ldfrag(Ss, 16 * eb, 32, 72, lane), Bq1, zf);
            zb = MFMA16(ldfrag(Ss, 128 + 16 * eb, 0, 72, lane), Bq0, zb); zb = MFMA16(ldfrag(Ss, 128 + 16 * eb, 32, 72, lane), Bq1, zb);
            Y[eb] = Y[eb] + zf * qf + zb * qbw; }
        float s = 0.f;
#pragma unroll
        for (int eb = 0; eb < 8; ++eb) s += (Y[eb][0] + Y[eb][1]) + (Y[eb][2] + Y[eb][3]);
        s += __shfl_xor(s, 16); s += __shfl_xor(s, 32);
        const float mu = s * (1.0f / 128.0f); float vq = 0.f;
#pragma unroll
        for (int eb = 0; eb < 8; ++eb) { const f32x4 d = Y[eb] - mu; vq += (d[0] * d[0] + d[1] * d[1]) + (d[2] * d[2] + d[3] * d[3]); }
        vq += __shfl_xor(vq, 16); vq += __shfl_xor(vq, 32);
        const float rstd = __builtin_amdgcn_rsqf(vq * (1.0f / 128.0f) + EPS);
        bf16* yo = F_YB(F) + (rb + il) * 3072 + 1024 + h * 128 + 4 * q;
        u32x2 gw2[4];
#pragma unroll
        for (int eb = 0; eb < 4; ++eb) gw2[eb] = *(const u32x2*)(gp + 16 * (4 + eb));
#pragma unroll
        for (int eb = 0; eb < 8; ++eb) { const u32x2 gw = eb < 4 ? gwv[eb & 3] : gw2[eb & 3]; const f32x4 yn = (Y[eb] - mu) * rstd;
            u32x2 o; o.x = pg8::cvt_pk_bf16(gm::fsilu_(bflo(gw.x)) * yn[0], gm::fsilu_(bfhi(gw.x)) * yn[1]); o.y = pg8::cvt_pk_bf16(gm::fsilu_(bflo(gw.y)) * yn[2], gm::fsilu_(bfhi(gw.y)) * yn[3]);
            if (F.wr) *(u32x2*)(yo + 16 * eb) = o; }
    }
#undef R2_LOAD
#undef R2_DECODE
}
__device__ __forceinline__ void att_rope_keys(Frame& F) {
    bf16* proj = F_PROJ(F); const f32x2* atab = (const f32x2*)(F.ws + WS_ROPE + 1 * MiB);
    const int stride = F.G * 512;
    for (int i0 = F.bid * 512 + F.tid; i0 < NLAT * 16; i0 += 4 * stride) {
        u32x4 xa[4], xb[4];
#pragma unroll
        for (int k = 0; k < 4; ++k) { const int i = i0 + k * stride; if (i < NLAT * 16) { const int pr = i & 3, g = (i >> 2) & 3, row = i >> 4; const int c = (pr & 1) + 4 * (pr >> 1);
            const bf16* src = proj + (size_t)row * LDP + C_CK + g * 64 + 8 * c; xa[k] = *(const u32x4*)src; xb[k] = *(const u32x4*)(src + 16); } }
#pragma unroll
        for (int k = 0; k < 4; ++k) { const int i = i0 + k * stride; if (i < NLAT * 16) { const int pr = i & 3, g = (i >> 2) & 3, row = i >> 4; const int c = (pr & 1) + 4 * (pr >> 1);
            bf16* src = proj + (size_t)row * LDP + C_CK + g * 64 + 8 * c;
            float x1[8], x2[8], o1[8], o2[8]; unpack8(xa[k], x1); unpack8(xb[k], x2);
            const int pos = row & (SEQ - 1); const int ap = (pr >> 1) ? (pos & 63) : (pos >> 6); att_rope8(atab + ap * 16 + 8 * (pr & 1), x1, x2, o1, o2);
            if (F.wr) { *(u32x4*)src = pack8(o1, 1.0f); *(u32x4*)(src + 16) = pack8(o2, 1.0f); } } }
    }
}
__device__ __forceinline__ void att_unit(Frame& F, int l, int b, int g, int qb, bool isctxq) {
    LAS bf16* Kt = (LAS bf16*)F.lds;
    LAS bf16* Vt = Kt + 64 * 72;
    LAS bf16* Pw = Vt + 64 * 72 + F.wave * (64 * 72);
    const int tid = F.tid, lane = F.lane, w = F.wave, q = lane >> 4, fr = lane & 15;
    const bf16* proj = F_PROJ(F); const f32x2* atab = (const f32x2*)(F.ws + WS_ROPE + 1 * MiB);
    const int hq = 4 * g + (w >> 1);
    const size_t qrow0 = (isctxq ? (size_t)NLAT + b * LCX : (size_t)b * SEQ) + qb * 128 + (w & 1) * 64;
    const int qpos0 = qb * 128 + (w & 1) * 64;
    constexpr float QS = 0.125f * 1.4426950408889634f;
    unsigned vmask = 0xFu;
    if (!isctxq) {
#pragma unroll
        for (int t = 4; t < 10; ++t) { const int kp = qb * 128 - 128 + 64 * (t - 4); if (kp >= 0 && kp < SEQ) vmask |= 1u << t; } }
    const int vrow = tid >> 3, vc8 = tid & 7;
    u32x4 kx = (u32x4){0u, 0u, 0u, 0u}, vx = kx;
#define ATT_KROW0(t) ((t) >= 4 ? (size_t)b * SEQ + (qb * 128 - 128 + 64 * ((t) - 4)) : (size_t)NLAT + b * LCX + 64 * (t))
#define ATT_LOAD(t) do { const size_t kr0_ = ATT_KROW0(t); kx = *(const u32x4*)(proj + (kr0_ + vrow) * LDP + C_CK + g * 64 + 8 * vc8); \
        vx = *(const u32x4*)(proj + (kr0_ + vrow) * LDP + C_CV + g * 64 + 8 * vc8); } while (0)
    int t = __builtin_ctz(vmask); vmask &= vmask - 1;
    ATT_LOAD(t);
    LDS_BARRIER();
#pragma unroll
    for (int i = 0; i < 4; ++i) { const int tt = lane + 64 * i, row = tt >> 2, pr = tt & 3;
        const int c = (pr & 1) + 4 * (pr >> 1); const bf16* src = proj + (qrow0 + row) * LDP + C_CQ + hq * 64;
        float x1[8], x2[8], o1[8], o2[8]; unpack8(*(const u32x4*)(src + 8 * c), x1); unpack8(*(const u32x4*)(src + 8 * c + 16), x2);
        if (!isctxq) { const int pos = qpos0 + row; const int ap = (pr >> 1) ? (pos & 63) : (pos >> 6); att_rope8(atab + ap * 16 + 8 * (pr & 1), x1, x2, o1, o2); }
        else {
#pragma unroll
            for (int e = 0; e < 8; ++e) { o1[e] = x1[e]; o2[e] = x2[e]; } }
        *(LAS u32x4*)(Pw + row * 72 + 8 * c) = pack8(o1, QS); *(LAS u32x4*)(Pw + row * 72 + 8 * c + 16) = pack8(o2, QS); }
    LDS_WAIT(); asm volatile("" ::: "memory");
    bf16x8 Bq[4][2];
#pragma unroll
    for (int ib = 0; ib < 4; ++ib)
#pragma unroll
        for (int ks = 0; ks < 2; ++ks) Bq[ib][ks] = ldfrag(Pw, 16 * ib, 32 * ks, 72, lane);
    LDS_WAIT(); asm volatile("" ::: "memory");
    const float sink = FIN(I_SINK)[l * 16 + hq] * 1.4426950408889634f;
    float mrow[4], lrow[4], aprev[4]; f32x4 O[4][4];
#pragma unroll
    for (int ib = 0; ib < 4; ++ib) { mrow[ib] = sink; aprev[ib] = 1.0f; lrow[ib] = (q == 0) ? 1.0f : 0.0f;
#pragma unroll
        for (int db = 0; db < 4; ++db) O[db][ib] = (f32x4){0.f, 0.f, 0.f, 0.f}; }
    const unsigned vt_lane = (unsigned)(size_t)Vt + (unsigned)((8 * q + (fr >> 2)) * 144 + (fr & 3) * 8);
#pragma unroll 1
    for (;;) {
        const int kpos0 = t >= 4 ? (qb * 128 - 128 + 64 * (t - 4)) : 0;
        LDS_BARRIER();
        *(LAS u32x4*)(Kt + vrow * 72 + 8 * vc8) = kx;
        *(LAS u32x4*)(Vt + vrow * 72 + 8 * vc8) = vx;
        LDS_BARRIER();
        const int tcur = t; const bool more = vmask != 0u;
        if (more) { t = __builtin_ctz(vmask); vmask &= vmask - 1; ATT_LOAD(t); }
        const bool skipt = !isctxq && tcur == ((w & 1) ? 4 : 9);
        const bool maskt = !isctxq && (tcur == ((w & 1) ? 5 : 4) || tcur == ((w & 1) ? 9 : 8));
        if (!skipt) {
#pragma unroll
        for (int hf = 0; hf < 2; ++hf) {
            f32x4 S[4][2];
#pragma unroll
            for (int jb = 0; jb < 4; ++jb) { const bf16x8 a0 = ldfrag(Kt, 16 * jb, 0, 72, lane), a1 = ldfrag(Kt, 16 * jb, 32, 72, lane);
#pragma unroll
                for (int i2 = 0; i2 < 2; ++i2) { const float nm = -mrow[2 * hf + i2]; f32x4 acc = (f32x4){nm, nm, nm, nm};
                    acc = MFMA16(a0, Bq[2 * hf + i2][0], acc); acc = MFMA16(a1, Bq[2 * hf + i2][1], acc); S[jb][i2] = acc; } }
            if (maskt) {
#pragma unroll
                for (int jb = 0; jb < 4; ++jb)
#pragma unroll
                    for (int i2 = 0; i2 < 2; ++i2)
#pragma unroll
                        for (int r = 0; r < 4; ++r) { const int dd = (qpos0 + 16 * (2 * hf + i2) + fr) - (kpos0 + 16 * jb + 4 * q + r); if (dd > 128 || dd < -128) S[jb][i2][r] = -1.0e30f; }
            }
#pragma unroll
            for (int i2 = 0; i2 < 2; ++i2) { const int ib = 2 * hf + i2;
                float mx = -1.0e30f;
#pragma unroll
                for (int jb = 0; jb < 4; ++jb) mx = fmaxf(mx, fmaxf(fmaxf(S[jb][i2][0], S[jb][i2][1]), fmaxf(S[jb][i2][2], S[jb][i2][3])));
                mx = fmaxf(mx, __shfl_xor(mx, 16)); mx = fmaxf(mx, __shfl_xor(mx, 32));
                const float alpha = aprev[ib]; const float dm = fmaxf(mx, 0.f); aprev[ib] = __builtin_amdgcn_exp2f(-dm); mrow[ib] += dm;
                float ps = 0.f;
#pragma unroll
                for (int jb = 0; jb < 4; ++jb) { float p[4];
#pragma unroll
                    for (int r = 0; r < 4; ++r) { p[r] = __builtin_amdgcn_exp2f(S[jb][i2][r]); ps += p[r]; }
                    u32x2 pw; pw.x = pk2(p[0], p[1]); pw.y = pk2(p[2], p[3]); *(LAS u32x2*)(Pw + (16 * ib + fr) * 72 + 16 * jb + 4 * q) = pw; }
                lrow[ib] = lrow[ib] * alpha + ps;
#pragma unroll
                for (int db = 0; db < 4; ++db) O[db][ib] = O[db][ib] * alpha;
            }
        }
        LDS_WAIT(); asm volatile("" ::: "memory");
#pragma unroll
        for (int ks = 0; ks < 2; ++ks) { bf16x8 av[4], bp[4];
            tr_frags4<144>(vt_lane + ks * 32 * 144, av); __builtin_amdgcn_sched_barrier(0);
#pragma unroll
            for (int ib = 0; ib < 4; ++ib) bp[ib] = ldfrag(Pw, 16 * ib, 32 * ks, 72, lane);
#pragma unroll
            for (int db = 0; db < 4; ++db)
#pragma unroll
                for (int ib = 0; ib < 4; ++ib) O[db][ib] = MFMA16(av[db], bp[ib], O[db][ib]); }
        LDS_WAIT(); asm volatile("" ::: "memory");
        }
        if (!more) break;
    }
#undef ATT_LOAD
#undef ATT_KROW0
#pragma unroll
    for (int ib = 0; ib < 4; ++ib) { float lt = lrow[ib]; lt += __shfl_xor(lt, 16); lt += __shfl_xor(lt, 32); const float inv = __builtin_amdgcn_rcpf(lt);
        bf16* dst = F_YB(F) + (qrow0 + 16 * ib + fr) * 3072 + 2048 + hq * 64 + 4 * q;
#pragma unroll
        for (int db = 0; db < 4; ++db) { const f32x4 o = O[db][ib] * inv; u32x2 ow; ow.x = pg8::cvt_pk_bf16(o[0], o[1]); ow.y = pg8::cvt_pk_bf16(o[2], o[3]); if (F.wr) *(u32x2*)(dst + 16 * db) = ow; } }
}
#ifndef PROBE_MASK
#define PROBE_MASK 0
#endif
#ifndef PROBE_SUB
#define PROBE_SUB 0
#endif
#ifdef PROBE_REAL
#define WR_DRY wr_true
#else
#define WR_DRY wr_false
#endif
#define NREP(n) (((PROBE_MASK >> (n)) & 1) ? 2 : 1)
#ifndef DIAG_PH
#define PHON(n) true
#else
#define PHON(n) ((n) == DIAG_PH)
#endif
constexpr int N_PHASES = 2 + 10 * DEPTH;
__global__ void __launch_bounds__(512, 2) fwd_kernel(Args args) {
    extern __shared__ __attribute__((aligned(16))) unsigned char lds_raw[];
    Frame F; F.lds = (LAS unsigned char*)lds_raw; F.tid = threadIdx.x; F.lane = F.tid & 63; F.wave = __builtin_amdgcn_readfirstlane(F.tid >> 6);
    F.G = gridDim.x; F.bid = blockIdx.x; F.gw = F.bid * 8 + F.wave; F.NGW = F.G * 8; F.in = (const __attribute__((address_space(4))) cfp_t*)__builtin_amdgcn_kernarg_segment_ptr(); F.out = args.out; F.ws = args.ws;
    volatile LAS unsigned* MISC = (volatile LAS unsigned*)(F.lds + MISC_OFF);
    for (int u = F.tid; u < (LDS_BYTES - LDS_CTL) / 4; u += 512) ((LAS unsigned*)(F.lds + LDS_CTL))[u] = 0u;
    __syncthreads();
    unsigned* ctl = (unsigned*)(F.ws + WS_CTL);
#if MK_N_LAUNCHES == 1
    XcdBarrier bar = xcd_barrier_post(ctl + CW_BAR, MISC + 8, gridDim.x);
    XcdBarrier sbar = xcd_barrier_post(ctl + (blockIdx.x < 32 ? CW_BAR_C : CW_BAR_L), MISC + 12, blockIdx.x < 32 ? 32u : gridDim.x - 32u);
#define SUB_BAR() do { GAS unsigned* _bp = (GAS unsigned*)sbar.bar; asm volatile("" : "+s"(_bp)); XcdBarrier _b2 = sbar; _b2.bar = (unsigned*)_bp; xcd_barrier(_b2); } while (0)
#define GRID_BAR() do { GAS unsigned* _bp = (GAS unsigned*)bar.bar; asm volatile("" : "+s"(_bp)); XcdBarrier _b2 = bar; _b2.bar = (unsigned*)_bp; xcd_barrier(_b2); } while (0)
#else
#define GRID_BAR() do {} while (0)
#define SUB_BAR() do {} while (0)
#endif
    const int wave0 = F.wave; const bool wr_true = args.ph_hi > 0, wr_false = args.ph_hi < 0; F.wr = wr_true;
    const int lo = args.ph_lo, hi = args.ph_hi;
#define FRESH() do { LAS unsigned char* _l = (LAS unsigned char*)lds_raw; asm volatile("" : "+s"(_l)); F.lds = _l; int _ln; asm volatile("v_mbcnt_lo_u32_b32 %0, -1, 0\n\tv_mbcnt_hi_u32_b32 %0, -1, %0" : "=v"(_ln)); F.tid = wave0 * 64 + _ln; F.lane = _ln; F.wave = wave0; F.gw = F.bid * 8 + F.wave; \
        GAS unsigned char* _ws = (GAS unsigned char*)args.ws; asm volatile("" : "+s"(_ws)); F.ws = (unsigned char*)_ws; GAS float* _out = (GAS float*)args.out; asm volatile("" : "+s"(_out)); F.out = (float*)_out; \
        const __attribute__((address_space(4))) cfp_t* _in = (const __attribute__((address_space(4))) cfp_t*)__builtin_amdgcn_kernarg_segment_ptr(); asm volatile("" : "+s"(_in)); F.in = _in; } while (0)
#define IN(k) (lo <= (k) && (k) < hi)
#define SEAM(k) do { if (IN(k) && IN((k) + 1)) GRID_BAR(); } while (0)
    if (PHON(0) && IN(0)) for (int rep_ = NREP(0); rep_ > 0; --rep_) { FRESH(); F.wr = (rep_ == 1) ? wr_true : WR_DRY; if (NREP(0) > 1) GRID_BAR(); ph_prologue(F); } SEAM(0);
    if (PHON(1) && IN(1)) for (int rep_ = NREP(1); rep_ > 0; --rep_) { FRESH(); F.wr = (rep_ == 1) ? wr_true : WR_DRY; if (NREP(1) > 1) GRID_BAR(); ph_convert(F, 0); ph_rows_u(F, 0, true); ph_router_fold(F); } SEAM(1);
#pragma unroll 1
    for (int l = 0; l < DEPTH; ++l) {
        const int pb = 2 + 10 * l; const bool lastl = (l == DEPTH - 1); const int nM2 = lastl ? 128 : 136; const int ntok = lastl ? NLAT : NTOK;
        unsigned char* wt = F.ws + WS_WT;
        if (PHON(2) && IN(pb + 0)) for (int rep_ = NREP(2); rep_ > 0; --rep_) { FRESH(); F.wr = (rep_ == 1) ? wr_true : WR_DRY; if (NREP(2) > 1) GRID_BAR();
            gm::SchedPlain<16, 1024> S; S.init(136, 38, F.G, F.bid); S.A = (const char*)(F.ws + WS_X); S.Bt = (const char*)(wt + WT_IN);
            gm::EpiProj E{F_PROJ(F), F.ws + WS_GT}; pg8::gemm_phase(F.lds, S, E, F.tid);
        } SEAM(pb + 0);
        if (PHON(3) && IN(pb + 1)) for (int rep_ = NREP(3); rep_ > 0; --rep_) { FRESH(); F.wr = (rep_ == 1) ? wr_true : WR_DRY; if (NREP(3) > 1) GRID_BAR();
            if (!(rep_ > 1 && PROBE_SUB == 2)) for (int u = F.bid; u < 256; u += F.G) { const int hu = ((u >> 4) << 3) + (u & 7); lru_unit(F, l, hu >> 4, hu & 15, (u >> 3) & 1); }
            if (!(rep_ > 1 && PROBE_SUB == 1)) { __syncthreads(); ph_ret_r1(F, l); __syncthreads(); }
            att_rope_keys(F);
        } SEAM(pb + 1);
        if (PHON(4) && IN(pb + 2)) for (int rep_ = NREP(4); rep_ > 0; --rep_) { FRESH(); F.wr = (rep_ == 1) ? wr_true : WR_DRY; if (NREP(4) > 1) GRID_BAR();
            if (!(rep_ > 1 && PROBE_SUB == 2)) ret_scan(F, l);
            if (!(rep_ > 1 && PROBE_SUB == 1))
            for (int u = F.bid; u < (lastl ? 1024 : 1088); u += F.G) { const bool cq = u >= 1024; const int v = u - 1024;
                int ab = cq ? (v >> 3) : (u >> 7), ag = cq ? ((v >> 1) & 3) : ((u >> 5) & 3), aq = cq ? (v & 1) : (u & 31);
                if (F.G == 256) { const int x = F.bid & 7, y = F.bid >> 3;
                    ab = x; ag = cq ? (y >> 1) : (u >> 8); aq = cq ? (y & 1) : y; }
                att_unit(F, l, ab, ag, aq, cq); }
        } SEAM(pb + 2);
        if (PHON(5) && IN(pb + 3)) for (int rep_ = NREP(5); rep_ > 0; --rep_) { FRESH(); F.wr = (rep_ == 1) ? wr_true : WR_DRY; if (NREP(5) > 1) GRID_BAR();
            ph_ret_r2(F, l, lastl);
        } SEAM(pb + 3);
#ifdef PROBE_MERGE_K
        if (IN(pb + 4)) { FRESH(); GRID_BAR();
            gm::SchedPlain<PROBE_MERGE_K, 3072> S; S.init(nM2, 4, F.G, F.bid); S.A = (const char*)(F.ws + WS_YB); S.Bt = (const char*)(wt + WT_BR);
            gm::EpiPlain E{(bf16*)(F.ws + WS_KV)}; pg8::gemm_phase(F.lds, S, E, F.tid); GRID_BAR(); }
#endif
        const bool split = !lastl && gridDim.x == 256 && MK_N_LAUNCHES == 1;
        if (PHON(6) && IN(pb + 4)) for (int rep_ = NREP(6); rep_ > 0; --rep_) { FRESH(); F.wr = (rep_ == 1) ? wr_true : WR_DRY; if (NREP(6) > 1) GRID_BAR();
            gm::SchedPlain<48, 3072> S; S.init(split ? 128 : nM2, 4, F.G, F.bid); S.A = (const char*)(F.ws + WS_YB); S.Bt = (const char*)(wt + WT_BR);
            gm::EpiMerge E{F.ws + WS_GT, F_X(F)}; pg8::gemm_phase(F.lds, S, E, F.tid);
        } SEAM(pb + 4);
        if (IN(pb + 5)) { FRESH(); F.wr = wr_true;
            const bool cgrp = split && F.bid < 32;
            if (cgrp) {
                gm::SchedPlain<48, 3072, gm::OrderSub> S; S.init(8, 4, 32, F.bid, 128, true); S.A = (const char*)(F.ws + WS_YB); S.Bt = (const char*)(wt + WT_BR);
                gm::EpiMerge E{F.ws + WS_GT, F_X(F)}; pg8::gemm_phase(F.lds, S, E, F.tid);
                SUB_BAR(); FRESH();
            }
            {
                gm::SchedPlain<16, 1024, gm::OrderSub> S; S.init(split ? (cgrp ? 8 : 128) : nM2, 4, split ? (cgrp ? 32 : 224) : F.G, split && !cgrp ? F.bid - 32 : F.bid, cgrp ? 128 : 0, true);
                S.A = (const char*)(F.ws + WS_X); S.Bt = (const char*)(wt + WT_WO);
                gm::EpiWo E{F.out, F_HC(F), F_MOD(F) + (size_t)l * 9 * 6144, F.wr, l == 0 ? (const float*)FIN(I_X) : (const float*)F.out, l == 0 ? (const float*)FIN(I_CTX) : (const float*)F_HC(F)}; pg8::gemm_phase(F.lds, S, E, F.tid);
            }
        }
        if (split) { if (IN(pb + 5) && IN(pb + 6)) SUB_BAR(); } else SEAM(pb + 5);
        if (PHON(8) && IN(pb + 6)) for (int rep_ = NREP(8); rep_ > 0; --rep_) { FRESH(); F.wr = (rep_ == 1) ? wr_true : WR_DRY; if (NREP(8) > 1) GRID_BAR();
            const bool cgrp = split && F.bid < 32;
            const int row0 = cgrp ? NLAT : 0, row1 = split && !cgrp ? NLAT : ntok, gc = split && !cgrp ? F.bid - 32 : F.bid, gn = split ? (cgrp ? 32 : 224) : F.G;
            if (!(rep_ > 1 && PROBE_SUB == 2)) ph_rows_v(F, l, row0, row1, gc * 8 + F.wave, gn * 8);
            if (!(rep_ > 1 && PROBE_SUB == 1)) ph_router(F, l, row0 / 128, row1 / 128, gc, gn);
        } SEAM(pb + 6);
        if (PHON(9) && IN(pb + 7)) for (int rep_ = NREP(9); rep_ > 0; --rep_) { FRESH(); F.wr = (rep_ == 1) ? wr_true : WR_DRY; if (NREP(9) > 1) GRID_BAR();
            volatile LAS int* tileoff; volatile LAS int* cntl; moe_tables(F, l, tileoff, cntl);
            gm::SchedMoe<16, true> S; S.tileoff = tileoff; S.cnt = cntl; S.G = F.G; S.c = F.bid; S.nunits = tileoff[32] * 4; S.wsbase = (const char*)F.ws; S.rowtok = (const int*)(F.ws + WS_ROWTOK);
            S.A = nullptr; S.Bt = (const char*)(wt + WT_GU);
            gm::EpiGU E{(bf16*)(F.ws + WS_HROWS)}; pg8::gemm_phase(F.lds, S, E, F.tid);
        } SEAM(pb + 7);
        if (PHON(10) && IN(pb + 8)) for (int rep_ = NREP(10); rep_ > 0; --rep_) { FRESH(); F.wr = (rep_ == 1) ? wr_true : WR_DRY; if (NREP(10) > 1) GRID_BAR();
            volatile LAS int* tileoff; volatile LAS int* cntl; moe_tables(F, l, tileoff, cntl);
            gm::SchedMoe<8, false> S; S.tileoff = tileoff; S.cnt = cntl; S.G = F.G; S.c = F.bid; S.nunits = tileoff[32] * 4; S.wsbase = (const char*)F.ws; S.rowtok = nullptr;
            S.A = (const char*)(F.ws + WS_HROWS); S.Bt = (const char*)(wt + WT_DN);
            gm::EpiDN E{(bf16*)(F.ws + WS_YROWS)}; pg8::gemm_phase(F.lds, S, E, F.tid);
        } SEAM(pb + 8);
        if (PHON(11) && IN(pb + 9)) for (int rep_ = NREP(11); rep_ > 0; --rep_) { FRESH(); F.wr = (rep_ == 1) ? wr_true : WR_DRY; if (NREP(11) > 1) GRID_BAR();
            if (!(rep_ > 1 && PROBE_SUB == 2)) ph_combine(F, l, ntok);
            if (!lastl && !(rep_ > 1 && PROBE_SUB == 1)) ph_convert(F, l + 1);
        } if (!lastl) SEAM(pb + 9);
    }
#undef IN
#undef SEAM
}

extern "C" void kernel_launch(void* const* d_in, const int* in_sizes, int n_in, void* d_out, int out_size, void* d_ws, size_t ws_size, hipStream_t stream) {
    static int grid = 0;
    if (grid == 0) {
        if (n_in != 30 || out_size != NLAT * D || ws_size < WS_END) { fprintf(stderr, "kernel_launch: unexpected shapes (n_in %d out %d ws %zu, need %zu)\n", n_in, out_size, ws_size, (size_t)WS_END); grid = -1; return; }
        int dev = 0, cus = 0;
        if (hipGetDevice(&dev) != hipSuccess || hipDeviceGetAttribute(&cus, hipDeviceAttributeMultiprocessorCount, dev) != hipSuccess) { grid = -1; return; }
        if (hipFuncSetAttribute((const void*)fwd_kernel, hipFuncAttributeMaxDynamicSharedMemorySize, LDS_BYTES) != hipSuccess) { fprintf(stderr, "kernel_launch: hipFuncSetAttribute failed\n"); grid = -1; return; }
        int per_cu = 0;
        if (hipOccupancyMaxActiveBlocksPerMultiprocessor(&per_cu, (const void*)fwd_kernel, 512, LDS_BYTES) != hipSuccess || per_cu < 1) { fprintf(stderr, "kernel_launch: occupancy query says %d\n", per_cu); }
        (void)hipGetLastError();
        grid = cus;
    }
    if (grid < 0) return;
    (void)hipMemsetAsync((char*)d_ws + WS_CTL, 0, CTL_BYTES, stream);
#ifdef DIAG_ZERO_GT
    (void)hipMemsetAsync((char*)d_ws + WS_GT, 0x3f, (size_t)204 * MiB, stream);
#endif
    Args a{};
    for (int i = 0; i < 30; ++i) a.in[i] = (const float*)d_in[i];
    a.out = (float*)d_out; a.ws = (unsigned char*)d_ws;
#if MK_N_LAUNCHES == 1
    a.ph_lo = 0; a.ph_hi = N_PHASES;
    hipLaunchKernelGGL(fwd_kernel, dim3(grid), dim3(512), LDS_BYTES, stream, a);
#else
    for (int p = 0; p < N_PHASES; ++p) { a.ph_lo = p; a.ph_hi = p + 1; hipLaunchKernelGGL(fwd_kernel, dim3(grid), dim3(512), LDS_BYTES, stream, a); }
#endif
}
```
